# Optimizing an MI355X kernel written in HIP

```python
import math
import jax, jax.numpy as jnp
from jax import lax
import numpy as np

D_MODEL = 1024
BATCH = 32
SEQ = 2048
DEPTH = 2

GRID_W = 64
CTX_LEN = 256
Q_BLOCK = 128
EPS = 1e-6
ROPE_BASE = 10000.0
N_MOD = 6

SC_WIDTH = D_MODEL // 2
SC_IN = 3 * SC_WIDTH
SC_KERNEL = 3
MLA_V = 128
MLA_NOPE = 128
MLA_ROPE = 64
MLA_HEADS = (D_MODEL - SC_WIDTH) // MLA_V
MLA_Q_RANK = 3 * D_MODEL // 8
MLA_KV_RANK = D_MODEL // 4
EVEN_IN = SC_IN + MLA_Q_RANK + MLA_KV_RANK + MLA_ROPE
MLA_SCALE = (MLA_NOPE + MLA_ROPE) ** -0.5
DIFF_WIDTH = 3 * D_MODEL // 4
DIFF_HEAD = 64
DIFF_HEADS = DIFF_WIDTH // (2 * DIFF_HEAD)
DIFF_SCALE = DIFF_HEAD ** -0.5
FNET_WIDTH = D_MODEL - DIFF_WIDTH
FNET_GROUPS = 4
FNET_GROUP_DIM = FNET_WIDTH // FNET_GROUPS
ODD_IN = 3 * DIFF_WIDTH + FNET_WIDTH
D_FF = ((8 * D_MODEL // 3 + 127) // 128) * 128
N_EXPERTS = 8
TOP_K = 2

kernel_name = 'hybrid_diffusion_conv_mla_diffattn_fnet_moe'


def _rms_norm(x, g):
    xf = x.astype(jnp.float32)
    y = xf * lax.rsqrt(jnp.mean(xf * xf, axis=-1, keepdims=True) + EPS)
    return (y * g.astype(jnp.float32)).astype(x.dtype)


def _ada(cond, w, b):
    m = (jax.nn.silu(cond) @ w + b)[:, None, :]
    return jnp.split(m, N_MOD, axis=-1)


def _modulate(h, shift, scale):
    return h * (1 + scale) + shift


def _axial_rope(rows, rot_dim):
    row = jnp.repeat(jnp.arange(rows, dtype=jnp.float32), GRID_W)
    col = jnp.tile(jnp.arange(GRID_W, dtype=jnp.float32), rows)
    n_freq = rot_dim // 4
    inv = ROPE_BASE ** (-jnp.arange(n_freq, dtype=jnp.float32) / n_freq)
    ang = jnp.concatenate([row[:, None] * inv, col[:, None] * inv], axis=-1)
    return jnp.cos(ang), jnp.sin(ang)


def _apply_rope(x, rope):
    cos, sin = rope
    shape = (1, x.shape[1]) + (1,) * (x.ndim - 3) + (cos.shape[-1],)
    cos, sin = cos.reshape(shape), sin.reshape(shape)
    x1, x2 = jnp.split(x.astype(jnp.float32), 2, axis=-1)
    return jnp.concatenate([x1 * cos - x2 * sin, x1 * sin + x2 * cos], axis=-1).astype(x.dtype)


def _map_query_blocks(fn, q):
    B, T = q.shape[:2]
    nb = T // Q_BLOCK
    qb = jnp.moveaxis(q.reshape((B, nb, Q_BLOCK) + q.shape[2:]), 1, 0)
    out = lax.map(fn, qb)
    return jnp.moveaxis(out, 0, 1).reshape((B, T) + out.shape[3:])


def _swiglu(h, wg, wu, wd):
    return (jax.nn.silu(h @ wg) * (h @ wu)) @ wd


def _moe(h, router_w, w_gate, w_up, w_down):
    logits = (h @ router_w).astype(jnp.float32)
    top_v, top_i = lax.top_k(logits, TOP_K)
    top_w = jax.nn.softmax(top_v, axis=-1)
    gates = jnp.einsum('btk,btke->bte', top_w, jax.nn.one_hot(top_i, N_EXPERTS, dtype=jnp.float32)).astype(h.dtype)
    out = jnp.zeros_like(h)
    for e in range(N_EXPERTS):
        out = out + gates[..., e:e + 1] * _swiglu(h, w_gate[e], w_up[e], w_down[e])
    return out


def _short_conv(z, conv_w):
    b_gate, c_gate, u = jnp.split(z, 3, axis=-1)
    u = c_gate * u
    conv = lax.conv_general_dilated(u, conv_w[:, None, :], window_strides=(1,), padding=((SC_KERNEL // 2, SC_KERNEL // 2),),
                                    dimension_numbers=('NWC', 'WIO', 'NWC'), feature_group_count=SC_WIDTH)
    return b_gate * conv


def _mla_q(zq, q_norm_g, w_uq, rope):
    B, T = zq.shape[:2]
    q = (_rms_norm(zq, q_norm_g) @ w_uq).reshape(B, T, MLA_HEADS, MLA_NOPE + MLA_ROPE)
    q_nope, q_pe = q[..., :MLA_NOPE], q[..., MLA_NOPE:]
    if rope is not None:
        q_pe = _apply_rope(q_pe, rope)
    return jnp.concatenate([q_nope, q_pe], axis=-1)


def _mla_kv(zkv, kv_norm_g, w_ukv, rope):
    B, T = zkv.shape[:2]
    kv = (_rms_norm(zkv[..., :MLA_KV_RANK], kv_norm_g) @ w_ukv).reshape(B, T, MLA_HEADS, MLA_NOPE + MLA_V)
    k_nope, v = kv[..., :MLA_NOPE], kv[..., MLA_NOPE:]
    k_pe = zkv[..., MLA_KV_RANK:][:, :, None, :]
    if rope is not None:
        k_pe = _apply_rope(k_pe, rope)
    k = jnp.concatenate([k_nope, jnp.broadcast_to(k_pe, (B, T, MLA_HEADS, MLA_ROPE))], axis=-1)
    return k, v


def _mla_block(qb, k, v):
    s = jnp.einsum('bqhd,bkhd->bhqk', qb, k).astype(jnp.float32) * MLA_SCALE
    p = jax.nn.softmax(s, axis=-1).astype(v.dtype)
    return jnp.einsum('bhqk,bkhd->bqhd', p, v)


def _even_mixer(h, hc, rope, w_in, conv_w, q_norm_g, w_uq, kv_norm_g, w_ukv, w_out, need_ctx):
    B, T, _ = h.shape
    z = h @ w_in
    a_lat = _short_conv(z[..., :SC_IN], conv_w)
    q_lat = _mla_q(z[..., SC_IN:SC_IN + MLA_Q_RANK], q_norm_g, w_uq, rope)
    k_lat, v_lat = _mla_kv(z[..., SC_IN + MLA_Q_RANK:], kv_norm_g, w_ukv, rope)
    if need_ctx:
        zc = hc @ w_in
        k_ctx, v_ctx = _mla_kv(zc[..., SC_IN + MLA_Q_RANK:], kv_norm_g, w_ukv, None)
    else:
        k_ctx, v_ctx = _mla_kv(hc @ w_in[:, SC_IN + MLA_Q_RANK:], kv_norm_g, w_ukv, None)
    k_all = jnp.concatenate([k_ctx, k_lat], axis=1)
    v_all = jnp.concatenate([v_ctx, v_lat], axis=1)
    b_lat = _map_query_blocks(lambda qb: _mla_block(qb, k_all, v_all), q_lat)
    y = jnp.concatenate([a_lat, b_lat.reshape(B, T, -1)], axis=-1) @ w_out
    yc = None
    if need_ctx:
        L = hc.shape[1]
        a_ctx = _short_conv(zc[..., :SC_IN], conv_w)
        q_ctx = _mla_q(zc[..., SC_IN:SC_IN + MLA_Q_RANK], q_norm_g, w_uq, None)
        b_ctx = _map_query_blocks(lambda qb: _mla_block(qb, k_ctx, v_ctx), q_ctx)
        yc = jnp.concatenate([a_ctx, b_ctx.reshape(hc.shape[0], L, -1)], axis=-1) @ w_out
    return y, yc


def _diff_q(zq, rope):
    B, T = zq.shape[:2]
    q = zq.reshape(B, T, DIFF_HEADS, 2, DIFF_HEAD)
    return q if rope is None else _apply_rope(q, rope)


def _diff_kv(zkv, rope):
    B, T = zkv.shape[:2]
    k = zkv[..., :DIFF_WIDTH].reshape(B, T, DIFF_HEADS, 2, DIFF_HEAD)
    if rope is not None:
        k = _apply_rope(k, rope)
    v = zkv[..., DIFF_WIDTH:].reshape(B, T, DIFF_HEADS, 2 * DIFF_HEAD)
    return k, v


def _diff_block(qb, k, v, lam, subln_g, lam_init):
    s = jnp.einsum('bqhmd,bkhmd->bhmqk', qb, k).astype(jnp.float32) * DIFF_SCALE
    p = jax.nn.softmax(s, axis=-1)
    a = (p[:, :, 0] - lam * p[:, :, 1]).astype(v.dtype)
    o = jnp.einsum('bhqk,bkhe->bqhe', a, v)
    return _rms_norm(o, subln_g) * (1.0 - lam_init)


def _fourier(f):
    B, T, _ = f.shape
    g = f.reshape(B, T, FNET_GROUPS, FNET_GROUP_DIM).astype(jnp.float32)
    y = jnp.fft.fftn(g, axes=(1, 3), norm='ortho').real
    return y.reshape(B, T, FNET_WIDTH).astype(f.dtype)


def _odd_mixer(h, hc, rope, w_in, lam_p, subln_g, w_out, lam_init, need_ctx):
    B, T, _ = h.shape
    lp = lam_p.astype(jnp.float32)
    lam = jnp.exp(jnp.sum(lp[0] * lp[1])) - jnp.exp(jnp.sum(lp[2] * lp[3])) + lam_init
    z = h @ w_in
    q_lat = _diff_q(z[..., :DIFF_WIDTH], rope)
    k_lat, v_lat = _diff_kv(z[..., DIFF_WIDTH:3 * DIFF_WIDTH], rope)
    if need_ctx:
        zc = hc @ w_in
        k_ctx, v_ctx = _diff_kv(zc[..., DIFF_WIDTH:3 * DIFF_WIDTH], None)
    else:
        k_ctx, v_ctx = _diff_kv(hc @ w_in[:, DIFF_WIDTH:3 * DIFF_WIDTH], None)
    k_all = jnp.concatenate([k_ctx, k_lat], axis=1)
    v_all = jnp.concatenate([v_ctx, v_lat], axis=1)
    c_lat = _map_query_blocks(lambda qb: _diff_block(qb, k_all, v_all, lam, subln_g, lam_init), q_lat)
    d_lat = _fourier(z[..., 3 * DIFF_WIDTH:])
    y = jnp.concatenate([c_lat.reshape(B, T, DIFF_WIDTH), d_lat], axis=-1) @ w_out
    yc = None
    if need_ctx:
        L = hc.shape[1]
        q_ctx = _diff_q(zc[..., :DIFF_WIDTH], None)
        c_ctx_out = _map_query_blocks(lambda qb: _diff_block(qb, k_ctx, v_ctx, lam, subln_g, lam_init), q_ctx)
        d_ctx = _fourier(zc[..., 3 * DIFF_WIDTH:])
        yc = jnp.concatenate([c_ctx_out.reshape(hc.shape[0], L, DIFF_WIDTH), d_ctx], axis=-1) @ w_out
    return y, yc


def setup_inputs(seed: int = 0) -> dict:
    key = jax.random.key(seed)
    ks = iter(list(jax.random.split(key, 32)))
    ne, no = (DEPTH + 1) // 2, DEPTH // 2
    D, F, E = D_MODEL, D_FF, N_EXPERTS

    def nrm(shape, std):
        return std * jax.random.normal(next(ks), shape, jnp.float32)

    def gain(shape):
        return 1.0 + nrm(shape, 0.02)

    return {
        'x': nrm((BATCH, SEQ, D), 1.0),
        'c': nrm((BATCH, D), 1.0),
        'ctx': nrm((BATCH, CTX_LEN, D), 1.0),
        'c_ctx': nrm((D,), 1.0),
        'ev_mod_w': nrm((ne, D, N_MOD * D), 0.5 * D ** -0.5),
        'ev_mod_b': nrm((ne, N_MOD * D), 0.02),
        'ev_norm_g': gain((ne, 4, D)),
        'ev_w_in': nrm((ne, D, EVEN_IN), D ** -0.5),
        'ev_conv_w': nrm((ne, SC_KERNEL, SC_WIDTH), SC_KERNEL ** -0.5),
        'ev_q_norm_g': gain((ne, MLA_Q_RANK)),
        'ev_w_uq': nrm((ne, MLA_Q_RANK, MLA_HEADS * (MLA_NOPE + MLA_ROPE)), MLA_Q_RANK ** -0.5),
        'ev_kv_norm_g': gain((ne, MLA_KV_RANK)),
        'ev_w_ukv': nrm((ne, MLA_KV_RANK, MLA_HEADS * (MLA_NOPE + MLA_V)), MLA_KV_RANK ** -0.5),
        'ev_w_out': nrm((ne, D, D), D ** -0.5),
        'ev_ffn_gate': nrm((ne, D, F), D ** -0.5),
        'ev_ffn_up': nrm((ne, D, F), D ** -0.5),
        'ev_ffn_down': nrm((ne, F, D), F ** -0.5),
        'od_mod_w': nrm((no, D, N_MOD * D), 0.5 * D ** -0.5),
        'od_mod_b': nrm((no, N_MOD * D), 0.02),
        'od_norm_g': gain((no, 4, D)),
        'od_w_in': nrm((no, D, ODD_IN), D ** -0.5),
        'od_lambda': nrm((no, 4, DIFF_HEAD), 0.1),
        'od_subln_g': gain((no, 2 * DIFF_HEAD)),
        'od_w_out': nrm((no, D, D), D ** -0.5),
        'od_router': nrm((no, D, E), D ** -0.5),
        'od_exp_gate': nrm((no, E, D, F), D ** -0.5),
        'od_exp_up': nrm((no, E, D, F), D ** -0.5),
        'od_exp_down': nrm((no, E, F, D), F ** -0.5),
    }


def reference(x, c, ctx, c_ctx, ev_mod_w, ev_mod_b, ev_norm_g, ev_w_in, ev_conv_w, ev_q_norm_g, ev_w_uq,
              ev_kv_norm_g, ev_w_ukv, ev_w_out, ev_ffn_gate, ev_ffn_up, ev_ffn_down, od_mod_w, od_mod_b,
              od_norm_g, od_w_in, od_lambda, od_subln_g, od_w_out, od_router, od_exp_gate, od_exp_up, od_exp_down):
    rows = x.shape[1] // GRID_W
    rope_mla = _axial_rope(rows, MLA_ROPE)
    rope_diff = _axial_rope(rows, DIFF_HEAD)
    c_ctx_row = c_ctx[None, :]
    for i in range(DEPTH):
        j = i // 2
        even = i % 2 == 0
        need_ctx = i < DEPTH - 1
        if even:
            mod_w, mod_b, norm_g = ev_mod_w[j], ev_mod_b[j], ev_norm_g[j]
            ffn = lambda t: _swiglu(t, ev_ffn_gate[j], ev_ffn_up[j], ev_ffn_down[j])
        else:
            mod_w, mod_b, norm_g = od_mod_w[j], od_mod_b[j], od_norm_g[j]
            ffn = lambda t: _moe(t, od_router[j], od_exp_gate[j], od_exp_up[j], od_exp_down[j])
        sh1, sc1, g1, sh2, sc2, g2 = _ada(c, mod_w, mod_b)
        csh1, csc1, cg1, csh2, csc2, cg2 = _ada(c_ctx_row, mod_w, mod_b)
        h = _modulate(_rms_norm(x, norm_g[0]), sh1, sc1)
        hc = _modulate(_rms_norm(ctx, norm_g[0]), csh1, csc1)
        if even:
            y, yc = _even_mixer(h, hc, rope_mla, ev_w_in[j], ev_conv_w[j], ev_q_norm_g[j], ev_w_uq[j],
                                ev_kv_norm_g[j], ev_w_ukv[j], ev_w_out[j], need_ctx)
        else:
            lam_init = 0.8 - 0.6 * math.exp(-0.3 * i)
            y, yc = _odd_mixer(h, hc, rope_diff, od_w_in[j], od_lambda[j], od_subln_g[j], od_w_out[j],
                               lam_init, need_ctx)
        x = x + g1 * _rms_norm(y, norm_g[1])
        h2 = _modulate(_rms_norm(x, norm_g[2]), sh2, sc2)
        x = x + g2 * _rms_norm(ffn(h2), norm_g[3])
        if need_ctx:
            ctx = ctx + cg1 * _rms_norm(yc, norm_g[1])
            hc2 = _modulate(_rms_norm(ctx, norm_g[2]), csh2, csc2)
            ctx = ctx + cg2 * _rms_norm(ffn(hc2), norm_g[3])
    return x
```

```cpp
#define ONE_LAUNCH 1
#include <hip/hip_runtime.h>
#include <cstdio>
#include <cstdint>
#include <cmath>

#ifndef CFG_NB
#define CFG_NB 32
#endif
namespace cfg {
constexpr int NB = CFG_NB;
constexpr int FULLB = 32;
constexpr int D = 1024, T = 2048, L = 256, S = T + L;
constexpr int GW = 64;
constexpr float EPS = 1e-6f;
constexpr int SCW = 512, SCIN = 1536;
constexpr int MLA_H = 4, MLA_NOPE = 128, MLA_ROPE = 64, MLA_V = 128, MLA_QK = 192, QRANK = 384, KVRANK = 256;
constexpr int EVEN_IN = 2240;
constexpr int DIFFW = 768, DIFF_H = 6, DIFF_HD = 64;
constexpr int FNW = 256, FNG = 4, FNGD = 64, ODD_IN = 2560;
constexpr int FF = 2816, NE = 8;
constexpr float LAM_INIT = 0.35550906759096944f;
}
namespace fp {
using namespace cfg;
#define LAS __attribute__((address_space(3)))
#define GAS __attribute__((address_space(1)))
typedef unsigned short bf16_t;
typedef short bf16x8 __attribute__((ext_vector_type(8)));
typedef short s16x4 __attribute__((ext_vector_type(4)));
typedef float f32x4 __attribute__((ext_vector_type(4)));
typedef float f32x2 __attribute__((ext_vector_type(2)));
typedef float f32x16 __attribute__((ext_vector_type(16)));
typedef unsigned u32x4 __attribute__((ext_vector_type(4)));
typedef unsigned u32x2 __attribute__((ext_vector_type(2)));

__device__ __forceinline__ unsigned cvt_pk_bf16(float lo, float hi) { unsigned r; asm volatile("v_cvt_pk_bf16_f32 %0, %1, %2" : "=v"(r) : "v"(lo), "v"(hi)); return r; }
__device__ __forceinline__ float bf2f(unsigned short b) { return __uint_as_float(((unsigned)b) << 16); }
__device__ __forceinline__ float bflo(unsigned w) { return __uint_as_float(w << 16); }
__device__ __forceinline__ float bfhi(unsigned w) { return __uint_as_float(w & 0xffff0000u); }
__device__ __forceinline__ unsigned short f2bf(float f) { return (unsigned short)(cvt_pk_bf16(f, 0.f) & 0xffffu); }
__device__ __forceinline__ float wave_sum(float v) {
#pragma unroll
    for (int o = 1; o < 64; o <<= 1) v += __shfl_xor(v, o);
    return v;
}
__device__ __forceinline__ float silu_f(float v) { return v / (1.f + __expf(-v)); }

#define XB_TMO      128
#define XB_XCNT(j)  (256  + 64 * (j))
#define XB_XSUB(j)  (1280 + 64 * (j))
#define XB_XGEN(j)  (2304 + 64 * (j))
#define XB_TOP      3328
#define XB_TOPGEN   3392
#define XCD_BAR_WORDS 3456
#define XB_SPIN_CAP (1u << 18)
__device__ __forceinline__ unsigned xb_ld(unsigned* p)              { return __hip_atomic_load(p, __ATOMIC_RELAXED, __HIP_MEMORY_SCOPE_AGENT); }
__device__ __forceinline__ unsigned xb_add(unsigned* p, unsigned v) { return __hip_atomic_fetch_add(p, v, __ATOMIC_RELAXED, __HIP_MEMORY_SCOPE_AGENT); }
__device__ __forceinline__ unsigned xb_xcc_id() { return (unsigned)__builtin_amdgcn_s_getreg((3 << 11) | 20) & 0xFu; }
#define XB_SPIN(cond, bar) do { unsigned _sp = 0; while (cond) { __builtin_amdgcn_s_sleep(1); \
    if ((++_sp & 255u) == 0u) { if (xb_ld(&(bar)[XB_TMO])) break; if (_sp > XB_SPIN_CAP) { atomicAdd(&(bar)[XB_TMO], 1u); break; } } } } while (0)
struct XcdBarrier { unsigned* bar; unsigned x; volatile LAS unsigned* st; };
__device__ __forceinline__ XcdBarrier xcd_barrier_post(unsigned* bar, volatile LAS unsigned* st) {
    XcdBarrier b; b.bar = bar; b.x = xb_xcc_id(); b.st = st;
    if (threadIdx.x == 0) (void)xb_add(&bar[XB_XCNT(b.x)], 1u);
    return b;
}
__device__ __forceinline__ void xcd_barrier_complete(unsigned* bar, unsigned x, unsigned& nloc, unsigned& nx) {
    const unsigned G = gridDim.x * gridDim.y * gridDim.z;
    unsigned sum, cnt, mine, sp = 0u;
    for (;;) {
        sum = 0u; cnt = 0u; mine = 0u;
#pragma unroll
        for (unsigned j = 0; j < 16; ++j) { const unsigned c = xb_ld(&bar[XB_XCNT(j)]); sum += c; cnt += (c > 0u) ? 1u : 0u; mine = (j == x) ? c : mine; }
        if (sum == G) break;
        __builtin_amdgcn_s_sleep(1);
        if ((++sp & 255u) == 0u) { if (xb_ld(&bar[XB_TMO])) break; if (sp > XB_SPIN_CAP) { atomicAdd(&bar[XB_TMO], 1u); break; } }
    }
    nloc = mine > 0u ? mine : 1u; nx = cnt > 0u ? cnt : 1u;
}
__device__ __forceinline__ void xcd_barrier(const XcdBarrier& b) {
    asm volatile("s_waitcnt vmcnt(0)" ::: "memory");
    __syncthreads();
    if (threadIdx.x == 0) {
        unsigned* bar = b.bar;
        __builtin_amdgcn_s_waitcnt(0);
        unsigned nloc = b.st[0], nx = b.st[1];
        if (nloc == 0u) { xcd_barrier_complete(bar, b.x, nloc, nx); b.st[0] = nloc; b.st[1] = nx; }
        const unsigned old = xb_add(&bar[XB_XSUB(b.x)], 1u);
        const unsigned gen = old / nloc;
        if (old + 1u == (gen + 1u) * nloc) {
            __builtin_amdgcn_fence(__ATOMIC_RELEASE, "agent");
            asm volatile("s_waitcnt vmcnt(0)" ::: "memory");
            const unsigned og = xb_add(&bar[XB_TOP], 1u);
            const unsigned tg = og / nx;
            if (og + 1u == (tg + 1u) * nx) xb_add(&bar[XB_TOPGEN], 1u);
            else XB_SPIN(xb_ld(&bar[XB_TOPGEN]) == tg, bar);
            __builtin_amdgcn_fence(__ATOMIC_ACQUIRE, "agent");
            xb_add(&bar[XB_XGEN(b.x)], 1u);
            asm volatile("s_waitcnt vmcnt(0)" ::: "memory");
        } else {
            XB_SPIN(xb_ld(&bar[XB_XGEN(b.x)]) == gen, bar);
            __builtin_amdgcn_fence(__ATOMIC_ACQUIRE, "agent");
            asm volatile("s_waitcnt vmcnt(0)" ::: "memory");
        }
    }
    __syncthreads();
}

namespace pg8 {
constexpr int BM = 256, BK = 64, HALF = 128, HTB = HALF * BK * 2, STAGE_BYTES = 8 * HTB, NXCD = 8, WGM = 8;
__host__ __device__ __forceinline__ int lds_byte(int r, int c) { const int st = (r >> 4) * 2 + (c >> 5), rr = r & 15, cc = c & 31, ob = rr * 64 + cc * 2; return st * 1024 + (ob ^ (((ob >> 9) & 1) << 5)); }
__host__ __device__ __forceinline__ void stage_rc(int b, int& R, int& C) { const int st = b / 1024, sb = b % 1024, swz = sb ^ (((sb >> 9) & 1) << 5); R = (st >> 1) * 16 + swz / 64; C = (st & 1) * 32 + (swz % 64) / 2; }
__host__ __device__ __forceinline__ int perm32(int rho) { const int n = rho >> 4, i = rho & 15; return 8 * (i >> 2) + 4 * n + (i & 3); }
struct Unit { const char* a; const char* b; int pm, pn; };
struct Gemm { int lda, ldb, K; };
__device__ __forceinline__ bool tile_of(int i, int G, int c, int nM, int nN, int& pm, int& pn) {
    const int nwg = nM * nN; const long Lq = (long)i * G + c; if (Lq >= nwg) return false;
    int wgid = (int)Lq; { const int q = nwg / NXCD, r = nwg % NXCD, xcd = wgid % NXCD, off = wgid / NXCD; wgid = (xcd < r ? xcd * (q + 1) : r * (q + 1) + (xcd - r) * q) + off; }
    const int nig = WGM * nN, gid = wgid / nig, fm = gid * WGM, gsz = (nM - fm) < WGM ? (nM - fm) : WGM;
    pm = fm + ((wgid % nig) % gsz); pn = (wgid % nig) / gsz; return true;
}
template <class Epi, class Sched>
__device__ __forceinline__ void gemm_phase(LAS unsigned char* lds, const Gemm g, const Sched& S, const Epi& E) {
    const int tid = threadIdx.x, wid = __builtin_amdgcn_readfirstlane(tid >> 6), lane = tid & 63, wr = wid >> 2, wc = wid & 3, fr = lane & 15, fq = lane >> 4;
    const int K = g.K, nt = K / BK;
    unsigned voffA[2], voffB[2];
#pragma unroll
    for (int i = 0; i < 2; ++i) { int R, C; stage_rc(tid * 16 + i * 8192, R, C); const int Rb = Epi::PERM ? ((R & ~31) + perm32(R & 31)) : R;
        voffA[i] = (unsigned)(R * g.lda + C) * 2u; voffB[i] = (unsigned)(Rb * g.ldb + C) * 2u; }
    const size_t kstep = (size_t)(BK * 2);
    const size_t hstepA = (size_t)HALF * g.lda * 2, hstepB = (size_t)HALF * g.ldb * 2;
    const unsigned ldsw = (unsigned)wid * 1024u;
    const int aoff = lds_byte(wr * 64 + fr, fq * 8), boff = lds_byte(wc * 32 + fr, fq * 8);
#define PG8_SA(b, h) (((b) * 2 + (h)) * HTB)
#define PG8_SB(b, h) ((4 + (b) * 2 + (h)) * HTB)
#define PG8_STAGE(bufoff, gbase, voff) do { _Pragma("unroll") for (int _i = 0; _i < 2; ++_i) \
        __builtin_amdgcn_global_load_lds((const unsigned*)((const char*)(gbase) + (voff)[_i]), (LAS unsigned*)(lds + (bufoff) + ldsw + _i * 8192), 16, 0, 0); } while (0)
#define PG8_LDA(dst, b, h) do { _Pragma("unroll") for (int m = 0; m < 4; ++m) _Pragma("unroll") for (int k = 0; k < 2; ++k) dst[m][k] = *(const LAS bf16x8*)(lds + PG8_SA(b, h) + aoff + m * 2048 + k * 1024); } while (0)
#define PG8_LDB(dst, b, h) do { _Pragma("unroll") for (int n = 0; n < 2; ++n) _Pragma("unroll") for (int k = 0; k < 2; ++k) dst[n][k] = *(const LAS bf16x8*)(lds + PG8_SB(b, h) + boff + n * 2048 + k * 1024); } while (0)
#define PG8_MMA(ai, bj, At, Bt) do { __builtin_amdgcn_s_setprio(1); _Pragma("unroll") for (int m = 0; m < 4; ++m) _Pragma("unroll") for (int n = 0; n < 2; ++n) _Pragma("unroll") for (int k = 0; k < 2; ++k) \
        acc[ai][bj][m][n] = __builtin_amdgcn_mfma_f32_16x16x32_bf16(Bt[n][k], At[m][k], acc[ai][bj][m][n], 0, 0, 0); __builtin_amdgcn_s_setprio(0); } while (0)
#define PG8_WAIT_V(n) asm volatile("s_waitcnt vmcnt(" #n ")" ::: "memory")
#define PG8_WAIT_L(n) asm volatile("s_waitcnt lgkmcnt(" #n ")" ::: "memory")
#define PG8_BAR __builtin_amdgcn_s_barrier()
#define PG8_SCHED __builtin_amdgcn_sched_barrier(0)
    Unit cur, nxt; int ui = 0;
    if (!S.next(0, cur)) return;
    f32x4 acc[2][2][4][2];
#pragma unroll
    for (int a = 0; a < 2; ++a)
#pragma unroll
        for (int b = 0; b < 2; ++b)
#pragma unroll
            for (int m = 0; m < 4; ++m)
#pragma unroll
                for (int n = 0; n < 2; ++n) acc[a][b][m][n] = (f32x4){0.f, 0.f, 0.f, 0.f};
    bf16x8 At[4][2], B0[2][2], B1[2][2];
    const char* cA = cur.a; const char* cB = cur.b;
    PG8_STAGE(PG8_SB(0, 0), cB, voffB); PG8_STAGE(PG8_SA(0, 0), cA, voffA); PG8_STAGE(PG8_SB(0, 1), cB + hstepB, voffB); PG8_STAGE(PG8_SA(0, 1), cA + hstepA, voffA);
    if (wr == 1) PG8_BAR;
    PG8_WAIT_V(4); PG8_BAR;
    PG8_STAGE(PG8_SB(1, 0), cB + kstep, voffB); PG8_STAGE(PG8_SA(1, 0), cA + kstep, voffA); PG8_STAGE(PG8_SB(1, 1), cB + hstepB + kstep, voffB);
    PG8_WAIT_V(6); PG8_BAR;
    for (;;) {
        const bool has_next = S.next(ui + 1, nxt);
        const char* nA = has_next ? nxt.a : cA; const char* nB = has_next ? nxt.b : cB;
#pragma unroll 1
        for (int t = 0; t < nt; t += 2) {
            const bool last = (t == nt - 2);
            const char* a1 = cA + (size_t)(t + 1) * kstep;
            const char* a2 = last ? nA : cA + (size_t)(t + 2) * kstep; const char* b2 = last ? nB : cB + (size_t)(t + 2) * kstep;
            const char* a3 = a2 + kstep; const char* b3 = b2 + kstep;
            PG8_LDB(B0, 0, 0); PG8_SCHED; PG8_LDA(At, 0, 0); PG8_STAGE(PG8_SA(1, 1), a1 + hstepA, voffA);
            PG8_WAIT_L(8); PG8_BAR; PG8_WAIT_L(0); PG8_MMA(0, 0, At, B0); PG8_BAR; PG8_SCHED;
            PG8_LDB(B1, 0, 1); PG8_STAGE(PG8_SB(0, 0), b2, voffB);
            PG8_BAR; PG8_WAIT_L(0); PG8_MMA(0, 1, At, B1); PG8_BAR;
            PG8_LDA(At, 0, 1); PG8_STAGE(PG8_SA(0, 0), a2, voffA);
            PG8_BAR; PG8_WAIT_L(0); PG8_MMA(1, 0, At, B0); PG8_BAR; PG8_SCHED;
            PG8_STAGE(PG8_SB(0, 1), b2 + hstepB, voffB);
            PG8_WAIT_V(6); PG8_BAR; PG8_MMA(1, 1, At, B1); PG8_BAR;
            PG8_LDB(B0, 1, 0); PG8_SCHED; PG8_LDA(At, 1, 0); PG8_STAGE(PG8_SA(0, 1), a2 + hstepA, voffA);
            PG8_WAIT_L(8); PG8_BAR; PG8_WAIT_L(0); PG8_MMA(0, 0, At, B0); PG8_BAR; PG8_SCHED;
            PG8_LDB(B1, 1, 1); PG8_STAGE(PG8_SB(1, 0), b3, voffB);
            PG8_BAR; PG8_WAIT_L(0); PG8_MMA(0, 1, At, B1); PG8_BAR;
            PG8_LDA(At, 1, 1); PG8_STAGE(PG8_SA(1, 0), a3, voffA);
            PG8_BAR; PG8_WAIT_L(0); PG8_MMA(1, 0, At, B0); PG8_BAR; PG8_SCHED;
            PG8_STAGE(PG8_SB(1, 1), b3 + hstepB, voffB);
            PG8_WAIT_V(6); PG8_BAR; PG8_MMA(1, 1, At, B1); PG8_BAR;
        }
        E(acc, cur, wr, wc, fr, fq);
        if (!has_next) break;
#pragma unroll
        for (int a = 0; a < 2; ++a)
#pragma unroll
            for (int b = 0; b < 2; ++b)
#pragma unroll
                for (int m = 0; m < 4; ++m)
#pragma unroll
                    for (int n = 0; n < 2; ++n) acc[a][b][m][n] = (f32x4){0.f, 0.f, 0.f, 0.f};
        cur = nxt; cA = nA; cB = nB; ++ui;
    }
    PG8_WAIT_V(0);
    if (wr == 0) PG8_BAR;
    PG8_BAR;
#undef PG8_SA
#undef PG8_SB
#undef PG8_STAGE
#undef PG8_LDA
#undef PG8_LDB
#undef PG8_MMA
#undef PG8_WAIT_V
#undef PG8_WAIT_L
#undef PG8_BAR
#undef PG8_SCHED
}

struct SchedPlain {
    const char* A; const char* Bt; size_t at, bt; int nM, nN, G, c; bool latM;
    __device__ __forceinline__ void init(const void* A_, int lda, const void* Bt_, int ldb, int nM_, int nN_, bool latM_) {
        A = (const char*)A_; Bt = (const char*)Bt_; at = (size_t)256 * lda * 2; bt = (size_t)256 * ldb * 2; nM = nM_; nN = nN_; G = gridDim.x; c = blockIdx.x; latM = latM_; }
    __device__ __forceinline__ bool next(int i, Unit& u) const {
        int pm, pn; if (!tile_of(i, G, c, nM, nN, pm, pn)) return false;
        if (latM) pm = (pm >> 3) * 9 + 1 + (pm & 7);
        u.pm = pm; u.pn = pn; u.a = A + (size_t)pm * at; u.b = Bt + (size_t)pn * bt; return true; }
};
struct SchedF1 {
    const char* A; const char* H; int nN, G, c;
    __device__ __forceinline__ bool next(int i, Unit& u) const {
        int pm, pn; if (!tile_of(i, G, c, 2, nN, pm, pn)) return false;
        u.pm = pm; u.pn = pn; u.a = A + (size_t)pm * 256 * D * 2; u.b = H + (size_t)((pn >> 3) * 9 + 1 + (pn & 7)) * 256 * D * 2; return true; }
};
struct SchedF2 {
    const char* Dft; const char* GT; int G, c;
    __device__ __forceinline__ bool next(int i, Unit& u) const {
        const int L_ = i * G + c; if (L_ >= NB * 8) return false; const int b = L_ >> 3, kt = L_ & 7;
        u.pm = b * 9 + 1 + kt; u.pn = 0; u.a = Dft + (size_t)kt * 256 * 4096 * 2; u.b = GT + (size_t)b * 256 * 4096 * 2; return true; }
};
struct SchedMoe {
    const char* A; const char* W; size_t at, bt, estride; int t0, nT, nN, G, c; int toff[NE + 1];
    __device__ __forceinline__ bool next(int i, Unit& u) const {
        int pm, pn; if (!tile_of(i, G, c, nT, nN, pm, pn)) return false; pm += t0;
        int e = 0;
#pragma unroll
        for (int j = 1; j < NE; ++j) e += (pm >= toff[j]) ? 1 : 0;
        u.pm = pm; u.pn = pn; u.a = A + (size_t)pm * at; u.b = W + (size_t)e * estride + (size_t)pn * bt; return true; }
};

#define EPI_LOOP_ROWS for (int ai = 0; ai < 2; ++ai) _Pragma("unroll") for (int m = 0; m < 4; ++m)
__device__ __forceinline__ u32x4 pack8(const f32x4 a, const f32x4 b) { u32x4 w; w.x = cvt_pk_bf16(a[0], a[1]); w.y = cvt_pk_bf16(a[2], a[3]); w.z = cvt_pk_bf16(b[0], b[1]); w.w = cvt_pk_bf16(b[2], b[3]); return w; }
struct EpiPlain {
    static constexpr bool PERM = true; bf16_t* O; int ldo;
    __device__ __forceinline__ void operator()(const f32x4 (&acc)[2][2][4][2], const Unit& u, int wr, int wc, int fr, int fq) const {
        const int row0 = u.pm * BM + wr * 64 + fr, col0 = u.pn * BM + wc * 32 + 8 * fq;
#pragma unroll
        EPI_LOOP_ROWS { bf16_t* rowp = O + (size_t)(row0 + ai * HALF + m * 16) * ldo + col0;
#pragma unroll
            for (int bj = 0; bj < 2; ++bj) *(u32x4*)(rowp + bj * HALF) = pack8(acc[ai][bj][m][0], acc[ai][bj][m][1]); }
    }
};
struct EpiSwiglu {
    static constexpr bool PERM = true; bf16_t* O; int ldo;
    __device__ __forceinline__ void operator()(const f32x4 (&acc)[2][2][4][2], const Unit& u, int wr, int wc, int fr, int fq) const {
        const int row0 = u.pm * BM + wr * 64 + fr, col0 = u.pn * 128 + wc * 16 + 4 * fq;
#pragma unroll
        EPI_LOOP_ROWS { bf16_t* rowp = O + (size_t)(row0 + ai * HALF + m * 16) * ldo + col0;
#pragma unroll
            for (int bj = 0; bj < 2; ++bj) { const f32x4 g = acc[ai][bj][m][0], up = acc[ai][bj][m][1]; f32x4 a;
#pragma unroll
                for (int j = 0; j < 4; ++j) a[j] = g[j] * __builtin_amdgcn_rcpf(1.f + __expf(-g[j])) * up[j];
                u32x2 w; w.x = cvt_pk_bf16(a[0], a[1]); w.y = cvt_pk_bf16(a[2], a[3]); *(u32x2*)(rowp + bj * 64) = w; } }
    }
};
struct EpiQ0 {
    static constexpr bool PERM = true; bf16_t* O; const float* rc; const float* rs;
    __device__ __forceinline__ void operator()(const f32x4 (&acc)[2][2][4][2], const Unit& u, int wr, int wc, int fr, int fq) const {
        const int row0 = u.pm * BM + wr * 64 + fr, col0 = u.pn * BM + wc * 32 + 8 * fq; const int pj = u.pm % 9; const bool lat = pj != 0; const int t0 = (pj - 1) * 256 + wr * 64 + fr;
#pragma unroll
        EPI_LOOP_ROWS { const int row = row0 + ai * HALF + m * 16; const int t = t0 + ai * HALF + m * 16; bf16_t* rowp = O + (size_t)row * 768 + col0;
#pragma unroll
            for (int bj = 0; bj < 2; ++bj) { const int cb = col0 + bj * HALF, within = cb % MLA_QK; f32x4 v0 = acc[ai][bj][m][0], v1 = acc[ai][bj][m][1];
                if (lat && within >= MLA_NOPE) { const int f0 = ((within - MLA_NOPE) >> 3) * 4; const f32x4 cs = *(const f32x4*)(rc + t * 32 + f0), sn = *(const f32x4*)(rs + t * 32 + f0);
                    const f32x4 o1 = v0 * cs - v1 * sn, o2 = v0 * sn + v1 * cs; v0 = o1; v1 = o2; }
                *(u32x4*)(rowp + bj * HALF) = pack8(v0, v1); }
            asm volatile("" ::: "memory"); }
    }
};
struct EpiKV0 {
    static constexpr bool PERM = true; bf16_t* Kn; bf16_t* V;
    __device__ __forceinline__ void operator()(const f32x4 (&acc)[2][2][4][2], const Unit& u, int wr, int wc, int fr, int fq) const {
        const int row0 = u.pm * BM + wr * 64 + fr, col0 = u.pn * 128 + wc * 32 + 8 * fq;
#pragma unroll
        EPI_LOOP_ROWS { const size_t ro = (size_t)(row0 + ai * HALF + m * 16) * 512 + col0;
            *(u32x4*)(Kn + ro) = pack8(acc[ai][0][m][0], acc[ai][0][m][1]); *(u32x4*)(V + ro) = pack8(acc[ai][1][m][0], acc[ai][1][m][1]); }
    }
};
struct EpiQKV1 {
    static constexpr bool PERM = true; bf16_t* O; size_t tstride; const float* rc; const float* rs;
    __device__ __forceinline__ void operator()(const f32x4 (&acc)[2][2][4][2], const Unit& u, int wr, int wc, int fr, int fq) const {
        const int which = u.pn / 3; const int row0 = u.pm * BM + wr * 64 + fr, col0 = (u.pn % 3) * BM + wc * 32 + 8 * fq; const int pj = u.pm % 9; const bool rope = (pj != 0) && which < 2;
        const int t0 = (pj - 1) * 256 + wr * 64 + fr; bf16_t* base = O + (size_t)which * tstride;
#pragma unroll
        EPI_LOOP_ROWS { const int row = row0 + ai * HALF + m * 16; const int t = t0 + ai * HALF + m * 16; bf16_t* rowp = base + (size_t)row * 768 + col0;
#pragma unroll
            for (int bj = 0; bj < 2; ++bj) { const int cb = col0 + bj * HALF; f32x4 v0 = acc[ai][bj][m][0], v1 = acc[ai][bj][m][1];
                if (rope) { const int f0 = ((cb & 63) >> 3) * 4; const f32x4 cs = *(const f32x4*)(rc + t * 32 + f0), sn = *(const f32x4*)(rs + t * 32 + f0);
                    const f32x4 o1 = v0 * cs - v1 * sn, o2 = v0 * sn + v1 * cs; v0 = o1; v1 = o2; }
                *(u32x4*)(rowp + bj * HALF) = pack8(v0, v1); }
            asm volatile("" ::: "memory"); }
    }
};
struct EpiGT {
    static constexpr bool PERM = true; bf16_t* O;
    __device__ __forceinline__ void operator()(const f32x4 (&acc)[2][2][4][2], const Unit& u, int wr, int wc, int fr, int fq) const {
        const int b = u.pn >> 3, tt = u.pn & 7, part = u.pm; const int c0 = wr * 64 + fr, t0 = tt * 256 + wc * 32 + 8 * fq;
#pragma unroll
        EPI_LOOP_ROWS { const int c = c0 + ai * HALF + m * 16; bf16_t* rowp = O + ((size_t)(b * 256 + c) * 2 + part) * 2048 + t0;
#pragma unroll
            for (int bj = 0; bj < 2; ++bj) *(u32x4*)(rowp + bj * HALF) = pack8(acc[ai][bj][m][0], acc[ai][bj][m][1]); }
    }
};
}
namespace att {
constexpr int NW = 8, QBLK = 32, KVBLK = 64, DV = 128;
constexpr float THR = 8.f;
constexpr size_t SHM_V = KVBLK * DV * 2;
template <int DQK> struct Cf {
    static constexpr int ND = DQK / 16, KC = DQK / 64, CPR = DQK / 8;
    static constexpr size_t SHM_K = (size_t)KVBLK * DQK * 2;
    static constexpr float SCALE = DQK == 192 ? 0.07216878364870322f : 0.125f;
    static constexpr size_t LDS_BYTES = 2 * SHM_V + 2 * SHM_K + NW * 64 * 4;
};
#define SBAR() __builtin_amdgcn_sched_barrier(0)
__device__ __forceinline__ int crow(int r, int hi) { return (r & 3) + 8 * (r >> 2) + 4 * hi; }
template <int DQK> __device__ __forceinline__ int kswz(int row, int colB) { return row * (DQK * 2) + (colB ^ ((row & 7) << 4)); }

template <int DQK>
__device__ __forceinline__ void partialSM(f32x16& p0, f32x16& p1, float& m_reg, float& mn, float& alpha) {
    constexpr float SCALE = Cf<DQK>::SCALE, C = SCALE * 1.4426950408889634f;
    float pmax = p0[0];
#pragma unroll
    for (int r = 1; r < 16; ++r) pmax = fmaxf(pmax, p0[r]);
#pragma unroll
    for (int r = 0; r < 16; ++r) pmax = fmaxf(pmax, p1[r]);
    { auto rr = __builtin_amdgcn_permlane32_swap(__float_as_uint(pmax), __float_as_uint(pmax), false, false);
      pmax = fmaxf(__uint_as_float(rr[0]), __uint_as_float(rr[1])); }
    if (__builtin_expect(__all(pmax - m_reg <= THR / SCALE), 1)) { mn = m_reg; alpha = 1.f; }
    else { mn = fmaxf(m_reg, pmax); alpha = __builtin_amdgcn_exp2f((m_reg - mn) * C); m_reg = mn; }
    const float mnC = -mn * C;
#pragma unroll
    for (int r = 0; r < 16; ++r) p0[r] = fmaf(p0[r], C, mnC);
#pragma unroll
    for (int r = 0; r < 16; ++r) p1[r] = fmaf(p1[r], C, mnC);
#pragma unroll
    for (int r = 0; r < 16; ++r) p0[r] = __builtin_amdgcn_exp2f(p0[r]);
}
__device__ __forceinline__ void finishSM(f32x16& p0, f32x16& p1, float alpha, float& l_reg, bf16x8& pa0, bf16x8& pa1, bf16x8& pa2, bf16x8& pa3) {
#pragma unroll
    for (int r = 0; r < 16; ++r) p1[r] = __builtin_amdgcn_exp2f(p1[r]);
    float ps = 0;
#pragma unroll
    for (int r = 0; r < 16; ++r) ps += p0[r];
#pragma unroll
    for (int r = 0; r < 16; ++r) ps += p1[r];
    { auto rr = __builtin_amdgcn_permlane32_swap(__float_as_uint(ps), __float_as_uint(ps), false, false);
      ps = __uint_as_float(rr[0]) + __uint_as_float(rr[1]); }
    l_reg = l_reg * alpha + ps;
#define PK4(P, BASE, OUT) do { unsigned a0 = cvt_pk_bf16(P[BASE + 0], P[BASE + 1]), a1 = cvt_pk_bf16(P[BASE + 2], P[BASE + 3]);   \
    unsigned b0 = cvt_pk_bf16(P[BASE + 4], P[BASE + 5]), b1 = cvt_pk_bf16(P[BASE + 6], P[BASE + 7]);                              \
    auto r0 = __builtin_amdgcn_permlane32_swap(a0, b0, false, false); auto r1 = __builtin_amdgcn_permlane32_swap(a1, b1, false, false); \
    u32x4 w = {r0[0], r1[0], r0[1], r1[1]}; OUT = *reinterpret_cast<bf16x8*>(&w); } while (0)
    PK4(p0, 0, pa0); PK4(p0, 8, pa1); PK4(p1, 0, pa2); PK4(p1, 8, pa3);
#undef PK4
}
template <int DQK, int NQR>
__device__ __forceinline__ void qkt(f32x16& p0, f32x16& p1, const char* Ks, const bf16x8* qr, const char* ql, int r32, int hi) {
    p0 = f32x16{}; p1 = f32x16{};
#pragma unroll
    for (int d0 = 0; d0 < Cf<DQK>::ND; ++d0) { const int cb = (d0 * 16 + hi * 8) * 2;
        const bf16x8 b0 = *reinterpret_cast<const bf16x8*>(Ks + kswz<DQK>(r32, cb));
        const bf16x8 b1 = *reinterpret_cast<const bf16x8*>(Ks + kswz<DQK>(32 + r32, cb));
        bf16x8 qf; if (d0 < NQR) qf = qr[d0]; else qf = *reinterpret_cast<const bf16x8*>(ql + (d0 - NQR) * 1024);
        p0 = __builtin_amdgcn_mfma_f32_32x32x16_bf16(b0, qf, p0, 0, 0, 0);
        p1 = __builtin_amdgcn_mfma_f32_32x32x16_bf16(b1, qf, p1, 0, 0, 0); }
}
__device__ __forceinline__ int v_st(int k, int c) { const int kk = (k & ~0xC) | ((k & 4) << 1) | ((k & 8) >> 1); return ((kk >> 3) * 4 + (c >> 5)) * 512 + ((kk & 7) * 32 + (c & 31)) * 2; }
__device__ __forceinline__ int v_rd_base(int lane) { return ((lane & 3) << 3) | (((lane >> 2) & 3) << 6) | (((lane >> 4) & 1) << 5) | (((lane >> 5) & 1) << 8); }
constexpr int v_rd_off(int d0, int ks, int half) { return d0 * 512 + ks * 4096 + half * 2048; }
template <int OFF> __device__ __forceinline__ s16x4 tr_read(int vb) {
    s16x4 r; asm volatile("ds_read_b64_tr_b16 %0, %1 offset:%2" : "=&v"(r) : "v"(vb), "i"(OFF) : "memory"); return r;
}
template <int D0> __device__ __forceinline__ void pv_one(f32x16& od, int vb, bf16x8 pa0, bf16x8 pa1, bf16x8 pa2, bf16x8 pa3) {
    const s16x4 l0 = tr_read<v_rd_off(D0, 0, 0)>(vb), h0 = tr_read<v_rd_off(D0, 0, 1)>(vb), l1 = tr_read<v_rd_off(D0, 1, 0)>(vb), h1 = tr_read<v_rd_off(D0, 1, 1)>(vb);
    const s16x4 l2 = tr_read<v_rd_off(D0, 2, 0)>(vb), h2 = tr_read<v_rd_off(D0, 2, 1)>(vb), l3 = tr_read<v_rd_off(D0, 3, 0)>(vb), h3 = tr_read<v_rd_off(D0, 3, 1)>(vb);
    asm volatile("s_waitcnt lgkmcnt(0)" ::: "memory"); SBAR();
#define PK(L_, H_) (bf16x8){L_[0], L_[1], L_[2], L_[3], H_[0], H_[1], H_[2], H_[3]}
    od = __builtin_amdgcn_mfma_f32_32x32x16_bf16(pa0, PK(l0, h0), od, 0, 0, 0);
    od = __builtin_amdgcn_mfma_f32_32x32x16_bf16(pa1, PK(l1, h1), od, 0, 0, 0);
    od = __builtin_amdgcn_mfma_f32_32x32x16_bf16(pa2, PK(l2, h2), od, 0, 0, 0);
    od = __builtin_amdgcn_mfma_f32_32x32x16_bf16(pa3, PK(l3, h3), od, 0, 0, 0);
#undef PK
}
__device__ __forceinline__ void pv_d0(f32x16* o, int vb, bf16x8 pa0, bf16x8 pa1, bf16x8 pa2, bf16x8 pa3) {
    pv_one<0>(o[0], vb, pa0, pa1, pa2, pa3); pv_one<1>(o[1], vb, pa0, pa1, pa2, pa3); pv_one<2>(o[2], vb, pa0, pa1, pa2, pa3); pv_one<3>(o[3], vb, pa0, pa1, pa2, pa3);
}

struct KSrc { const bf16_t* ka; int lda; const bf16_t* kb; int ldb; };
struct AOut {
    bf16_t* O; int ldo; float* stash; const float* subg; float lam; int sub;
};
template <int DQK, int SDEPTH, int MODE>
__device__ __forceinline__ void attn_body(const bf16_t* __restrict__ Qb, int ldq, const KSrc ks, const bf16_t* __restrict__ Vh, int ldv, int seq, char* lds, const AOut ao) {
    using C = Cf<DQK>; constexpr int ND = C::ND, KC = C::KC, CPR = C::CPR, CA = DQK == 192 ? 16 : CPR; constexpr size_t SHM_K = C::SHM_K;
    int tid_ = threadIdx.x; asm volatile("" : "+v"(tid_));
    const int tid = tid_, wid = tid >> 6, lane = tid & 63, r32 = lane & 31, hi = lane >> 5;
    char* V_lds = lds; char* K_lds = lds + 2 * SHM_V;
    float* ws = (float*)(lds + 2 * SHM_V + 2 * SHM_K) + wid * 64; float* li_l = ws; float* al_l = ws + 32;
    constexpr int NQR = ND;
    char* ql = lds + 2 * SHM_V + 2 * SHM_K + NW * 64 * 4 + wid * 4096 + lane * 16;
    float m_reg = -1e30f, l_reg = 0; f32x16 o[4] = {}; bf16x8 qr[NQR];
    const bf16_t* Qw = Qb + (long)(wid * QBLK + r32) * ldq + hi * 8;
#pragma unroll
    for (int d0 = 0; d0 < ND; ++d0) { const bf16x8 qv = *reinterpret_cast<const bf16x8*>(Qw + d0 * 16); if (d0 < NQR) qr[d0] = qv; else *reinterpret_cast<bf16x8*>(ql + (d0 - NQR) * 1024) = qv; }
    const int sr = tid >> 4, sc = (tid & 15) * 8, vst0 = v_st(sr, sc), vst1 = v_st(32 + sr, sc);
    const int vb0 = (int)(uintptr_t)V_lds + v_rd_base(lane);
    const bf16_t* kptr[KC]; int kstride[KC]; int klds[KC];
#pragma unroll
    for (int i = 0; i < KC; ++i) { const int q = tid + 512 * i, row = q / CPR, c8 = q % CPR; klds[i] = kswz<DQK>(row, c8 * 16);
        if (c8 < CA) { kptr[i] = ks.ka + (long)row * ks.lda + c8 * 8; kstride[i] = ks.lda; } else { kptr[i] = ks.kb + (long)row * ks.ldb + (c8 - CA) * 8; kstride[i] = ks.ldb; } }
    struct Slot { bf16x8 vs0, vs1; bf16x8 kk[KC]; } sl[SDEPTH];
#define SLOAD(i_, k0_) do { sl[i_].vs0 = *reinterpret_cast<const bf16x8*>(&Vh[(long)((k0_) + sr) * ldv + sc]); sl[i_].vs1 = *reinterpret_cast<const bf16x8*>(&Vh[(long)((k0_) + 32 + sr) * ldv + sc]); \
    _Pragma("unroll") for (int c_ = 0; c_ < KC; ++c_) sl[i_].kk[c_] = *reinterpret_cast<const bf16x8*>(kptr[c_] + (long)(k0_) * kstride[c_]); } while (0)
#define SWRITE(b_, i_) do { *(bf16x8*)(V_lds + (b_) * SHM_V + vst0) = sl[i_].vs0; *(bf16x8*)(V_lds + (b_) * SHM_V + vst1) = sl[i_].vs1; \
    _Pragma("unroll") for (int c_ = 0; c_ < KC; ++c_) *(bf16x8*)(K_lds + (b_) * SHM_K + klds[c_]) = sl[i_].kk[c_]; } while (0)
#define SWAIT() do { if constexpr (SDEPTH == 2) { if constexpr (KC == 3) asm volatile("s_waitcnt vmcnt(5)" ::: "memory"); else asm volatile("s_waitcnt vmcnt(3)" ::: "memory"); } \
    else asm volatile("s_waitcnt vmcnt(0)" ::: "memory"); } while (0)
#define RESC(a_) do { if (__any((a_) < 1.f)) { if (hi == 0) al_l[r32] = (a_); asm volatile("s_waitcnt lgkmcnt(0)" ::: "memory"); \
    _Pragma("unroll") for (int d_ = 0; d_ < 4; ++d_) _Pragma("unroll") for (int r_ = 0; r_ < 16; ++r_) o[d_][r_] *= al_l[crow(r_, hi)]; } } while (0)
    f32x16 pA0, pA1, pB0, pB1; float mnA, mnB, alA, alB; bf16x8 pa0, pa1, pa2, pa3; const int NT = seq / KVBLK;
    constexpr int SE = 0, SO = SDEPTH - 1;
    SLOAD(SE, 0); asm volatile("s_waitcnt vmcnt(0)" ::: "memory"); SWRITE(0, SE); __syncthreads();
    qkt<DQK, NQR>(pA0, pA1, K_lds, qr, ql, r32, hi); partialSM<DQK>(pA0, pA1, m_reg, mnA, alA);
    SLOAD(SO, KVBLK); if constexpr (SDEPTH == 2) { if (2 < NT) SLOAD(SE, 2 * KVBLK); }
    SWAIT(); SWRITE(1, SO); __syncthreads();
    for (int j = 1; j + 1 < NT; j += 2) {
        SBAR(); qkt<DQK, NQR>(pB0, pB1, K_lds + SHM_K, qr, ql, r32, hi);
        finishSM(pA0, pA1, alA, l_reg, pa0, pa1, pa2, pa3); SBAR();
        SLOAD(SO, (j + SDEPTH) * KVBLK); SBAR();
        pv_d0(o, vb0, pa0, pa1, pa2, pa3); partialSM<DQK>(pB0, pB1, m_reg, mnB, alB);
        __syncthreads(); SWAIT(); SWRITE(0, SE);
        RESC(alB); __syncthreads();
        SBAR(); qkt<DQK, NQR>(pA0, pA1, K_lds, qr, ql, r32, hi);
        finishSM(pB0, pB1, alB, l_reg, pa0, pa1, pa2, pa3); SBAR();
        if (SDEPTH == 1 || j + 3 < NT) SLOAD(SE, (j + 1 + SDEPTH) * KVBLK); SBAR();
        pv_d0(o, vb0 + (int)SHM_V, pa0, pa1, pa2, pa3); partialSM<DQK>(pA0, pA1, m_reg, mnA, alA);
        __syncthreads(); SWAIT(); SWRITE(1, SO);
        RESC(alA); __syncthreads();
    }
    SBAR(); qkt<DQK, NQR>(pB0, pB1, K_lds + SHM_K, qr, ql, r32, hi);
    finishSM(pA0, pA1, alA, l_reg, pa0, pa1, pa2, pa3); SBAR();
    pv_d0(o, vb0, pa0, pa1, pa2, pa3); partialSM<DQK>(pB0, pB1, m_reg, mnB, alB);
    __syncthreads(); RESC(alB);
    finishSM(pB0, pB1, alB, l_reg, pa0, pa1, pa2, pa3); SBAR();
    pv_d0(o, vb0 + (int)SHM_V, pa0, pa1, pa2, pa3);
    if (hi == 0) li_l[r32] = l_reg; asm volatile("s_waitcnt lgkmcnt(0)" ::: "memory");
    float rli[16];
#pragma unroll
    for (int r = 0; r < 16; ++r) rli[r] = __builtin_amdgcn_rcpf(li_l[crow(r, hi)]);
    if constexpr (MODE == 0) {
        bf16_t* Ow = ao.O + (long)(wid * QBLK) * ao.ldo;
#pragma unroll
        for (int r = 0; r < 16; ++r) { const int orow = crow(r, hi);
#pragma unroll
            for (int d0 = 0; d0 < 4; ++d0) Ow[(long)orow * ao.ldo + d0 * 32 + r32] = f2bf(o[d0][r] * rli[r]); }
    } else {
        float* st = ao.stash + (wid * 64) * 64 + lane;
        if (ao.sub == 0) {
#pragma unroll
            for (int r = 0; r < 16; ++r)
#pragma unroll
                for (int d0 = 0; d0 < 4; ++d0) st[(r * 4 + d0) * 64] = o[d0][r] * rli[r];
        } else {
            const float lam = ao.lam; float sg[4];
#pragma unroll
            for (int d0 = 0; d0 < 4; ++d0) sg[d0] = ao.subg[d0 * 32 + r32] * (1.f - LAM_INIT);
            bf16_t* Ow = ao.O + (long)(wid * QBLK) * ao.ldo;
#pragma unroll
            for (int r = 0; r < 16; ++r) { float ss = 0.f;
#pragma unroll
                for (int d0 = 0; d0 < 4; ++d0) { const float v = st[(r * 4 + d0) * 64] - lam * (o[d0][r] * rli[r]); o[d0][r] = v; ss += v * v; }
                ss += __shfl_xor(ss, 1); ss += __shfl_xor(ss, 2); ss += __shfl_xor(ss, 4); ss += __shfl_xor(ss, 8); ss += __shfl_xor(ss, 16);
                const float rn = 1.0f / sqrtf(ss * (1.f / 128.f) + EPS); const int orow = crow(r, hi);
#pragma unroll
                for (int d0 = 0; d0 < 4; ++d0) Ow[(long)orow * ao.ldo + d0 * 32 + r32] = f2bf(o[d0][r] * rn * sg[d0]); }
        }
    }
    asm volatile("s_waitcnt vmcnt(0) lgkmcnt(0)" ::: "memory");
    __syncthreads();
#undef SLOAD
#undef SWRITE
#undef SWAIT
#undef RESC
}
template <int DQK>
__device__ __forceinline__ void attn_body_np(const bf16_t* __restrict__ Qb, int ldq, const KSrc ks, const bf16_t* __restrict__ Vh, int ldv, int seq, char* lds, const AOut ao) {
    using C = Cf<DQK>; constexpr int ND = C::ND, KC = C::KC, CPR = C::CPR, CA = DQK == 192 ? 16 : CPR; constexpr size_t SHM_K = C::SHM_K;
    int tid_ = threadIdx.x; asm volatile("" : "+v"(tid_));
    const int tid = tid_, wid = tid >> 6, lane = tid & 63, r32 = lane & 31, hi = lane >> 5;
    char* V_lds = lds; char* K_lds = lds + 2 * SHM_V;
    float* ws = (float*)(lds + 2 * SHM_V + 2 * SHM_K) + wid * 64; float* li_l = ws; float* al_l = ws + 32;
    float m_reg = -1e30f, l_reg = 0; f32x16 o[4] = {}; bf16x8 qr[ND];
    const bf16_t* Qw = Qb + (long)(wid * QBLK + r32) * ldq + hi * 8;
#pragma unroll
    for (int d0 = 0; d0 < ND; ++d0) qr[d0] = *reinterpret_cast<const bf16x8*>(Qw + d0 * 16);
    const int sr = tid >> 4, sc = (tid & 15) * 8, vst0 = v_st(sr, sc), vst1 = v_st(32 + sr, sc);
    const int vb0 = (int)(uintptr_t)V_lds + v_rd_base(lane);
    const bf16_t* kptr[KC]; int kstride[KC]; int klds[KC];
#pragma unroll
    for (int i = 0; i < KC; ++i) { const int q = tid + 512 * i, row = q / CPR, c8 = q % CPR; klds[i] = kswz<DQK>(row, c8 * 16);
        if (c8 < CA) { kptr[i] = ks.ka + (long)row * ks.lda + c8 * 8; kstride[i] = ks.lda; } else { kptr[i] = ks.kb + (long)row * ks.ldb + (c8 - CA) * 8; kstride[i] = ks.ldb; } }
    bf16x8 vs0, vs1, kk[KC];
#define SLOAD1(k0_) do { vs0 = *reinterpret_cast<const bf16x8*>(&Vh[(long)((k0_) + sr) * ldv + sc]); vs1 = *reinterpret_cast<const bf16x8*>(&Vh[(long)((k0_) + 32 + sr) * ldv + sc]); \
    _Pragma("unroll") for (int c_ = 0; c_ < KC; ++c_) kk[c_] = *reinterpret_cast<const bf16x8*>(kptr[c_] + (long)(k0_) * kstride[c_]); } while (0)
#define SWRITE1(b_) do { *(bf16x8*)(V_lds + (b_) * SHM_V + vst0) = vs0; *(bf16x8*)(V_lds + (b_) * SHM_V + vst1) = vs1; \
    _Pragma("unroll") for (int c_ = 0; c_ < KC; ++c_) *(bf16x8*)(K_lds + (b_) * SHM_K + klds[c_]) = kk[c_]; } while (0)
    f32x16 p0, p1; float mn, al; bf16x8 pa0, pa1, pa2, pa3; const int NT = seq / KVBLK;
    SLOAD1(0); asm volatile("s_waitcnt vmcnt(0)" ::: "memory"); SWRITE1(0); SLOAD1(KVBLK); __syncthreads();
#pragma unroll 1
    for (int j = 0; j < NT; ++j) {
        const int buf = j & 1;
        SBAR(); qkt<DQK, ND>(p0, p1, K_lds + buf * SHM_K, qr, nullptr, r32, hi);
        partialSM<DQK>(p0, p1, m_reg, mn, al);
        if (__any(al < 1.f)) { if (hi == 0) al_l[r32] = al; asm volatile("s_waitcnt lgkmcnt(0)" ::: "memory");
#pragma unroll
            for (int d_ = 0; d_ < 4; ++d_)
#pragma unroll
                for (int r_ = 0; r_ < 16; ++r_) o[d_][r_] *= al_l[crow(r_, hi)]; }
        finishSM(p0, p1, al, l_reg, pa0, pa1, pa2, pa3); SBAR();
        if (j + 1 < NT) { asm volatile("s_waitcnt vmcnt(0)" ::: "memory"); SWRITE1(buf ^ 1); if (j + 2 < NT) SLOAD1((j + 2) * KVBLK); }
        SBAR();
        pv_d0(o, vb0 + buf * (int)SHM_V, pa0, pa1, pa2, pa3);
        __syncthreads();
    }
#undef SLOAD1
#undef SWRITE1
    if (hi == 0) li_l[r32] = l_reg; asm volatile("s_waitcnt lgkmcnt(0)" ::: "memory");
    float rli[16];
#pragma unroll
    for (int r = 0; r < 16; ++r) rli[r] = __builtin_amdgcn_rcpf(li_l[crow(r, hi)]);
    bf16_t* Ow = ao.O + (long)(wid * QBLK) * ao.ldo;
#pragma unroll
    for (int r = 0; r < 16; ++r) { const int orow = crow(r, hi);
#pragma unroll
        for (int d0 = 0; d0 < 4; ++d0) Ow[(long)orow * ao.ldo + d0 * 32 + r32] = f2bf(o[d0][r] * rli[r]); }
    asm volatile("s_waitcnt vmcnt(0) lgkmcnt(0)" ::: "memory");
    __syncthreads();
}
}
constexpr int M = NB * S, ML = NB * T;
constexpr int NCH = ML / 256;
constexpr int MAXT = 2 * ML / 256 + NE;
constexpr int TCH = (MAXT + 1) / 2;
constexpr size_t al256(size_t x) { return (x + 255) / 256 * 256; }
constexpr size_t WS_CTL = 0, CTL_BYTES = 1u << 20;
constexpr int CW_BAR = 4096;
constexpr size_t WS_MODV = WS_CTL + CTL_BYTES;
constexpr size_t WS_ROPE = WS_MODV + al256((size_t)2 * 33 * 6144 * 4);
constexpr size_t WS_W = WS_ROPE + 2 * 2048 * 32 * 4;
constexpr size_t W_IN0 = WS_W, W_UQ = W_IN0 + (size_t)2304 * 1024 * 2, W_UKV = W_UQ + (size_t)768 * 384 * 2, W_OUT0 = W_UKV + (size_t)1024 * 256 * 2,
    W_GU0 = W_OUT0 + (size_t)1024 * 1024 * 2, W_DN0 = W_GU0 + (size_t)5632 * 1024 * 2, W_IN1 = W_DN0 + (size_t)1024 * 2816 * 2, W_FOLD = W_IN1 + (size_t)2304 * 1024 * 2,
    W_OUT1 = W_FOLD + (size_t)512 * 1024 * 2, W_GU1 = W_OUT1 + (size_t)1024 * 1024 * 2, W_DN1 = W_GU1 + (size_t)NE * 5632 * 1024 * 2, W_DFT = W_DN1 + (size_t)NE * 1024 * 2816 * 2,
    WS_WEND = W_DFT + (size_t)2048 * 4096 * 2;
constexpr size_t WS_CTXS = WS_WEND;
constexpr size_t WS_STASH = WS_CTXS;
constexpr size_t CTXS_BYTES = ((size_t)NB * L * D * 4 > (size_t)256 * 131072) ? (size_t)NB * L * D * 4 : (size_t)256 * 131072;
constexpr size_t WS_ROUTE = WS_CTXS + CTXS_BYTES;
constexpr size_t RT_INFO = WS_ROUTE, RT_W = RT_INFO + (size_t)ML * 16, RT_POS = RT_W + (size_t)ML * 8, RT_WCNT = RT_POS + (size_t)ML * 8, RT_TOFF = RT_WCNT + (size_t)NCH * 64 * 4, WS_RTEND = al256(RT_TOFF + 256);
constexpr size_t AR = WS_RTEND;
constexpr size_t H2S_BYTES = (size_t)(2 * ML + NE * 256) * 2048, ACTM_BYTES = (size_t)TCH * 256 * 2816 * 2, GT_BYTES = (size_t)NB * 256 * 4096 * 2;
#if CFG_NB >= 32
constexpr size_t AR_A = AR, AR_B = AR + (size_t)M * 2048, AR_C = AR + (size_t)M * 4096, AR_D = AR_C + (size_t)M * 5632, AR_END = AR_D + (size_t)M * 1280;
constexpr size_t B_H = AR_A, B_Q0 = AR_A, B_Y = AR_A, B_F = AR_A, B_AOUT1 = AR_A;
constexpr size_t B_AOUT0 = AR_B, B_H2 = AR_B, B_H1 = AR_B, B_Y1 = AR_B;
constexpr size_t B_Z = AR_C, B_KPE = AR_C + (size_t)M * 4608, B_K0N = AR_C, B_V0 = AR_C + (size_t)M * 1024, B_ACT = AR_C,
    B_QKV1 = AR_C, B_GT = AR_C + (size_t)M * 4608, B_ACTM = AR_C;
constexpr size_t B_ZQN = AR_D, B_ZKVN = AR_D + (size_t)M * 768;
constexpr size_t B_H2TOK = AR_END - (size_t)ML * 2048, B_H2S = AR_A;
static_assert(H2S_BYTES <= (size_t)M * 4096, "h2s fits A+B");
static_assert(ACTM_BYTES <= (size_t)M * 5632 + (size_t)M * 1280, "MoE act chunk fits C(+D)");
static_assert(B_H2TOK >= AR_C + ACTM_BYTES || true, "h2tok placement");
static_assert(GT_BYTES <= (size_t)M * 1024, "GT fits the tail of C");
static_assert(AR_END <= ((size_t)1 << 30), "workspace map exceeds 1 GiB");
#else
constexpr size_t B_H = AR, B_Z = B_H + (size_t)M * 2048, B_KPE = B_Z + (size_t)M * 4608, B_AOUT0 = B_KPE + (size_t)M * 128, B_ZQN = B_AOUT0 + (size_t)M * 2048, B_ZKVN = B_ZQN + (size_t)M * 768,
    B_Q0 = B_ZKVN + (size_t)M * 512, B_K0N = B_Q0 + (size_t)M * 1536, B_V0 = B_K0N + (size_t)M * 1024, B_Y = B_V0 + (size_t)M * 1024, B_H2 = B_Y + (size_t)M * 2048, B_ACT = B_H2 + (size_t)M * 2048,
    B_F = B_ACT + (size_t)M * 5632, B_H1 = B_F + (size_t)M * 2048, B_QKV1 = B_H1 + (size_t)M * 2048, B_GT = B_QKV1 + (size_t)M * 4608, B_AOUT1 = B_GT + GT_BYTES, B_Y1 = B_AOUT1 + (size_t)M * 2048,
    B_H2TOK = B_Y1 + (size_t)M * 2048, B_H2S = B_H2TOK + (size_t)ML * 2048, B_ACTM = B_H2S + H2S_BYTES, AR_END = B_ACTM + ACTM_BYTES;
#endif

struct P {
    const float *x, *c, *ctx, *c_ctx, *ev_mod_w, *ev_mod_b, *ev_norm_g, *ev_w_in, *ev_conv_w, *ev_q_norm_g, *ev_w_uq, *ev_kv_norm_g, *ev_w_ukv, *ev_w_out,
        *ev_ffn_gate, *ev_ffn_up, *ev_ffn_down, *od_mod_w, *od_mod_b, *od_norm_g, *od_w_in, *od_lambda, *od_subln_g, *od_w_out, *od_router, *od_exp_gate, *od_exp_up, *od_exp_down;
    float* out; unsigned char* ws; int ph_lo, ph_hi;
};

__device__ __forceinline__ void ld_f32(const float* p, int lane, float (&v)[16]) {
#pragma unroll
    for (int j2 = 0; j2 < 2; ++j2) { const f32x4 a = *(const f32x4*)(p + 512 * j2 + 8 * lane), b = *(const f32x4*)(p + 512 * j2 + 8 * lane + 4);
#pragma unroll
        for (int i = 0; i < 4; ++i) { v[j2 * 8 + i] = a[i]; v[j2 * 8 + 4 + i] = b[i]; } }
}
__device__ __forceinline__ void st_f32(float* p, int lane, const float (&v)[16]) {
#pragma unroll
    for (int j2 = 0; j2 < 2; ++j2) { f32x4 a, b;
#pragma unroll
        for (int i = 0; i < 4; ++i) { a[i] = v[j2 * 8 + i]; b[i] = v[j2 * 8 + 4 + i]; }
        *(f32x4*)(p + 512 * j2 + 8 * lane) = a; *(f32x4*)(p + 512 * j2 + 8 * lane + 4) = b; }
}
__device__ __forceinline__ void unpack8(const u32x4 w, float* v) { v[0] = bflo(w.x); v[1] = bfhi(w.x); v[2] = bflo(w.y); v[3] = bfhi(w.y); v[4] = bflo(w.z); v[5] = bfhi(w.z); v[6] = bflo(w.w); v[7] = bfhi(w.w); }
__device__ __forceinline__ u32x4 pack8f(const float* v) { u32x4 w; w.x = cvt_pk_bf16(v[0], v[1]); w.y = cvt_pk_bf16(v[2], v[3]); w.z = cvt_pk_bf16(v[4], v[5]); w.w = cvt_pk_bf16(v[6], v[7]); return w; }
__device__ __forceinline__ void ld_bf16(const bf16_t* p, int lane, float (&v)[16]) {
#pragma unroll
    for (int j2 = 0; j2 < 2; ++j2) { const u32x4 w = *(const u32x4*)(p + 512 * j2 + 8 * lane); unpack8(w, &v[j2 * 8]); }
}
__device__ __forceinline__ void st_bf16(bf16_t* p, int lane, const float (&v)[16]) {
#pragma unroll
    for (int j2 = 0; j2 < 2; ++j2) *(u32x4*)(p + 512 * j2 + 8 * lane) = pack8f(&v[j2 * 8]);
}
__device__ __forceinline__ float sumsq16(const float (&v)[16]) { float s = 0.f;
#pragma unroll
    for (int i = 0; i < 16; ++i) s += v[i] * v[i];
    return wave_sum(s); }
__device__ __forceinline__ void resid16(float (&xv)[16], const float (&y)[16], const float* g, const float* gate, int lane) {
    const float ry = 1.0f / sqrtf(sumsq16(y) * (1.f / D) + EPS); float gv[16], tv[16]; ld_f32(g, lane, gv); ld_f32(gate, lane, tv);
#pragma unroll
    for (int i = 0; i < 16; ++i) xv[i] += tv[i] * (y[i] * ry * gv[i]);
}
__device__ __forceinline__ void normmod16(const float (&xv)[16], float (&h)[16], const float* g, const float* shift, const float* scale, int lane) {
    const float rx = 1.0f / sqrtf(sumsq16(xv) * (1.f / D) + EPS); float gv[16], sh[16], sc[16]; ld_f32(g, lane, gv); ld_f32(shift, lane, sh); ld_f32(scale, lane, sc);
#pragma unroll
    for (int i = 0; i < 16; ++i) h[i] = xv[i] * rx * gv[i] * (1.f + sc[i]) + sh[i];
}
__device__ __forceinline__ int rope_pos(int e) { return e < 32 ? 8 * (e >> 2) + (e & 3) : 8 * ((e - 32) >> 2) + 4 + (e & 3); }
__device__ __forceinline__ int rope_elem(int s) { const int i = s >> 3, j = s & 7; return j < 4 ? 4 * i + j : 32 + 4 * i + (j - 4); }

struct Ctx {
    LAS unsigned char* lds; unsigned char* ws; int tid, lane, wave, gw, ngw;
};

template <int MAP>
__device__ __forceinline__ void p0_item(const float* W, const float* W2, int ldw, int nvalid, int K, bf16_t* WT, LAS float* scr, int item, int nblk, int lane) {
    const int kb = item / nblk, nb = item % nblk, k0 = 64 * kb, n0 = 32 * nb; const int np = n0 + (lane & 31);
    const float* src = W; int col = np;
    if (MAP == 0) { if (np >= nvalid) col = -1; }
    if (MAP == 1) { const int h = np / MLA_QK, w = np % MLA_QK; col = w < MLA_NOPE ? np : h * MLA_QK + MLA_NOPE + rope_elem(w - MLA_NOPE); }
    if (MAP == 2) { const int g8 = np >> 3, j = np & 7; if (j < 4) { col = 4 * g8 + j; } else { src = W2; col = 4 * g8 + (j - 4); } }
    if (MAP == 3) { col = np < 2 * DIFFW ? (np & ~63) + rope_elem(np & 63) : np; }
#pragma unroll 8
    for (int i = 0; i < 32; ++i) { const int kk = 2 * i + (lane >> 5); scr[kk * 33 + (lane & 31)] = col >= 0 ? src[(size_t)(k0 + kk) * ldw + col] : 0.f; }
    asm volatile("s_waitcnt lgkmcnt(0)" ::: "memory");
    const int c = lane & 7;
#pragma unroll
    for (int j = 0; j < 4; ++j) { const int n = (lane >> 3) + 8 * j; const LAS float* s = scr + (8 * c) * 33 + n;
        u32x4 o; o.x = cvt_pk_bf16(s[0 * 33], s[1 * 33]); o.y = cvt_pk_bf16(s[2 * 33], s[3 * 33]); o.z = cvt_pk_bf16(s[4 * 33], s[5 * 33]); o.w = cvt_pk_bf16(s[6 * 33], s[7 * 33]);
        *(u32x4*)(WT + (size_t)(n0 + n) * K + k0 + 8 * c) = o; }
    asm volatile("s_waitcnt lgkmcnt(0)" ::: "memory");
}
__device__ __forceinline__ void p0_fold_item(const float* W, bf16_t* WT, LAS float* scr, const LAS float* tab, int item, int lane) {
    const int kb = item / 16, nb = item % 16, k0 = 64 * kb, n0 = 32 * nb; const int r = n0 + (lane & 31), part = r >> 8, g = (r >> 6) & 3, l = r & 63;
    for (int i = 0; i < 32; ++i) { const int kk = 2 * i + (lane >> 5); const float* wr = W + (size_t)(k0 + kk) * ODD_IN + 3 * DIFFW + g * 64; float a = 0.f;
        for (int j = 0; j < 64; ++j) a += wr[j] * tab[part * 64 + ((l * j) & 63)];
        scr[kk * 33 + (lane & 31)] = a; }
    asm volatile("s_waitcnt lgkmcnt(0)" ::: "memory");
    const int c = lane & 7;
#pragma unroll
    for (int j = 0; j < 4; ++j) { const int n = (lane >> 3) + 8 * j; const LAS float* s = scr + (8 * c) * 33 + n;
        u32x4 o; o.x = cvt_pk_bf16(s[0 * 33], s[1 * 33]); o.y = cvt_pk_bf16(s[2 * 33], s[3 * 33]); o.z = cvt_pk_bf16(s[4 * 33], s[5 * 33]); o.w = cvt_pk_bf16(s[6 * 33], s[7 * 33]);
        *(u32x4*)(WT + (size_t)(n0 + n) * D + k0 + 8 * c) = o; }
    asm volatile("s_waitcnt lgkmcnt(0)" ::: "memory");
}
__device__ __forceinline__ void p0_mod_unit(const P& p, const Ctx& c, int u) {
    const int layer = u / 48, col0 = (u % 48) * 128; const float* W = layer ? p.od_mod_w : p.ev_mod_w; const float* bias = layer ? p.od_mod_b : p.ev_mod_b;
    float* mod = (float*)(c.ws + WS_MODV) + (size_t)layer * 33 * 6144;
    LAS float* sc = (LAS float*)c.lds;
    LAS float* red = (LAS float*)(c.lds + 40960);
    const int n = c.tid & 127, kq = c.tid >> 7; float acc[33];
#pragma unroll
    for (int r = 0; r < 33; ++r) acc[r] = 0.f;
    for (int ch = 0; ch < 4; ++ch) {
        __syncthreads();
        for (int e = c.tid; e < 4 * 64 * 36; e += 512) { const int r = e % 36, kk = (e / 36) % 64, q = e / (36 * 64); const int k = q * 256 + ch * 64 + kk;
            float v = 0.f; if (r < 33) { const float cv = r < 32 ? p.c[r * D + k] : p.c_ctx[k]; v = cv / (1.f + expf(-cv)); } sc[e] = v; }
        __syncthreads();
        const float* wp = W + (size_t)(kq * 256 + ch * 64) * 6144 + col0 + n;
        for (int kk = 0; kk < 64; ++kk) { const float w = wp[(size_t)kk * 6144]; const LAS f32x4* s4 = (const LAS f32x4*)(sc + (kq * 64 + kk) * 36);
#pragma unroll
            for (int q = 0; q < 8; ++q) { const f32x4 s = s4[q];
#pragma unroll
                for (int i = 0; i < 4; ++i) acc[q * 4 + i] = fmaf(s[i], w, acc[q * 4 + i]); }
            acc[32] = fmaf(s4[8][0], w, acc[32]); }
    }
#pragma unroll
    for (int r = 0; r < 33; ++r) red[(kq * 33 + r) * 128 + n] = acc[r];
    __syncthreads();
    for (int r = kq; r < 33; r += 4) { const float v = red[(0 * 33 + r) * 128 + n] + red[(1 * 33 + r) * 128 + n] + red[(2 * 33 + r) * 128 + n] + red[(3 * 33 + r) * 128 + n];
        mod[(size_t)r * 6144 + col0 + n] = v + bias[col0 + n]; }
    __syncthreads();
}
__device__ __forceinline__ void phase_prologue(const P& p, const Ctx& c) {
    for (int u = blockIdx.x; u < 96; u += gridDim.x) p0_mod_unit(p, c, u);
    __syncthreads();
    LAS float* tab = (LAS float*)(c.lds + 8 * 16384);
    if (c.tid < 64) { const float a = (float)c.tid * (6.283185307179586f / 64.f); tab[c.tid] = cosf(a); tab[64 + c.tid] = sinf(a); }
    __syncthreads();
    LAS float* scr = (LAS float*)(c.lds + c.wave * 16384);
    constexpr int I0 = 16 * 72, I1 = 6 * 24, I2 = 4 * 32, I3 = 16 * 32, I4 = 16 * 176, I5 = 44 * 32, I6 = 16 * 72, I7 = 16 * 32, I8 = NE * I4, I9 = NE * I5, I10 = 16 * 16;
    constexpr int NITEMS = I0 + I1 + I2 + I3 + I4 + I5 + I6 + I7 + I8 + I9 + I10;
    for (int it = c.gw; it < NITEMS; it += c.ngw) {
        int r = it;
        if (r < I0) { p0_item<0>(p.ev_w_in, nullptr, EVEN_IN, EVEN_IN, D, (bf16_t*)(c.ws + W_IN0), scr, r, 72, c.lane); continue; } r -= I0;
        if (r < I1) { p0_item<1>(p.ev_w_uq, nullptr, 768, 768, QRANK, (bf16_t*)(c.ws + W_UQ), scr, r, 24, c.lane); continue; } r -= I1;
        if (r < I2) { p0_item<0>(p.ev_w_ukv, nullptr, 1024, 1024, KVRANK, (bf16_t*)(c.ws + W_UKV), scr, r, 32, c.lane); continue; } r -= I2;
        if (r < I3) { p0_item<0>(p.ev_w_out, nullptr, D, D, D, (bf16_t*)(c.ws + W_OUT0), scr, r, 32, c.lane); continue; } r -= I3;
        if (r < I4) { p0_item<2>(p.ev_ffn_gate, p.ev_ffn_up, FF, FF, D, (bf16_t*)(c.ws + W_GU0), scr, r, 176, c.lane); continue; } r -= I4;
        if (r < I5) { p0_item<0>(p.ev_ffn_down, nullptr, D, D, FF, (bf16_t*)(c.ws + W_DN0), scr, r, 32, c.lane); continue; } r -= I5;
        if (r < I6) { p0_item<3>(p.od_w_in, nullptr, ODD_IN, ODD_IN, D, (bf16_t*)(c.ws + W_IN1), scr, r, 72, c.lane); continue; } r -= I6;
        if (r < I7) { p0_item<0>(p.od_w_out, nullptr, D, D, D, (bf16_t*)(c.ws + W_OUT1), scr, r, 32, c.lane); continue; } r -= I7;
        if (r < I8) { const int e = r / I4; p0_item<2>(p.od_exp_gate + (size_t)e * D * FF, p.od_exp_up + (size_t)e * D * FF, FF, FF, D, (bf16_t*)(c.ws + W_GU1) + (size_t)e * 5632 * 1024, scr, r % I4, 176, c.lane); continue; } r -= I8;
        if (r < I9) { const int e = r / I5; p0_item<0>(p.od_exp_down + (size_t)e * FF * D, nullptr, D, D, FF, (bf16_t*)(c.ws + W_DN1) + (size_t)e * 1024 * 2816, scr, r % I5, 32, c.lane); continue; } r -= I9;
        p0_fold_item(p.od_w_in, (bf16_t*)(c.ws + W_FOLD), scr, tab, r, c.lane);
    }
    { bf16_t* dft = (bf16_t*)(c.ws + W_DFT); const int gt = blockIdx.x * 512 + c.tid, ngt = gridDim.x * 512; const float scl = 0.0027621358640099515f;
      for (int i8 = gt; i8 < 2048 * 4096 / 8; i8 += ngt) { const int k = i8 >> 9, tt0 = (i8 & 511) * 8; float v[8];
#pragma unroll
          for (int j = 0; j < 8; ++j) { const int tt = tt0 + j, t = tt & 2047, q = (k * t) & 2047; const float a = (float)q * (6.283185307179586f / 2048.f); v[j] = (tt < 2048 ? cosf(a) : -sinf(a)) * scl; }
          *(u32x4*)(dft + (size_t)i8 * 8) = pack8f(v); } }
    { float* rc = (float*)(c.ws + WS_ROPE); float* rs = rc + 2048 * 32; const int gt = blockIdx.x * 512 + c.tid, ngt = gridDim.x * 512;
      for (int i = gt; i < 2048 * 32; i += ngt) { const int t = i >> 5, f = i & 31; const int pos = f < 16 ? t / GW : t % GW; const float inv = powf(10000.f, -(float)(f & 15) / 16.f);
          const float ang = (float)pos * inv; rc[i] = cosf(ang); rs[i] = sinf(ang); } }
}

__device__ __forceinline__ const float* in_row(const P& p, int m) { const int b = m / S, j = m % S; return j < L ? p.ctx + ((size_t)b * L + j) * D : p.x + ((size_t)b * T + (j - L)) * D; }
__device__ __forceinline__ float* stream_row(const P& p, unsigned char* ws, int m) { const int b = m / S, j = m % S; return j < L ? (float*)(ws + WS_CTXS) + ((size_t)b * L + j) * D : p.out + ((size_t)b * T + (j - L)) * D; }
__device__ __forceinline__ const float* mod_row(unsigned char* ws, int layer, int m) { const int b = m / S, j = m % S; return (const float*)(ws + WS_MODV) + ((size_t)layer * 33 + (j < L ? 32 : b)) * 6144; }

__device__ __forceinline__ void phase_norm0(const P& p, const Ctx& c) {
    bf16_t* H = (bf16_t*)(c.ws + B_H);
    for (int m = c.gw; m < M; m += c.ngw) { float xv[16], h[16]; ld_f32(in_row(p, m), c.lane, xv); const float* mr = mod_row(c.ws, 0, m);
        normmod16(xv, h, p.ev_norm_g, mr, mr + D, c.lane); st_bf16(H + (size_t)m * D, c.lane, h); }
}
__device__ __forceinline__ void phase_even_elem(const P& p, const Ctx& c) {
    const bf16_t* Z = (const bf16_t*)(c.ws + B_Z); bf16_t* AO = (bf16_t*)(c.ws + B_AOUT0); bf16_t* ZQ = (bf16_t*)(c.ws + B_ZQN); bf16_t* ZKV = (bf16_t*)(c.ws + B_ZKVN); bf16_t* KPE = (bf16_t*)(c.ws + B_KPE);
    const float* rc = (const float*)(c.ws + WS_ROPE); const float* rs = rc + 2048 * 32; const int lane = c.lane;
    for (int m = c.gw; m < M; m += c.ngw) {
        const int j = m % S; const int lo = j < L ? 0 : L, hi = j < L ? L : S; const bf16_t* zr = Z + (size_t)m * 2304;
        {
            float bg[8], acc[8]; unpack8(*(const u32x4*)(zr + 8 * lane), bg);
#pragma unroll
            for (int i = 0; i < 8; ++i) acc[i] = 0.f;
#pragma unroll
            for (int dt = -1; dt <= 1; ++dt) { const int jj = j + dt; if (jj < lo || jj >= hi) continue; const bf16_t* zn = zr + (long)dt * 2304; float cg[8], uu[8], w[8];
                unpack8(*(const u32x4*)(zn + SCW + 8 * lane), cg); unpack8(*(const u32x4*)(zn + 2 * SCW + 8 * lane), uu);
                const f32x4 w0 = *(const f32x4*)(p.ev_conv_w + (dt + 1) * SCW + 8 * lane), w1 = *(const f32x4*)(p.ev_conv_w + (dt + 1) * SCW + 8 * lane + 4);
#pragma unroll
                for (int i = 0; i < 4; ++i) { w[i] = w0[i]; w[4 + i] = w1[i]; }
#pragma unroll
                for (int i = 0; i < 8; ++i) acc[i] += w[i] * (cg[i] * uu[i]); }
#pragma unroll
            for (int i = 0; i < 8; ++i) acc[i] *= bg[i];
            *(u32x4*)(AO + (size_t)m * D + 8 * lane) = pack8f(acc); }
        {
            float v[8]; float s = 0.f;
            if (lane < 48) { unpack8(*(const u32x4*)(zr + SCIN + 8 * lane), v);
#pragma unroll
                for (int i = 0; i < 8; ++i) s += v[i] * v[i]; }
            s = wave_sum(s); const float r = 1.0f / sqrtf(s * (1.f / QRANK) + EPS);
            if (lane < 48) { const f32x4 g0 = *(const f32x4*)(p.ev_q_norm_g + 8 * lane), g1 = *(const f32x4*)(p.ev_q_norm_g + 8 * lane + 4);
#pragma unroll
                for (int i = 0; i < 4; ++i) { v[i] *= r * g0[i]; v[4 + i] *= r * g1[i]; }
                *(u32x4*)(ZQ + (size_t)m * QRANK + 8 * lane) = pack8f(v); } }
        {
            float v[8]; float s = 0.f;
            if (lane < 32) { unpack8(*(const u32x4*)(zr + SCIN + QRANK + 8 * lane), v);
#pragma unroll
                for (int i = 0; i < 8; ++i) s += v[i] * v[i]; }
            s = wave_sum(s); const float r = 1.0f / sqrtf(s * (1.f / KVRANK) + EPS);
            if (lane < 32) { const f32x4 g0 = *(const f32x4*)(p.ev_kv_norm_g + 8 * lane), g1 = *(const f32x4*)(p.ev_kv_norm_g + 8 * lane + 4);
#pragma unroll
                for (int i = 0; i < 4; ++i) { v[i] *= r * g0[i]; v[4 + i] *= r * g1[i]; }
                *(u32x4*)(ZKV + (size_t)m * KVRANK + 8 * lane) = pack8f(v); } }
        if (lane < 32) {
            const bf16_t* kp = zr + SCIN + QRANK + KVRANK; const float k1 = bf2f(kp[lane]), k2 = bf2f(kp[32 + lane]); float cs = 1.f, sn = 0.f;
            if (j >= L) { cs = rc[(j - L) * 32 + lane]; sn = rs[(j - L) * 32 + lane]; }
            bf16_t* ko = KPE + (size_t)m * 64; ko[rope_pos(lane)] = f2bf(k1 * cs - k2 * sn); ko[rope_pos(32 + lane)] = f2bf(k1 * sn + k2 * cs); }
    }
}
__device__ __forceinline__ void phase_mid0(const P& p, const Ctx& c) {
    const bf16_t* Y = (const bf16_t*)(c.ws + B_Y); bf16_t* H2 = (bf16_t*)(c.ws + B_H2);
    for (int m = c.gw; m < M; m += c.ngw) { float xv[16], y[16], h[16]; ld_f32(in_row(p, m), c.lane, xv); ld_bf16(Y + (size_t)m * D, c.lane, y); const float* mr = mod_row(c.ws, 0, m);
        resid16(xv, y, p.ev_norm_g + D, mr + 2 * D, c.lane); st_f32(stream_row(p, c.ws, m), c.lane, xv);
        normmod16(xv, h, p.ev_norm_g + 2 * D, mr + 3 * D, mr + 4 * D, c.lane); st_bf16(H2 + (size_t)m * D, c.lane, h); }
}
__device__ __forceinline__ void phase_end0(const P& p, const Ctx& c) {
    const bf16_t* F = (const bf16_t*)(c.ws + B_F); bf16_t* H = (bf16_t*)(c.ws + B_H1);
    for (int m = c.gw; m < M; m += c.ngw) { float xv[16], y[16], h[16]; float* sr = stream_row(p, c.ws, m); ld_f32(sr, c.lane, xv); ld_bf16(F + (size_t)m * D, c.lane, y);
        const float* mr = mod_row(c.ws, 0, m); resid16(xv, y, p.ev_norm_g + 3 * D, mr + 5 * D, c.lane);
        if ((m % S) >= L) st_f32(sr, c.lane, xv);
        const float* mr1 = mod_row(c.ws, 1, m); normmod16(xv, h, p.od_norm_g, mr1, mr1 + D, c.lane); st_bf16(H + (size_t)m * D, c.lane, h); }
}
__device__ __forceinline__ void phase_mid1(const P& p, const Ctx& c) {
    const bf16_t* Y = (const bf16_t*)(c.ws + B_Y1); bf16_t* H2 = (bf16_t*)(c.ws + B_H2TOK);
    int* rinfo = (int*)(c.ws + RT_INFO); float* rw = (float*)(c.ws + RT_W); int* wcnt = (int*)(c.ws + RT_WCNT);
    volatile LAS int* wc = (volatile LAS int*)(c.lds) + c.wave * 8; const int lane = c.lane;
    for (int ch = blockIdx.x; ch < NCH; ch += gridDim.x) {
        if (lane < 8) wc[lane] = 0;
        for (int i = 0; i < 32; ++i) {
            const int tok = ch * 256 + c.wave * 32 + i; const int b = tok / T, t = tok % T; const int m = b * S + L + t;
            float xv[16], y[16], h[16]; float* orow = p.out + (size_t)tok * D; ld_f32(orow, lane, xv); ld_bf16(Y + (size_t)m * D, lane, y);
            const float* mr = (const float*)(c.ws + WS_MODV) + ((size_t)33 + b) * 6144;
            resid16(xv, y, p.od_norm_g + D, mr + 2 * D, lane); st_f32(orow, lane, xv);
            normmod16(xv, h, p.od_norm_g + 2 * D, mr + 3 * D, mr + 4 * D, lane); st_bf16(H2 + (size_t)tok * D, lane, h);
            float lg[NE];
#pragma unroll
            for (int e = 0; e < NE; ++e) lg[e] = 0.f;
#pragma unroll
            for (int j2 = 0; j2 < 2; ++j2)
#pragma unroll
                for (int i8 = 0; i8 < 8; ++i8) { const float* rr = p.od_router + (size_t)(512 * j2 + 8 * lane + i8) * NE; const f32x4 r0 = *(const f32x4*)rr, r1 = *(const f32x4*)(rr + 4); const float hv = h[j2 * 8 + i8];
#pragma unroll
                    for (int e = 0; e < 4; ++e) { lg[e] = fmaf(hv, r0[e], lg[e]); lg[4 + e] = fmaf(hv, r1[e], lg[4 + e]); } }
#pragma unroll
            for (int e = 0; e < NE; ++e) lg[e] = wave_sum(lg[e]);
            int e0 = 0; float v0 = lg[0];
#pragma unroll
            for (int e = 1; e < NE; ++e) if (lg[e] > v0) { v0 = lg[e]; e0 = e; }
            int e1 = -1; float v1 = -3.0e38f;
#pragma unroll
            for (int e = 0; e < NE; ++e) if (e != e0 && lg[e] > v1) { v1 = lg[e]; e1 = e; }
            const float p1 = expf(v1 - v0), w0 = 1.f / (1.f + p1), w1 = p1 / (1.f + p1);
            if (lane == 0) { const int r0 = wc[e0], r1 = wc[e1]; wc[e0] = r0 + 1; wc[e1] = r1 + 1;
                *(int4*)(rinfo + (size_t)tok * 4) = make_int4(e0, e1, r0, r1); *(float2*)(rw + (size_t)tok * 2) = make_float2(w0, w1); }
        }
        asm volatile("s_waitcnt lgkmcnt(0)" ::: "memory");
        if (lane < 8) wcnt[(ch * 8 + c.wave) * 8 + lane] = wc[lane];
    }
}
__device__ __forceinline__ void phase_gather(const P& p, const Ctx& c) {
    const int* rinfo = (const int*)(c.ws + RT_INFO); const int* wcnt = (const int*)(c.ws + RT_WCNT); int* tpos = (int*)(c.ws + RT_POS); int* toffg = (int*)(c.ws + RT_TOFF);
    const bf16_t* H2 = (const bf16_t*)(c.ws + B_H2TOK); bf16_t* HS = (bf16_t*)(c.ws + B_H2S);
    LAS int* wpre = (LAS int*)c.lds;
    LAS int* csum = wpre + NCH * 64;
    LAS int* cpre = csum + NCH * 8;
    LAS int* eoff = cpre + NCH * 8;
    for (int i = c.tid; i < NCH * 8; i += 512) { const int ch = i >> 3, e = i & 7; int run = 0;
        for (int w = 0; w < 8; ++w) { wpre[(ch * 8 + w) * 8 + e] = run; run += wcnt[(ch * 8 + w) * 8 + e]; }
        csum[i] = run; }
    __syncthreads();
    if (c.tid < 8) { int run = 0; for (int ch = 0; ch < NCH; ++ch) { cpre[ch * 8 + c.tid] = run; run += csum[ch * 8 + c.tid]; } eoff[16 + c.tid] = run; }
    __syncthreads();
    if (c.tid == 0) { int o = 0; for (int e = 0; e < NE; ++e) { eoff[e] = o; o += (eoff[16 + e] + 255) & ~255; } eoff[NE] = o;
        if (blockIdx.x == 0) { for (int e = 0; e <= NE; ++e) toffg[e] = eoff[e] >> 8; } }
    __syncthreads();
    for (int tok = c.gw; tok < ML; tok += c.ngw) {
        const int4 ri = *(const int4*)(rinfo + (size_t)tok * 4); const int ch = tok >> 8, w = (tok >> 5) & 7;
        const int p0 = eoff[ri.x] + cpre[ch * 8 + ri.x] + wpre[(ch * 8 + w) * 8 + ri.x] + ri.z, p1 = eoff[ri.y] + cpre[ch * 8 + ri.y] + wpre[(ch * 8 + w) * 8 + ri.y] + ri.w;
        if (c.lane == 0) *(int2*)(tpos + (size_t)tok * 2) = make_int2(p0, p1);
        const u32x4 a = *(const u32x4*)(H2 + (size_t)tok * D + 8 * c.lane), b = *(const u32x4*)(H2 + (size_t)tok * D + 512 + 8 * c.lane);
        *(u32x4*)(HS + (size_t)p0 * D + 8 * c.lane) = a; *(u32x4*)(HS + (size_t)p0 * D + 512 + 8 * c.lane) = b;
        *(u32x4*)(HS + (size_t)p1 * D + 8 * c.lane) = a; *(u32x4*)(HS + (size_t)p1 * D + 512 + 8 * c.lane) = b;
    }
    for (int i = c.gw; i < NE * 256; i += c.ngw) { const int e = i >> 8, r = i & 255; const int n = eoff[16 + e], pad = ((n + 255) & ~255) - n;
        if (r < pad) { const u32x4 z = {0u, 0u, 0u, 0u}; bf16_t* row = HS + (size_t)(eoff[e] + n + r) * D; *(u32x4*)(row + 8 * c.lane) = z; *(u32x4*)(row + 512 + 8 * c.lane) = z; } }
}
__device__ __forceinline__ void phase_final(const P& p, const Ctx& c) {
    const bf16_t* FS = (const bf16_t*)(c.ws + B_H2S); const int* tpos = (const int*)(c.ws + RT_POS); const float* rw = (const float*)(c.ws + RT_W);
    for (int tok = c.gw; tok < ML; tok += c.ngw) { const int b = tok / T; const int2 ps = *(const int2*)(tpos + (size_t)tok * 2); const float2 w = *(const float2*)(rw + (size_t)tok * 2);
        float xv[16], f0[16], f1[16]; float* orow = p.out + (size_t)tok * D; ld_f32(orow, c.lane, xv); ld_bf16(FS + (size_t)ps.x * D, c.lane, f0); ld_bf16(FS + (size_t)ps.y * D, c.lane, f1);
#pragma unroll
        for (int i = 0; i < 16; ++i) f0[i] = w.x * f0[i] + w.y * f1[i];
        const float* mr = (const float*)(c.ws + WS_MODV) + ((size_t)33 + b) * 6144;
        resid16(xv, f0, p.od_norm_g + 3 * D, mr + 5 * D, c.lane); st_f32(orow, c.lane, xv); }
}
constexpr int LDS_BYTES = 147456;
constexpr int LDS_MISC = 131072 + 2048;
constexpr int NPH = 21;

__device__ __forceinline__ void attn_mla_phase(const Ctx& c) {
    const bf16_t* Q0 = (const bf16_t*)(c.ws + B_Q0); const bf16_t* KN = (const bf16_t*)(c.ws + B_K0N); const bf16_t* KPE = (const bf16_t*)(c.ws + B_KPE); const bf16_t* V0 = (const bf16_t*)(c.ws + B_V0);
    bf16_t* AO = (bf16_t*)(c.ws + B_AOUT0);
    constexpr int NU_LAT = NB * MLA_H * 8, NU = NU_LAT + NB * MLA_H;
#pragma unroll 1
    for (int u = blockIdx.x; u < NU; u += gridDim.x) {
        int b, h, row0, seq;
        if (u < NU_LAT) { b = u / 32; h = (u >> 3) & 3; row0 = b * S + L + (u & 7) * 256; seq = S; } else { const int v = u - NU_LAT; b = v >> 2; h = v & 3; row0 = b * S; seq = L; }
        const att::KSrc ks{KN + (size_t)b * S * 512 + h * 128, 512, KPE + (size_t)b * S * 64, 64};
        const att::AOut ao{AO + (size_t)row0 * D + SCW + h * 128, D, nullptr, nullptr, 0.f, 0};
        att::attn_body_np<192>(Q0 + (size_t)row0 * 768 + h * MLA_QK, 768, ks, V0 + (size_t)b * S * 512 + h * 128, 512, seq, (char*)c.lds, ao);
    }
}
__device__ __forceinline__ void attn_diff_phase(const P& p, const Ctx& c) {
    const bf16_t* Q1 = (const bf16_t*)(c.ws + B_QKV1); const bf16_t* K1 = Q1 + (size_t)M * 768; const bf16_t* V1 = K1 + (size_t)M * 768; bf16_t* AO = (bf16_t*)(c.ws + B_AOUT1);
    float* stash = (float*)(c.ws + WS_STASH) + (size_t)blockIdx.x * 32768;
    float d01 = p.od_lambda[c.lane] * p.od_lambda[64 + c.lane], d23 = p.od_lambda[128 + c.lane] * p.od_lambda[192 + c.lane];
    d01 = wave_sum(d01); d23 = wave_sum(d23); const float lam = expf(d01) - expf(d23) + LAM_INIT;
    constexpr int NU = NB * DIFF_H * 8;
#pragma unroll 1
    for (int i2 = 2 * blockIdx.x; i2 < 2 * NU; i2 = (i2 & 1) ? i2 + 2 * (int)gridDim.x - 1 : i2 + 1) {
        const int it = i2 >> 1, sub = i2 & 1; const int b = it / 48, h = (it >> 3) % 6, row0 = b * S + L + (it & 7) * 256;
        const att::KSrc ks{K1 + (size_t)b * S * 768 + h * 128 + sub * 64, 768, nullptr, 0};
        const att::AOut ao{AO + (size_t)row0 * D + h * 128, D, stash, p.od_subln_g, lam, sub};
        att::attn_body<64, 2, 1>(Q1 + (size_t)row0 * 768 + h * 128 + sub * 64, 768, ks, V1 + (size_t)b * S * 768 + h * 128, 768, S, (char*)c.lds, ao);
    }
}
__device__ __forceinline__ void moe_load_toff(const Ctx& c, pg8::SchedMoe& Sm) {
    const int* toffg = (const int*)(c.ws + RT_TOFF);
#pragma unroll
    for (int e = 0; e <= NE; ++e) Sm.toff[e] = __builtin_amdgcn_readfirstlane(toffg[e]);
}

__global__ void __launch_bounds__(512, 2) fwd(P p) {
    extern __shared__ __attribute__((aligned(16))) unsigned char lds_[];
    Ctx c; c.lds = (LAS unsigned char*)lds_; c.ws = p.ws; c.tid = threadIdx.x; c.lane = c.tid & 63; c.wave = __builtin_amdgcn_readfirstlane(c.tid >> 6);
    c.gw = blockIdx.x * 8 + c.wave; c.ngw = gridDim.x * 8;
    volatile LAS unsigned* misc = (volatile LAS unsigned*)(c.lds + LDS_MISC);
    if (c.tid < 8) misc[c.tid] = 0u;
    __syncthreads();
    const int lo = p.ph_lo, hi = p.ph_hi;
    XcdBarrier bar; bar.bar = (unsigned*)(c.ws + WS_CTL) + CW_BAR; bar.x = 0; bar.st = misc;
    if (hi - lo > 1) bar = xcd_barrier_post((unsigned*)(c.ws + WS_CTL) + CW_BAR, misc);
#ifdef PH_ONLY
#define IN(k) ((k) == PH_ONLY)
#else
#define IN(k) (lo <= (k) && (k) < hi)
#endif
#define SEAM(k) do { if (IN(k) && IN((k) + 1)) xcd_barrier(bar); } while (0)
    LAS unsigned char* lds = c.lds;
    const float* rc = (const float*)(c.ws + WS_ROPE); const float* rs = rc + 2048 * 32;

    if (IN(0)) { phase_prologue(p, c); } SEAM(0);
    if (IN(1)) { phase_norm0(p, c); } SEAM(1);
    if (IN(2)) { pg8::Gemm g{D, D, D}; pg8::SchedPlain Sc; Sc.init(c.ws + B_H, D, c.ws + W_IN0, D, M / 256, 9, false); pg8::EpiPlain E{(bf16_t*)(c.ws + B_Z), 2304};
        pg8::gemm_phase(lds, g, Sc, E); } SEAM(2);
    if (IN(3)) { phase_even_elem(p, c); } SEAM(3);
    if (IN(4)) {
        { pg8::Gemm g{QRANK, QRANK, QRANK}; pg8::SchedPlain Sc; Sc.init(c.ws + B_ZQN, QRANK, c.ws + W_UQ, QRANK, M / 256, 3, false); pg8::EpiQ0 E{(bf16_t*)(c.ws + B_Q0), rc, rs}; pg8::gemm_phase(lds, g, Sc, E); }
        { pg8::Gemm g{KVRANK, KVRANK, KVRANK}; pg8::SchedPlain Sc; Sc.init(c.ws + B_ZKVN, KVRANK, c.ws + W_UKV, KVRANK, M / 256, 4, false); pg8::EpiKV0 E{(bf16_t*)(c.ws + B_K0N), (bf16_t*)(c.ws + B_V0)}; pg8::gemm_phase(lds, g, Sc, E); }
    } SEAM(4);
    if (IN(5)) { attn_mla_phase(c); } SEAM(5);
    if (IN(6)) { pg8::Gemm g{D, D, D}; pg8::SchedPlain Sc; Sc.init(c.ws + B_AOUT0, D, c.ws + W_OUT0, D, M / 256, 4, false); pg8::EpiPlain E{(bf16_t*)(c.ws + B_Y), D}; pg8::gemm_phase(lds, g, Sc, E); } SEAM(6);
    if (IN(7)) { phase_mid0(p, c); } SEAM(7);
    if (IN(8)) { pg8::Gemm g{D, D, D}; pg8::SchedPlain Sc; Sc.init(c.ws + B_H2, D, c.ws + W_GU0, D, M / 256, 22, false); pg8::EpiSwiglu E{(bf16_t*)(c.ws + B_ACT), FF}; pg8::gemm_phase(lds, g, Sc, E); } SEAM(8);
    if (IN(9)) { pg8::Gemm g{FF, FF, FF}; pg8::SchedPlain Sc; Sc.init(c.ws + B_ACT, FF, c.ws + W_DN0, FF, M / 256, 4, false); pg8::EpiPlain E{(bf16_t*)(c.ws + B_F), D}; pg8::gemm_phase(lds, g, Sc, E); } SEAM(9);
    if (IN(10)) { phase_end0(p, c); } SEAM(10);
    if (IN(11)) {
        { pg8::Gemm g{D, D, D}; pg8::SchedPlain Sc; Sc.init(c.ws + B_H1, D, c.ws + W_IN1, D, M / 256, 9, false); pg8::EpiQKV1 E{(bf16_t*)(c.ws + B_QKV1), (size_t)M * 768, rc, rs}; pg8::gemm_phase(lds, g, Sc, E); }
        { pg8::Gemm g{D, D, D}; pg8::SchedF1 Sc{(const char*)(c.ws + W_FOLD), (const char*)(c.ws + B_H1), NB * 8, (int)gridDim.x, (int)blockIdx.x}; pg8::EpiGT E{(bf16_t*)(c.ws + B_GT)}; pg8::gemm_phase(lds, g, Sc, E); }
    } SEAM(11);
    if (IN(12)) {
        { pg8::Gemm g{4096, 4096, 4096}; pg8::SchedF2 Sc{(const char*)(c.ws + W_DFT), (const char*)(c.ws + B_GT), (int)gridDim.x, (int)blockIdx.x}; pg8::EpiPlain E{(bf16_t*)(c.ws + B_AOUT1) + DIFFW, D}; pg8::gemm_phase(lds, g, Sc, E); }
        attn_diff_phase(p, c);
    } SEAM(12);
    if (IN(13)) { pg8::Gemm g{D, D, D}; pg8::SchedPlain Sc; Sc.init(c.ws + B_AOUT1, D, c.ws + W_OUT1, D, NB * 8, 4, true); pg8::EpiPlain E{(bf16_t*)(c.ws + B_Y1), D}; pg8::gemm_phase(lds, g, Sc, E); } SEAM(13);
    if (IN(14)) { phase_mid1(p, c); } SEAM(14);
    if (IN(15)) { phase_gather(p, c); } SEAM(15);
#pragma unroll 1
    for (int ck = 0; ck < 2; ++ck) {
        if (IN(16 + 2 * ck)) { pg8::SchedMoe Sm; moe_load_toff(c, Sm); const int t0 = ck * TCH; int nT = Sm.toff[NE] - t0; nT = nT < 0 ? 0 : (nT > TCH ? TCH : nT);
            Sm.A = (const char*)(c.ws + B_H2S); Sm.W = (const char*)(c.ws + W_GU1); Sm.at = (size_t)256 * D * 2; Sm.bt = (size_t)256 * D * 2; Sm.estride = (size_t)5632 * 1024 * 2; Sm.t0 = t0; Sm.nT = nT; Sm.nN = 22; Sm.G = gridDim.x; Sm.c = blockIdx.x;
            pg8::Gemm g{D, D, D}; pg8::EpiSwiglu E{(bf16_t*)(c.ws + B_ACTM) - (size_t)t0 * 256 * FF, FF}; pg8::gemm_phase(lds, g, Sm, E); }
        SEAM(16 + 2 * ck);
        if (IN(17 + 2 * ck)) { pg8::SchedMoe Sm; moe_load_toff(c, Sm); const int t0 = ck * TCH; int nT = Sm.toff[NE] - t0; nT = nT < 0 ? 0 : (nT > TCH ? TCH : nT);
            Sm.A = (const char*)(c.ws + B_ACTM) - (size_t)t0 * 256 * FF * 2; Sm.W = (const char*)(c.ws + W_DN1); Sm.at = (size_t)256 * FF * 2; Sm.bt = (size_t)256 * FF * 2; Sm.estride = (size_t)1024 * 2816 * 2; Sm.t0 = t0; Sm.nT = nT; Sm.nN = 4; Sm.G = gridDim.x; Sm.c = blockIdx.x;
            pg8::Gemm g{FF, FF, FF}; pg8::EpiPlain E{(bf16_t*)(c.ws + B_H2S), D}; pg8::gemm_phase(lds, g, Sm, E); }
        SEAM(17 + 2 * ck);
    }
    if (IN(20)) { phase_final(p, c); }
#undef IN
#undef SEAM
}
}
#ifndef CHECK_MODE
#define CHECK_MODE 0
#endif
#ifndef ONE_LAUNCH
#define ONE_LAUNCH 1
#endif

static fp::P make_params(void* const* d_in, void* d_out, void* d_ws) {
    fp::P p{}; const float** q = (const float**)&p; for (int i = 0; i < 28; ++i) q[i] = (const float*)d_in[i];
    p.out = (float*)d_out; p.ws = (unsigned char*)d_ws; p.ph_lo = 0; p.ph_hi = fp::NPH; return p;
}
static int fast_grid() {
    static int grid = 0;
    if (grid == 0) {
        int dev = 0, cus = 0;
        if (hipGetDevice(&dev) != hipSuccess || hipDeviceGetAttribute(&cus, hipDeviceAttributeMultiprocessorCount, dev) != hipSuccess) { grid = -1; return grid; }
        if (hipFuncSetAttribute((const void*)fp::fwd, hipFuncAttributeMaxDynamicSharedMemorySize, fp::LDS_BYTES) != hipSuccess) { grid = -1; return grid; }
        int per_cu = 0; (void)hipOccupancyMaxActiveBlocksPerMultiprocessor(&per_cu, (const void*)fp::fwd, 512, fp::LDS_BYTES); (void)hipGetLastError();
        if (per_cu < 1) fprintf(stderr, "occupancy query reports %d blocks per CU\n", per_cu);
        grid = cus > 256 ? 256 : cus;
    }
    return grid;
}
static void fast_forward(void* const* d_in, void* d_out, void* d_ws, hipStream_t stream, int ph_end, bool one_launch) {
    const int grid = fast_grid(); if (grid <= 0) return;
    (void)hipMemsetAsync((char*)d_ws + fp::WS_CTL, 0, fp::CTL_BYTES, stream);
    fp::P p = make_params(d_in, d_out, d_ws);
    if (one_launch) { p.ph_lo = 0; p.ph_hi = ph_end; hipLaunchKernelGGL(fp::fwd, dim3(grid), dim3(512), fp::LDS_BYTES, stream, p); }
    else for (int k = 0; k < ph_end; ++k) { p.ph_lo = k; p.ph_hi = k + 1; hipLaunchKernelGGL(fp::fwd, dim3(grid), dim3(512), fp::LDS_BYTES, stream, p); }
}

#if CHECK_MODE
namespace chk {
using namespace cfg;
__device__ __forceinline__ int rope_pos(int e) { return e < 32 ? 8 * (e >> 2) + (e & 3) : 8 * ((e - 32) >> 2) + 4 + (e & 3); }
__global__ void k_cmp(const void* fast, int fast_bf16, int ldf, int fcol0, const float* ref, int ldr, int rcol0, int rows, int cols, int rowmode, int perm, float* acc) {
    float sd = 0.f, sr = 0.f;
    for (long i = (long)blockIdx.x * 256 + threadIdx.x; i < (long)rows * cols; i += (long)gridDim.x * 256) {
        const int r = (int)(i / cols), ci = (int)(i % cols); int rr = r, fr = r;
        if (rowmode == 1 && (r % S) < L) continue;
        if (rowmode == 3 && (r % S) >= L) continue;
        if (rowmode == 2) { rr = (r / T) * S + L + (r % T); }
        int fc = ci;
        if (perm == 1) { const int h = ci / 192, w = ci % 192; fc = w < 128 ? ci : h * 192 + 128 + rope_pos(w - 128); }
        if (perm == 2) { fc = (ci & ~63) + rope_pos(ci & 63); }
        if (perm == 3) { fc = rope_pos(ci); }
        const float rv = ref[(long)rr * ldr + rcol0 + ci];
        const float fv = fast_bf16 ? __uint_as_float(((unsigned)((const unsigned short*)fast)[(long)fr * ldf + fcol0 + fc]) << 16) : ((const float*)fast)[(long)fr * ldf + fcol0 + fc];
        const float d = fv - rv; sd += d * d; sr += rv * rv;
    }
    for (int o = 32; o >= 1; o >>= 1) { sd += __shfl_xor(sd, o); sr += __shfl_xor(sr, o); }
    if ((threadIdx.x & 63) == 0) { atomicAdd(acc, sd); atomicAdd(acc + 1, sr); }
}
__global__ void k_cmp_gt(const unsigned short* gt, const float* gcs, int nb, float* acc) {
    float sd = 0.f, sr = 0.f;
    for (long i = (long)blockIdx.x * 256 + threadIdx.x; i < (long)nb * 2 * T * 256; i += (long)gridDim.x * 256) {
        const int c = (int)(i % 256); const int t = (int)((i / 256) % T); const int part = (int)((i / (256L * T)) % 2); const int b = (int)(i / (256L * T * 2));
        const float rv = gcs[i]; const float fv = __uint_as_float(((unsigned)gt[(((long)b * 256 + c) * 2 + part) * T + t]) << 16);
        const float d = fv - rv; sd += d * d; sr += rv * rv; }
    for (int o = 32; o >= 1; o >>= 1) { sd += __shfl_xor(sd, o); sr += __shfl_xor(sr, o); }
    if ((threadIdx.x & 63) == 0) { atomicAdd(acc, sd); atomicAdd(acc + 1, sr); }
}
__global__ void k_encode(const float* acc, int nchecks, float tol, const float* x, float* out, long n) {
    int code = 0;
    for (int k = 0; k < nchecks; ++k) { const float sd = acc[2 * k], sr = acc[2 * k + 1]; if (!(sd <= tol * sr) || !(sr > 0.f)) { code = k + 1; break; } }
    const float s = 1.f + (float)code;
    for (long i = (long)blockIdx.x * 256 + threadIdx.x; i < n; i += (long)gridDim.x * 256) out[i] = x[i] * s;
}
}
#endif

extern "C" void kernel_launch(void* const* d_in, const int* in_sizes, int n_in, void* d_out, int out_size, void* d_ws, size_t ws_size, hipStream_t stream) {
    (void)in_sizes; (void)n_in; (void)out_size;
#if CHECK_MODE
    using namespace cfg; using fp::M; using fp::ML;
    const nv::In I = nv::make_in(d_in);
    nv::Scratch s; char* nbase = (char*)d_ws + ((fp::AR_END + 4095) / 4096) * 4096;
    size_t need = nv::Scratch::carve(s, nbase, NB);
    float* snap0 = (float*)(nbase + need); need += (size_t)M * D * 4;
    float* snap1 = (float*)(nbase + need); need += (size_t)M * D * 4;
    float* snap2 = (float*)(nbase + need); need += (size_t)M * D * 4;
    float* acc = (float*)(nbase + need); need += 4096;
    if ((size_t)(nbase - (char*)d_ws) + need > ws_size) { fprintf(stderr, "check build: ws too small\n"); return; }
    nv::global_setup(stream, I, s);
    nv::forward_chunk(stream, I, s, 0, NB, nullptr, CHECK_MODE == 1 ? 3 : 7, snap0, snap1, snap2);
    fast_forward(d_in, d_out, d_ws, stream, CHECK_MODE == 1 ? 10 : fp::NPH, ONE_LAUNCH != 0);
    (void)hipMemsetAsync(acc, 0, 4096, stream);
    unsigned char* ws = (unsigned char*)d_ws; int k = 0;
#define CMP(fast, isbf, ldf, fc0, ref, ldr, rc0, rows, cols, rowmode, perm) do { hipLaunchKernelGGL(chk::k_cmp, dim3(512), dim3(256), 0, stream, (const void*)(fast), isbf, ldf, fc0, ref, ldr, rc0, rows, cols, rowmode, perm, acc + 2 * k); ++k; } while (0)
#if CHECK_MODE == 1
    CMP(ws + fp::WS_MODV, 0, 6144, 0, s.mod0, 6144, 0, 33, 6144, 0, 0);
    CMP(ws + fp::WS_MODV + (size_t)33 * 6144 * 4, 0, 6144, 0, s.mod1, 6144, 0, 33, 6144, 0, 0);
    CMP(ws + fp::B_H, 1, D, 0, snap0, D, 0, M, D, 0, 0);
    CMP(ws + fp::B_Z, 1, 2304, 0, s.z, EVEN_IN, 0, M, EVEN_IN, 0, 0);
    CMP(ws + fp::B_AOUT0, 1, D, 0, s.aout, D, 0, M, SCW, 0, 0);
    CMP(ws + fp::B_ZQN, 1, QRANK, 0, s.zqn, QRANK, 0, M, QRANK, 0, 0);
    CMP(ws + fp::B_ZKVN, 1, KVRANK, 0, s.zkvn, KVRANK, 0, M, KVRANK, 0, 0);
    CMP(ws + fp::B_KPE, 1, 64, 0, s.Kf, 768, 128, M, 64, 0, 3);
    CMP(ws + fp::B_Q0, 1, 768, 0, s.Qf, 768, 0, M, 768, 0, 1);
    for (int h = 0; h < 4; ++h) CMP(ws + fp::B_K0N, 1, 512, h * 128, s.Kf, 768, h * 192, M, 128, 0, 0);
    CMP(ws + fp::B_V0, 1, 512, 0, s.Vf, 512, 0, M, 512, 0, 0);
    CMP(ws + fp::B_AOUT0, 1, D, SCW, s.aout, D, SCW, M, 512, 1, 0);
    CMP(ws + fp::B_AOUT0, 1, D, SCW, s.aout, D, SCW, M, 512, 3, 0);
    CMP(ws + fp::B_Y, 1, D, 0, s.y, D, 0, M, D, 0, 0);
    CMP(d_out, 0, D, 0, s.xs, D, 0, ML, D, 2, 0);
    CMP(ws + fp::B_H2, 1, D, 0, s.h, D, 0, M, D, 0, 0);
    CMP(ws + fp::B_ACT, 1, FF, 0, s.act, FF, 0, M, FF, 0, 0);
    CMP(ws + fp::B_F, 1, D, 0, s.f, D, 0, M, D, 0, 0);
#else
    CMP(ws + fp::B_H1, 1, D, 0, snap1, D, 0, M, D, 0, 0);
    CMP(ws + fp::B_QKV1, 1, 768, 0, s.Qf, 768, 0, M, 768, 0, 2);
    CMP(ws + fp::B_QKV1 + (size_t)M * 1536, 1, 768, 0, s.Kf, 768, 0, M, 768, 0, 2);
    CMP(ws + fp::B_QKV1 + (size_t)M * 3072, 1, 768, 0, s.z, ODD_IN, 2 * DIFFW, M, 768, 0, 0);
    hipLaunchKernelGGL(chk::k_cmp_gt, dim3(512), dim3(256), 0, stream, (const unsigned short*)(ws + fp::B_GT), s.gcs, NB, acc + 2 * k); ++k;
    CMP(ws + fp::B_AOUT1, 1, D, DIFFW, s.aout, D, DIFFW, M, FNW, 1, 0);
    CMP(ws + fp::B_AOUT1, 1, D, 0, s.aout, D, 0, M, DIFFW, 1, 0);
    CMP(ws + fp::B_Y1, 1, D, 0, s.y, D, 0, M, D, 1, 0);
    CMP(ws + fp::B_H2TOK, 1, D, 0, s.h, D, 0, ML, D, 2, 0);
    CMP(d_out, 0, D, 0, s.xs, D, 0, ML, D, 2, 0);
#endif
#undef CMP
    hipLaunchKernelGGL(chk::k_encode, dim3(2048), dim3(256), 0, stream, acc, k, 2e-3f, (const float*)d_in[0], (float*)d_out, (long)FULLB * T * D);
#else
    if (ws_size < fp::AR_END) { fprintf(stderr, "kernel_launch: workspace too small: need %zu have %zu\n", (size_t)fp::AR_END, ws_size); return; }
    fast_forward(d_in, d_out, d_ws, stream, fp::NPH, ONE_LAUNCH != 0);
#endif
}
```

```cpp
#define ONE_LAUNCH 1
#include <hip/hip_runtime.h>
#include <cstdio>
#include <cstdint>
#include <cmath>

#ifndef CFG_NB
#define CFG_NB 32
#endif
namespace cfg {
constexpr int NB = CFG_NB;
constexpr int FULLB = 32;
constexpr int D = 1024, T = 2048, L = 256, S = T + L;
constexpr int GW = 64;
constexpr float EPS = 1e-6f;
constexpr int SCW = 512, SCIN = 1536;
constexpr int MLA_H = 4, MLA_NOPE = 128, MLA_ROPE = 64, MLA_V = 128, MLA_QK = 192, QRANK = 384, KVRANK = 256;
constexpr int EVEN_IN = 2240;
constexpr int DIFFW = 768, DIFF_H = 6, DIFF_HD = 64;
constexpr int FNW = 256, FNG = 4, FNGD = 64, ODD_IN = 2560;
constexpr int FF = 2816, NE = 8;
constexpr float LAM_INIT = 0.35550906759096944f;
}
namespace fp {
using namespace cfg;
#define LAS __attribute__((address_space(3)))
#define GAS __attribute__((address_space(1)))
typedef unsigned short bf16_t;
typedef short bf16x8 __attribute__((ext_vector_type(8)));
typedef short s16x4 __attribute__((ext_vector_type(4)));
typedef float f32x4 __attribute__((ext_vector_type(4)));
typedef float f32x2 __attribute__((ext_vector_type(2)));
typedef float f32x16 __attribute__((ext_vector_type(16)));
typedef unsigned u32x4 __attribute__((ext_vector_type(4)));
typedef unsigned u32x2 __attribute__((ext_vector_type(2)));

__device__ __forceinline__ unsigned cvt_pk_bf16(float lo, float hi) { unsigned r; asm volatile("v_cvt_pk_bf16_f32 %0, %1, %2" : "=v"(r) : "v"(lo), "v"(hi)); return r; }
__device__ __forceinline__ float bf2f(unsigned short b) { return __uint_as_float(((unsigned)b) << 16); }
__device__ __forceinline__ float bflo(unsigned w) { return __uint_as_float(w << 16); }
__device__ __forceinline__ float bfhi(unsigned w) { return __uint_as_float(w & 0xffff0000u); }
__device__ __forceinline__ unsigned short f2bf(float f) { return (unsigned short)(cvt_pk_bf16(f, 0.f) & 0xffffu); }
__device__ __forceinline__ float wave_sum(float v) {
#pragma unroll
    for (int o = 1; o < 64; o <<= 1) v += __shfl_xor(v, o);
    return v;
}
__device__ __forceinline__ float silu_f(float v) { return v / (1.f + __expf(-v)); }

#define XB_TMO      128
#define XB_XCNT(j)  (256  + 64 * (j))
#define XB_XSUB(j)  (1280 + 64 * (j))
#define XB_XGEN(j)  (2304 + 64 * (j))
#define XB_TOP      3328
#define XB_TOPGEN   3392
#define XCD_BAR_WORDS 3456
#define XB_SPIN_CAP (1u << 18)
__device__ __forceinline__ unsigned xb_ld(unsigned* p)              { return __hip_atomic_load(p, __ATOMIC_RELAXED, __HIP_MEMORY_SCOPE_AGENT); }
__device__ __forceinline__ unsigned xb_add(unsigned* p, unsigned v) { return __hip_atomic_fetch_add(p, v, __ATOMIC_RELAXED, __HIP_MEMORY_SCOPE_AGENT); }
__device__ __forceinline__ unsigned xb_xcc_id() { return (unsigned)__builtin_amdgcn_s_getreg((3 << 11) | 20) & 0xFu; }
#define XB_SPIN(cond, bar) do { unsigned _sp = 0; while (cond) { __builtin_amdgcn_s_sleep(1); \
    if ((++_sp & 255u) == 0u) { if (xb_ld(&(bar)[XB_TMO])) break; if (_sp > XB_SPIN_CAP) { atomicAdd(&(bar)[XB_TMO], 1u); break; } } } } while (0)
struct XcdBarrier { unsigned* bar; unsigned x; volatile LAS unsigned* st; };
__device__ __forceinline__ XcdBarrier xcd_barrier_post(unsigned* bar, volatile LAS unsigned* st) {
    XcdBarrier b; b.bar = bar; b.x = xb_xcc_id(); b.st = st;
    if (threadIdx.x == 0) (void)xb_add(&bar[XB_XCNT(b.x)], 1u);
    return b;
}
__device__ __forceinline__ void xcd_barrier_complete(unsigned* bar, unsigned x, unsigned& nloc, unsigned& nx) {
    const unsigned G = gridDim.x * gridDim.y * gridDim.z;
    unsigned sum, cnt, mine, sp = 0u;
    for (;;) {
        sum = 0u; cnt = 0u; mine = 0u;
#pragma unroll
        for (unsigned j = 0; j < 16; ++j) { const unsigned c = xb_ld(&bar[XB_XCNT(j)]); sum += c; cnt += (c > 0u) ? 1u : 0u; mine = (j == x) ? c : mine; }
        if (sum == G) break;
        __builtin_amdgcn_s_sleep(1);
        if ((++sp & 255u) == 0u) { if (xb_ld(&bar[XB_TMO])) break; if (sp > XB_SPIN_CAP) { atomicAdd(&bar[XB_TMO], 1u); break; } }
    }
    nloc = mine > 0u ? mine : 1u; nx = cnt > 0u ? cnt : 1u;
}
__device__ __forceinline__ void xcd_barrier(const XcdBarrier& b) {
    asm volatile("s_waitcnt vmcnt(0)" ::: "memory");
    __syncthreads();
    if (threadIdx.x == 0) {
        unsigned* bar = b.bar;
        __builtin_amdgcn_s_waitcnt(0);
        unsigned nloc = b.st[0], nx = b.st[1];
        if (nloc == 0u) { xcd_barrier_complete(bar, b.x, nloc, nx); b.st[0] = nloc; b.st[1] = nx; }
        const unsigned old = xb_add(&bar[XB_XSUB(b.x)], 1u);
        const unsigned gen = old / nloc;
        if (old + 1u == (gen + 1u) * nloc) {
            __builtin_amdgcn_fence(__ATOMIC_RELEASE, "agent");
            asm volatile("s_waitcnt vmcnt(0)" ::: "memory");
            const unsigned og = xb_add(&bar[XB_TOP], 1u);
            const unsigned tg = og / nx;
            if (og + 1u == (tg + 1u) * nx) xb_add(&bar[XB_TOPGEN], 1u);
            else XB_SPIN(xb_ld(&bar[XB_TOPGEN]) == tg, bar);
            __builtin_amdgcn_fence(__ATOMIC_ACQUIRE, "agent");
            xb_add(&bar[XB_XGEN(b.x)], 1u);
            asm volatile("s_waitcnt vmcnt(0)" ::: "memory");
        } else {
            XB_SPIN(xb_ld(&bar[XB_XGEN(b.x)]) == gen, bar);
            __builtin_amdgcn_fence(__ATOMIC_ACQUIRE, "agent");
            asm volatile("s_waitcnt vmcnt(0)" ::: "memory");
        }
    }
    __syncthreads();
}

namespace pg8 {
constexpr int BM = 256, BK = 64, HALF = 128, HTB = HALF * BK * 2, STAGE_BYTES = 8 * HTB, NXCD = 8, WGM = 8;
__host__ __device__ __forceinline__ int lds_byte(int r, int c) { const int st = (r >> 4) * 2 + (c >> 5), rr = r & 15, cc = c & 31, ob = rr * 64 + cc * 2; return st * 1024 + (ob ^ (((ob >> 9) & 1) << 5)); }
__host__ __device__ __forceinline__ void stage_rc(int b, int& R, int& C) { const int st = b / 1024, sb = b % 1024, swz = sb ^ (((sb >> 9) & 1) << 5); R = (st >> 1) * 16 + swz / 64; C = (st & 1) * 32 + (swz % 64) / 2; }
__host__ __device__ __forceinline__ int perm32(int rho) { const int n = rho >> 4, i = rho & 15; return 8 * (i >> 2) + 4 * n + (i & 3); }
struct Unit { const char* a; const char* b; int pm, pn; };
struct Gemm { int lda, ldb, K; int sa = 0x7f7f7f7f, sb = 0x7f7f7f7f; };
typedef int i32x8 __attribute__((ext_vector_type(8)));
typedef int i32x4 __attribute__((ext_vector_type(4)));
__device__ __forceinline__ bool tile_of(int i, int G, int c, int nM, int nN, int& pm, int& pn) {
    const int nwg = nM * nN; const long Lq = (long)i * G + c; if (Lq >= nwg) return false;
    int wgid = (int)Lq; { const int q = nwg / NXCD, r = nwg % NXCD, xcd = wgid % NXCD, off = wgid / NXCD; wgid = (xcd < r ? xcd * (q + 1) : r * (q + 1) + (xcd - r) * q) + off; }
    const int nig = WGM * nN, gid = wgid / nig, fm = gid * WGM, gsz = (nM - fm) < WGM ? (nM - fm) : WGM;
    pm = fm + ((wgid % nig) % gsz); pn = (wgid % nig) / gsz; return true;
}
__device__ __forceinline__ const char* uni_ptr(const char* p) { const unsigned long long v = (unsigned long long)p; const unsigned lo = __builtin_amdgcn_readfirstlane((unsigned)v), hi = __builtin_amdgcn_readfirstlane((unsigned)(v >> 32)); return (const char*)(((unsigned long long)hi << 32) | lo); }
__device__ __forceinline__ void uni_unit(Unit& u) { u.a = uni_ptr(u.a); u.b = uni_ptr(u.b); u.pm = __builtin_amdgcn_readfirstlane(u.pm); u.pn = __builtin_amdgcn_readfirstlane(u.pn); }
template <class Epi, class Sched, bool FP8 = false>
__device__ __forceinline__ void gemm_phase(LAS unsigned char* lds, const Gemm g, const Sched& S, const Epi& E) {
    const int tid = threadIdx.x, wid = __builtin_amdgcn_readfirstlane(tid >> 6), lane = tid & 63, wr = wid >> 2, wc = wid & 3, fr = lane & 15, fq = lane >> 4;
    const int K = g.K, nt = K / BK;
    unsigned voffA[2], voffB[2];
#pragma unroll
    for (int i = 0; i < 2; ++i) { int R, C; stage_rc(tid * 16 + i * 8192, R, C); const int Rb = Epi::PERM ? ((R & ~31) + perm32(R & 31)) : R;
        voffA[i] = (unsigned)(R * g.lda + C) * 2u; voffB[i] = (unsigned)(Rb * g.ldb + C) * 2u; }
    const size_t kstep = (size_t)(BK * 2);
    const size_t hstepA = (size_t)HALF * g.lda * 2, hstepB = (size_t)HALF * g.ldb * 2;
    const unsigned ldsw = (unsigned)wid * 1024u;
    const int aoff = lds_byte(wr * 64 + fr, fq * 8), boff = lds_byte(wc * 32 + fr, fq * 8);
#define PG8_SA(b, h) (((b) * 2 + (h)) * HTB)
#define PG8_SB(b, h) ((4 + (b) * 2 + (h)) * HTB)
#define PG8_STAGE(bufoff, gbase, voff) do { const char* _gb = (const char*)(gbase); asm volatile("" : "+s"(_gb));     \
        _Pragma("unroll") for (int _i = 0; _i < 2; ++_i) \
        __builtin_amdgcn_global_load_lds((const unsigned*)(_gb + (voff)[_i]), (LAS unsigned*)(lds + (bufoff) + ldsw + _i * 8192), 16, 0, 0); } while (0)
#define PG8_CAT(x0, x1) __builtin_shufflevector(x0, x1, 0, 1, 2, 3, 4, 5, 6, 7)
#define PG8_LDA(dst, b, h) do { if constexpr (FP8) { _Pragma("unroll") for (int m = 0; m < 4; ++m) dst##8[m] = PG8_CAT(*(const LAS i32x4*)(lds + PG8_SA(b, h) + aoff + m * 2048), *(const LAS i32x4*)(lds + PG8_SA(b, h) + aoff + m * 2048 + 1024)); } \
        else { _Pragma("unroll") for (int m = 0; m < 4; ++m) _Pragma("unroll") for (int k = 0; k < 2; ++k) dst[m][k] = *(const LAS bf16x8*)(lds + PG8_SA(b, h) + aoff + m * 2048 + k * 1024); } } while (0)
#define PG8_LDB(dst, b, h) do { if constexpr (FP8) { _Pragma("unroll") for (int n = 0; n < 2; ++n) dst##8[n] = PG8_CAT(*(const LAS i32x4*)(lds + PG8_SB(b, h) + boff + n * 2048), *(const LAS i32x4*)(lds + PG8_SB(b, h) + boff + n * 2048 + 1024)); } \
        else { _Pragma("unroll") for (int n = 0; n < 2; ++n) _Pragma("unroll") for (int k = 0; k < 2; ++k) dst[n][k] = *(const LAS bf16x8*)(lds + PG8_SB(b, h) + boff + n * 2048 + k * 1024); } } while (0)
#define PG8_MMA(ai, bj, At, Bt) do { __builtin_amdgcn_s_setprio(1); \
        if constexpr (FP8) { _Pragma("unroll") for (int m = 0; m < 4; ++m) _Pragma("unroll") for (int n = 0; n < 2; ++n) \
            asm volatile("v_mfma_scale_f32_16x16x128_f8f6f4 %0, %1, %2, %0, %3, %4 op_sel_hi:[0,0,0]" : "+v"(acc[ai][bj][m][n]) : "v"(Bt##8[n]), "v"(At##8[m]), "v"(g.sb), "v"(g.sa));   } \
        else { _Pragma("unroll") for (int m = 0; m < 4; ++m) _Pragma("unroll") for (int n = 0; n < 2; ++n) _Pragma("unroll") for (int k = 0; k < 2; ++k) \
            acc[ai][bj][m][n] = __builtin_amdgcn_mfma_f32_16x16x32_bf16(Bt[n][k], At[m][k], acc[ai][bj][m][n], 0, 0, 0); } \
        __builtin_amdgcn_s_setprio(0); } while (0)
#define PG8_WAIT_V(n) asm volatile("s_waitcnt vmcnt(" #n ")" ::: "memory")
#define PG8_WAIT_L(n) asm volatile("s_waitcnt lgkmcnt(" #n ")" ::: "memory")
#define PG8_BAR __builtin_amdgcn_s_barrier()
#define PG8_SCHED __builtin_amdgcn_sched_barrier(0)
    Unit cur, nxt; int ui = 0;
    if (!S.next(0, cur)) return;
    uni_unit(cur);
    f32x4 acc[2][2][4][2];
#pragma unroll
    for (int a = 0; a < 2; ++a)
#pragma unroll
        for (int b = 0; b < 2; ++b)
#pragma unroll
            for (int m = 0; m < 4; ++m)
#pragma unroll
                for (int n = 0; n < 2; ++n) acc[a][b][m][n] = (f32x4){0.f, 0.f, 0.f, 0.f};
    bf16x8 At[4][2], B0[2][2], B1[2][2]; i32x8 At8[4], B08[2], B18[2];
    const char* cA = cur.a; const char* cB = cur.b;
    PG8_STAGE(PG8_SB(0, 0), cB, voffB); PG8_STAGE(PG8_SA(0, 0), cA, voffA); PG8_STAGE(PG8_SB(0, 1), cB + hstepB, voffB); PG8_STAGE(PG8_SA(0, 1), cA + hstepA, voffA);
    if (wr == 1) PG8_BAR;
    PG8_WAIT_V(4); PG8_BAR;
    PG8_STAGE(PG8_SB(1, 0), cB + kstep, voffB); PG8_STAGE(PG8_SA(1, 0), cA + kstep, voffA); PG8_STAGE(PG8_SB(1, 1), cB + hstepB + kstep, voffB);
    PG8_WAIT_V(6); PG8_BAR;
    for (;;) {
        const bool has_next = S.next(ui + 1, nxt); if (has_next) uni_unit(nxt);
        const char* nA = has_next ? nxt.a : cA; const char* nB = has_next ? nxt.b : cB;
#pragma unroll 1
        for (int t = 0; t < nt; t += 2) {
            const bool last = (t == nt - 2);
            const char* a1 = cA + (size_t)(t + 1) * kstep;
            const char* a2 = last ? nA : cA + (size_t)(t + 2) * kstep; const char* b2 = last ? nB : cB + (size_t)(t + 2) * kstep;
            const char* a3 = a2 + kstep; const char* b3 = b2 + kstep;
            PG8_LDB(B0, 0, 0); PG8_SCHED; PG8_LDA(At, 0, 0); PG8_STAGE(PG8_SA(1, 1), a1 + hstepA, voffA);
            PG8_WAIT_L(8); PG8_BAR; PG8_WAIT_L(0); PG8_MMA(0, 0, At, B0); PG8_BAR; PG8_SCHED;
            PG8_LDB(B1, 0, 1); PG8_STAGE(PG8_SB(0, 0), b2, voffB);
            PG8_BAR; PG8_WAIT_L(0); PG8_MMA(0, 1, At, B1); PG8_BAR;
            PG8_LDA(At, 0, 1); PG8_STAGE(PG8_SA(0, 0), a2, voffA);
            PG8_BAR; PG8_WAIT_L(0); PG8_MMA(1, 0, At, B0); PG8_BAR; PG8_SCHED;
            PG8_STAGE(PG8_SB(0, 1), b2 + hstepB, voffB);
            PG8_WAIT_V(6); PG8_BAR; PG8_MMA(1, 1, At, B1); PG8_BAR;
            PG8_LDB(B0, 1, 0); PG8_SCHED; PG8_LDA(At, 1, 0); PG8_STAGE(PG8_SA(0, 1), a2 + hstepA, voffA);
            PG8_WAIT_L(8); PG8_BAR; PG8_WAIT_L(0); PG8_MMA(0, 0, At, B0); PG8_BAR; PG8_SCHED;
            PG8_LDB(B1, 1, 1); PG8_STAGE(PG8_SB(1, 0), b3, voffB);
            PG8_BAR; PG8_WAIT_L(0); PG8_MMA(0, 1, At, B1); PG8_BAR;
            PG8_LDA(At, 1, 1); PG8_STAGE(PG8_SA(1, 0), a3, voffA);
            PG8_BAR; PG8_WAIT_L(0); PG8_MMA(1, 0, At, B0); PG8_BAR; PG8_SCHED;
            PG8_STAGE(PG8_SB(1, 1), b3 + hstepB, voffB);
            PG8_WAIT_V(6); PG8_BAR; PG8_MMA(1, 1, At, B1); PG8_BAR;
        }
        if constexpr (FP8) asm volatile("s_nop 15\n\ts_nop 7" ::: "memory");
        E(acc, cur, wr, wc, fr, fq);
        if (!has_next) break;
#pragma unroll
        for (int a = 0; a < 2; ++a)
#pragma unroll
            for (int b = 0; b < 2; ++b)
#pragma unroll
                for (int m = 0; m < 4; ++m)
#pragma unroll
                    for (int n = 0; n < 2; ++n) acc[a][b][m][n] = (f32x4){0.f, 0.f, 0.f, 0.f};
        cur = nxt; cA = nA; cB = nB; ++ui;
    }
    PG8_WAIT_V(0);
    if (wr == 0) PG8_BAR;
    PG8_BAR;
#undef PG8_SA
#undef PG8_SB
#undef PG8_STAGE
#undef PG8_LDA
#undef PG8_LDB
#undef PG8_MMA
#undef PG8_CAT
#undef PG8_WAIT_V
#undef PG8_WAIT_L
#undef PG8_BAR
#undef PG8_SCHED
}

struct SchedPlain {
    const char* A; const char* Bt; size_t at, bt; int nM, nN, G, c; bool latM;
    __device__ __forceinline__ void init(const void* A_, int lda, const void* Bt_, int ldb, int nM_, int nN_, bool latM_) {
        A = (const char*)A_; Bt = (const char*)Bt_; at = (size_t)256 * lda * 2; bt = (size_t)256 * ldb * 2; nM = nM_; nN = nN_; G = gridDim.x; c = blockIdx.x; latM = latM_; }
    __device__ __forceinline__ bool next(int i, Unit& u) const {
        int pm, pn; if (!tile_of(i, G, c, nM, nN, pm, pn)) return false;
        if (latM) pm = (pm >> 3) * 9 + 1 + (pm & 7);
        u.pm = pm; u.pn = pn; u.a = A + (size_t)pm * at; u.b = Bt + (size_t)pn * bt; return true; }
};
struct SchedF1 {
    const char* A; const char* H; int nN, G, c;
    __device__ __forceinline__ bool next(int i, Unit& u) const {
        int pm, pn; if (!tile_of(i, G, c, 2, nN, pm, pn)) return false;
        u.pm = pm; u.pn = pn; u.a = A + (size_t)pm * 256 * D * 2; u.b = H + (size_t)((pn >> 3) * 9 + 1 + (pn & 7)) * 256 * D * 2; return true; }
};
struct SchedF2 {
    const char* Dft; const char* GT; int G, c;
    __device__ __forceinline__ bool next(int i, Unit& u) const {
        const int L_ = i * G + c; if (L_ >= NB * 8) return false; const int b = L_ >> 3, kt = L_ & 7;
        u.pm = b * 9 + 1 + kt; u.pn = 0; u.a = Dft + (size_t)kt * 256 * 4096 * 2; u.b = GT + (size_t)b * 256 * 4096 * 2; return true; }
};
struct SchedMoe {
    const char* A; const char* W; size_t at, bt, estride; int t0, nT, nN, G, c; int toff[NE + 1];
    __device__ __forceinline__ bool next(int i, Unit& u) const {
        int pm, pn; if (!tile_of(i, G, c, nT, nN, pm, pn)) return false; pm += t0;
        int e = 0;
#pragma unroll
        for (int j = 1; j < NE; ++j) e += (pm >= toff[j]) ? 1 : 0;
        u.pm = pm; u.pn = pn; u.a = A + (size_t)pm * at; u.b = W + (size_t)e * estride + (size_t)pn * bt; return true; }
};

#define EPI_LOOP_ROWS for (int ai = 0; ai < 2; ++ai) _Pragma("unroll") for (int m = 0; m < 4; ++m)
__device__ __forceinline__ u32x4 pack8(const f32x4 a, const f32x4 b) { u32x4 w; w.x = cvt_pk_bf16(a[0], a[1]); w.y = cvt_pk_bf16(a[2], a[3]); w.z = cvt_pk_bf16(b[0], b[1]); w.w = cvt_pk_bf16(b[2], b[3]); return w; }
struct EpiPlain {
    static constexpr bool PERM = true; bf16_t* O; int ldo;
    __device__ __forceinline__ void operator()(const f32x4 (&acc)[2][2][4][2], const Unit& u, int wr, int wc, int fr, int fq) const {
        const int row0 = u.pm * BM + wr * 64 + fr, col0 = u.pn * BM + wc * 32 + 8 * fq;
#pragma unroll
        EPI_LOOP_ROWS { bf16_t* rowp = O + (size_t)(row0 + ai * HALF + m * 16) * ldo + col0;
#pragma unroll
            for (int bj = 0; bj < 2; ++bj) *(u32x4*)(rowp + bj * HALF) = pack8(acc[ai][bj][m][0], acc[ai][bj][m][1]); }
    }
};
struct EpiSwiglu {
    static constexpr bool PERM = true; bf16_t* O; int ldo;
    __device__ __forceinline__ void operator()(const f32x4 (&acc)[2][2][4][2], const Unit& u, int wr, int wc, int fr, int fq) const {
        const int row0 = u.pm * BM + wr * 64 + fr, col0 = u.pn * 128 + wc * 16 + 4 * fq;
#pragma unroll
        EPI_LOOP_ROWS { bf16_t* rowp = O + (size_t)(row0 + ai * HALF + m * 16) * ldo + col0;
#pragma unroll
            for (int bj = 0; bj < 2; ++bj) { const f32x4 g = acc[ai][bj][m][0], up = acc[ai][bj][m][1]; f32x4 a;
#pragma unroll
                for (int j = 0; j < 4; ++j) a[j] = g[j] * __builtin_amdgcn_rcpf(1.f + __expf(-g[j])) * up[j];
                u32x2 w; w.x = cvt_pk_bf16(a[0], a[1]); w.y = cvt_pk_bf16(a[2], a[3]); *(u32x2*)(rowp + bj * 64) = w; } }
    }
};
__device__ __forceinline__ unsigned pack4_fp8(float a, float b, float c, float d) {
    a = __builtin_amdgcn_fmed3f(a, -448.f, 448.f); b = __builtin_amdgcn_fmed3f(b, -448.f, 448.f); c = __builtin_amdgcn_fmed3f(c, -448.f, 448.f); d = __builtin_amdgcn_fmed3f(d, -448.f, 448.f);
    int p = __builtin_amdgcn_cvt_pk_fp8_f32(a, b, 0, false); p = __builtin_amdgcn_cvt_pk_fp8_f32(c, d, p, true); return (unsigned)p; }
struct EpiSwiglu8 {
    static constexpr bool PERM = true; unsigned char* O; int ldo; float oscale;
    __device__ __forceinline__ void operator()(const f32x4 (&acc)[2][2][4][2], const Unit& u, int wr, int wc, int fr, int fq) const {
        const int row0 = u.pm * BM + wr * 64 + fr, col0 = u.pn * 128 + wc * 16 + 4 * fq;
#pragma unroll
        EPI_LOOP_ROWS { unsigned char* rowp = O + (size_t)(row0 + ai * HALF + m * 16) * ldo + col0;
#pragma unroll
            for (int bj = 0; bj < 2; ++bj) { const f32x4 g = acc[ai][bj][m][0], up = acc[ai][bj][m][1]; f32x4 a;
#pragma unroll
                for (int j = 0; j < 4; ++j) a[j] = g[j] * __builtin_amdgcn_rcpf(1.f + __expf(-g[j])) * up[j] * oscale;
                *(unsigned*)(rowp + bj * 64) = pack4_fp8(a[0], a[1], a[2], a[3]); } }
    }
};
struct EpiQ0 {
    static constexpr bool PERM = true; bf16_t* O; const float* rc; const float* rs;
    __device__ __forceinline__ void operator()(const f32x4 (&acc)[2][2][4][2], const Unit& u, int wr, int wc, int fr, int fq) const {
        const int row0 = u.pm * BM + wr * 64 + fr, col0 = u.pn * BM + wc * 32 + 8 * fq; const int pj = u.pm % 9; const bool lat = pj != 0; const int t0 = (pj - 1) * 256 + wr * 64 + fr;
#pragma unroll
        EPI_LOOP_ROWS { const int row = row0 + ai * HALF + m * 16; const int t = t0 + ai * HALF + m * 16; bf16_t* rowp = O + (size_t)row * 768 + col0;
#pragma unroll
            for (int bj = 0; bj < 2; ++bj) { const int cb = col0 + bj * HALF, within = cb % MLA_QK; f32x4 v0 = acc[ai][bj][m][0], v1 = acc[ai][bj][m][1];
                if (lat && within >= MLA_NOPE) { const int f0 = ((within - MLA_NOPE) >> 3) * 4; const f32x4 cs = *(const f32x4*)(rc + t * 32 + f0), sn = *(const f32x4*)(rs + t * 32 + f0);
                    const f32x4 o1 = v0 * cs - v1 * sn, o2 = v0 * sn + v1 * cs; v0 = o1; v1 = o2; }
                *(u32x4*)(rowp + bj * HALF) = pack8(v0, v1); }
            asm volatile("" ::: "memory"); }
    }
};
struct EpiKV0 {
    static constexpr bool PERM = true; bf16_t* Kn; bf16_t* V;
    __device__ __forceinline__ void operator()(const f32x4 (&acc)[2][2][4][2], const Unit& u, int wr, int wc, int fr, int fq) const {
        const int row0 = u.pm * BM + wr * 64 + fr, col0 = u.pn * 128 + wc * 32 + 8 * fq;
#pragma unroll
        EPI_LOOP_ROWS { const size_t ro = (size_t)(row0 + ai * HALF + m * 16) * 512 + col0;
            *(u32x4*)(Kn + ro) = pack8(acc[ai][0][m][0], acc[ai][0][m][1]); *(u32x4*)(V + ro) = pack8(acc[ai][1][m][0], acc[ai][1][m][1]); }
    }
};
struct EpiQKV1 {
    static constexpr bool PERM = true; bf16_t* O; size_t tstride; const float* rc; const float* rs;
    __device__ __forceinline__ void operator()(const f32x4 (&acc)[2][2][4][2], const Unit& u, int wr, int wc, int fr, int fq) const {
        const int which = u.pn / 3; const int row0 = u.pm * BM + wr * 64 + fr, col0 = (u.pn % 3) * BM + wc * 32 + 8 * fq; const int pj = u.pm % 9; const bool rope = (pj != 0) && which < 2;
        const int t0 = (pj - 1) * 256 + wr * 64 + fr; bf16_t* base = O + (size_t)which * tstride;
#pragma unroll
        EPI_LOOP_ROWS { const int row = row0 + ai * HALF + m * 16; const int t = t0 + ai * HALF + m * 16; bf16_t* rowp = base + (size_t)row * 768 + col0;
#pragma unroll
            for (int bj = 0; bj < 2; ++bj) { const int cb = col0 + bj * HALF; f32x4 v0 = acc[ai][bj][m][0], v1 = acc[ai][bj][m][1];
                if (rope) { const int f0 = ((cb & 63) >> 3) * 4; const f32x4 cs = *(const f32x4*)(rc + t * 32 + f0), sn = *(const f32x4*)(rs + t * 32 + f0);
                    const f32x4 o1 = v0 * cs - v1 * sn, o2 = v0 * sn + v1 * cs; v0 = o1; v1 = o2; }
                *(u32x4*)(rowp + bj * HALF) = pack8(v0, v1); }
            asm volatile("" ::: "memory"); }
    }
};
struct EpiGT {
    static constexpr bool PERM = true; bf16_t* O;
    __device__ __forceinline__ void operator()(const f32x4 (&acc)[2][2][4][2], const Unit& u, int wr, int wc, int fr, int fq) const {
        const int b = u.pn >> 3, tt = u.pn & 7, part = u.pm; const int c0 = wr * 64 + fr, t0 = tt * 256 + wc * 32 + 8 * fq;
#pragma unroll
        EPI_LOOP_ROWS { const int c = c0 + ai * HALF + m * 16; bf16_t* rowp = O + ((size_t)(b * 256 + c) * 2 + part) * 2048 + t0;
#pragma unroll
            for (int bj = 0; bj < 2; ++bj) *(u32x4*)(rowp + bj * HALF) = pack8(acc[ai][bj][m][0], acc[ai][bj][m][1]); }
    }
};
}
namespace att {
constexpr int NW = 8, QBLK = 32, KVBLK = 64, DV = 128;
constexpr float THR = 8.f;
constexpr size_t SHM_V = KVBLK * DV * 2;
template <int DQK> struct Cf {
    static constexpr int ND = DQK / 16, KC = DQK / 64, CPR = DQK / 8;
    static constexpr size_t SHM_K = (size_t)KVBLK * DQK * 2;
    static constexpr float SCALE = DQK == 192 ? 0.07216878364870322f : 0.125f;
    static constexpr size_t LDS_BYTES = 2 * SHM_V + 2 * SHM_K + NW * 64 * 4;
};
#define SBAR() __builtin_amdgcn_sched_barrier(0)
__device__ __forceinline__ int crow(int r, int hi) { return (r & 3) + 8 * (r >> 2) + 4 * hi; }
template <int DQK> __device__ __forceinline__ int kswz(int row, int colB) { return row * (DQK * 2) + (colB ^ ((row & 7) << 4)); }

template <int DQK>
__device__ __forceinline__ void partialSM(f32x16& p0, f32x16& p1, float& m_reg, float& mn, float& alpha) {
    constexpr float SCALE = Cf<DQK>::SCALE, C = SCALE * 1.4426950408889634f;
    float pmax = p0[0];
#pragma unroll
    for (int r = 1; r < 16; ++r) pmax = fmaxf(pmax, p0[r]);
#pragma unroll
    for (int r = 0; r < 16; ++r) pmax = fmaxf(pmax, p1[r]);
    { auto rr = __builtin_amdgcn_permlane32_swap(__float_as_uint(pmax), __float_as_uint(pmax), false, false);
      pmax = fmaxf(__uint_as_float(rr[0]), __uint_as_float(rr[1])); }
    if (__builtin_expect(__all(pmax - m_reg <= THR / SCALE), 1)) { mn = m_reg; alpha = 1.f; }
    else { mn = fmaxf(m_reg, pmax); alpha = __builtin_amdgcn_exp2f((m_reg - mn) * C); m_reg = mn; }
    const float mnC = -mn * C;
#pragma unroll
    for (int r = 0; r < 16; ++r) p0[r] = fmaf(p0[r], C, mnC);
#pragma unroll
    for (int r = 0; r < 16; ++r) p1[r] = fmaf(p1[r], C, mnC);
#pragma unroll
    for (int r = 0; r < 16; ++r) p0[r] = __builtin_amdgcn_exp2f(p0[r]);
}
__device__ __forceinline__ void finishSM(f32x16& p0, f32x16& p1, float alpha, float& l_reg, bf16x8& pa0, bf16x8& pa1, bf16x8& pa2, bf16x8& pa3) {
#pragma unroll
    for (int r = 0; r < 16; ++r) p1[r] = __builtin_amdgcn_exp2f(p1[r]);
    float ps = 0;
#pragma unroll
    for (int r = 0; r < 16; ++r) ps += p0[r];
#pragma unroll
    for (int r = 0; r < 16; ++r) ps += p1[r];
    { auto rr = __builtin_amdgcn_permlane32_swap(__float_as_uint(ps), __float_as_uint(ps), false, false);
      ps = __uint_as_float(rr[0]) + __uint_as_float(rr[1]); }
    l_reg = l_reg * alpha + ps;
#define PK4(P, BASE, OUT) do { unsigned a0 = cvt_pk_bf16(P[BASE + 0], P[BASE + 1]), a1 = cvt_pk_bf16(P[BASE + 2], P[BASE + 3]);   \
    unsigned b0 = cvt_pk_bf16(P[BASE + 4], P[BASE + 5]), b1 = cvt_pk_bf16(P[BASE + 6], P[BASE + 7]);                              \
    auto r0 = __builtin_amdgcn_permlane32_swap(a0, b0, false, false); auto r1 = __builtin_amdgcn_permlane32_swap(a1, b1, false, false); \
    u32x4 w = {r0[0], r1[0], r0[1], r1[1]}; OUT = *reinterpret_cast<bf16x8*>(&w); } while (0)
    PK4(p0, 0, pa0); PK4(p0, 8, pa1); PK4(p1, 0, pa2); PK4(p1, 8, pa3);
#undef PK4
}
template <int DQK, int NQR>
__device__ __forceinline__ void qkt(f32x16& p0, f32x16& p1, const char* Ks, const bf16x8* qr, const char* ql, int r32, int hi) {
    p0 = f32x16{}; p1 = f32x16{};
#pragma unroll
    for (int d0 = 0; d0 < Cf<DQK>::ND; ++d0) { const int cb = (d0 * 16 + hi * 8) * 2;
        const bf16x8 b0 = *reinterpret_cast<const bf16x8*>(Ks + kswz<DQK>(r32, cb));
        const bf16x8 b1 = *reinterpret_cast<const bf16x8*>(Ks + kswz<DQK>(32 + r32, cb));
        bf16x8 qf; if (d0 < NQR) qf = qr[d0]; else qf = *reinterpret_cast<const bf16x8*>(ql + (d0 - NQR) * 1024);
        p0 = __builtin_amdgcn_mfma_f32_32x32x16_bf16(b0, qf, p0, 0, 0, 0);
        p1 = __builtin_amdgcn_mfma_f32_32x32x16_bf16(b1, qf, p1, 0, 0, 0); }
}
__device__ __forceinline__ int v_st(int k, int c) { const int kk = (k & ~0xC) | ((k & 4) << 1) | ((k & 8) >> 1); return ((kk >> 3) * 4 + (c >> 5)) * 512 + ((kk & 7) * 32 + (c & 31)) * 2; }
__device__ __forceinline__ int v_rd_base(int lane) { return ((lane & 3) << 3) | (((lane >> 2) & 3) << 6) | (((lane >> 4) & 1) << 5) | (((lane >> 5) & 1) << 8); }
constexpr int v_rd_off(int d0, int ks, int half) { return d0 * 512 + ks * 4096 + half * 2048; }
template <int OFF> __device__ __forceinline__ s16x4 tr_read(int vb) {
    s16x4 r; asm volatile("ds_read_b64_tr_b16 %0, %1 offset:%2" : "=&v"(r) : "v"(vb), "i"(OFF) : "memory"); return r;
}
template <int D0> __device__ __forceinline__ void pv_one(f32x16& od, int vb, bf16x8 pa0, bf16x8 pa1, bf16x8 pa2, bf16x8 pa3) {
    const s16x4 l0 = tr_read<v_rd_off(D0, 0, 0)>(vb), h0 = tr_read<v_rd_off(D0, 0, 1)>(vb), l1 = tr_read<v_rd_off(D0, 1, 0)>(vb), h1 = tr_read<v_rd_off(D0, 1, 1)>(vb);
    const s16x4 l2 = tr_read<v_rd_off(D0, 2, 0)>(vb), h2 = tr_read<v_rd_off(D0, 2, 1)>(vb), l3 = tr_read<v_rd_off(D0, 3, 0)>(vb), h3 = tr_read<v_rd_off(D0, 3, 1)>(vb);
    asm volatile("s_waitcnt lgkmcnt(0)" ::: "memory"); SBAR();
#define PK(L_, H_) (bf16x8){L_[0], L_[1], L_[2], L_[3], H_[0], H_[1], H_[2], H_[3]}
    od = __builtin_amdgcn_mfma_f32_32x32x16_bf16(pa0, PK(l0, h0), od, 0, 0, 0);
    od = __builtin_amdgcn_mfma_f32_32x32x16_bf16(pa1, PK(l1, h1), od, 0, 0, 0);
    od = __builtin_amdgcn_mfma_f32_32x32x16_bf16(pa2, PK(l2, h2), od, 0, 0, 0);
    od = __builtin_amdgcn_mfma_f32_32x32x16_bf16(pa3, PK(l3, h3), od, 0, 0, 0);
#undef PK
}
__device__ __forceinline__ void pv_d0(f32x16* o, int vb, bf16x8 pa0, bf16x8 pa1, bf16x8 pa2, bf16x8 pa3) {
    pv_one<0>(o[0], vb, pa0, pa1, pa2, pa3); pv_one<1>(o[1], vb, pa0, pa1, pa2, pa3); pv_one<2>(o[2], vb, pa0, pa1, pa2, pa3); pv_one<3>(o[3], vb, pa0, pa1, pa2, pa3);
}

struct KSrc { const bf16_t* ka; int lda; const bf16_t* kb; int ldb; };
struct AOut {
    bf16_t* O; int ldo; float* stash; const float* subg; float lam; int sub;
};
template <int DQK, int SDEPTH, int MODE>
__device__ __forceinline__ void attn_body(const bf16_t* __restrict__ Qb, int ldq, const KSrc ks, const bf16_t* __restrict__ Vh, int ldv, int seq, char* lds, const AOut ao) {
    using C = Cf<DQK>; constexpr int ND = C::ND, KC = C::KC, CPR = C::CPR, CA = DQK == 192 ? 16 : CPR; constexpr size_t SHM_K = C::SHM_K;
    int tid_ = threadIdx.x; asm volatile("" : "+v"(tid_));
    const int tid = tid_, wid = tid >> 6, lane = tid & 63, r32 = lane & 31, hi = lane >> 5;
    char* V_lds = lds; char* K_lds = lds + 2 * SHM_V;
    float* ws = (float*)(lds + 2 * SHM_V + 2 * SHM_K) + wid * 64; float* li_l = ws; float* al_l = ws + 32;
    constexpr int NQR = ND;
    char* ql = lds + 2 * SHM_V + 2 * SHM_K + NW * 64 * 4 + wid * 4096 + lane * 16;
    float m_reg = -1e30f, l_reg = 0; f32x16 o[4] = {}; bf16x8 qr[NQR];
    const bf16_t* Qw = Qb + (long)(wid * QBLK + r32) * ldq + hi * 8;
#pragma unroll
    for (int d0 = 0; d0 < ND; ++d0) { const bf16x8 qv = *reinterpret_cast<const bf16x8*>(Qw + d0 * 16); if (d0 < NQR) qr[d0] = qv; else *reinterpret_cast<bf16x8*>(ql + (d0 - NQR) * 1024) = qv; }
    const int sr = tid >> 4, sc = (tid & 15) * 8, vst0 = v_st(sr, sc), vst1 = v_st(32 + sr, sc);
    const int vb0 = (int)(uintptr_t)V_lds + v_rd_base(lane);
    const bf16_t* kptr[KC]; int kstride[KC]; int klds[KC];
#pragma unroll
    for (int i = 0; i < KC; ++i) { const int q = tid + 512 * i, row = q / CPR, c8 = q % CPR; klds[i] = kswz<DQK>(row, c8 * 16);
        if (c8 < CA) { kptr[i] = ks.ka + (long)row * ks.lda + c8 * 8; kstride[i] = ks.lda; } else { kptr[i] = ks.kb + (long)row * ks.ldb + (c8 - CA) * 8; kstride[i] = ks.ldb; } }
    struct Slot { bf16x8 vs0, vs1; bf16x8 kk[KC]; } sl[SDEPTH];
#define SLOAD(i_, k0_) do { sl[i_].vs0 = *reinterpret_cast<const bf16x8*>(&Vh[(long)((k0_) + sr) * ldv + sc]); sl[i_].vs1 = *reinterpret_cast<const bf16x8*>(&Vh[(long)((k0_) + 32 + sr) * ldv + sc]); \
    _Pragma("unroll") for (int c_ = 0; c_ < KC; ++c_) sl[i_].kk[c_] = *reinterpret_cast<const bf16x8*>(kptr[c_] + (long)(k0_) * kstride[c_]); } while (0)
#define SWRITE(b_, i_) do { *(bf16x8*)(V_lds + (b_) * SHM_V + vst0) = sl[i_].vs0; *(bf16x8*)(V_lds + (b_) * SHM_V + vst1) = sl[i_].vs1; \
    _Pragma("unroll") for (int c_ = 0; c_ < KC; ++c_) *(bf16x8*)(K_lds + (b_) * SHM_K + klds[c_]) = sl[i_].kk[c_]; } while (0)
#define SWAIT() do { if constexpr (SDEPTH == 2) { if constexpr (KC == 3) asm volatile("s_waitcnt vmcnt(5)" ::: "memory"); else asm volatile("s_waitcnt vmcnt(3)" ::: "memory"); } \
    else asm volatile("s_waitcnt vmcnt(0)" ::: "memory"); } while (0)
#define RESC(a_) do { if (__any((a_) < 1.f)) { if (hi == 0) al_l[r32] = (a_); asm volatile("s_waitcnt lgkmcnt(0)" ::: "memory"); \
    _Pragma("unroll") for (int d_ = 0; d_ < 4; ++d_) _Pragma("unroll") for (int r_ = 0; r_ < 16; ++r_) o[d_][r_] *= al_l[crow(r_, hi)]; } } while (0)
    f32x16 pA0, pA1, pB0, pB1; float mnA, mnB, alA, alB; bf16x8 pa0, pa1, pa2, pa3; const int NT = seq / KVBLK;
    constexpr int SE = 0, SO = SDEPTH - 1;
    SLOAD(SE, 0); asm volatile("s_waitcnt vmcnt(0)" ::: "memory"); SWRITE(0, SE); __syncthreads();
    qkt<DQK, NQR>(pA0, pA1, K_lds, qr, ql, r32, hi); partialSM<DQK>(pA0, pA1, m_reg, mnA, alA);
    SLOAD(SO, KVBLK); if constexpr (SDEPTH == 2) { if (2 < NT) SLOAD(SE, 2 * KVBLK); }
    SWAIT(); SWRITE(1, SO); __syncthreads();
    for (int j = 1; j + 1 < NT; j += 2) {
        SBAR(); qkt<DQK, NQR>(pB0, pB1, K_lds + SHM_K, qr, ql, r32, hi);
        finishSM(pA0, pA1, alA, l_reg, pa0, pa1, pa2, pa3); SBAR();
        SLOAD(SO, (j + SDEPTH) * KVBLK); SBAR();
        pv_d0(o, vb0, pa0, pa1, pa2, pa3); partialSM<DQK>(pB0, pB1, m_reg, mnB, alB);
        __syncthreads(); SWAIT(); SWRITE(0, SE);
        RESC(alB); __syncthreads();
        SBAR(); qkt<DQK, NQR>(pA0, pA1, K_lds, qr, ql, r32, hi);
        finishSM(pB0, pB1, alB, l_reg, pa0, pa1, pa2, pa3); SBAR();
        if (SDEPTH == 1 || j + 3 < NT) SLOAD(SE, (j + 1 + SDEPTH) * KVBLK); SBAR();
        pv_d0(o, vb0 + (int)SHM_V, pa0, pa1, pa2, pa3); partialSM<DQK>(pA0, pA1, m_reg, mnA, alA);
        __syncthreads(); SWAIT(); SWRITE(1, SO);
        RESC(alA); __syncthreads();
    }
    SBAR(); qkt<DQK, NQR>(pB0, pB1, K_lds + SHM_K, qr, ql, r32, hi);
    finishSM(pA0, pA1, alA, l_reg, pa0, pa1, pa2, pa3); SBAR();
    pv_d0(o, vb0, pa0, pa1, pa2, pa3); partialSM<DQK>(pB0, pB1, m_reg, mnB, alB);
    __syncthreads(); RESC(alB);
    finishSM(pB0, pB1, alB, l_reg, pa0, pa1, pa2, pa3); SBAR();
    pv_d0(o, vb0 + (int)SHM_V, pa0, pa1, pa2, pa3);
    if (hi == 0) li_l[r32] = l_reg; asm volatile("s_waitcnt lgkmcnt(0)" ::: "memory");
    float rli[16];
#pragma unroll
    for (int r = 0; r < 16; ++r) rli[r] = __builtin_amdgcn_rcpf(li_l[crow(r, hi)]);
    if constexpr (MODE == 0) {
        bf16_t* Ow = ao.O + (long)(wid * QBLK) * ao.ldo;
#pragma unroll
        for (int r = 0; r < 16; ++r) { const int orow = crow(r, hi);
#pragma unroll
            for (int d0 = 0; d0 < 4; ++d0) Ow[(long)orow * ao.ldo + d0 * 32 + r32] = f2bf(o[d0][r] * rli[r]); }
    } else {
        float* st = ao.stash + (wid * 64) * 64 + lane;
        if (ao.sub == 0) {
#pragma unroll
            for (int r = 0; r < 16; ++r)
#pragma unroll
                for (int d0 = 0; d0 < 4; ++d0) st[(r * 4 + d0) * 64] = o[d0][r] * rli[r];
        } else {
            const float lam = ao.lam; float sg[4];
#pragma unroll
            for (int d0 = 0; d0 < 4; ++d0) sg[d0] = ao.subg[d0 * 32 + r32] * (1.f - LAM_INIT);
            bf16_t* Ow = ao.O + (long)(wid * QBLK) * ao.ldo;
#pragma unroll
            for (int r = 0; r < 16; ++r) { float ss = 0.f;
#pragma unroll
                for (int d0 = 0; d0 < 4; ++d0) { const float v = st[(r * 4 + d0) * 64] - lam * (o[d0][r] * rli[r]); o[d0][r] = v; ss += v * v; }
                ss += __shfl_xor(ss, 1); ss += __shfl_xor(ss, 2); ss += __shfl_xor(ss, 4); ss += __shfl_xor(ss, 8); ss += __shfl_xor(ss, 16);
                const float rn = 1.0f / sqrtf(ss * (1.f / 128.f) + EPS); const int orow = crow(r, hi);
#pragma unroll
                for (int d0 = 0; d0 < 4; ++d0) Ow[(long)orow * ao.ldo + d0 * 32 + r32] = f2bf(o[d0][r] * rn * sg[d0]); }
        }
    }
    asm volatile("s_waitcnt vmcnt(0) lgkmcnt(0)" ::: "memory");
    __syncthreads();
#undef SLOAD
#undef SWRITE
#undef SWAIT
#undef RESC
}
template <int DQK>
__device__ __forceinline__ void attn_body_np(const bf16_t* __restrict__ Qb, int ldq, const KSrc ks, const bf16_t* __restrict__ Vh, int ldv, int seq, char* lds, const AOut ao) {
    using C = Cf<DQK>; constexpr int ND = C::ND, KC = C::KC, CPR = C::CPR, CA = DQK == 192 ? 16 : CPR; constexpr size_t SHM_K = C::SHM_K;
    int tid_ = threadIdx.x; asm volatile("" : "+v"(tid_));
    const int tid = tid_, wid = tid >> 6, lane = tid & 63, r32 = lane & 31, hi = lane >> 5;
    char* V_lds = lds; char* K_lds = lds + 2 * SHM_V;
    float* ws = (float*)(lds + 2 * SHM_V + 2 * SHM_K) + wid * 64; float* li_l = ws; float* al_l = ws + 32;
    float m_reg = -1e30f, l_reg = 0; f32x16 o[4] = {}; bf16x8 qr[ND];
    const bf16_t* Qw = Qb + (long)(wid * QBLK + r32) * ldq + hi * 8;
#pragma unroll
    for (int d0 = 0; d0 < ND; ++d0) qr[d0] = *reinterpret_cast<const bf16x8*>(Qw + d0 * 16);
    const int sr = tid >> 4, sc = (tid & 15) * 8, vst0 = v_st(sr, sc), vst1 = v_st(32 + sr, sc);
    const int vb0 = (int)(uintptr_t)V_lds + v_rd_base(lane);
    const bf16_t* kptr[KC]; int kstride[KC]; int klds[KC];
#pragma unroll
    for (int i = 0; i < KC; ++i) { const int q = tid + 512 * i, row = q / CPR, c8 = q % CPR; klds[i] = kswz<DQK>(row, c8 * 16);
        if (c8 < CA) { kptr[i] = ks.ka + (long)row * ks.lda + c8 * 8; kstride[i] = ks.lda; } else { kptr[i] = ks.kb + (long)row * ks.ldb + (c8 - CA) * 8; kstride[i] = ks.ldb; } }
    bf16x8 vs0, vs1, kk[KC];
#define SLOAD1(k0_) do { vs0 = *reinterpret_cast<const bf16x8*>(&Vh[(long)((k0_) + sr) * ldv + sc]); vs1 = *reinterpret_cast<const bf16x8*>(&Vh[(long)((k0_) + 32 + sr) * ldv + sc]); \
    _Pragma("unroll") for (int c_ = 0; c_ < KC; ++c_) kk[c_] = *reinterpret_cast<const bf16x8*>(kptr[c_] + (long)(k0_) * kstride[c_]); } while (0)
#define SWRITE1(b_) do { *(bf16x8*)(V_lds + (b_) * SHM_V + vst0) = vs0; *(bf16x8*)(V_lds + (b_) * SHM_V + vst1) = vs1; \
    _Pragma("unroll") for (int c_ = 0; c_ < KC; ++c_) *(bf16x8*)(K_lds + (b_) * SHM_K + klds[c_]) = kk[c_]; } while (0)
    f32x16 p0, p1; float mn, al; bf16x8 pa0, pa1, pa2, pa3; const int NT = seq / KVBLK;
    SLOAD1(0); asm volatile("s_waitcnt vmcnt(0)" ::: "memory"); SWRITE1(0); SLOAD1(KVBLK); __syncthreads();
#pragma unroll 1
    for (int j = 0; j < NT; ++j) {
        const int buf = j & 1;
        SBAR(); qkt<DQK, ND>(p0, p1, K_lds + buf * SHM_K, qr, nullptr, r32, hi);
        partialSM<DQK>(p0, p1, m_reg, mn, al);
        if (__any(al < 1.f)) { if (hi == 0) al_l[r32] = al; asm volatile("s_waitcnt lgkmcnt(0)" ::: "memory");
#pragma unroll
            for (int d_ = 0; d_ < 4; ++d_)
#pragma unroll
                for (int r_ = 0; r_ < 16; ++r_) o[d_][r_] *= al_l[crow(r_, hi)]; }
        finishSM(p0, p1, al, l_reg, pa0, pa1, pa2, pa3); SBAR();
        if (j + 1 < NT) { asm volatile("s_waitcnt vmcnt(0)" ::: "memory"); SWRITE1(buf ^ 1); if (j + 2 < NT) SLOAD1((j + 2) * KVBLK); }
        SBAR();
        pv_d0(o, vb0 + buf * (int)SHM_V, pa0, pa1, pa2, pa3);
        __syncthreads();
    }
#undef SLOAD1
#undef SWRITE1
    if (hi == 0) li_l[r32] = l_reg; asm volatile("s_waitcnt lgkmcnt(0)" ::: "memory");
    float rli[16];
#pragma unroll
    for (int r = 0; r < 16; ++r) rli[r] = __builtin_amdgcn_rcpf(li_l[crow(r, hi)]);
    bf16_t* Ow = ao.O + (long)(wid * QBLK) * ao.ldo;
#pragma unroll
    for (int r = 0; r < 16; ++r) { const int orow = crow(r, hi);
#pragma unroll
        for (int d0 = 0; d0 < 4; ++d0) Ow[(long)orow * ao.ldo + d0 * 32 + r32] = f2bf(o[d0][r] * rli[r]); }
    asm volatile("s_waitcnt vmcnt(0) lgkmcnt(0)" ::: "memory");
    __syncthreads();
}
}
constexpr int M = NB * S, ML = NB * T;
constexpr int NCH = ML / 256;
constexpr int MAXT = 2 * ML / 256 + NE;
constexpr size_t al256(size_t x) { return (x + 255) / 256 * 256; }
constexpr size_t WS_CTL = 0, CTL_BYTES = 1u << 20;
constexpr int CW_BAR = 4096;
constexpr size_t WS_MODV = WS_CTL + CTL_BYTES;
constexpr size_t WS_ROPE = WS_MODV + al256((size_t)2 * 33 * 6144 * 4);
constexpr size_t WS_W = WS_ROPE + 2 * 2048 * 32 * 4;
constexpr size_t W_IN0 = WS_W, W_UQ = W_IN0 + (size_t)2304 * 1024 * 2, W_UKV = W_UQ + (size_t)768 * 384 * 2, W_OUT0 = W_UKV + (size_t)1024 * 256 * 2,
    W_GU0 = W_OUT0 + (size_t)1024 * 1024 * 2, W_DN0 = W_GU0 + (size_t)5632 * 1024 * 2, W_IN1 = W_DN0 + (size_t)1024 * 2816 * 2, W_FOLD = W_IN1 + (size_t)2304 * 1024 * 2,
    W_OUT1 = W_FOLD + (size_t)512 * 1024 * 2, W_GU1 = W_OUT1 + (size_t)1024 * 1024 * 2, W_DN1 = W_GU1 + (size_t)NE * 5632 * 1024, W_DFT = W_DN1 + (size_t)NE * 1024 * 2816,
    WS_WEND = W_DFT + (size_t)2048 * 4096 * 2;
constexpr size_t WS_CTXS = WS_WEND;
constexpr size_t WS_STASH = WS_CTXS;
constexpr size_t CTXS_BYTES = ((size_t)NB * L * D * 4 > (size_t)256 * 131072) ? (size_t)NB * L * D * 4 : (size_t)256 * 131072;
constexpr size_t WS_ROUTE = WS_CTXS + CTXS_BYTES;
constexpr size_t RT_INFO = WS_ROUTE, RT_W = RT_INFO + (size_t)ML * 16, RT_POS = RT_W + (size_t)ML * 8, RT_WCNT = RT_POS + (size_t)ML * 8, RT_TOFF = RT_WCNT + (size_t)NCH * 64 * 4, WS_RTEND = al256(RT_TOFF + 256);
constexpr size_t AR = WS_RTEND;
constexpr size_t SROWS = (size_t)2 * ML + NE * 256;
constexpr size_t H2S_BYTES = SROWS * 1024, FS_BYTES = SROWS * 2048, ACTM_BYTES = (size_t)MAXT * 256 * 2816, GT_BYTES = (size_t)NB * 256 * 4096 * 2;
#if CFG_NB >= 32
constexpr size_t AR_A = AR, AR_B = AR + (size_t)M * 2048, AR_C = AR + (size_t)M * 4096, AR_D = AR_C + (size_t)M * 5632;
constexpr size_t AR_END = AR_D + (H2S_BYTES > (size_t)M * 1280 ? H2S_BYTES : (size_t)M * 1280);
constexpr size_t B_H = AR_A, B_Q0 = AR_A, B_Y = AR_A, B_F = AR_A, B_AOUT1 = AR_A, B_H2TOK = AR_A, B_FS = AR_A;
constexpr size_t B_AOUT0 = AR_B, B_H2 = AR_B, B_H1 = AR_B, B_Y1 = AR_B;
constexpr size_t B_Z = AR_C, B_KPE = AR_C + (size_t)M * 4608, B_K0N = AR_C, B_V0 = AR_C + (size_t)M * 1024, B_ACT = AR_C,
    B_QKV1 = AR_C, B_GT = AR_C + (size_t)M * 4608, B_ACTM = AR_C;
constexpr size_t B_ZQN = AR_D, B_ZKVN = AR_D + (size_t)M * 768, B_H2S = AR_D;
static_assert(FS_BYTES <= (size_t)M * 4096, "f_sorted fits A+B");
static_assert(ACTM_BYTES <= (size_t)M * 5632, "MoE act fits C");
static_assert(GT_BYTES <= (size_t)M * 1024, "GT fits the tail of C");
static_assert(AR_END <= ((size_t)1 << 30), "workspace map exceeds 1 GiB");
#else
constexpr size_t B_H = AR, B_Z = B_H + (size_t)M * 2048, B_KPE = B_Z + (size_t)M * 4608, B_AOUT0 = B_KPE + (size_t)M * 128, B_ZQN = B_AOUT0 + (size_t)M * 2048, B_ZKVN = B_ZQN + (size_t)M * 768,
    B_Q0 = B_ZKVN + (size_t)M * 512, B_K0N = B_Q0 + (size_t)M * 1536, B_V0 = B_K0N + (size_t)M * 1024, B_Y = B_V0 + (size_t)M * 1024, B_H2 = B_Y + (size_t)M * 2048, B_ACT = B_H2 + (size_t)M * 2048,
    B_F = B_ACT + (size_t)M * 5632, B_H1 = B_F + (size_t)M * 2048, B_QKV1 = B_H1 + (size_t)M * 2048, B_GT = B_QKV1 + (size_t)M * 4608, B_AOUT1 = B_GT + GT_BYTES, B_Y1 = B_AOUT1 + (size_t)M * 2048,
    B_H2TOK = B_Y1 + (size_t)M * 2048, B_H2S = B_H2TOK + (size_t)ML * 1024, B_ACTM = B_H2S + H2S_BYTES, B_FS = B_ACTM + ACTM_BYTES, AR_END = B_FS + FS_BYTES;
#endif

struct P {
    const float *x, *c, *ctx, *c_ctx, *ev_mod_w, *ev_mod_b, *ev_norm_g, *ev_w_in, *ev_conv_w, *ev_q_norm_g, *ev_w_uq, *ev_kv_norm_g, *ev_w_ukv, *ev_w_out,
        *ev_ffn_gate, *ev_ffn_up, *ev_ffn_down, *od_mod_w, *od_mod_b, *od_norm_g, *od_w_in, *od_lambda, *od_subln_g, *od_w_out, *od_router, *od_exp_gate, *od_exp_up, *od_exp_down;
    float* out; unsigned char* ws; int ph_lo, ph_hi;
};

__device__ __forceinline__ void ld_f32(const float* p, int lane, float (&v)[16]) {
#pragma unroll
    for (int j2 = 0; j2 < 2; ++j2) { const f32x4 a = *(const f32x4*)(p + 512 * j2 + 8 * lane), b = *(const f32x4*)(p + 512 * j2 + 8 * lane + 4);
#pragma unroll
        for (int i = 0; i < 4; ++i) { v[j2 * 8 + i] = a[i]; v[j2 * 8 + 4 + i] = b[i]; } }
}
__device__ __forceinline__ void st_f32(float* p, int lane, const float (&v)[16]) {
#pragma unroll
    for (int j2 = 0; j2 < 2; ++j2) { f32x4 a, b;
#pragma unroll
        for (int i = 0; i < 4; ++i) { a[i] = v[j2 * 8 + i]; b[i] = v[j2 * 8 + 4 + i]; }
        *(f32x4*)(p + 512 * j2 + 8 * lane) = a; *(f32x4*)(p + 512 * j2 + 8 * lane + 4) = b; }
}
__device__ __forceinline__ void unpack8(const u32x4 w, float* v) { v[0] = bflo(w.x); v[1] = bfhi(w.x); v[2] = bflo(w.y); v[3] = bfhi(w.y); v[4] = bflo(w.z); v[5] = bfhi(w.z); v[6] = bflo(w.w); v[7] = bfhi(w.w); }
__device__ __forceinline__ u32x4 pack8f(const float* v) { u32x4 w; w.x = cvt_pk_bf16(v[0], v[1]); w.y = cvt_pk_bf16(v[2], v[3]); w.z = cvt_pk_bf16(v[4], v[5]); w.w = cvt_pk_bf16(v[6], v[7]); return w; }
__device__ __forceinline__ void ld_bf16(const bf16_t* p, int lane, float (&v)[16]) {
#pragma unroll
    for (int j2 = 0; j2 < 2; ++j2) { const u32x4 w = *(const u32x4*)(p + 512 * j2 + 8 * lane); unpack8(w, &v[j2 * 8]); }
}
__device__ __forceinline__ void st_bf16(bf16_t* p, int lane, const float (&v)[16]) {
#pragma unroll
    for (int j2 = 0; j2 < 2; ++j2) *(u32x4*)(p + 512 * j2 + 8 * lane) = pack8f(&v[j2 * 8]);
}
__device__ __forceinline__ float sumsq16(const float (&v)[16]) { float s = 0.f;
#pragma unroll
    for (int i = 0; i < 16; ++i) s += v[i] * v[i];
    return wave_sum(s); }
__device__ __forceinline__ void resid16(float (&xv)[16], const float (&y)[16], const float* g, const float* gate, int lane) {
    const float ry = 1.0f / sqrtf(sumsq16(y) * (1.f / D) + EPS); float gv[16], tv[16]; ld_f32(g, lane, gv); ld_f32(gate, lane, tv);
#pragma unroll
    for (int i = 0; i < 16; ++i) xv[i] += tv[i] * (y[i] * ry * gv[i]);
}
__device__ __forceinline__ void normmod16(const float (&xv)[16], float (&h)[16], const float* g, const float* shift, const float* scale, int lane) {
    const float rx = 1.0f / sqrtf(sumsq16(xv) * (1.f / D) + EPS); float gv[16], sh[16], sc[16]; ld_f32(g, lane, gv); ld_f32(shift, lane, sh); ld_f32(scale, lane, sc);
#pragma unroll
    for (int i = 0; i < 16; ++i) h[i] = xv[i] * rx * gv[i] * (1.f + sc[i]) + sh[i];
}
__device__ __forceinline__ int rope_pos(int e) { return e < 32 ? 8 * (e >> 2) + (e & 3) : 8 * ((e - 32) >> 2) + 4 + (e & 3); }
__device__ __forceinline__ int rope_elem(int s) { const int i = s >> 3, j = s & 7; return j < 4 ? 4 * i + j : 32 + 4 * i + (j - 4); }

struct Ctx {
    LAS unsigned char* lds; unsigned char* ws; int tid, lane, wave, gw, ngw;
};

template <int MAP, bool OUT8 = false>
__device__ __forceinline__ void p0_item(const float* W, const float* W2, int ldw, int nvalid, int K, bf16_t* WT, LAS float* scr, int item, int nblk, int lane, float wscale = 1.f) {
    const int kb = item / nblk, nb = item % nblk, k0 = 64 * kb, n0 = 32 * nb; const int np = n0 + (lane & 31);
    const float* src = W; int col = np;
    if (MAP == 0) { if (np >= nvalid) col = -1; }
    if (MAP == 1) { const int h = np / MLA_QK, w = np % MLA_QK; col = w < MLA_NOPE ? np : h * MLA_QK + MLA_NOPE + rope_elem(w - MLA_NOPE); }
    if (MAP == 2) { const int g8 = np >> 3, j = np & 7; if (j < 4) { col = 4 * g8 + j; } else { src = W2; col = 4 * g8 + (j - 4); } }
    if (MAP == 3) { col = np < 2 * DIFFW ? (np & ~63) + rope_elem(np & 63) : np; }
#pragma unroll 8
    for (int i = 0; i < 32; ++i) { const int kk = 2 * i + (lane >> 5); scr[kk * 33 + (lane & 31)] = col >= 0 ? src[(size_t)(k0 + kk) * ldw + col] : 0.f; }
    asm volatile("s_waitcnt lgkmcnt(0)" ::: "memory");
    const int c = lane & 7;
#pragma unroll
    for (int j = 0; j < 4; ++j) { const int n = (lane >> 3) + 8 * j; const LAS float* s = scr + (8 * c) * 33 + n;
        if constexpr (OUT8) { u32x2 o; o.x = pg8::pack4_fp8(s[0 * 33] * wscale, s[1 * 33] * wscale, s[2 * 33] * wscale, s[3 * 33] * wscale); o.y = pg8::pack4_fp8(s[4 * 33] * wscale, s[5 * 33] * wscale, s[6 * 33] * wscale, s[7 * 33] * wscale);
            *(u32x2*)((unsigned char*)WT + (size_t)(n0 + n) * K + k0 + 8 * c) = o; }
        else { u32x4 o; o.x = cvt_pk_bf16(s[0 * 33], s[1 * 33]); o.y = cvt_pk_bf16(s[2 * 33], s[3 * 33]); o.z = cvt_pk_bf16(s[4 * 33], s[5 * 33]); o.w = cvt_pk_bf16(s[6 * 33], s[7 * 33]);
            *(u32x4*)(WT + (size_t)(n0 + n) * K + k0 + 8 * c) = o; } }
    asm volatile("s_waitcnt lgkmcnt(0)" ::: "memory");
}
__device__ __forceinline__ void p0_fold_item(const float* W, bf16_t* WT, LAS float* scr, const LAS float* tab, int item, int lane) {
    const int kb = item / 16, nb = item % 16, k0 = 64 * kb, n0 = 32 * nb; const int r = n0 + (lane & 31), part = r >> 8, g = (r >> 6) & 3, l = r & 63;
    for (int i = 0; i < 32; ++i) { const int kk = 2 * i + (lane >> 5); const float* wr = W + (size_t)(k0 + kk) * ODD_IN + 3 * DIFFW + g * 64; float a = 0.f;
        for (int j = 0; j < 64; ++j) a += wr[j] * tab[part * 64 + ((l * j) & 63)];
        scr[kk * 33 + (lane & 31)] = a; }
    asm volatile("s_waitcnt lgkmcnt(0)" ::: "memory");
    const int c = lane & 7;
#pragma unroll
    for (int j = 0; j < 4; ++j) { const int n = (lane >> 3) + 8 * j; const LAS float* s = scr + (8 * c) * 33 + n;
        u32x4 o; o.x = cvt_pk_bf16(s[0 * 33], s[1 * 33]); o.y = cvt_pk_bf16(s[2 * 33], s[3 * 33]); o.z = cvt_pk_bf16(s[4 * 33], s[5 * 33]); o.w = cvt_pk_bf16(s[6 * 33], s[7 * 33]);
        *(u32x4*)(WT + (size_t)(n0 + n) * D + k0 + 8 * c) = o; }
    asm volatile("s_waitcnt lgkmcnt(0)" ::: "memory");
}
__device__ __forceinline__ void p0_mod_unit(const P& p, const Ctx& c, int u) {
    const int layer = u / 48, col0 = (u % 48) * 128; const float* W = layer ? p.od_mod_w : p.ev_mod_w; const float* bias = layer ? p.od_mod_b : p.ev_mod_b;
    float* mod = (float*)(c.ws + WS_MODV) + (size_t)layer * 33 * 6144;
    LAS float* sc = (LAS float*)c.lds;
    LAS float* red = (LAS float*)(c.lds + 40960);
    const int n = c.tid & 127, kq = c.tid >> 7; float acc[33];
#pragma unroll
    for (int r = 0; r < 33; ++r) acc[r] = 0.f;
    for (int ch = 0; ch < 4; ++ch) {
        __syncthreads();
        for (int e = c.tid; e < 4 * 64 * 36; e += 512) { const int r = e % 36, kk = (e / 36) % 64, q = e / (36 * 64); const int k = q * 256 + ch * 64 + kk;
            float v = 0.f; if (r < 33) { const float cv = r < 32 ? p.c[r * D + k] : p.c_ctx[k]; v = cv / (1.f + expf(-cv)); } sc[e] = v; }
        __syncthreads();
        const float* wp = W + (size_t)(kq * 256 + ch * 64) * 6144 + col0 + n;
        for (int kk = 0; kk < 64; ++kk) { const float w = wp[(size_t)kk * 6144]; const LAS f32x4* s4 = (const LAS f32x4*)(sc + (kq * 64 + kk) * 36);
#pragma unroll
            for (int q = 0; q < 8; ++q) { const f32x4 s = s4[q];
#pragma unroll
                for (int i = 0; i < 4; ++i) acc[q * 4 + i] = fmaf(s[i], w, acc[q * 4 + i]); }
            acc[32] = fmaf(s4[8][0], w, acc[32]); }
    }
#pragma unroll
    for (int r = 0; r < 33; ++r) red[(kq * 33 + r) * 128 + n] = acc[r];
    __syncthreads();
    for (int r = kq; r < 33; r += 4) { const float v = red[(0 * 33 + r) * 128 + n] + red[(1 * 33 + r) * 128 + n] + red[(2 * 33 + r) * 128 + n] + red[(3 * 33 + r) * 128 + n];
        mod[(size_t)r * 6144 + col0 + n] = v + bias[col0 + n]; }
    __syncthreads();
}
__device__ __forceinline__ void phase_prologue(const P& p, const Ctx& c) {
    for (int u = blockIdx.x; u < 96; u += gridDim.x) p0_mod_unit(p, c, u);
    __syncthreads();
    LAS float* tab = (LAS float*)(c.lds + 8 * 16384);
    if (c.tid < 64) { const float a = (float)c.tid * (6.283185307179586f / 64.f); tab[c.tid] = cosf(a); tab[64 + c.tid] = sinf(a); }
    __syncthreads();
    LAS float* scr = (LAS float*)(c.lds + c.wave * 16384);
    constexpr int I0 = 16 * 72, I1 = 6 * 24, I2 = 4 * 32, I3 = 16 * 32, I4 = 16 * 176, I5 = 44 * 32, I6 = 16 * 72, I7 = 16 * 32, I8 = NE * I4, I9 = NE * I5, I10 = 16 * 16;
    constexpr int NITEMS = I0 + I1 + I2 + I3 + I4 + I5 + I6 + I7 + I8 + I9 + I10;
    for (int it = c.gw; it < NITEMS; it += c.ngw) {
        int r = it;
        if (r < I0) { p0_item<0>(p.ev_w_in, nullptr, EVEN_IN, EVEN_IN, D, (bf16_t*)(c.ws + W_IN0), scr, r, 72, c.lane); continue; } r -= I0;
        if (r < I1) { p0_item<1>(p.ev_w_uq, nullptr, 768, 768, QRANK, (bf16_t*)(c.ws + W_UQ), scr, r, 24, c.lane); continue; } r -= I1;
        if (r < I2) { p0_item<0>(p.ev_w_ukv, nullptr, 1024, 1024, KVRANK, (bf16_t*)(c.ws + W_UKV), scr, r, 32, c.lane); continue; } r -= I2;
        if (r < I3) { p0_item<0>(p.ev_w_out, nullptr, D, D, D, (bf16_t*)(c.ws + W_OUT0), scr, r, 32, c.lane); continue; } r -= I3;
        if (r < I4) { p0_item<2>(p.ev_ffn_gate, p.ev_ffn_up, FF, FF, D, (bf16_t*)(c.ws + W_GU0), scr, r, 176, c.lane); continue; } r -= I4;
        if (r < I5) { p0_item<0>(p.ev_ffn_down, nullptr, D, D, FF, (bf16_t*)(c.ws + W_DN0), scr, r, 32, c.lane); continue; } r -= I5;
        if (r < I6) { p0_item<3>(p.od_w_in, nullptr, ODD_IN, ODD_IN, D, (bf16_t*)(c.ws + W_IN1), scr, r, 72, c.lane); continue; } r -= I6;
        if (r < I7) { p0_item<0>(p.od_w_out, nullptr, D, D, D, (bf16_t*)(c.ws + W_OUT1), scr, r, 32, c.lane); continue; } r -= I7;
        if (r < I8) { const int e = r / I4; p0_item<2, true>(p.od_exp_gate + (size_t)e * D * FF, p.od_exp_up + (size_t)e * D * FF, FF, FF, D, (bf16_t*)(c.ws + W_GU1 + (size_t)e * 5632 * 1024), scr, r % I4, 176, c.lane, 32.f); continue; } r -= I8;
        if (r < I9) { const int e = r / I5; p0_item<0, true>(p.od_exp_down + (size_t)e * FF * D, nullptr, D, D, FF, (bf16_t*)(c.ws + W_DN1 + (size_t)e * 1024 * 2816), scr, r % I5, 32, c.lane, 64.f); continue; } r -= I9;
        p0_fold_item(p.od_w_in, (bf16_t*)(c.ws + W_FOLD), scr, tab, r, c.lane);
    }
    { bf16_t* dft = (bf16_t*)(c.ws + W_DFT); const int gt = blockIdx.x * 512 + c.tid, ngt = gridDim.x * 512; const float scl = 0.0027621358640099515f;
      for (int i8 = gt; i8 < 2048 * 4096 / 8; i8 += ngt) { const int k = i8 >> 9, tt0 = (i8 & 511) * 8; float v[8];
#pragma unroll
          for (int j = 0; j < 8; ++j) { const int tt = tt0 + j, t = tt & 2047, q = (k * t) & 2047; const float a = (float)q * (6.283185307179586f / 2048.f); v[j] = (tt < 2048 ? cosf(a) : -sinf(a)) * scl; }
          *(u32x4*)(dft + (size_t)i8 * 8) = pack8f(v); } }
    { float* rc = (float*)(c.ws + WS_ROPE); float* rs = rc + 2048 * 32; const int gt = blockIdx.x * 512 + c.tid, ngt = gridDim.x * 512;
      for (int i = gt; i < 2048 * 32; i += ngt) { const int t = i >> 5, f = i & 31; const int pos = f < 16 ? t / GW : t % GW; const float inv = powf(10000.f, -(float)(f & 15) / 16.f);
          const float ang = (float)pos * inv; rc[i] = cosf(ang); rs[i] = sinf(ang); } }
}

__device__ __forceinline__ const float* in_row(const P& p, int m) { const int b = m / S, j = m % S; return j < L ? p.ctx + ((size_t)b * L + j) * D : p.x + ((size_t)b * T + (j - L)) * D; }
__device__ __forceinline__ float* stream_row(const P& p, unsigned char* ws, int m) { const int b = m / S, j = m % S; return j < L ? (float*)(ws + WS_CTXS) + ((size_t)b * L + j) * D : p.out + ((size_t)b * T + (j - L)) * D; }
__device__ __forceinline__ const float* mod_row(unsigned char* ws, int layer, int m) { const int b = m / S, j = m % S; return (const float*)(ws + WS_MODV) + ((size_t)layer * 33 + (j < L ? 32 : b)) * 6144; }

__device__ __forceinline__ void phase_norm0(const P& p, const Ctx& c) {
    bf16_t* H = (bf16_t*)(c.ws + B_H);
    for (int m0 = c.gw * 2; m0 < M; m0 += c.ngw * 2) { float xv[2][16];
#pragma unroll
        for (int r = 0; r < 2; ++r) ld_f32(in_row(p, m0 + r), c.lane, xv[r]);
#pragma unroll
        for (int r = 0; r < 2; ++r) { const int m = m0 + r; float h[16]; const float* mr = mod_row(c.ws, 0, m);
            normmod16(xv[r], h, p.ev_norm_g, mr, mr + D, c.lane); st_bf16(H + (size_t)m * D, c.lane, h); } }
}
__device__ __forceinline__ void phase_even_elem(const P& p, const Ctx& c) {
    const bf16_t* Z = (const bf16_t*)(c.ws + B_Z); bf16_t* AO = (bf16_t*)(c.ws + B_AOUT0); bf16_t* ZQ = (bf16_t*)(c.ws + B_ZQN); bf16_t* ZKV = (bf16_t*)(c.ws + B_ZKVN); bf16_t* KPE = (bf16_t*)(c.ws + B_KPE);
    const float* rc = (const float*)(c.ws + WS_ROPE); const float* rs = rc + 2048 * 32; const int lane = c.lane;
    for (int m = c.gw; m < M; m += c.ngw) {
        const int j = m % S; const int lo = j < L ? 0 : L, hi = j < L ? L : S; const bf16_t* zr = Z + (size_t)m * 2304;
        {
            float bg[8], acc[8]; unpack8(*(const u32x4*)(zr + 8 * lane), bg);
#pragma unroll
            for (int i = 0; i < 8; ++i) acc[i] = 0.f;
#pragma unroll
            for (int dt = -1; dt <= 1; ++dt) { const int jj = j + dt; if (jj < lo || jj >= hi) continue; const bf16_t* zn = zr + (long)dt * 2304; float cg[8], uu[8], w[8];
                unpack8(*(const u32x4*)(zn + SCW + 8 * lane), cg); unpack8(*(const u32x4*)(zn + 2 * SCW + 8 * lane), uu);
                const f32x4 w0 = *(const f32x4*)(p.ev_conv_w + (dt + 1) * SCW + 8 * lane), w1 = *(const f32x4*)(p.ev_conv_w + (dt + 1) * SCW + 8 * lane + 4);
#pragma unroll
                for (int i = 0; i < 4; ++i) { w[i] = w0[i]; w[4 + i] = w1[i]; }
#pragma unroll
                for (int i = 0; i < 8; ++i) acc[i] += w[i] * (cg[i] * uu[i]); }
#pragma unroll
            for (int i = 0; i < 8; ++i) acc[i] *= bg[i];
            *(u32x4*)(AO + (size_t)m * D + 8 * lane) = pack8f(acc); }
        {
            float v[8]; float s = 0.f;
            if (lane < 48) { unpack8(*(const u32x4*)(zr + SCIN + 8 * lane), v);
#pragma unroll
                for (int i = 0; i < 8; ++i) s += v[i] * v[i]; }
            s = wave_sum(s); const float r = 1.0f / sqrtf(s * (1.f / QRANK) + EPS);
            if (lane < 48) { const f32x4 g0 = *(const f32x4*)(p.ev_q_norm_g + 8 * lane), g1 = *(const f32x4*)(p.ev_q_norm_g + 8 * lane + 4);
#pragma unroll
                for (int i = 0; i < 4; ++i) { v[i] *= r * g0[i]; v[4 + i] *= r * g1[i]; }
                *(u32x4*)(ZQ + (size_t)m * QRANK + 8 * lane) = pack8f(v); } }
        {
            float v[8]; float s = 0.f;
            if (lane < 32) { unpack8(*(const u32x4*)(zr + SCIN + QRANK + 8 * lane), v);
#pragma unroll
                for (int i = 0; i < 8; ++i) s += v[i] * v[i]; }
            s = wave_sum(s); const float r = 1.0f / sqrtf(s * (1.f / KVRANK) + EPS);
            if (lane < 32) { const f32x4 g0 = *(const f32x4*)(p.ev_kv_norm_g + 8 * lane), g1 = *(const f32x4*)(p.ev_kv_norm_g + 8 * lane + 4);
#pragma unroll
                for (int i = 0; i < 4; ++i) { v[i] *= r * g0[i]; v[4 + i] *= r * g1[i]; }
                *(u32x4*)(ZKV + (size_t)m * KVRANK + 8 * lane) = pack8f(v); } }
        if (lane < 32) {
            const bf16_t* kp = zr + SCIN + QRANK + KVRANK; const float k1 = bf2f(kp[lane]), k2 = bf2f(kp[32 + lane]); float cs = 1.f, sn = 0.f;
            if (j >= L) { cs = rc[(j - L) * 32 + lane]; sn = rs[(j - L) * 32 + lane]; }
            bf16_t* ko = KPE + (size_t)m * 64; ko[rope_pos(lane)] = f2bf(k1 * cs - k2 * sn); ko[rope_pos(32 + lane)] = f2bf(k1 * sn + k2 * cs); }
    }
}
__device__ __forceinline__ void phase_mid0(const P& p, const Ctx& c) {
    const bf16_t* Y = (const bf16_t*)(c.ws + B_Y); bf16_t* H2 = (bf16_t*)(c.ws + B_H2);
    for (int m0 = c.gw * 2; m0 < M; m0 += c.ngw * 2) { float xv[2][16], y[2][16];
#pragma unroll
        for (int r = 0; r < 2; ++r) { ld_f32(in_row(p, m0 + r), c.lane, xv[r]); ld_bf16(Y + (size_t)(m0 + r) * D, c.lane, y[r]); }
#pragma unroll
        for (int r = 0; r < 2; ++r) { const int m = m0 + r; float h[16]; const float* mr = mod_row(c.ws, 0, m);
            resid16(xv[r], y[r], p.ev_norm_g + D, mr + 2 * D, c.lane); st_f32(stream_row(p, c.ws, m), c.lane, xv[r]);
            normmod16(xv[r], h, p.ev_norm_g + 2 * D, mr + 3 * D, mr + 4 * D, c.lane); st_bf16(H2 + (size_t)m * D, c.lane, h); } }
}
__device__ __forceinline__ void phase_end0(const P& p, const Ctx& c) {
    const bf16_t* F = (const bf16_t*)(c.ws + B_F); bf16_t* H = (bf16_t*)(c.ws + B_H1);
    for (int m0 = c.gw * 2; m0 < M; m0 += c.ngw * 2) { float xv[2][16], y[2][16];
#pragma unroll
        for (int r = 0; r < 2; ++r) { ld_f32(stream_row(p, c.ws, m0 + r), c.lane, xv[r]); ld_bf16(F + (size_t)(m0 + r) * D, c.lane, y[r]); }
#pragma unroll
        for (int r = 0; r < 2; ++r) { const int m = m0 + r; float h[16]; const float* mr = mod_row(c.ws, 0, m);
            resid16(xv[r], y[r], p.ev_norm_g + 3 * D, mr + 5 * D, c.lane);
            if ((m % S) >= L) st_f32(stream_row(p, c.ws, m), c.lane, xv[r]);
            const float* mr1 = mod_row(c.ws, 1, m); normmod16(xv[r], h, p.od_norm_g, mr1, mr1 + D, c.lane); st_bf16(H + (size_t)m * D, c.lane, h); } }
}
__device__ __forceinline__ void phase_mid1(const P& p, const Ctx& c) {
    const bf16_t* Y = (const bf16_t*)(c.ws + B_Y1); unsigned char* H8 = c.ws + B_H2TOK;
    int* rinfo = (int*)(c.ws + RT_INFO); float* rw = (float*)(c.ws + RT_W); int* wcnt = (int*)(c.ws + RT_WCNT);
    volatile LAS int* wc = (volatile LAS int*)(c.lds) + c.wave * 8; const int lane = c.lane;
    for (int ch = blockIdx.x; ch < NCH; ch += gridDim.x) {
        if (lane < 8) wc[lane] = 0;
        for (int i0 = 0; i0 < 32; i0 += 2) {
            const int tok0 = ch * 256 + c.wave * 32 + i0; const int b = tok0 / T;
            float xv[2][16], y[2][16];
#pragma unroll
            for (int r = 0; r < 2; ++r) { const int tok = tok0 + r, t = tok % T; ld_f32(p.out + (size_t)tok * D, lane, xv[r]); ld_bf16(Y + ((size_t)b * S + L + t) * D, lane, y[r]); }
            const float* mr = (const float*)(c.ws + WS_MODV) + ((size_t)33 + b) * 6144;
            int e0[2], e1[2]; float w0[2], w1[2];
#pragma unroll
            for (int r = 0; r < 2; ++r) { const int tok = tok0 + r; float h[16];
                resid16(xv[r], y[r], p.od_norm_g + D, mr + 2 * D, lane); st_f32(p.out + (size_t)tok * D, lane, xv[r]);
                normmod16(xv[r], h, p.od_norm_g + 2 * D, mr + 3 * D, mr + 4 * D, lane);
#pragma unroll
                for (int j2 = 0; j2 < 2; ++j2) { u32x2 w; w.x = pg8::pack4_fp8(h[j2 * 8 + 0], h[j2 * 8 + 1], h[j2 * 8 + 2], h[j2 * 8 + 3]); w.y = pg8::pack4_fp8(h[j2 * 8 + 4], h[j2 * 8 + 5], h[j2 * 8 + 6], h[j2 * 8 + 7]);
                    *(u32x2*)(H8 + (size_t)tok * 1024 + 512 * j2 + 8 * lane) = w; }
                float lg[NE];
#pragma unroll
                for (int e = 0; e < NE; ++e) lg[e] = 0.f;
#pragma unroll
                for (int j2 = 0; j2 < 2; ++j2)
#pragma unroll
                    for (int i8 = 0; i8 < 8; ++i8) { const float* rr = p.od_router + (size_t)(512 * j2 + 8 * lane + i8) * NE; const f32x4 r0 = *(const f32x4*)rr, r1 = *(const f32x4*)(rr + 4); const float hv = h[j2 * 8 + i8];
#pragma unroll
                        for (int e = 0; e < 4; ++e) { lg[e] = fmaf(hv, r0[e], lg[e]); lg[4 + e] = fmaf(hv, r1[e], lg[4 + e]); } }
#pragma unroll
                for (int e = 0; e < NE; ++e) lg[e] = wave_sum(lg[e]);
                int a0 = 0; float v0 = lg[0];
#pragma unroll
                for (int e = 1; e < NE; ++e) if (lg[e] > v0) { v0 = lg[e]; a0 = e; }
                int a1 = -1; float v1 = -3.0e38f;
#pragma unroll
                for (int e = 0; e < NE; ++e) if (e != a0 && lg[e] > v1) { v1 = lg[e]; a1 = e; }
                const float p1 = expf(v1 - v0); e0[r] = a0; e1[r] = a1; w0[r] = 1.f / (1.f + p1); w1[r] = p1 / (1.f + p1); }
            if (lane == 0) {
#pragma unroll
                for (int r = 0; r < 2; ++r) { const int tok = tok0 + r; const int r0 = wc[e0[r]], r1 = wc[e1[r]]; wc[e0[r]] = r0 + 1; wc[e1[r]] = r1 + 1;
                    *(int4*)(rinfo + (size_t)tok * 4) = make_int4(e0[r], e1[r], r0, r1); *(float2*)(rw + (size_t)tok * 2) = make_float2(w0[r], w1[r]); } }
        }
        asm volatile("s_waitcnt lgkmcnt(0)" ::: "memory");
        if (lane < 8) wcnt[(ch * 8 + c.wave) * 8 + lane] = wc[lane];
    }
}
__device__ __forceinline__ void phase_gather(const P& p, const Ctx& c) {
    const int* rinfo = (const int*)(c.ws + RT_INFO); const int* wcnt = (const int*)(c.ws + RT_WCNT); int* tpos = (int*)(c.ws + RT_POS); int* toffg = (int*)(c.ws + RT_TOFF);
    const unsigned char* H8 = c.ws + B_H2TOK; unsigned char* HS = c.ws + B_H2S;
    LAS int* wpre = (LAS int*)c.lds;
    LAS int* csum = wpre + NCH * 64;
    LAS int* cpre = csum + NCH * 8;
    LAS int* eoff = cpre + NCH * 8;
    for (int i = c.tid; i < NCH * 8; i += 512) { const int ch = i >> 3, e = i & 7; int run = 0;
        for (int w = 0; w < 8; ++w) { wpre[(ch * 8 + w) * 8 + e] = run; run += wcnt[(ch * 8 + w) * 8 + e]; }
        csum[i] = run; }
    __syncthreads();
    if (c.tid < 8) { int run = 0; for (int ch = 0; ch < NCH; ++ch) { cpre[ch * 8 + c.tid] = run; run += csum[ch * 8 + c.tid]; } eoff[16 + c.tid] = run; }
    __syncthreads();
    if (c.tid == 0) { int o = 0; for (int e = 0; e < NE; ++e) { eoff[e] = o; o += (eoff[16 + e] + 255) & ~255; } eoff[NE] = o;
        if (blockIdx.x == 0) { for (int e = 0; e <= NE; ++e) toffg[e] = eoff[e] >> 8; } }
    __syncthreads();
    for (int t0 = c.gw * 2; t0 < ML; t0 += c.ngw * 2) { u32x4 a[2]; int p0[2], p1[2];
#pragma unroll
        for (int r = 0; r < 2; ++r) { const int tok = t0 + r; a[r] = *(const u32x4*)(H8 + (size_t)tok * 1024 + 16 * c.lane);
            const int4 ri = *(const int4*)(rinfo + (size_t)tok * 4); const int ch = tok >> 8, w = (tok >> 5) & 7;
            p0[r] = eoff[ri.x] + cpre[ch * 8 + ri.x] + wpre[(ch * 8 + w) * 8 + ri.x] + ri.z; p1[r] = eoff[ri.y] + cpre[ch * 8 + ri.y] + wpre[(ch * 8 + w) * 8 + ri.y] + ri.w; }
#pragma unroll
        for (int r = 0; r < 2; ++r) { const int tok = t0 + r; if (c.lane == 0) *(int2*)(tpos + (size_t)tok * 2) = make_int2(p0[r], p1[r]);
            *(u32x4*)(HS + (size_t)p0[r] * 1024 + 16 * c.lane) = a[r]; *(u32x4*)(HS + (size_t)p1[r] * 1024 + 16 * c.lane) = a[r]; } }
    for (int i = c.gw; i < NE * 256; i += c.ngw) { const int e = i >> 8, r = i & 255; const int n = eoff[16 + e], pad = ((n + 255) & ~255) - n;
        if (r < pad) { const u32x4 z = {0u, 0u, 0u, 0u}; *(u32x4*)(HS + (size_t)(eoff[e] + n + r) * 1024 + 16 * c.lane) = z; } }
}
__device__ __forceinline__ void phase_final(const P& p, const Ctx& c) {
    const bf16_t* FS = (const bf16_t*)(c.ws + B_FS); const int* tpos = (const int*)(c.ws + RT_POS); const float* rw = (const float*)(c.ws + RT_W);
    for (int t0 = c.gw * 2; t0 < ML; t0 += c.ngw * 2) { float xv[2][16], f0[2][16], f1[2][16]; float2 w[2];
#pragma unroll
        for (int r = 0; r < 2; ++r) { const int tok = t0 + r; const int2 ps = *(const int2*)(tpos + (size_t)tok * 2); w[r] = *(const float2*)(rw + (size_t)tok * 2);
            ld_f32(p.out + (size_t)tok * D, c.lane, xv[r]); ld_bf16(FS + (size_t)ps.x * D, c.lane, f0[r]); ld_bf16(FS + (size_t)ps.y * D, c.lane, f1[r]); }
#pragma unroll
        for (int r = 0; r < 2; ++r) { const int tok = t0 + r, b = tok / T;
#pragma unroll
            for (int i = 0; i < 16; ++i) f0[r][i] = w[r].x * f0[r][i] + w[r].y * f1[r][i];
            const float* mr = (const float*)(c.ws + WS_MODV) + ((size_t)33 + b) * 6144;
            resid16(xv[r], f0[r], p.od_norm_g + 3 * D, mr + 5 * D, c.lane); st_f32(p.out + (size_t)tok * D, c.lane, xv[r]); } }
}
constexpr int LDS_BYTES = 147456;
constexpr int LDS_MISC = 131072 + 2048;
constexpr int NPH = 19;

__device__ __forceinline__ void attn_mla_phase(const Ctx& c) {
    const bf16_t* Q0 = (const bf16_t*)(c.ws + B_Q0); const bf16_t* KN = (const bf16_t*)(c.ws + B_K0N); const bf16_t* KPE = (const bf16_t*)(c.ws + B_KPE); const bf16_t* V0 = (const bf16_t*)(c.ws + B_V0);
    bf16_t* AO = (bf16_t*)(c.ws + B_AOUT0);
    constexpr int NU_LAT = NB * MLA_H * 8, NU = NU_LAT + NB * MLA_H;
#pragma unroll 1
    for (int u = blockIdx.x; u < NU; u += gridDim.x) {
        int b, h, row0, seq;
        if (u < NU_LAT) { b = u / 32; h = (u >> 3) & 3; row0 = b * S + L + (u & 7) * 256; seq = S; } else { const int v = u - NU_LAT; b = v >> 2; h = v & 3; row0 = b * S; seq = L; }
        const att::KSrc ks{KN + (size_t)b * S * 512 + h * 128, 512, KPE + (size_t)b * S * 64, 64};
        const att::AOut ao{AO + (size_t)row0 * D + SCW + h * 128, D, nullptr, nullptr, 0.f, 0};
        att::attn_body_np<192>(Q0 + (size_t)row0 * 768 + h * MLA_QK, 768, ks, V0 + (size_t)b * S * 512 + h * 128, 512, seq, (char*)c.lds, ao);
    }
}
__device__ __forceinline__ void attn_diff_phase(const P& p, const Ctx& c) {
    const bf16_t* Q1 = (const bf16_t*)(c.ws + B_QKV1); const bf16_t* K1 = Q1 + (size_t)M * 768; const bf16_t* V1 = K1 + (size_t)M * 768; bf16_t* AO = (bf16_t*)(c.ws + B_AOUT1);
    float* stash = (float*)(c.ws + WS_STASH) + (size_t)blockIdx.x * 32768;
    float d01 = p.od_lambda[c.lane] * p.od_lambda[64 + c.lane], d23 = p.od_lambda[128 + c.lane] * p.od_lambda[192 + c.lane];
    d01 = wave_sum(d01); d23 = wave_sum(d23); const float lam = expf(d01) - expf(d23) + LAM_INIT;
    constexpr int NU = NB * DIFF_H * 8;
#pragma unroll 1
    for (int i2 = 2 * blockIdx.x; i2 < 2 * NU; i2 = (i2 & 1) ? i2 + 2 * (int)gridDim.x - 1 : i2 + 1) {
        const int it = i2 >> 1, sub = i2 & 1; const int b = it / 48, h = (it >> 3) % 6, row0 = b * S + L + (it & 7) * 256;
        const att::KSrc ks{K1 + (size_t)b * S * 768 + h * 128 + sub * 64, 768, nullptr, 0};
        const att::AOut ao{AO + (size_t)row0 * D + h * 128, D, stash, p.od_subln_g, lam, sub};
        att::attn_body<64, 2, 1>(Q1 + (size_t)row0 * 768 + h * 128 + sub * 64, 768, ks, V1 + (size_t)b * S * 768 + h * 128, 768, S, (char*)c.lds, ao);
    }
}
__device__ __forceinline__ void moe_load_toff(const Ctx& c, pg8::SchedMoe& Sm) {
    const int* toffg = (const int*)(c.ws + RT_TOFF);
#pragma unroll
    for (int e = 0; e <= NE; ++e) Sm.toff[e] = __builtin_amdgcn_readfirstlane(toffg[e]);
}

__global__ void __launch_bounds__(512, 2) fwd(P p) {
    extern __shared__ __attribute__((aligned(16))) unsigned char lds_[];
    Ctx c; c.lds = (LAS unsigned char*)lds_; c.ws = p.ws; c.tid = threadIdx.x; c.lane = c.tid & 63; c.wave = __builtin_amdgcn_readfirstlane(c.tid >> 6);
    c.gw = blockIdx.x * 8 + c.wave; c.ngw = gridDim.x * 8;
    volatile LAS unsigned* misc = (volatile LAS unsigned*)(c.lds + LDS_MISC);
    if (c.tid < 8) misc[c.tid] = 0u;
    __syncthreads();
    const int lo = p.ph_lo, hi = p.ph_hi;
    XcdBarrier bar; bar.bar = (unsigned*)(c.ws + WS_CTL) + CW_BAR; bar.x = 0; bar.st = misc;
    if (hi - lo > 1) bar = xcd_barrier_post((unsigned*)(c.ws + WS_CTL) + CW_BAR, misc);
#ifdef PH_ONLY
#define IN(k) ((k) == PH_ONLY)
#else
#define IN(k) (lo <= (k) && (k) < hi)
#endif
#define SEAM(k) do { if (IN(k) && IN((k) + 1)) xcd_barrier(bar); } while (0)
    LAS unsigned char* lds = c.lds;
    const float* rc = (const float*)(c.ws + WS_ROPE); const float* rs = rc + 2048 * 32;

#ifndef REPEAT_MASK
#define REPEAT_MASK 0u
#endif
#define REP(k) (((unsigned)(REPEAT_MASK) >> (k)) & 1u)
#define PHASE(k, ...) do { if (IN(k)) { __VA_ARGS__ if (REP(k)) { xcd_barrier(bar); __VA_ARGS__ } } SEAM(k); } while (0)
    PHASE(0, { phase_prologue(p, c); });
    PHASE(1, { phase_norm0(p, c); });
    PHASE(2, { pg8::Gemm g{D, D, D}; pg8::SchedPlain Sc; Sc.init(c.ws + B_H, D, c.ws + W_IN0, D, M / 256, 9, false); pg8::EpiPlain E{(bf16_t*)(c.ws + B_Z), 2304}; pg8::gemm_phase(lds, g, Sc, E); });
    PHASE(3, { phase_even_elem(p, c); });
    PHASE(4, {
        { pg8::Gemm g{QRANK, QRANK, QRANK}; pg8::SchedPlain Sc; Sc.init(c.ws + B_ZQN, QRANK, c.ws + W_UQ, QRANK, M / 256, 3, false); pg8::EpiQ0 E{(bf16_t*)(c.ws + B_Q0), rc, rs}; pg8::gemm_phase(lds, g, Sc, E); }
        { pg8::Gemm g{KVRANK, KVRANK, KVRANK}; pg8::SchedPlain Sc; Sc.init(c.ws + B_ZKVN, KVRANK, c.ws + W_UKV, KVRANK, M / 256, 4, false); pg8::EpiKV0 E{(bf16_t*)(c.ws + B_K0N), (bf16_t*)(c.ws + B_V0)}; pg8::gemm_phase(lds, g, Sc, E); }
    });
    PHASE(5, { attn_mla_phase(c); });
    PHASE(6, { pg8::Gemm g{D, D, D}; pg8::SchedPlain Sc; Sc.init(c.ws + B_AOUT0, D, c.ws + W_OUT0, D, M / 256, 4, false); pg8::EpiPlain E{(bf16_t*)(c.ws + B_Y), D}; pg8::gemm_phase(lds, g, Sc, E); });
    PHASE(7, { phase_mid0(p, c); });
    PHASE(8, { pg8::Gemm g{D, D, D}; pg8::SchedPlain Sc; Sc.init(c.ws + B_H2, D, c.ws + W_GU0, D, M / 256, 22, false); pg8::EpiSwiglu E{(bf16_t*)(c.ws + B_ACT), FF}; pg8::gemm_phase(lds, g, Sc, E); });
    PHASE(9, { pg8::Gemm g{FF, FF, FF}; pg8::SchedPlain Sc; Sc.init(c.ws + B_ACT, FF, c.ws + W_DN0, FF, M / 256, 4, false); pg8::EpiPlain E{(bf16_t*)(c.ws + B_F), D}; pg8::gemm_phase(lds, g, Sc, E); });
    PHASE(10, { phase_end0(p, c); });
    PHASE(11, {
        { pg8::Gemm g{D, D, D}; pg8::SchedPlain Sc; Sc.init(c.ws + B_H1, D, c.ws + W_IN1, D, M / 256, 9, false); pg8::EpiQKV1 E{(bf16_t*)(c.ws + B_QKV1), (size_t)M * 768, rc, rs}; pg8::gemm_phase(lds, g, Sc, E); }
        { pg8::Gemm g{D, D, D}; pg8::SchedF1 Sc{(const char*)(c.ws + W_FOLD), (const char*)(c.ws + B_H1), NB * 8, (int)gridDim.x, (int)blockIdx.x}; pg8::EpiGT E{(bf16_t*)(c.ws + B_GT)}; pg8::gemm_phase(lds, g, Sc, E); }
    });
    PHASE(12, {
        { pg8::Gemm g{4096, 4096, 4096}; pg8::SchedF2 Sc{(const char*)(c.ws + W_DFT), (const char*)(c.ws + B_GT), (int)gridDim.x, (int)blockIdx.x}; pg8::EpiPlain E{(bf16_t*)(c.ws + B_AOUT1) + DIFFW, D}; pg8::gemm_phase(lds, g, Sc, E); }
        attn_diff_phase(p, c);
    });
    PHASE(13, { pg8::Gemm g{D, D, D}; pg8::SchedPlain Sc; Sc.init(c.ws + B_AOUT1, D, c.ws + W_OUT1, D, NB * 8, 4, true); pg8::EpiPlain E{(bf16_t*)(c.ws + B_Y1), D}; pg8::gemm_phase(lds, g, Sc, E); });
    PHASE(14, { phase_mid1(p, c); });
    PHASE(15, { phase_gather(p, c); });
    PHASE(16, { pg8::SchedMoe Sm; moe_load_toff(c, Sm);
        Sm.A = (const char*)(c.ws + B_H2S); Sm.W = (const char*)(c.ws + W_GU1); Sm.at = (size_t)256 * 1024; Sm.bt = (size_t)256 * 1024; Sm.estride = (size_t)5632 * 1024; Sm.t0 = 0; Sm.nT = Sm.toff[NE]; Sm.nN = 22; Sm.G = gridDim.x; Sm.c = blockIdx.x;
        pg8::Gemm g{512, 512, 512, 0x7f7f7f7f, 0x7a7a7a7a}; pg8::EpiSwiglu8 E{c.ws + B_ACTM, FF, 8.f}; pg8::gemm_phase<pg8::EpiSwiglu8, pg8::SchedMoe, true>(lds, g, Sm, E); });
    PHASE(17, { pg8::SchedMoe Sm; moe_load_toff(c, Sm);
        Sm.A = (const char*)(c.ws + B_ACTM); Sm.W = (const char*)(c.ws + W_DN1); Sm.at = (size_t)256 * FF; Sm.bt = (size_t)256 * FF; Sm.estride = (size_t)1024 * 2816; Sm.t0 = 0; Sm.nT = Sm.toff[NE]; Sm.nN = 4; Sm.G = gridDim.x; Sm.c = blockIdx.x;
        pg8::Gemm g{FF / 2, FF / 2, FF / 2, 0x7c7c7c7c, 0x79797979}; pg8::EpiPlain E{(bf16_t*)(c.ws + B_FS), D}; pg8::gemm_phase<pg8::EpiPlain, pg8::SchedMoe, true>(lds, g, Sm, E); });
    PHASE(18, { phase_final(p, c); });
#undef PHASE
#undef REP
#undef IN
#undef SEAM
}
}
#ifndef CHECK_MODE
#define CHECK_MODE 0
#endif
#ifndef ONE_LAUNCH
#define ONE_LAUNCH 1
#endif

static fp::P make_params(void* const* d_in, void* d_out, void* d_ws) {
    fp::P p{}; const float** q = (const float**)&p; for (int i = 0; i < 28; ++i) q[i] = (const float*)d_in[i];
    p.out = (float*)d_out; p.ws = (unsigned char*)d_ws; p.ph_lo = 0; p.ph_hi = fp::NPH; return p;
}
static int fast_grid() {
    static int grid = 0;
    if (grid == 0) {
        int dev = 0, cus = 0;
        if (hipGetDevice(&dev) != hipSuccess || hipDeviceGetAttribute(&cus, hipDeviceAttributeMultiprocessorCount, dev) != hipSuccess) { grid = -1; return grid; }
        if (hipFuncSetAttribute((const void*)fp::fwd, hipFuncAttributeMaxDynamicSharedMemorySize, fp::LDS_BYTES) != hipSuccess) { grid = -1; return grid; }
        int per_cu = 0; (void)hipOccupancyMaxActiveBlocksPerMultiprocessor(&per_cu, (const void*)fp::fwd, 512, fp::LDS_BYTES); (void)hipGetLastError();
        if (per_cu < 1) fprintf(stderr, "occupancy query reports %d blocks per CU\n", per_cu);
        grid = cus > 256 ? 256 : cus;
    }
    return grid;
}
static void fast_forward(void* const* d_in, void* d_out, void* d_ws, hipStream_t stream, int ph_end, bool one_launch) {
    const int grid = fast_grid(); if (grid <= 0) return;
    (void)hipMemsetAsync((char*)d_ws + fp::WS_CTL, 0, fp::CTL_BYTES, stream);
    fp::P p = make_params(d_in, d_out, d_ws);
    if (one_launch) { p.ph_lo = 0; p.ph_hi = ph_end; hipLaunchKernelGGL(fp::fwd, dim3(grid), dim3(512), fp::LDS_BYTES, stream, p); }
    else for (int k = 0; k < ph_end; ++k) { p.ph_lo = k; p.ph_hi = k + 1; hipLaunchKernelGGL(fp::fwd, dim3(grid), dim3(512), fp::LDS_BYTES, stream, p); }
}

#if CHECK_MODE
namespace chk {
using namespace cfg;
__device__ __forceinline__ int rope_pos(int e) { return e < 32 ? 8 * (e >> 2) + (e & 3) : 8 * ((e - 32) >> 2) + 4 + (e & 3); }
__global__ void k_cmp(const void* fast, int fast_bf16, int ldf, int fcol0, const float* ref, int ldr, int rcol0, int rows, int cols, int rowmode, int perm, float* acc) {
    float sd = 0.f, sr = 0.f;
    for (long i = (long)blockIdx.x * 256 + threadIdx.x; i < (long)rows * cols; i += (long)gridDim.x * 256) {
        const int r = (int)(i / cols), ci = (int)(i % cols); int rr = r, fr = r;
        if (rowmode == 1 && (r % S) < L) continue;
        if (rowmode == 3 && (r % S) >= L) continue;
        if (rowmode == 2) { rr = (r / T) * S + L + (r % T); }
        int fc = ci;
        if (perm == 1) { const int h = ci / 192, w = ci % 192; fc = w < 128 ? ci : h * 192 + 128 + rope_pos(w - 128); }
        if (perm == 2) { fc = (ci & ~63) + rope_pos(ci & 63); }
        if (perm == 3) { fc = rope_pos(ci); }
        const float rv = ref[(long)rr * ldr + rcol0 + ci];
        const float fv = fast_bf16 ? __uint_as_float(((unsigned)((const unsigned short*)fast)[(long)fr * ldf + fcol0 + fc]) << 16) : ((const float*)fast)[(long)fr * ldf + fcol0 + fc];
        const float d = fv - rv; sd += d * d; sr += rv * rv;
    }
    for (int o = 32; o >= 1; o >>= 1) { sd += __shfl_xor(sd, o); sr += __shfl_xor(sr, o); }
    if ((threadIdx.x & 63) == 0) { atomicAdd(acc, sd); atomicAdd(acc + 1, sr); }
}
__global__ void k_cmp_gt(const unsigned short* gt, const float* gcs, int nb, float* acc) {
    float sd = 0.f, sr = 0.f;
    for (long i = (long)blockIdx.x * 256 + threadIdx.x; i < (long)nb * 2 * T * 256; i += (long)gridDim.x * 256) {
        const int c = (int)(i % 256); const int t = (int)((i / 256) % T); const int part = (int)((i / (256L * T)) % 2); const int b = (int)(i / (256L * T * 2));
        const float rv = gcs[i]; const float fv = __uint_as_float(((unsigned)gt[(((long)b * 256 + c) * 2 + part) * T + t]) << 16);
        const float d = fv - rv; sd += d * d; sr += rv * rv; }
    for (int o = 32; o >= 1; o >>= 1) { sd += __shfl_xor(sd, o); sr += __shfl_xor(sr, o); }
    if ((threadIdx.x & 63) == 0) { atomicAdd(acc, sd); atomicAdd(acc + 1, sr); }
}
__global__ void k_encode(const float* acc, int nchecks, float tol, const float* x, float* out, long n) {
    int code = 0;
    for (int k = 0; k < nchecks; ++k) { const float sd = acc[2 * k], sr = acc[2 * k + 1]; if (!(sd <= tol * sr) || !(sr > 0.f)) { code = k + 1; break; } }
    const float s = 1.f + (float)code;
    for (long i = (long)blockIdx.x * 256 + threadIdx.x; i < n; i += (long)gridDim.x * 256) out[i] = x[i] * s;
}
}
#endif

extern "C" void kernel_launch(void* const* d_in, const int* in_sizes, int n_in, void* d_out, int out_size, void* d_ws, size_t ws_size, hipStream_t stream) {
    (void)in_sizes; (void)n_in; (void)out_size;
#if CHECK_MODE
    using namespace cfg; using fp::M; using fp::ML;
    const nv::In I = nv::make_in(d_in);
    nv::Scratch s; char* nbase = (char*)d_ws + ((fp::AR_END + 4095) / 4096) * 4096;
    size_t need = nv::Scratch::carve(s, nbase, NB);
    float* snap0 = (float*)(nbase + need); need += (size_t)M * D * 4;
    float* snap1 = (float*)(nbase + need); need += (size_t)M * D * 4;
    float* snap2 = (float*)(nbase + need); need += (size_t)M * D * 4;
    float* acc = (float*)(nbase + need); need += 4096;
    if ((size_t)(nbase - (char*)d_ws) + need > ws_size) { fprintf(stderr, "check build: ws too small\n"); return; }
    nv::global_setup(stream, I, s);
    nv::forward_chunk(stream, I, s, 0, NB, nullptr, CHECK_MODE == 1 ? 3 : 7, snap0, snap1, snap2);
    fast_forward(d_in, d_out, d_ws, stream, CHECK_MODE == 1 ? 10 : fp::NPH, ONE_LAUNCH != 0);
    (void)hipMemsetAsync(acc, 0, 4096, stream);
    unsigned char* ws = (unsigned char*)d_ws; int k = 0;
#define CMP(fast, isbf, ldf, fc0, ref, ldr, rc0, rows, cols, rowmode, perm) do { hipLaunchKernelGGL(chk::k_cmp, dim3(512), dim3(256), 0, stream, (const void*)(fast), isbf, ldf, fc0, ref, ldr, rc0, rows, cols, rowmode, perm, acc + 2 * k); ++k; } while (0)
#if CHECK_MODE == 1
    CMP(ws + fp::WS_MODV, 0, 6144, 0, s.mod0, 6144, 0, 33, 6144, 0, 0);
    CMP(ws + fp::WS_MODV + (size_t)33 * 6144 * 4, 0, 6144, 0, s.mod1, 6144, 0, 33, 6144, 0, 0);
    CMP(ws + fp::B_H, 1, D, 0, snap0, D, 0, M, D, 0, 0);
    CMP(ws + fp::B_Z, 1, 2304, 0, s.z, EVEN_IN, 0, M, EVEN_IN, 0, 0);
    CMP(ws + fp::B_AOUT0, 1, D, 0, s.aout, D, 0, M, SCW, 0, 0);
    CMP(ws + fp::B_ZQN, 1, QRANK, 0, s.zqn, QRANK, 0, M, QRANK, 0, 0);
    CMP(ws + fp::B_ZKVN, 1, KVRANK, 0, s.zkvn, KVRANK, 0, M, KVRANK, 0, 0);
    CMP(ws + fp::B_KPE, 1, 64, 0, s.Kf, 768, 128, M, 64, 0, 3);
    CMP(ws + fp::B_Q0, 1, 768, 0, s.Qf, 768, 0, M, 768, 0, 1);
    for (int h = 0; h < 4; ++h) CMP(ws + fp::B_K0N, 1, 512, h * 128, s.Kf, 768, h * 192, M, 128, 0, 0);
    CMP(ws + fp::B_V0, 1, 512, 0, s.Vf, 512, 0, M, 512, 0, 0);
    CMP(ws + fp::B_AOUT0, 1, D, SCW, s.aout, D, SCW, M, 512, 1, 0);
    CMP(ws + fp::B_AOUT0, 1, D, SCW, s.aout, D, SCW, M, 512, 3, 0);
    CMP(ws + fp::B_Y, 1, D, 0, s.y, D, 0, M, D, 0, 0);
    CMP(d_out, 0, D, 0, s.xs, D, 0, ML, D, 2, 0);
    CMP(ws + fp::B_H2, 1, D, 0, s.h, D, 0, M, D, 0, 0);
    CMP(ws + fp::B_ACT, 1, FF, 0, s.act, FF, 0, M, FF, 0, 0);
    CMP(ws + fp::B_F, 1, D, 0, s.f, D, 0, M, D, 0, 0);
#else
    CMP(ws + fp::B_H1, 1, D, 0, snap1, D, 0, M, D, 0, 0);
    CMP(ws + fp::B_QKV1, 1, 768, 0, s.Qf, 768, 0, M, 768, 0, 2);
    CMP(ws + fp::B_QKV1 + (size_t)M * 1536, 1, 768, 0, s.Kf, 768, 0, M, 768, 0, 2);
    CMP(ws + fp::B_QKV1 + (size_t)M * 3072, 1, 768, 0, s.z, ODD_IN, 2 * DIFFW, M, 768, 0, 0);
    hipLaunchKernelGGL(chk::k_cmp_gt, dim3(512), dim3(256), 0, stream, (const unsigned short*)(ws + fp::B_GT), s.gcs, NB, acc + 2 * k); ++k;
    CMP(ws + fp::B_AOUT1, 1, D, DIFFW, s.aout, D, DIFFW, M, FNW, 1, 0);
    CMP(ws + fp::B_AOUT1, 1, D, 0, s.aout, D, 0, M, DIFFW, 1, 0);
    CMP(ws + fp::B_Y1, 1, D, 0, s.y, D, 0, M, D, 1, 0);
    CMP(d_out, 0, D, 0, s.xs, D, 0, ML, D, 2, 0);
#endif
#undef CMP
    hipLaunchKernelGGL(chk::k_encode, dim3(2048), dim3(256), 0, stream, acc, k, 2e-3f, (const float*)d_in[0], (float*)d_out, (long)FULLB * T * D);
#else
    if (ws_size < fp::AR_END) { fprintf(stderr, "kernel_launch: workspace too small: need %zu have %zu\n", (size_t)fp::AR_END, ws_size); return; }
    fast_forward(d_in, d_out, d_ws, stream, fp::NPH, ONE_LAUNCH != 0);
#endif
}
```

```cpp
#define ONE_LAUNCH 1
#include <hip/hip_runtime.h>
#include <cstdio>
#include <cstdint>
#include <cmath>

#ifndef CFG_NB
#define CFG_NB 32
#endif
namespace cfg {
constexpr int NB = CFG_NB;
constexpr int FULLB = 32;
constexpr int D = 1024, T = 2048, L = 256, S = T + L;
constexpr int GW = 64;
constexpr float EPS = 1e-6f;
constexpr int SCW = 512, SCIN = 1536;
constexpr int MLA_H = 4, MLA_NOPE = 128, MLA_ROPE = 64, MLA_V = 128, MLA_QK = 192, QRANK = 384, KVRANK = 256;
constexpr int EVEN_IN = 2240;
constexpr int DIFFW = 768, DIFF_H = 6, DIFF_HD = 64;
constexpr int FNW = 256, FNG = 4, FNGD = 64, ODD_IN = 2560;
constexpr int FF = 2816, NE = 8;
constexpr float LAM_INIT = 0.35550906759096944f;
}
namespace fp {
using namespace cfg;
#define LAS __attribute__((address_space(3)))
#define GAS __attribute__((address_space(1)))
typedef unsigned short bf16_t;
typedef short bf16x8 __attribute__((ext_vector_type(8)));
typedef short s16x4 __attribute__((ext_vector_type(4)));
typedef float f32x4 __attribute__((ext_vector_type(4)));
typedef float f32x2 __attribute__((ext_vector_type(2)));
typedef float f32x16 __attribute__((ext_vector_type(16)));
typedef unsigned u32x4 __attribute__((ext_vector_type(4)));
typedef unsigned u32x2 __attribute__((ext_vector_type(2)));

__device__ __forceinline__ unsigned cvt_pk_bf16(float lo, float hi) { unsigned r; asm volatile("v_cvt_pk_bf16_f32 %0, %1, %2" : "=v"(r) : "v"(lo), "v"(hi)); return r; }
__device__ __forceinline__ float bf2f(unsigned short b) { return __uint_as_float(((unsigned)b) << 16); }
__device__ __forceinline__ float bflo(unsigned w) { return __uint_as_float(w << 16); }
__device__ __forceinline__ float bfhi(unsigned w) { return __uint_as_float(w & 0xffff0000u); }
__device__ __forceinline__ unsigned short f2bf(float f) { return (unsigned short)(cvt_pk_bf16(f, 0.f) & 0xffffu); }
__device__ __forceinline__ float wave_sum(float v) {
#pragma unroll
    for (int o = 1; o < 64; o <<= 1) v += __shfl_xor(v, o);
    return v;
}
__device__ __forceinline__ float silu_f(float v) { return v / (1.f + __expf(-v)); }

#define XB_TMO      128
#define XB_XCNT(j)  (256  + 64 * (j))
#define XB_XSUB(j)  (1280 + 64 * (j))
#define XB_XGEN(j)  (2304 + 64 * (j))
#define XB_TOP      3328
#define XB_TOPGEN   3392
#define XCD_BAR_WORDS 3456
#define XB_SPIN_CAP (1u << 18)
__device__ __forceinline__ unsigned xb_ld(unsigned* p)              { return __hip_atomic_load(p, __ATOMIC_RELAXED, __HIP_MEMORY_SCOPE_AGENT); }
__device__ __forceinline__ unsigned xb_add(unsigned* p, unsigned v) { return __hip_atomic_fetch_add(p, v, __ATOMIC_RELAXED, __HIP_MEMORY_SCOPE_AGENT); }
__device__ __forceinline__ unsigned xb_xcc_id() { return (unsigned)__builtin_amdgcn_s_getreg((3 << 11) | 20) & 0xFu; }
#define XB_SPIN(cond, bar) do { unsigned _sp = 0; while (cond) { __builtin_amdgcn_s_sleep(1); \
    if ((++_sp & 255u) == 0u) { if (xb_ld(&(bar)[XB_TMO])) break; if (_sp > XB_SPIN_CAP) { atomicAdd(&(bar)[XB_TMO], 1u); break; } } } } while (0)
struct XcdBarrier { unsigned* bar; unsigned x; volatile LAS unsigned* st; };
__device__ __forceinline__ XcdBarrier xcd_barrier_post(unsigned* bar, volatile LAS unsigned* st) {
    XcdBarrier b; b.bar = bar; b.x = xb_xcc_id(); b.st = st;
    if (threadIdx.x == 0) (void)xb_add(&bar[XB_XCNT(b.x)], 1u);
    return b;
}
__device__ __forceinline__ void xcd_barrier_complete(unsigned* bar, unsigned x, unsigned& nloc, unsigned& nx) {
    const unsigned G = gridDim.x * gridDim.y * gridDim.z;
    unsigned sum, cnt, mine, sp = 0u;
    for (;;) {
        sum = 0u; cnt = 0u; mine = 0u;
#pragma unroll
        for (unsigned j = 0; j < 16; ++j) { const unsigned c = xb_ld(&bar[XB_XCNT(j)]); sum += c; cnt += (c > 0u) ? 1u : 0u; mine = (j == x) ? c : mine; }
        if (sum == G) break;
        __builtin_amdgcn_s_sleep(1);
        if ((++sp & 255u) == 0u) { if (xb_ld(&bar[XB_TMO])) break; if (sp > XB_SPIN_CAP) { atomicAdd(&bar[XB_TMO], 1u); break; } }
    }
    nloc = mine > 0u ? mine : 1u; nx = cnt > 0u ? cnt : 1u;
}
__device__ __forceinline__ void xcd_barrier(const XcdBarrier& b) {
    asm volatile("s_waitcnt vmcnt(0)" ::: "memory");
    __syncthreads();
    if (threadIdx.x == 0) {
        unsigned* bar = b.bar;
        __builtin_amdgcn_s_waitcnt(0);
        unsigned nloc = b.st[0], nx = b.st[1];
        if (nloc == 0u) { xcd_barrier_complete(bar, b.x, nloc, nx); b.st[0] = nloc; b.st[1] = nx; }
        const unsigned old = xb_add(&bar[XB_XSUB(b.x)], 1u);
        const unsigned gen = old / nloc;
        if (old + 1u == (gen + 1u) * nloc) {
            __builtin_amdgcn_fence(__ATOMIC_RELEASE, "agent");
            asm volatile("s_waitcnt vmcnt(0)" ::: "memory");
            const unsigned og = xb_add(&bar[XB_TOP], 1u);
            const unsigned tg = og / nx;
            if (og + 1u == (tg + 1u) * nx) xb_add(&bar[XB_TOPGEN], 1u);
            else XB_SPIN(xb_ld(&bar[XB_TOPGEN]) == tg, bar);
            __builtin_amdgcn_fence(__ATOMIC_ACQUIRE, "agent");
            xb_add(&bar[XB_XGEN(b.x)], 1u);
            asm volatile("s_waitcnt vmcnt(0)" ::: "memory");
        } else {
            XB_SPIN(xb_ld(&bar[XB_XGEN(b.x)]) == gen, bar);
            __builtin_amdgcn_fence(__ATOMIC_ACQUIRE, "agent");
            asm volatile("s_waitcnt vmcnt(0)" ::: "memory");
        }
    }
    __syncthreads();
}

namespace pg8 {
constexpr int BM = 256, BK = 64, HALF = 128, HTB = HALF * BK * 2, STAGE_BYTES = 8 * HTB, NXCD = 8, WGM = 8;
__host__ __device__ __forceinline__ int lds_byte(int r, int c) { const int st = (r >> 4) * 2 + (c >> 5), rr = r & 15, cc = c & 31, ob = rr * 64 + cc * 2; return st * 1024 + (ob ^ (((ob >> 9) & 1) << 5)); }
__host__ __device__ __forceinline__ void stage_rc(int b, int& R, int& C) { const int st = b / 1024, sb = b % 1024, swz = sb ^ (((sb >> 9) & 1) << 5); R = (st >> 1) * 16 + swz / 64; C = (st & 1) * 32 + (swz % 64) / 2; }
__host__ __device__ __forceinline__ int perm32(int rho) { const int n = rho >> 4, i = rho & 15; return 8 * (i >> 2) + 4 * n + (i & 3); }
struct Unit { const char* a; const char* b; int pm, pn; };
struct Gemm { int lda, ldb, K; int sa = 0x7f7f7f7f, sb = 0x7f7f7f7f; };
typedef int i32x8 __attribute__((ext_vector_type(8)));
typedef int i32x4 __attribute__((ext_vector_type(4)));
__device__ __forceinline__ bool tile_of(int i, int G, int c, int nM, int nN, int& pm, int& pn) {
    const int nwg = nM * nN; const long Lq = (long)i * G + c; if (Lq >= nwg) return false;
    int wgid = (int)Lq; { const int q = nwg / NXCD, r = nwg % NXCD, xcd = wgid % NXCD, off = wgid / NXCD; wgid = (xcd < r ? xcd * (q + 1) : r * (q + 1) + (xcd - r) * q) + off; }
    const int nig = WGM * nN, gid = wgid / nig, fm = gid * WGM, gsz = (nM - fm) < WGM ? (nM - fm) : WGM;
    pm = fm + ((wgid % nig) % gsz); pn = (wgid % nig) / gsz; return true;
}
__device__ __forceinline__ const char* uni_ptr(const char* p) { const unsigned long long v = (unsigned long long)p; const unsigned lo = __builtin_amdgcn_readfirstlane((unsigned)v), hi = __builtin_amdgcn_readfirstlane((unsigned)(v >> 32)); return (const char*)(((unsigned long long)hi << 32) | lo); }
__device__ __forceinline__ void uni_unit(Unit& u) { u.a = uni_ptr(u.a); u.b = uni_ptr(u.b); u.pm = __builtin_amdgcn_readfirstlane(u.pm); u.pn = __builtin_amdgcn_readfirstlane(u.pn); }
template <class Epi, class Sched, bool FP8 = false>
__device__ __forceinline__ void gemm_phase(LAS unsigned char* lds, const Gemm g, const Sched& S, const Epi& E) {
    const int tid = threadIdx.x, wid = __builtin_amdgcn_readfirstlane(tid >> 6), lane = tid & 63, wr = wid >> 2, wc = wid & 3, fr = lane & 15, fq = lane >> 4;
    const int K = g.K, nt = K / BK;
    unsigned voffA[2], voffB[2];
#pragma unroll
    for (int i = 0; i < 2; ++i) { int R, C; stage_rc(tid * 16 + i * 8192, R, C); const int Rb = Epi::PERM ? ((R & ~31) + perm32(R & 31)) : R;
        voffA[i] = (unsigned)(R * g.lda + C) * 2u; voffB[i] = (unsigned)(Rb * g.ldb + C) * 2u; }
    const size_t kstep = (size_t)(BK * 2);
    const size_t hstepA = (size_t)HALF * g.lda * 2, hstepB = (size_t)HALF * g.ldb * 2;
    const unsigned ldsw = (unsigned)wid * 1024u;
    const int aoff = lds_byte(wr * 64 + fr, fq * 8), boff = lds_byte(wc * 32 + fr, fq * 8);
#define PG8_SA(b, h) (((b) * 2 + (h)) * HTB)
#define PG8_SB(b, h) ((4 + (b) * 2 + (h)) * HTB)
#define PG8_STAGE(bufoff, gbase, voff) do { const char* _gb = (const char*)(gbase); asm volatile("" : "+s"(_gb));     \
        _Pragma("unroll") for (int _i = 0; _i < 2; ++_i) \
        __builtin_amdgcn_global_load_lds((const unsigned*)(_gb + (voff)[_i]), (LAS unsigned*)(lds + (bufoff) + ldsw + _i * 8192), 16, 0, 0); } while (0)
#define PG8_CAT(x0, x1) __builtin_shufflevector(x0, x1, 0, 1, 2, 3, 4, 5, 6, 7)
#define PG8_LDA(dst, b, h) do { if constexpr (FP8) { _Pragma("unroll") for (int m = 0; m < 4; ++m) dst##8[m] = PG8_CAT(*(const LAS i32x4*)(lds + PG8_SA(b, h) + aoff + m * 2048), *(const LAS i32x4*)(lds + PG8_SA(b, h) + aoff + m * 2048 + 1024)); } \
        else { _Pragma("unroll") for (int m = 0; m < 4; ++m) _Pragma("unroll") for (int k = 0; k < 2; ++k) dst[m][k] = *(const LAS bf16x8*)(lds + PG8_SA(b, h) + aoff + m * 2048 + k * 1024); } } while (0)
#define PG8_LDB(dst, b, h) do { if constexpr (FP8) { _Pragma("unroll") for (int n = 0; n < 2; ++n) dst##8[n] = PG8_CAT(*(const LAS i32x4*)(lds + PG8_SB(b, h) + boff + n * 2048), *(const LAS i32x4*)(lds + PG8_SB(b, h) + boff + n * 2048 + 1024)); } \
        else { _Pragma("unroll") for (int n = 0; n < 2; ++n) _Pragma("unroll") for (int k = 0; k < 2; ++k) dst[n][k] = *(const LAS bf16x8*)(lds + PG8_SB(b, h) + boff + n * 2048 + k * 1024); } } while (0)
#define PG8_MMA(ai, bj, At, Bt) do { __builtin_amdgcn_s_setprio(1); \
        if constexpr (FP8) { _Pragma("unroll") for (int m = 0; m < 4; ++m) _Pragma("unroll") for (int n = 0; n < 2; ++n) \
            asm volatile("v_mfma_scale_f32_16x16x128_f8f6f4 %0, %1, %2, %0, %3, %4 op_sel_hi:[0,0,0]" : "+v"(acc[ai][bj][m][n]) : "v"(Bt##8[n]), "v"(At##8[m]), "v"(g.sb), "v"(g.sa));   } \
        else { _Pragma("unroll") for (int m = 0; m < 4; ++m) _Pragma("unroll") for (int n = 0; n < 2; ++n) _Pragma("unroll") for (int k = 0; k < 2; ++k) \
            acc[ai][bj][m][n] = __builtin_amdgcn_mfma_f32_16x16x32_bf16(Bt[n][k], At[m][k], acc[ai][bj][m][n], 0, 0, 0); } \
        __builtin_amdgcn_s_setprio(0); } while (0)
#define PG8_WAIT_V(n) asm volatile("s_waitcnt vmcnt(" #n ")" ::: "memory")
#define PG8_WAIT_L(n) asm volatile("s_waitcnt lgkmcnt(" #n ")" ::: "memory")
#define PG8_BAR __builtin_amdgcn_s_barrier()
#define PG8_SCHED __builtin_amdgcn_sched_barrier(0)
    Unit cur, nxt; int ui = 0;
    if (!S.next(0, cur)) return;
    uni_unit(cur);
    f32x4 acc[2][2][4][2];
#pragma unroll
    for (int a = 0; a < 2; ++a)
#pragma unroll
        for (int b = 0; b < 2; ++b)
#pragma unroll
            for (int m = 0; m < 4; ++m)
#pragma unroll
                for (int n = 0; n < 2; ++n) acc[a][b][m][n] = (f32x4){0.f, 0.f, 0.f, 0.f};
    bf16x8 At[4][2], B0[2][2], B1[2][2]; i32x8 At8[4], B08[2], B18[2];
    const char* cA = cur.a; const char* cB = cur.b;
    PG8_STAGE(PG8_SB(0, 0), cB, voffB); PG8_STAGE(PG8_SA(0, 0), cA, voffA); PG8_STAGE(PG8_SB(0, 1), cB + hstepB, voffB); PG8_STAGE(PG8_SA(0, 1), cA + hstepA, voffA);
    if (wr == 1) PG8_BAR;
    PG8_WAIT_V(4); PG8_BAR;
    PG8_STAGE(PG8_SB(1, 0), cB + kstep, voffB); PG8_STAGE(PG8_SA(1, 0), cA + kstep, voffA); PG8_STAGE(PG8_SB(1, 1), cB + hstepB + kstep, voffB);
    PG8_WAIT_V(6); PG8_BAR;
    for (;;) {
        const bool has_next = S.next(ui + 1, nxt); if (has_next) uni_unit(nxt);
        const char* nA = has_next ? nxt.a : cA; const char* nB = has_next ? nxt.b : cB;
#pragma unroll 1
        for (int t = 0; t < nt; t += 2) {
            const bool last = (t == nt - 2);
            const char* a1 = cA + (size_t)(t + 1) * kstep;
            const char* a2 = last ? nA : cA + (size_t)(t + 2) * kstep; const char* b2 = last ? nB : cB + (size_t)(t + 2) * kstep;
            const char* a3 = a2 + kstep; const char* b3 = b2 + kstep;
            PG8_LDB(B0, 0, 0); PG8_SCHED; PG8_LDA(At, 0, 0); PG8_STAGE(PG8_SA(1, 1), a1 + hstepA, voffA);
            PG8_WAIT_L(8); PG8_BAR; PG8_WAIT_L(0); PG8_MMA(0, 0, At, B0); PG8_BAR; PG8_SCHED;
            PG8_LDB(B1, 0, 1); PG8_STAGE(PG8_SB(0, 0), b2, voffB);
            PG8_BAR; PG8_WAIT_L(0); PG8_MMA(0, 1, At, B1); PG8_BAR;
            PG8_LDA(At, 0, 1); PG8_STAGE(PG8_SA(0, 0), a2, voffA);
            PG8_BAR; PG8_WAIT_L(0); PG8_MMA(1, 0, At, B0); PG8_BAR; PG8_SCHED;
            PG8_STAGE(PG8_SB(0, 1), b2 + hstepB, voffB);
            PG8_WAIT_V(6); PG8_BAR; PG8_MMA(1, 1, At, B1); PG8_BAR;
            PG8_LDB(B0, 1, 0); PG8_SCHED; PG8_LDA(At, 1, 0); PG8_STAGE(PG8_SA(0, 1), a2 + hstepA, voffA);
            PG8_WAIT_L(8); PG8_BAR; PG8_WAIT_L(0); PG8_MMA(0, 0, At, B0); PG8_BAR; PG8_SCHED;
            PG8_LDB(B1, 1, 1); PG8_STAGE(PG8_SB(1, 0), b3, voffB);
            PG8_BAR; PG8_WAIT_L(0); PG8_MMA(0, 1, At, B1); PG8_BAR;
            PG8_LDA(At, 1, 1); PG8_STAGE(PG8_SA(1, 0), a3, voffA);
            PG8_BAR; PG8_WAIT_L(0); PG8_MMA(1, 0, At, B0); PG8_BAR; PG8_SCHED;
            PG8_STAGE(PG8_SB(1, 1), b3 + hstepB, voffB);
            PG8_WAIT_V(6); PG8_BAR; PG8_MMA(1, 1, At, B1); PG8_BAR;
        }
        if constexpr (FP8) asm volatile("s_nop 15\n\ts_nop 7" ::: "memory");
        E(acc, cur, wr, wc, fr, fq);
        if (!has_next) break;
#pragma unroll
        for (int a = 0; a < 2; ++a)
#pragma unroll
            for (int b = 0; b < 2; ++b)
#pragma unroll
                for (int m = 0; m < 4; ++m)
#pragma unroll
                    for (int n = 0; n < 2; ++n) acc[a][b][m][n] = (f32x4){0.f, 0.f, 0.f, 0.f};
        cur = nxt; cA = nA; cB = nB; ++ui;
    }
    PG8_WAIT_V(0);
    if (wr == 0) PG8_BAR;
    PG8_BAR;
#undef PG8_SA
#undef PG8_SB
#undef PG8_STAGE
#undef PG8_LDA
#undef PG8_LDB
#undef PG8_MMA
#undef PG8_CAT
#undef PG8_WAIT_V
#undef PG8_WAIT_L
#undef PG8_BAR
#undef PG8_SCHED
}

struct SchedPlain {
    const char* A; const char* Bt; size_t at, bt; int nM, nN, G, c; bool latM;
    __device__ __forceinline__ void init(const void* A_, int lda, const void* Bt_, int ldb, int nM_, int nN_, bool latM_) {
        A = (const char*)A_; Bt = (const char*)Bt_; at = (size_t)256 * lda * 2; bt = (size_t)256 * ldb * 2; nM = nM_; nN = nN_; G = gridDim.x; c = blockIdx.x; latM = latM_; }
    __device__ __forceinline__ bool next(int i, Unit& u) const {
        int pm, pn; if (!tile_of(i, G, c, nM, nN, pm, pn)) return false;
        if (latM) pm = (pm >> 3) * 9 + 1 + (pm & 7);
        u.pm = pm; u.pn = pn; u.a = A + (size_t)pm * at; u.b = Bt + (size_t)pn * bt; return true; }
};
struct SchedF1 {
    const char* A; const char* H; int nN, G, c;
    __device__ __forceinline__ bool next(int i, Unit& u) const {
        int pm, pn; if (!tile_of(i, G, c, 2, nN, pm, pn)) return false;
        u.pm = pm; u.pn = pn; u.a = A + (size_t)pm * 256 * D * 2; u.b = H + (size_t)((pn >> 3) * 9 + 1 + (pn & 7)) * 256 * D * 2; return true; }
};
struct SchedF2 {
    const char* Dft; const char* GT; int G, c;
    __device__ __forceinline__ bool next(int i, Unit& u) const {
        const int L_ = i * G + c; if (L_ >= NB * 8) return false; const int b = L_ >> 3, kt = L_ & 7;
        u.pm = b * 9 + 1 + kt; u.pn = 0; u.a = Dft + (size_t)kt * 256 * 4096 * 2; u.b = GT + (size_t)b * 256 * 4096 * 2; return true; }
};
struct SchedMoe {
    const char* A; const char* W; size_t at, bt, estride; int t0, nT, nN, G, c; int toff[NE + 1];
    __device__ __forceinline__ bool next(int i, Unit& u) const {
        int pm, pn; if (!tile_of(i, G, c, nT, nN, pm, pn)) return false; pm += t0;
        int e = 0;
#pragma unroll
        for (int j = 1; j < NE; ++j) e += (pm >= toff[j]) ? 1 : 0;
        u.pm = pm; u.pn = pn; u.a = A + (size_t)pm * at; u.b = W + (size_t)e * estride + (size_t)pn * bt; return true; }
};

#define EPI_LOOP_ROWS for (int ai = 0; ai < 2; ++ai) _Pragma("unroll") for (int m = 0; m < 4; ++m)
__device__ __forceinline__ u32x4 pack8(const f32x4 a, const f32x4 b) { u32x4 w; w.x = cvt_pk_bf16(a[0], a[1]); w.y = cvt_pk_bf16(a[2], a[3]); w.z = cvt_pk_bf16(b[0], b[1]); w.w = cvt_pk_bf16(b[2], b[3]); return w; }
struct EpiPlain {
    static constexpr bool PERM = true; bf16_t* O; int ldo;
    __device__ __forceinline__ void operator()(const f32x4 (&acc)[2][2][4][2], const Unit& u, int wr, int wc, int fr, int fq) const {
        const int row0 = u.pm * BM + wr * 64 + fr, col0 = u.pn * BM + wc * 32 + 8 * fq;
#pragma unroll
        EPI_LOOP_ROWS { bf16_t* rowp = O + (size_t)(row0 + ai * HALF + m * 16) * ldo + col0;
#pragma unroll
            for (int bj = 0; bj < 2; ++bj) *(u32x4*)(rowp + bj * HALF) = pack8(acc[ai][bj][m][0], acc[ai][bj][m][1]); }
    }
};
struct EpiSwiglu {
    static constexpr bool PERM = true; bf16_t* O; int ldo; int skip = 0;
    __device__ __forceinline__ void operator()(const f32x4 (&acc)[2][2][4][2], const Unit& u, int wr, int wc, int fr, int fq) const {
        if (skip) {
#pragma unroll
            for (int ai = 0; ai < 2; ++ai)
#pragma unroll
                for (int bj = 0; bj < 2; ++bj)
#pragma unroll
                    for (int m = 0; m < 4; ++m) { asm volatile("" :: "v"(acc[ai][bj][m][0]), "v"(acc[ai][bj][m][1])); }
            return; }
        const int row0 = u.pm * BM + wr * 64 + fr, col0 = u.pn * 128 + wc * 16 + 4 * fq;
#pragma unroll
        EPI_LOOP_ROWS { bf16_t* rowp = O + (size_t)(row0 + ai * HALF + m * 16) * ldo + col0;
#pragma unroll
            for (int bj = 0; bj < 2; ++bj) { const f32x4 g = acc[ai][bj][m][0], up = acc[ai][bj][m][1]; f32x4 a;
#pragma unroll
                for (int j = 0; j < 4; ++j) a[j] = g[j] * __builtin_amdgcn_rcpf(1.f + __expf(-g[j])) * up[j];
                u32x2 w; w.x = cvt_pk_bf16(a[0], a[1]); w.y = cvt_pk_bf16(a[2], a[3]); *(u32x2*)(rowp + bj * 64) = w; } }
    }
};
__device__ __forceinline__ unsigned pack4_fp8(float a, float b, float c, float d) {
    a = __builtin_amdgcn_fmed3f(a, -448.f, 448.f); b = __builtin_amdgcn_fmed3f(b, -448.f, 448.f); c = __builtin_amdgcn_fmed3f(c, -448.f, 448.f); d = __builtin_amdgcn_fmed3f(d, -448.f, 448.f);
    int p = __builtin_amdgcn_cvt_pk_fp8_f32(a, b, 0, false); p = __builtin_amdgcn_cvt_pk_fp8_f32(c, d, p, true); return (unsigned)p; }
struct EpiSwiglu8 {
    static constexpr bool PERM = true; unsigned char* O; int ldo; float oscale;
    __device__ __forceinline__ void operator()(const f32x4 (&acc)[2][2][4][2], const Unit& u, int wr, int wc, int fr, int fq) const {
        const int row0 = u.pm * BM + wr * 64 + fr, col0 = u.pn * 128 + wc * 16 + 4 * fq;
#pragma unroll
        EPI_LOOP_ROWS { unsigned char* rowp = O + (size_t)(row0 + ai * HALF + m * 16) * ldo + col0;
#pragma unroll
            for (int bj = 0; bj < 2; ++bj) { const f32x4 g = acc[ai][bj][m][0], up = acc[ai][bj][m][1]; f32x4 a;
#pragma unroll
                for (int j = 0; j < 4; ++j) a[j] = g[j] * __builtin_amdgcn_rcpf(1.f + __expf(-g[j])) * up[j] * oscale;
                *(unsigned*)(rowp + bj * 64) = pack4_fp8(a[0], a[1], a[2], a[3]); } }
    }
};
struct EpiQ0 {
    static constexpr bool PERM = true; bf16_t* O; const float* rc; const float* rs;
    __device__ __forceinline__ void operator()(const f32x4 (&acc)[2][2][4][2], const Unit& u, int wr, int wc, int fr, int fq) const {
        const int row0 = u.pm * BM + wr * 64 + fr, col0 = u.pn * BM + wc * 32 + 8 * fq; const int pj = u.pm % 9; const bool lat = pj != 0; const int t0 = (pj - 1) * 256 + wr * 64 + fr;
#pragma unroll
        EPI_LOOP_ROWS { const int row = row0 + ai * HALF + m * 16; const int t = t0 + ai * HALF + m * 16; bf16_t* rowp = O + (size_t)row * 768 + col0;
#pragma unroll
            for (int bj = 0; bj < 2; ++bj) { const int cb = col0 + bj * HALF, within = cb % MLA_QK; f32x4 v0 = acc[ai][bj][m][0], v1 = acc[ai][bj][m][1];
                if (lat && within >= MLA_NOPE) { const int f0 = ((within - MLA_NOPE) >> 3) * 4; const f32x4 cs = *(const f32x4*)(rc + t * 32 + f0), sn = *(const f32x4*)(rs + t * 32 + f0);
                    const f32x4 o1 = v0 * cs - v1 * sn, o2 = v0 * sn + v1 * cs; v0 = o1; v1 = o2; }
                *(u32x4*)(rowp + bj * HALF) = pack8(v0, v1); }
            asm volatile("" ::: "memory"); }
    }
};
struct EpiKV0 {
    static constexpr bool PERM = true; bf16_t* Kn; bf16_t* V;
    __device__ __forceinline__ void operator()(const f32x4 (&acc)[2][2][4][2], const Unit& u, int wr, int wc, int fr, int fq) const {
        const int row0 = u.pm * BM + wr * 64 + fr, col0 = u.pn * 128 + wc * 32 + 8 * fq;
#pragma unroll
        EPI_LOOP_ROWS { const size_t ro = (size_t)(row0 + ai * HALF + m * 16) * 512 + col0;
            *(u32x4*)(Kn + ro) = pack8(acc[ai][0][m][0], acc[ai][0][m][1]); *(u32x4*)(V + ro) = pack8(acc[ai][1][m][0], acc[ai][1][m][1]); }
    }
};
struct EpiQKV1 {
    static constexpr bool PERM = true; bf16_t* O; size_t tstride; const float* rc; const float* rs;
    __device__ __forceinline__ void operator()(const f32x4 (&acc)[2][2][4][2], const Unit& u, int wr, int wc, int fr, int fq) const {
        const int which = u.pn / 3; const int row0 = u.pm * BM + wr * 64 + fr, col0 = (u.pn % 3) * BM + wc * 32 + 8 * fq; const int pj = u.pm % 9; const bool rope = (pj != 0) && which < 2;
        const int t0 = (pj - 1) * 256 + wr * 64 + fr; bf16_t* base = O + (size_t)which * tstride;
#pragma unroll
        EPI_LOOP_ROWS { const int row = row0 + ai * HALF + m * 16; const int t = t0 + ai * HALF + m * 16; bf16_t* rowp = base + (size_t)row * 768 + col0;
#pragma unroll
            for (int bj = 0; bj < 2; ++bj) { const int cb = col0 + bj * HALF; f32x4 v0 = acc[ai][bj][m][0], v1 = acc[ai][bj][m][1];
                if (rope) { const int f0 = ((cb & 63) >> 3) * 4; const f32x4 cs = *(const f32x4*)(rc + t * 32 + f0), sn = *(const f32x4*)(rs + t * 32 + f0);
                    const f32x4 o1 = v0 * cs - v1 * sn, o2 = v0 * sn + v1 * cs; v0 = o1; v1 = o2; }
                *(u32x4*)(rowp + bj * HALF) = pack8(v0, v1); }
            asm volatile("" ::: "memory"); }
    }
};
struct EpiGT {
    static constexpr bool PERM = true; bf16_t* O;
    __device__ __forceinline__ void operator()(const f32x4 (&acc)[2][2][4][2], const Unit& u, int wr, int wc, int fr, int fq) const {
        const int b = u.pn >> 3, tt = u.pn & 7, part = u.pm; const int c0 = wr * 64 + fr, t0 = tt * 256 + wc * 32 + 8 * fq;
#pragma unroll
        EPI_LOOP_ROWS { const int c = c0 + ai * HALF + m * 16; bf16_t* rowp = O + ((size_t)(b * 256 + c) * 2 + part) * 2048 + t0;
#pragma unroll
            for (int bj = 0; bj < 2; ++bj) *(u32x4*)(rowp + bj * HALF) = pack8(acc[ai][bj][m][0], acc[ai][bj][m][1]); }
    }
};
}
namespace att {
constexpr int NW = 8, QBLK = 32, KVBLK = 64, DV = 128;
constexpr float THR = 8.f;
constexpr size_t SHM_V = KVBLK * DV * 2;
template <int DQK> struct Cf {
    static constexpr int ND = DQK / 16, KC = DQK / 64, CPR = DQK / 8;
    static constexpr size_t SHM_K = (size_t)KVBLK * DQK * 2;
    static constexpr float SCALE = DQK == 192 ? 0.07216878364870322f : 0.125f;
    static constexpr size_t LDS_BYTES = 2 * SHM_V + 2 * SHM_K + NW * 64 * 4;
};
#define SBAR() __builtin_amdgcn_sched_barrier(0)
__device__ __forceinline__ int crow(int r, int hi) { return (r & 3) + 8 * (r >> 2) + 4 * hi; }
template <int DQK> __device__ __forceinline__ int kswz(int row, int colB) { return row * (DQK * 2) + (colB ^ (((row >> 1) & 7) << 4)); }

template <int DQK, int VAR = 0>
__device__ __forceinline__ void partialSM(f32x16& p0, f32x16& p1, float& m_reg, float& mn, float& alpha) {
    constexpr float SCALE = Cf<DQK>::SCALE, C = SCALE * 1.4426950408889634f;
    if constexpr (VAR == 3 || VAR == 7) { mn = m_reg; alpha = 1.f; return; }
    float pmax = p0[0];
#pragma unroll
    for (int r = 1; r < 16; ++r) pmax = fmaxf(pmax, p0[r]);
#pragma unroll
    for (int r = 0; r < 16; ++r) pmax = fmaxf(pmax, p1[r]);
    { auto rr = __builtin_amdgcn_permlane32_swap(__float_as_uint(pmax), __float_as_uint(pmax), false, false);
      pmax = fmaxf(__uint_as_float(rr[0]), __uint_as_float(rr[1])); }
    if (__builtin_expect(__all(pmax - m_reg <= THR / SCALE), 1)) { mn = m_reg; alpha = 1.f; }
    else { mn = fmaxf(m_reg, pmax); alpha = __builtin_amdgcn_exp2f((m_reg - mn) * C); m_reg = mn; }
    const float mnC = -mn * C;
#pragma unroll
    for (int r = 0; r < 16; ++r) p0[r] = fmaf(p0[r], C, mnC);
#pragma unroll
    for (int r = 0; r < 16; ++r) p1[r] = fmaf(p1[r], C, mnC);
#pragma unroll
    for (int r = 0; r < 16; ++r) p0[r] = VAR == 2 ? p0[r] : __builtin_amdgcn_exp2f(p0[r]);
}
template <int VAR = 0>
__device__ __forceinline__ void finishSM(f32x16& p0, f32x16& p1, float alpha, float& l_reg, bf16x8& pa0, bf16x8& pa1, bf16x8& pa2, bf16x8& pa3) {
    float ps = 0;
    if constexpr (VAR != 3 && VAR != 7) {
#pragma unroll
    for (int r = 0; r < 16; ++r) p1[r] = VAR == 2 ? p1[r] : __builtin_amdgcn_exp2f(p1[r]);
#pragma unroll
    for (int r = 0; r < 16; ++r) ps += p0[r];
#pragma unroll
    for (int r = 0; r < 16; ++r) ps += p1[r];
    }
    { auto rr = __builtin_amdgcn_permlane32_swap(__float_as_uint(ps), __float_as_uint(ps), false, false);
      ps = __uint_as_float(rr[0]) + __uint_as_float(rr[1]); }
    l_reg = l_reg * alpha + ps;
#define PK4(P, BASE, OUT) do { unsigned a0 = cvt_pk_bf16(P[BASE + 0], P[BASE + 1]), a1 = cvt_pk_bf16(P[BASE + 2], P[BASE + 3]);   \
    unsigned b0 = cvt_pk_bf16(P[BASE + 4], P[BASE + 5]), b1 = cvt_pk_bf16(P[BASE + 6], P[BASE + 7]);                              \
    auto r0 = __builtin_amdgcn_permlane32_swap(a0, b0, false, false); auto r1 = __builtin_amdgcn_permlane32_swap(a1, b1, false, false); \
    u32x4 w = {r0[0], r1[0], r0[1], r1[1]}; OUT = *reinterpret_cast<bf16x8*>(&w); } while (0)
    PK4(p0, 0, pa0); PK4(p0, 8, pa1); PK4(p1, 0, pa2); PK4(p1, 8, pa3);
#undef PK4
}
template <int DQK, int NQR, int VAR = 0>
__device__ __forceinline__ void qkt(f32x16& p0, f32x16& p1, const char* Ks, const bf16x8* qr, const char* ql, int r32, int hi) {
    p0 = f32x16{}; p1 = f32x16{};
    if constexpr (VAR == 5) return;
#pragma unroll
    for (int d0 = 0; d0 < Cf<DQK>::ND; ++d0) { const int cb = (d0 * 16 + hi * 8) * 2;
        bf16x8 b0, b1;
        if constexpr (VAR == 7) { b0 = qr[d0]; b1 = qr[(d0 + 1) % Cf<DQK>::ND]; asm volatile("" : "+v"(b0), "+v"(b1)); }
        else { b0 = *reinterpret_cast<const bf16x8*>(Ks + kswz<DQK>(r32, cb)); b1 = *reinterpret_cast<const bf16x8*>(Ks + kswz<DQK>(32 + r32, cb)); }
        bf16x8 qf; if (d0 < NQR) qf = qr[d0]; else qf = *reinterpret_cast<const bf16x8*>(ql + (d0 - NQR) * 1024);
        if constexpr (VAR == 4) { p0[d0] += __builtin_bit_cast(float, (int)b0[0] + (int)qf[0]); p1[d0] += __builtin_bit_cast(float, (int)b1[0]); }
        else { p0 = __builtin_amdgcn_mfma_f32_32x32x16_bf16(b0, qf, p0, 0, 0, 0);
        p1 = __builtin_amdgcn_mfma_f32_32x32x16_bf16(b1, qf, p1, 0, 0, 0); } }
}
__device__ __forceinline__ int v_st(int k, int c) { const int kk = (k & ~0xC) | ((k & 4) << 1) | ((k & 8) >> 1); return ((kk >> 3) * 4 + (c >> 5)) * 512 + ((kk & 7) * 32 + (c & 31)) * 2; }
__device__ __forceinline__ int v_rd_base(int lane) { return ((lane & 3) << 3) | (((lane >> 2) & 3) << 6) | (((lane >> 4) & 1) << 5) | (((lane >> 5) & 1) << 8); }
constexpr int v_rd_off(int d0, int ks, int half) { return d0 * 512 + ks * 4096 + half * 2048; }
template <int OFF> __device__ __forceinline__ s16x4 tr_read(int vb) {
    s16x4 r; asm volatile("ds_read_b64_tr_b16 %0, %1 offset:%2" : "=&v"(r) : "v"(vb), "i"(OFF) : "memory"); return r;
}
struct VFrag { s16x4 l0, h0, l1, h1, l2, h2, l3, h3; };
template <int D0> __device__ __forceinline__ void pv_rd(VFrag& f, int vb) {
    f.l0 = tr_read<v_rd_off(D0, 0, 0)>(vb); f.h0 = tr_read<v_rd_off(D0, 0, 1)>(vb); f.l1 = tr_read<v_rd_off(D0, 1, 0)>(vb); f.h1 = tr_read<v_rd_off(D0, 1, 1)>(vb);
    f.l2 = tr_read<v_rd_off(D0, 2, 0)>(vb); f.h2 = tr_read<v_rd_off(D0, 2, 1)>(vb); f.l3 = tr_read<v_rd_off(D0, 3, 0)>(vb); f.h3 = tr_read<v_rd_off(D0, 3, 1)>(vb);
}
template <int VAR = 0>
__device__ __forceinline__ void pv_mf(f32x16& od, const VFrag& f, bf16x8 pa0, bf16x8 pa1, bf16x8 pa2, bf16x8 pa3) {
    if constexpr (VAR == 4) { od[0] += __builtin_bit_cast(float, (int)f.l0[0] + (int)f.h3[0] + (int)pa0[0] + (int)pa3[0]); return; }
#define PK(L_, H_) (bf16x8){L_[0], L_[1], L_[2], L_[3], H_[0], H_[1], H_[2], H_[3]}
    od = __builtin_amdgcn_mfma_f32_32x32x16_bf16(pa0, PK(f.l0, f.h0), od, 0, 0, 0);
    od = __builtin_amdgcn_mfma_f32_32x32x16_bf16(pa1, PK(f.l1, f.h1), od, 0, 0, 0);
    od = __builtin_amdgcn_mfma_f32_32x32x16_bf16(pa2, PK(f.l2, f.h2), od, 0, 0, 0);
    od = __builtin_amdgcn_mfma_f32_32x32x16_bf16(pa3, PK(f.l3, f.h3), od, 0, 0, 0);
#undef PK
}
template <int VAR = 0>
__device__ __forceinline__ void pv_d0(f32x16* o, int vb, bf16x8 pa0, bf16x8 pa1, bf16x8 pa2, bf16x8 pa3) {
    if constexpr (VAR == 5) { o[0][0] += __builtin_bit_cast(float, (int)pa0[0] + (int)pa1[0] + (int)pa2[0] + (int)pa3[0]); return; }
    if constexpr (VAR == 7) { bf16x8 x = pa0; asm volatile("" : "+v"(x));
#pragma unroll
        for (int d = 0; d < 4; ++d) { o[d] = __builtin_amdgcn_mfma_f32_32x32x16_bf16(pa0, x, o[d], 0, 0, 0); o[d] = __builtin_amdgcn_mfma_f32_32x32x16_bf16(pa1, x, o[d], 0, 0, 0); o[d] = __builtin_amdgcn_mfma_f32_32x32x16_bf16(pa2, x, o[d], 0, 0, 0); o[d] = __builtin_amdgcn_mfma_f32_32x32x16_bf16(pa3, x, o[d], 0, 0, 0); }
        return; }
    VFrag A, B;
    pv_rd<0>(A, vb); pv_rd<1>(B, vb);
    asm volatile("s_waitcnt lgkmcnt(8)" ::: "memory"); SBAR(); pv_mf<VAR>(o[0], A, pa0, pa1, pa2, pa3); SBAR();
    pv_rd<2>(A, vb);
    asm volatile("s_waitcnt lgkmcnt(8)" ::: "memory"); SBAR(); pv_mf<VAR>(o[1], B, pa0, pa1, pa2, pa3); SBAR();
    pv_rd<3>(B, vb);
    asm volatile("s_waitcnt lgkmcnt(8)" ::: "memory"); SBAR(); pv_mf<VAR>(o[2], A, pa0, pa1, pa2, pa3); SBAR();
    asm volatile("s_waitcnt lgkmcnt(0)" ::: "memory"); SBAR(); pv_mf<VAR>(o[3], B, pa0, pa1, pa2, pa3);
}

struct KSrc { const bf16_t* ka; int lda; const bf16_t* kb; int ldb; };
struct AOut {
    bf16_t* O; int ldo; float* stash; const float* subg; float lam; int sub;
};
template <int DQK, int SDEPTH, int MODE, int VAR, bool ALT>
__device__ __forceinline__ void attn_body_impl(const bf16_t* __restrict__ Qb, int ldq, const KSrc ks, const bf16_t* __restrict__ Vh, int ldv, int seq, char* lds, const AOut ao) {
    using C = Cf<DQK>; constexpr int ND = C::ND, KC = C::KC, CPR = C::CPR, CA = DQK == 192 ? 16 : CPR; constexpr size_t SHM_K = C::SHM_K;
    int tid_ = threadIdx.x; asm volatile("" : "+v"(tid_));
    const int tid = tid_, wid = tid >> 6, lane = tid & 63, r32 = lane & 31, hi = lane >> 5;
    char* V_lds = lds; char* K_lds = lds + 2 * SHM_V;
    float* ws = (float*)(lds + 2 * SHM_V + 2 * SHM_K) + wid * 64; float* li_l = ws; float* al_l = ws + 32;
    constexpr int NQR = ND;
    char* ql = lds + 2 * SHM_V + 2 * SHM_K + NW * 64 * 4 + wid * 4096 + lane * 16;
    float m_reg = -1e30f, l_reg = 0; f32x16 o[4] = {}; bf16x8 qr[NQR];
    const bf16_t* Qw = Qb + (long)(wid * QBLK + r32) * ldq + hi * 8;
#pragma unroll
    for (int d0 = 0; d0 < ND; ++d0) { const bf16x8 qv = *reinterpret_cast<const bf16x8*>(Qw + d0 * 16); if (d0 < NQR) qr[d0] = qv; else *reinterpret_cast<bf16x8*>(ql + (d0 - NQR) * 1024) = qv; }
    const int sr = tid >> 4, sc = (tid & 15) * 8, vst0 = v_st(sr, sc), vst1 = v_st(32 + sr, sc);
    const int vb0 = (int)(uintptr_t)V_lds + v_rd_base(lane);
    const bf16_t* kptr[KC]; int kstride[KC]; int klds[KC];
#pragma unroll
    for (int i = 0; i < KC; ++i) { const int q = tid + 512 * i, row = q / CPR, c8 = q % CPR; klds[i] = kswz<DQK>(row, c8 * 16);
        if (c8 < CA) { kptr[i] = ks.ka + (long)row * ks.lda + c8 * 8; kstride[i] = ks.lda; } else { kptr[i] = ks.kb + (long)row * ks.ldb + (c8 - CA) * 8; kstride[i] = ks.ldb; } }
    struct Slot { bf16x8 vs0, vs1; bf16x8 kk[KC]; } sl[SDEPTH];
#define SLOAD(i_, k0_) do { if constexpr (VAR == 1) break; sl[i_].vs0 = *reinterpret_cast<const bf16x8*>(&Vh[(long)((k0_) + sr) * ldv + sc]); sl[i_].vs1 = *reinterpret_cast<const bf16x8*>(&Vh[(long)((k0_) + 32 + sr) * ldv + sc]); \
    _Pragma("unroll") for (int c_ = 0; c_ < KC; ++c_) sl[i_].kk[c_] = *reinterpret_cast<const bf16x8*>(kptr[c_] + (long)(k0_) * kstride[c_]); } while (0)
#define SWRITE(b_, i_) do { if constexpr (VAR == 1) break; *(bf16x8*)(V_lds + (b_) * SHM_V + vst0) = sl[i_].vs0; *(bf16x8*)(V_lds + (b_) * SHM_V + vst1) = sl[i_].vs1; \
    _Pragma("unroll") for (int c_ = 0; c_ < KC; ++c_) *(bf16x8*)(K_lds + (b_) * SHM_K + klds[c_]) = sl[i_].kk[c_]; } while (0)
#define SWAIT() do { if constexpr (SDEPTH == 2) { if constexpr (KC == 3) asm volatile("s_waitcnt vmcnt(5)" ::: "memory"); else asm volatile("s_waitcnt vmcnt(3)" ::: "memory"); } \
    else asm volatile("s_waitcnt vmcnt(0)" ::: "memory"); } while (0)
#define RESC(a_) do { if (__any((a_) < 1.f)) { if (hi == 0) al_l[r32] = (a_); asm volatile("s_waitcnt lgkmcnt(0)" ::: "memory"); \
    _Pragma("unroll") for (int d_ = 0; d_ < 4; ++d_) _Pragma("unroll") for (int r_ = 0; r_ < 16; ++r_) o[d_][r_] *= al_l[crow(r_, hi)]; } } while (0)
    f32x16 pA0, pA1, pB0, pB1; float mnA, mnB, alA, alB; bf16x8 pa0, pa1, pa2, pa3; const int NT = seq / KVBLK;
    constexpr int SE = 0, SO = SDEPTH - 1;
    SLOAD(SE, 0); asm volatile("s_waitcnt vmcnt(0)" ::: "memory"); SWRITE(0, SE); __syncthreads();
    qkt<DQK, NQR, VAR>(pA0, pA1, K_lds, qr, ql, r32, hi); partialSM<DQK, VAR>(pA0, pA1, m_reg, mnA, alA);
    SLOAD(SO, KVBLK); if constexpr (SDEPTH == 2) { if (2 < NT) SLOAD(SE, 2 * KVBLK); }
    SWAIT(); SWRITE(1, SO); __syncthreads();
    constexpr bool alt = ALT;
    for (int j = 1; j + 1 < NT; j += 2) {
        if constexpr (!alt) {
            SBAR(); qkt<DQK, NQR, VAR>(pB0, pB1, K_lds + SHM_K, qr, ql, r32, hi);
            finishSM<VAR>(pA0, pA1, alA, l_reg, pa0, pa1, pa2, pa3); SBAR();
            SLOAD(SO, (j + SDEPTH) * KVBLK); SBAR();
            pv_d0<VAR>(o, vb0, pa0, pa1, pa2, pa3); partialSM<DQK, VAR>(pB0, pB1, m_reg, mnB, alB);
        } else {
            SBAR(); finishSM<VAR>(pA0, pA1, alA, l_reg, pa0, pa1, pa2, pa3); SBAR();
            qkt<DQK, NQR, VAR>(pB0, pB1, K_lds + SHM_K, qr, ql, r32, hi); SBAR();
            SLOAD(SO, (j + SDEPTH) * KVBLK); SBAR();
            partialSM<DQK, VAR>(pB0, pB1, m_reg, mnB, alB); SBAR(); pv_d0<VAR>(o, vb0, pa0, pa1, pa2, pa3);
        }
        if constexpr (VAR != 6) __syncthreads(); SWAIT(); SWRITE(0, SE);
        RESC(alB); if constexpr (VAR != 6) __syncthreads();
        if constexpr (!alt) {
            SBAR(); qkt<DQK, NQR, VAR>(pA0, pA1, K_lds, qr, ql, r32, hi);
            finishSM<VAR>(pB0, pB1, alB, l_reg, pa0, pa1, pa2, pa3); SBAR();
            if (SDEPTH == 1 || j + 3 < NT) SLOAD(SE, (j + 1 + SDEPTH) * KVBLK); SBAR();
            pv_d0<VAR>(o, vb0 + (int)SHM_V, pa0, pa1, pa2, pa3); partialSM<DQK, VAR>(pA0, pA1, m_reg, mnA, alA);
        } else {
            SBAR(); finishSM<VAR>(pB0, pB1, alB, l_reg, pa0, pa1, pa2, pa3); SBAR();
            qkt<DQK, NQR, VAR>(pA0, pA1, K_lds, qr, ql, r32, hi); SBAR();
            if (SDEPTH == 1 || j + 3 < NT) SLOAD(SE, (j + 1 + SDEPTH) * KVBLK); SBAR();
            partialSM<DQK, VAR>(pA0, pA1, m_reg, mnA, alA); SBAR(); pv_d0<VAR>(o, vb0 + (int)SHM_V, pa0, pa1, pa2, pa3);
        }
        if constexpr (VAR != 6) __syncthreads(); SWAIT(); SWRITE(1, SO);
        RESC(alA); if constexpr (VAR != 6) __syncthreads();
    }
    SBAR(); qkt<DQK, NQR, VAR>(pB0, pB1, K_lds + SHM_K, qr, ql, r32, hi);
    finishSM<VAR>(pA0, pA1, alA, l_reg, pa0, pa1, pa2, pa3); SBAR();
    pv_d0<VAR>(o, vb0, pa0, pa1, pa2, pa3); partialSM<DQK, VAR>(pB0, pB1, m_reg, mnB, alB);
    __syncthreads(); RESC(alB);
    finishSM<VAR>(pB0, pB1, alB, l_reg, pa0, pa1, pa2, pa3); SBAR();
    pv_d0<VAR>(o, vb0 + (int)SHM_V, pa0, pa1, pa2, pa3);
    if (hi == 0) li_l[r32] = l_reg; asm volatile("s_waitcnt lgkmcnt(0)" ::: "memory");
    float rli[16];
#pragma unroll
    for (int r = 0; r < 16; ++r) rli[r] = __builtin_amdgcn_rcpf(li_l[crow(r, hi)]);
    if constexpr (MODE == 0) {
        bf16_t* Ow = ao.O + (long)(wid * QBLK) * ao.ldo;
#pragma unroll
        for (int r = 0; r < 16; ++r) { const int orow = crow(r, hi);
#pragma unroll
            for (int d0 = 0; d0 < 4; ++d0) Ow[(long)orow * ao.ldo + d0 * 32 + r32] = f2bf(o[d0][r] * rli[r]); }
    } else {
        float* st = ao.stash + (wid * 64) * 64 + lane;
        if (ao.sub == 0) {
#pragma unroll
            for (int r = 0; r < 16; ++r)
#pragma unroll
                for (int d0 = 0; d0 < 4; ++d0) st[(r * 4 + d0) * 64] = o[d0][r] * rli[r];
        } else {
            const float lam = ao.lam; float sg[4];
#pragma unroll
            for (int d0 = 0; d0 < 4; ++d0) sg[d0] = ao.subg[d0 * 32 + r32] * (1.f - LAM_INIT);
            bf16_t* Ow = ao.O + (long)(wid * QBLK) * ao.ldo;
#pragma unroll
            for (int r = 0; r < 16; ++r) { float ss = 0.f;
#pragma unroll
                for (int d0 = 0; d0 < 4; ++d0) { const float v = st[(r * 4 + d0) * 64] - lam * (o[d0][r] * rli[r]); o[d0][r] = v; ss += v * v; }
                ss += __shfl_xor(ss, 1); ss += __shfl_xor(ss, 2); ss += __shfl_xor(ss, 4); ss += __shfl_xor(ss, 8); ss += __shfl_xor(ss, 16);
                const float rn = 1.0f / sqrtf(ss * (1.f / 128.f) + EPS); const int orow = crow(r, hi);
#pragma unroll
                for (int d0 = 0; d0 < 4; ++d0) Ow[(long)orow * ao.ldo + d0 * 32 + r32] = f2bf(o[d0][r] * rn * sg[d0]); }
        }
    }
    asm volatile("s_waitcnt vmcnt(0) lgkmcnt(0)" ::: "memory");
    __syncthreads();
#undef SLOAD
#undef SWRITE
#undef SWAIT
#undef RESC
}
template <int DQK, int SDEPTH, int MODE, int VAR = 0>
__device__ __forceinline__ void attn_body(const bf16_t* __restrict__ Qb, int ldq, const KSrc ks, const bf16_t* __restrict__ Vh, int ldv, int seq, char* lds, const AOut ao) {
    if (__builtin_amdgcn_readfirstlane((int)threadIdx.x >> 8) == 0) attn_body_impl<DQK, SDEPTH, MODE, VAR, false>(Qb, ldq, ks, Vh, ldv, seq, lds, ao);
    else attn_body_impl<DQK, SDEPTH, MODE, VAR, true>(Qb, ldq, ks, Vh, ldv, seq, lds, ao);
}
template <int DQK>
__device__ __forceinline__ void attn_body_np(const bf16_t* __restrict__ Qb, int ldq, const KSrc ks, const bf16_t* __restrict__ Vh, int ldv, int seq, char* lds, const AOut ao) {
    using C = Cf<DQK>; constexpr int ND = C::ND, KC = C::KC, CPR = C::CPR, CA = DQK == 192 ? 16 : CPR; constexpr size_t SHM_K = C::SHM_K;
    int tid_ = threadIdx.x; asm volatile("" : "+v"(tid_));
    const int tid = tid_, wid = tid >> 6, lane = tid & 63, r32 = lane & 31, hi = lane >> 5;
    char* V_lds = lds; char* K_lds = lds + 2 * SHM_V;
    float* ws = (float*)(lds + 2 * SHM_V + 2 * SHM_K) + wid * 64; float* li_l = ws; float* al_l = ws + 32;
    float m_reg = -1e30f, l_reg = 0; f32x16 o[4] = {}; bf16x8 qr[ND];
    const bf16_t* Qw = Qb + (long)(wid * QBLK + r32) * ldq + hi * 8;
#pragma unroll
    for (int d0 = 0; d0 < ND; ++d0) qr[d0] = *reinterpret_cast<const bf16x8*>(Qw + d0 * 16);
    const int sr = tid >> 4, sc = (tid & 15) * 8, vst0 = v_st(sr, sc), vst1 = v_st(32 + sr, sc);
    const int vb0 = (int)(uintptr_t)V_lds + v_rd_base(lane);
    const bf16_t* kptr[KC]; int kstride[KC]; int klds[KC];
#pragma unroll
    for (int i = 0; i < KC; ++i) { const int q = tid + 512 * i, row = q / CPR, c8 = q % CPR; klds[i] = kswz<DQK>(row, c8 * 16);
        if (c8 < CA) { kptr[i] = ks.ka + (long)row * ks.lda + c8 * 8; kstride[i] = ks.lda; } else { kptr[i] = ks.kb + (long)row * ks.ldb + (c8 - CA) * 8; kstride[i] = ks.ldb; } }
    bf16x8 vs0, vs1, kk[KC];
#define SLOAD1(k0_) do { vs0 = *reinterpret_cast<const bf16x8*>(&Vh[(long)((k0_) + sr) * ldv + sc]); vs1 = *reinterpret_cast<const bf16x8*>(&Vh[(long)((k0_) + 32 + sr) * ldv + sc]); \
    _Pragma("unroll") for (int c_ = 0; c_ < KC; ++c_) kk[c_] = *reinterpret_cast<const bf16x8*>(kptr[c_] + (long)(k0_) * kstride[c_]); } while (0)
#define SWRITE1(b_) do { *(bf16x8*)(V_lds + (b_) * SHM_V + vst0) = vs0; *(bf16x8*)(V_lds + (b_) * SHM_V + vst1) = vs1; \
    _Pragma("unroll") for (int c_ = 0; c_ < KC; ++c_) *(bf16x8*)(K_lds + (b_) * SHM_K + klds[c_]) = kk[c_]; } while (0)
    f32x16 p0, p1; float mn, al; bf16x8 pa0, pa1, pa2, pa3; const int NT = seq / KVBLK;
    SLOAD1(0); asm volatile("s_waitcnt vmcnt(0)" ::: "memory"); SWRITE1(0); SLOAD1(KVBLK); __syncthreads();
#pragma unroll 1
    for (int j = 0; j < NT; ++j) {
        const int buf = j & 1;
        SBAR(); qkt<DQK, ND>(p0, p1, K_lds + buf * SHM_K, qr, nullptr, r32, hi);
        partialSM<DQK>(p0, p1, m_reg, mn, al);
        if (__any(al < 1.f)) { if (hi == 0) al_l[r32] = al; asm volatile("s_waitcnt lgkmcnt(0)" ::: "memory");
#pragma unroll
            for (int d_ = 0; d_ < 4; ++d_)
#pragma unroll
                for (int r_ = 0; r_ < 16; ++r_) o[d_][r_] *= al_l[crow(r_, hi)]; }
        finishSM(p0, p1, al, l_reg, pa0, pa1, pa2, pa3); SBAR();
        if (j + 1 < NT) { asm volatile("s_waitcnt vmcnt(0)" ::: "memory"); SWRITE1(buf ^ 1); if (j + 2 < NT) SLOAD1((j + 2) * KVBLK); }
        SBAR();
        pv_d0(o, vb0 + buf * (int)SHM_V, pa0, pa1, pa2, pa3);
        __syncthreads();
    }
#undef SLOAD1
#undef SWRITE1
    if (hi == 0) li_l[r32] = l_reg; asm volatile("s_waitcnt lgkmcnt(0)" ::: "memory");
    float rli[16];
#pragma unroll
    for (int r = 0; r < 16; ++r) rli[r] = __builtin_amdgcn_rcpf(li_l[crow(r, hi)]);
    bf16_t* Ow = ao.O + (long)(wid * QBLK) * ao.ldo;
#pragma unroll
    for (int r = 0; r < 16; ++r) { const int orow = crow(r, hi);
#pragma unroll
        for (int d0 = 0; d0 < 4; ++d0) Ow[(long)orow * ao.ldo + d0 * 32 + r32] = f2bf(o[d0][r] * rli[r]); }
    asm volatile("s_waitcnt vmcnt(0) lgkmcnt(0)" ::: "memory");
    __syncthreads();
}
}
constexpr int M = NB * S, ML = NB * T;
constexpr int NCH = ML / 256;
constexpr int MAXT = 2 * ML / 256 + NE;
constexpr size_t al256(size_t x) { return (x + 255) / 256 * 256; }
constexpr size_t WS_CTL = 0, CTL_BYTES = 1u << 20;
constexpr int CW_BAR = 4096;
constexpr int CW_TICKET = 64;
constexpr size_t WS_MODV = WS_CTL + CTL_BYTES;
constexpr size_t WS_ROPE = WS_MODV + al256((size_t)2 * 33 * 6144 * 4);
constexpr size_t WS_W = WS_ROPE + 2 * 2048 * 32 * 4;
constexpr size_t W_IN0 = WS_W, W_UQ = W_IN0 + (size_t)2304 * 1024 * 2, W_UKV = W_UQ + (size_t)768 * 384 * 2, W_OUT0 = W_UKV + (size_t)1024 * 256 * 2,
    W_GU0 = W_OUT0 + (size_t)1024 * 1024 * 2, W_DN0 = W_GU0 + (size_t)5632 * 1024 * 2, W_IN1 = W_DN0 + (size_t)1024 * 2816 * 2, W_FOLD = W_IN1 + (size_t)2304 * 1024 * 2,
    W_OUT1 = W_FOLD + (size_t)512 * 1024 * 2, W_GU1 = W_OUT1 + (size_t)1024 * 1024 * 2, W_DN1 = W_GU1 + (size_t)NE * 5632 * 1024, W_DFT = W_DN1 + (size_t)NE * 1024 * 2816,
    WS_WEND = W_DFT + (size_t)2048 * 4096 * 2;
constexpr size_t WS_CTXS = WS_WEND;
constexpr size_t WS_STASH = WS_CTXS;
constexpr size_t CTXS_BYTES = ((size_t)NB * L * D * 4 > (size_t)256 * 131072) ? (size_t)NB * L * D * 4 : (size_t)256 * 131072;
constexpr size_t WS_ROUTE = WS_CTXS + CTXS_BYTES;
constexpr size_t RT_INFO = WS_ROUTE, RT_W = RT_INFO + (size_t)ML * 16, RT_POS = RT_W + (size_t)ML * 8, RT_WCNT = RT_POS + (size_t)ML * 8, RT_TOFF = RT_WCNT + (size_t)NCH * 64 * 4, WS_RTEND = al256(RT_TOFF + 256);
constexpr size_t AR = WS_RTEND;
constexpr size_t SROWS = (size_t)2 * ML + NE * 256;
constexpr size_t H2S_BYTES = SROWS * 1024, FS_BYTES = SROWS * 2048, ACTM_BYTES = (size_t)MAXT * 256 * 2816, GT_BYTES = (size_t)NB * 256 * 4096 * 2;
#if CFG_NB >= 32
constexpr size_t AR_A = AR, AR_B = AR + (size_t)M * 2048, AR_C = AR + (size_t)M * 4096, AR_D = AR_C + (size_t)M * 5632;
constexpr size_t AR_END = AR_D + (H2S_BYTES > (size_t)M * 1280 ? H2S_BYTES : (size_t)M * 1280);
constexpr size_t B_H = AR_A, B_Q0 = AR_A, B_Y = AR_A, B_F = AR_A, B_AOUT1 = AR_A, B_H2TOK = AR_A, B_FS = AR_A;
constexpr size_t B_AOUT0 = AR_B, B_H2 = AR_B, B_H1 = AR_B, B_Y1 = AR_B;
constexpr size_t B_Z = AR_C, B_KPE = AR_C + (size_t)M * 4608, B_K0N = AR_C, B_V0 = AR_C + (size_t)M * 1024, B_ACT = AR_C,
    B_QKV1 = AR_C, B_GT = AR_C + (size_t)M * 4608, B_ACTM = AR_C;
constexpr size_t B_ZQN = AR_D, B_ZKVN = AR_D + (size_t)M * 768, B_H2S = AR_D;
static_assert(FS_BYTES <= (size_t)M * 4096, "f_sorted fits A+B");
static_assert(ACTM_BYTES <= (size_t)M * 5632, "MoE act fits C");
static_assert(GT_BYTES <= (size_t)M * 1024, "GT fits the tail of C");
static_assert(AR_END <= ((size_t)1 << 30), "workspace map exceeds 1 GiB");
#else
constexpr size_t B_H = AR, B_Z = B_H + (size_t)M * 2048, B_KPE = B_Z + (size_t)M * 4608, B_AOUT0 = B_KPE + (size_t)M * 128, B_ZQN = B_AOUT0 + (size_t)M * 2048, B_ZKVN = B_ZQN + (size_t)M * 768,
    B_Q0 = B_ZKVN + (size_t)M * 512, B_K0N = B_Q0 + (size_t)M * 1536, B_V0 = B_K0N + (size_t)M * 1024, B_Y = B_V0 + (size_t)M * 1024, B_H2 = B_Y + (size_t)M * 2048, B_ACT = B_H2 + (size_t)M * 2048,
    B_F = B_ACT + (size_t)M * 5632, B_H1 = B_F + (size_t)M * 2048, B_QKV1 = B_H1 + (size_t)M * 2048, B_GT = B_QKV1 + (size_t)M * 4608, B_AOUT1 = B_GT + GT_BYTES, B_Y1 = B_AOUT1 + (size_t)M * 2048,
    B_H2TOK = B_Y1 + (size_t)M * 2048, B_H2S = B_H2TOK + (size_t)ML * 1024, B_ACTM = B_H2S + H2S_BYTES, B_FS = B_ACTM + ACTM_BYTES, AR_END = B_FS + FS_BYTES;
#endif

#ifndef FFN0_FP8
#define FFN0_FP8 0
#endif
struct P {
    const float *x, *c, *ctx, *c_ctx, *ev_mod_w, *ev_mod_b, *ev_norm_g, *ev_w_in, *ev_conv_w, *ev_q_norm_g, *ev_w_uq, *ev_kv_norm_g, *ev_w_ukv, *ev_w_out,
        *ev_ffn_gate, *ev_ffn_up, *ev_ffn_down, *od_mod_w, *od_mod_b, *od_norm_g, *od_w_in, *od_lambda, *od_subln_g, *od_w_out, *od_router, *od_exp_gate, *od_exp_up, *od_exp_down;
    float* out; unsigned char* ws; int ph_lo, ph_hi;
};

__device__ __forceinline__ void ld_f32(const float* p, int lane, float (&v)[16]) {
#pragma unroll
    for (int j2 = 0; j2 < 2; ++j2) { const f32x4 a = *(const f32x4*)(p + 512 * j2 + 8 * lane), b = *(const f32x4*)(p + 512 * j2 + 8 * lane + 4);
#pragma unroll
        for (int i = 0; i < 4; ++i) { v[j2 * 8 + i] = a[i]; v[j2 * 8 + 4 + i] = b[i]; } }
}
__device__ __forceinline__ void st_f32(float* p, int lane, const float (&v)[16]) {
#pragma unroll
    for (int j2 = 0; j2 < 2; ++j2) { f32x4 a, b;
#pragma unroll
        for (int i = 0; i < 4; ++i) { a[i] = v[j2 * 8 + i]; b[i] = v[j2 * 8 + 4 + i]; }
        *(f32x4*)(p + 512 * j2 + 8 * lane) = a; *(f32x4*)(p + 512 * j2 + 8 * lane + 4) = b; }
}
__device__ __forceinline__ void unpack8(const u32x4 w, float* v) { v[0] = bflo(w.x); v[1] = bfhi(w.x); v[2] = bflo(w.y); v[3] = bfhi(w.y); v[4] = bflo(w.z); v[5] = bfhi(w.z); v[6] = bflo(w.w); v[7] = bfhi(w.w); }
__device__ __forceinline__ u32x4 pack8f(const float* v) { u32x4 w; w.x = cvt_pk_bf16(v[0], v[1]); w.y = cvt_pk_bf16(v[2], v[3]); w.z = cvt_pk_bf16(v[4], v[5]); w.w = cvt_pk_bf16(v[6], v[7]); return w; }
__device__ __forceinline__ void ld_bf16(const bf16_t* p, int lane, float (&v)[16]) {
#pragma unroll
    for (int j2 = 0; j2 < 2; ++j2) { const u32x4 w = *(const u32x4*)(p + 512 * j2 + 8 * lane); unpack8(w, &v[j2 * 8]); }
}
__device__ __forceinline__ void st_bf16(bf16_t* p, int lane, const float (&v)[16]) {
#pragma unroll
    for (int j2 = 0; j2 < 2; ++j2) *(u32x4*)(p + 512 * j2 + 8 * lane) = pack8f(&v[j2 * 8]);
}
__device__ __forceinline__ float sumsq16(const float (&v)[16]) { float s = 0.f;
#pragma unroll
    for (int i = 0; i < 16; ++i) s += v[i] * v[i];
    return wave_sum(s); }
__device__ __forceinline__ void resid16(float (&xv)[16], const float (&y)[16], const float* g, const float* gate, int lane) {
    const float ry = 1.0f / sqrtf(sumsq16(y) * (1.f / D) + EPS); float gv[16], tv[16]; ld_f32(g, lane, gv); ld_f32(gate, lane, tv);
#pragma unroll
    for (int i = 0; i < 16; ++i) xv[i] += tv[i] * (y[i] * ry * gv[i]);
}
__device__ __forceinline__ void normmod16(const float (&xv)[16], float (&h)[16], const float* g, const float* shift, const float* scale, int lane) {
    const float rx = 1.0f / sqrtf(sumsq16(xv) * (1.f / D) + EPS); float gv[16], sh[16], sc[16]; ld_f32(g, lane, gv); ld_f32(shift, lane, sh); ld_f32(scale, lane, sc);
#pragma unroll
    for (int i = 0; i < 16; ++i) h[i] = xv[i] * rx * gv[i] * (1.f + sc[i]) + sh[i];
}
__device__ __forceinline__ int rope_pos(int e) { return e < 32 ? 8 * (e >> 2) + (e & 3) : 8 * ((e - 32) >> 2) + 4 + (e & 3); }
__device__ __forceinline__ int rope_elem(int s) { const int i = s >> 3, j = s & 7; return j < 4 ? 4 * i + j : 32 + 4 * i + (j - 4); }

struct Ctx {
    LAS unsigned char* lds; unsigned char* ws; int tid, lane, wave, gw, ngw;
};

constexpr int P0_PITCH = 65, P0_SCR_BYTES = 64 * P0_PITCH * 4;
template <int MAP, bool OUT8 = false>
__device__ __forceinline__ void p0_item(const float* W, const float* W2, int ldw, int nvalid, int K, bf16_t* WT, LAS float* scr, int item, int nblk, int lane, float wscale = 1.f) {
    const int kb = item / nblk, nb = item % nblk, k0 = 64 * kb, n0 = 64 * nb; const int q = lane & 15, kr = lane >> 4; const int np = n0 + 4 * q;
    const float* src = W; int col = np;
    if (MAP == 0) { if (np >= nvalid) col = -1; }
    if (MAP == 1) { const int h = np / MLA_QK, w = np % MLA_QK; col = w < MLA_NOPE ? np : h * MLA_QK + MLA_NOPE + rope_elem(w - MLA_NOPE); }
    if (MAP == 2) { const int g8 = np >> 3, j = np & 7; if (j < 4) { col = 4 * g8; } else { src = W2; col = 4 * g8; } }
    if (MAP == 3) { col = np < 2 * DIFFW ? (np & ~63) + rope_elem(np & 63) : np; }
    f32x4 v[16];
#pragma unroll
    for (int i = 0; i < 16; ++i) v[i] = col >= 0 ? *(const f32x4*)(src + (size_t)(k0 + kr + 4 * i) * ldw + col) : (f32x4){0.f, 0.f, 0.f, 0.f};
#pragma unroll
    for (int i = 0; i < 16; ++i)
#pragma unroll
        for (int j = 0; j < 4; ++j) scr[(4 * q + j) * P0_PITCH + kr + 4 * i] = v[i][j];
    asm volatile("s_waitcnt lgkmcnt(0)" ::: "memory");
    const int c = lane & 7;
#pragma unroll
    for (int jj = 0; jj < 8; ++jj) { const int n = (lane >> 3) + 8 * jj; const LAS float* s = scr + n * P0_PITCH + 8 * c;
        if constexpr (OUT8) { u32x2 o; o.x = pg8::pack4_fp8(s[0] * wscale, s[1] * wscale, s[2] * wscale, s[3] * wscale); o.y = pg8::pack4_fp8(s[4] * wscale, s[5] * wscale, s[6] * wscale, s[7] * wscale);
            *(u32x2*)((unsigned char*)WT + (size_t)(n0 + n) * K + k0 + 8 * c) = o; }
        else { u32x4 o; o.x = cvt_pk_bf16(s[0], s[1]); o.y = cvt_pk_bf16(s[2], s[3]); o.z = cvt_pk_bf16(s[4], s[5]); o.w = cvt_pk_bf16(s[6], s[7]);
            *(u32x4*)(WT + (size_t)(n0 + n) * K + k0 + 8 * c) = o; } }
    asm volatile("s_waitcnt lgkmcnt(0)" ::: "memory");
}
__device__ __forceinline__ void p0_fold_item(const float* W, bf16_t* WT, LAS float* scr, const LAS float* tab, int item, int lane) {
    const int kb = item / 16, nb = item % 16, k0 = 64 * kb, n0 = 32 * nb; const int r = n0 + (lane & 31), part = r >> 8, g = (r >> 6) & 3, l = r & 63;
    for (int i = 0; i < 32; ++i) { const int kk = 2 * i + (lane >> 5); const float* wr = W + (size_t)(k0 + kk) * ODD_IN + 3 * DIFFW + g * 64; float a = 0.f;
        for (int j = 0; j < 64; ++j) a += wr[j] * tab[part * 64 + ((l * j) & 63)];
        scr[kk * 33 + (lane & 31)] = a; }
    asm volatile("s_waitcnt lgkmcnt(0)" ::: "memory");
    const int c = lane & 7;
#pragma unroll
    for (int j = 0; j < 4; ++j) { const int n = (lane >> 3) + 8 * j; const LAS float* s = scr + (8 * c) * 33 + n;
        u32x4 o; o.x = cvt_pk_bf16(s[0 * 33], s[1 * 33]); o.y = cvt_pk_bf16(s[2 * 33], s[3 * 33]); o.z = cvt_pk_bf16(s[4 * 33], s[5 * 33]); o.w = cvt_pk_bf16(s[6 * 33], s[7 * 33]);
        *(u32x4*)(WT + (size_t)(n0 + n) * D + k0 + 8 * c) = o; }
    asm volatile("s_waitcnt lgkmcnt(0)" ::: "memory");
}
__device__ __forceinline__ void p0_mod_unit(const P& p, const Ctx& c, int u) {
    const int layer = u / 128, col0 = (u % 128) * 48; const float* W = layer ? p.od_mod_w : p.ev_mod_w; const float* bias = layer ? p.od_mod_b : p.ev_mod_b;
    float* mod = (float*)(c.ws + WS_MODV) + (size_t)layer * 33 * 6144;
    LAS float* sc = (LAS float*)c.lds;
    LAS float* red = (LAS float*)(c.lds + 40960);
    const bool act = c.tid < 384; const int n = c.tid % 48, kq = act ? c.tid / 48 : 0; float acc[33];
#pragma unroll
    for (int r = 0; r < 33; ++r) acc[r] = 0.f;
    for (int ch = 0; ch < 4; ++ch) {
        __syncthreads();
        for (int e = c.tid; e < 8 * 32 * 36; e += 512) { const int r = e % 36, kk = (e / 36) % 32, q = e / (36 * 32); const int k = q * 128 + ch * 32 + kk;
            float v = 0.f; if (r < 33) { const float cv = r < 32 ? p.c[r * D + k] : p.c_ctx[k]; v = cv / (1.f + expf(-cv)); } sc[e] = v; }
        __syncthreads();
        if (act) { const float* wp = W + (size_t)(kq * 128 + ch * 32) * 6144 + col0 + n;
            float wv[32];
#pragma unroll
            for (int kk = 0; kk < 32; ++kk) wv[kk] = wp[(size_t)kk * 6144];
#pragma unroll 4
            for (int kk = 0; kk < 32; ++kk) { const float w = wv[kk]; const LAS f32x4* s4 = (const LAS f32x4*)(sc + (kq * 32 + kk) * 36);
#pragma unroll
                for (int q = 0; q < 8; ++q) { const f32x4 s = s4[q];
#pragma unroll
                    for (int i = 0; i < 4; ++i) acc[q * 4 + i] = fmaf(s[i], w, acc[q * 4 + i]); }
                acc[32] = fmaf(s4[8][0], w, acc[32]); } }
    }
    if (act) {
#pragma unroll
        for (int r = 0; r < 33; ++r) red[(kq * 33 + r) * 48 + n] = acc[r]; }
    __syncthreads();
    if (act) for (int r = kq; r < 33; r += 8) { float v = bias[col0 + n];
#pragma unroll
        for (int q = 0; q < 8; ++q) v += red[(q * 33 + r) * 48 + n];
        mod[(size_t)r * 6144 + col0 + n] = v; }
    __syncthreads();
}
__device__ __forceinline__ void phase_prologue(const P& p, const Ctx& c, int parts, int rp = 0) {
    if (parts & 1) for (int u = blockIdx.x; u < 256; u += gridDim.x) p0_mod_unit(p, c, u);
    __syncthreads();
    LAS float* tab = (LAS float*)(c.lds + 8 * P0_SCR_BYTES + 512);
    if (c.tid < 64) { const float a = (float)c.tid * (6.283185307179586f / 64.f); tab[c.tid] = cosf(a); tab[64 + c.tid] = sinf(a); }
    __syncthreads();
    LAS float* scr = (LAS float*)(c.lds + c.wave * P0_SCR_BYTES);
    constexpr int I0 = 16 * 36, I1 = 6 * 12, I2 = 4 * 16, I3 = 16 * 16, I4 = 16 * 88, I5 = 44 * 16, I6 = 16 * 36, I7 = 16 * 16, I8 = NE * I4, I9 = NE * I5, I10 = 16 * 16;
    constexpr int NITEMS = I0 + I1 + I2 + I3 + I4 + I5 + I6 + I7 + I8 + I9 + I10;
    (void)rp;
    if (parts & 2) for (int it = c.gw; it < NITEMS; it += c.ngw) {
        int r = it;
        if (r < I0) { p0_item<0>(p.ev_w_in, nullptr, EVEN_IN, EVEN_IN, D, (bf16_t*)(c.ws + W_IN0), scr, r, 36, c.lane); continue; } r -= I0;
        if (r < I1) { p0_item<1>(p.ev_w_uq, nullptr, 768, 768, QRANK, (bf16_t*)(c.ws + W_UQ), scr, r, 12, c.lane); continue; } r -= I1;
        if (r < I2) { p0_item<0>(p.ev_w_ukv, nullptr, 1024, 1024, KVRANK, (bf16_t*)(c.ws + W_UKV), scr, r, 16, c.lane); continue; } r -= I2;
        if (r < I3) { p0_item<0>(p.ev_w_out, nullptr, D, D, D, (bf16_t*)(c.ws + W_OUT0), scr, r, 16, c.lane); continue; } r -= I3;
#if FFN0_FP8
        if (r < I4) { p0_item<2, true>(p.ev_ffn_gate, p.ev_ffn_up, FF, FF, D, (bf16_t*)(c.ws + W_GU0), scr, r, 88, c.lane, 32.f); continue; } r -= I4;
        if (r < I5) { p0_item<0, true>(p.ev_ffn_down, nullptr, D, D, FF, (bf16_t*)(c.ws + W_DN0), scr, r, 16, c.lane, 64.f); continue; } r -= I5;
#else
        if (r < I4) { p0_item<2>(p.ev_ffn_gate, p.ev_ffn_up, FF, FF, D, (bf16_t*)(c.ws + W_GU0), scr, r, 88, c.lane); continue; } r -= I4;
        if (r < I5) { p0_item<0>(p.ev_ffn_down, nullptr, D, D, FF, (bf16_t*)(c.ws + W_DN0), scr, r, 16, c.lane); continue; } r -= I5;
#endif
        if (r < I6) { p0_item<3>(p.od_w_in, nullptr, ODD_IN, ODD_IN, D, (bf16_t*)(c.ws + W_IN1), scr, r, 36, c.lane); continue; } r -= I6;
        if (r < I7) { p0_item<0>(p.od_w_out, nullptr, D, D, D, (bf16_t*)(c.ws + W_OUT1), scr, r, 16, c.lane); continue; } r -= I7;
        if (r < I8) { const int e = r / I4; p0_item<2, true>(p.od_exp_gate + (size_t)e * D * FF, p.od_exp_up + (size_t)e * D * FF, FF, FF, D, (bf16_t*)(c.ws + W_GU1 + (size_t)e * 5632 * 1024), scr, r % I4, 88, c.lane, 32.f); continue; } r -= I8;
        if (r < I9) { const int e = r / I5; p0_item<0, true>(p.od_exp_down + (size_t)e * FF * D, nullptr, D, D, FF, (bf16_t*)(c.ws + W_DN1 + (size_t)e * 1024 * 2816), scr, r % I5, 16, c.lane, 64.f); continue; } r -= I9;
        p0_fold_item(p.od_w_in, (bf16_t*)(c.ws + W_FOLD), scr, tab, r, c.lane);
    }
    if (parts & 4) { bf16_t* dft = (bf16_t*)(c.ws + W_DFT); const int gt = blockIdx.x * 512 + c.tid, ngt = gridDim.x * 512; const float scl = 0.0027621358640099515f;
      for (int i8 = gt; i8 < 2048 * 4096 / 8; i8 += ngt) { const int k = i8 >> 9, tt0 = (i8 & 511) * 8; float v[8];
#pragma unroll
          for (int j = 0; j < 8; ++j) { const int tt = tt0 + j, t = tt & 2047, q = (k * t) & 2047; const float a = (float)q * (6.283185307179586f / 2048.f); v[j] = (tt < 2048 ? cosf(a) : -sinf(a)) * scl; }
          *(u32x4*)(dft + (size_t)i8 * 8) = pack8f(v); } }
    if (parts & 4) { float* rc = (float*)(c.ws + WS_ROPE); float* rs = rc + 2048 * 32; const int gt = blockIdx.x * 512 + c.tid, ngt = gridDim.x * 512;
      for (int i = gt; i < 2048 * 32; i += ngt) { const int t = i >> 5, f = i & 31; const int pos = f < 16 ? t / GW : t % GW; const float inv = powf(10000.f, -(float)(f & 15) / 16.f);
          const float ang = (float)pos * inv; rc[i] = cosf(ang); rs[i] = sinf(ang); } }
}

__device__ __forceinline__ const float* in_row(const P& p, int m) { const int b = m / S, j = m % S; return j < L ? p.ctx + ((size_t)b * L + j) * D : p.x + ((size_t)b * T + (j - L)) * D; }
__device__ __forceinline__ float* stream_row(const P& p, unsigned char* ws, int m) { const int b = m / S, j = m % S; return j < L ? (float*)(ws + WS_CTXS) + ((size_t)b * L + j) * D : p.out + ((size_t)b * T + (j - L)) * D; }
__device__ __forceinline__ const float* mod_row(unsigned char* ws, int layer, int m) { const int b = m / S, j = m % S; return (const float*)(ws + WS_MODV) + ((size_t)layer * 33 + (j < L ? 32 : b)) * 6144; }

__device__ __forceinline__ void phase_norm0(const P& p, const Ctx& c) {
    bf16_t* H = (bf16_t*)(c.ws + B_H);
    for (int m0 = c.gw * 2; m0 < M; m0 += c.ngw * 2) { float xv[2][16];
#pragma unroll
        for (int r = 0; r < 2; ++r) ld_f32(in_row(p, m0 + r), c.lane, xv[r]);
#pragma unroll
        for (int r = 0; r < 2; ++r) { const int m = m0 + r; float h[16]; const float* mr = mod_row(c.ws, 0, m);
            normmod16(xv[r], h, p.ev_norm_g, mr, mr + D, c.lane); st_bf16(H + (size_t)m * D, c.lane, h); } }
}
__device__ __forceinline__ void phase_even_elem(const P& p, const Ctx& c) {
    const bf16_t* Z = (const bf16_t*)(c.ws + B_Z); bf16_t* AO = (bf16_t*)(c.ws + B_AOUT0); bf16_t* ZQ = (bf16_t*)(c.ws + B_ZQN); bf16_t* ZKV = (bf16_t*)(c.ws + B_ZKVN); bf16_t* KPE = (bf16_t*)(c.ws + B_KPE);
    const float* rc = (const float*)(c.ws + WS_ROPE); const float* rs = rc + 2048 * 32; const int lane = c.lane;
    float cw[3][8];
#pragma unroll
    for (int t = 0; t < 3; ++t) { const f32x4 w0 = *(const f32x4*)(p.ev_conv_w + t * SCW + 8 * lane), w1 = *(const f32x4*)(p.ev_conv_w + t * SCW + 8 * lane + 4);
#pragma unroll
        for (int i = 0; i < 4; ++i) { cw[t][i] = w0[i]; cw[t][4 + i] = w1[i]; } }
    float gq[8], gkv[8];
    { const int lq = lane < 48 ? lane : 0, lk = lane < 32 ? lane : 0;
      const f32x4 a0 = *(const f32x4*)(p.ev_q_norm_g + 8 * lq), a1 = *(const f32x4*)(p.ev_q_norm_g + 8 * lq + 4), b0 = *(const f32x4*)(p.ev_kv_norm_g + 8 * lk), b1 = *(const f32x4*)(p.ev_kv_norm_g + 8 * lk + 4);
#pragma unroll
      for (int i = 0; i < 4; ++i) { gq[i] = a0[i]; gq[4 + i] = a1[i]; gkv[i] = b0[i]; gkv[4 + i] = b1[i]; } }
    for (int m0 = c.gw * 4; m0 < M; m0 += c.ngw * 4) {
        const int j0 = m0 % S; const int lo = j0 < L ? 0 : L, hi = j0 < L ? L : S; const bf16_t* z0 = Z + (size_t)m0 * 2304;
        u32x4 rcg[6], ruu[6], rbg[4], rzq[4], rzk[4]; float k1[4], k2[4];
#pragma unroll
        for (int r = 0; r < 6; ++r) { const int jj = j0 + r - 1; const bool ok = jj >= lo && jj < hi; const bf16_t* zn = z0 + (long)(r - 1) * 2304;
            rcg[r] = ok ? *(const u32x4*)(zn + SCW + 8 * lane) : (u32x4){0u, 0u, 0u, 0u}; ruu[r] = ok ? *(const u32x4*)(zn + 2 * SCW + 8 * lane) : (u32x4){0u, 0u, 0u, 0u}; }
#pragma unroll
        for (int r = 0; r < 4; ++r) { const bf16_t* zr = z0 + (size_t)r * 2304; rbg[r] = *(const u32x4*)(zr + 8 * lane);
            rzq[r] = lane < 48 ? *(const u32x4*)(zr + SCIN + 8 * lane) : (u32x4){0u, 0u, 0u, 0u}; rzk[r] = lane < 32 ? *(const u32x4*)(zr + SCIN + QRANK + 8 * lane) : (u32x4){0u, 0u, 0u, 0u};
            const bf16_t* kp = zr + SCIN + QRANK + KVRANK; k1[r] = bf2f(kp[lane & 31]); k2[r] = bf2f(kp[32 + (lane & 31)]); }
        float prod[6][8];
#pragma unroll
        for (int r = 0; r < 6; ++r) { float a[8], b[8]; unpack8(rcg[r], a); unpack8(ruu[r], b);
#pragma unroll
            for (int i = 0; i < 8; ++i) prod[r][i] = a[i] * b[i]; }
#pragma unroll
        for (int r = 0; r < 4; ++r) { const int m = m0 + r, j = j0 + r; float bg[8], acc[8]; unpack8(rbg[r], bg);
#pragma unroll
            for (int i = 0; i < 8; ++i) acc[i] = bg[i] * (cw[0][i] * prod[r][i] + cw[1][i] * prod[r + 1][i] + cw[2][i] * prod[r + 2][i]);
            *(u32x4*)(AO + (size_t)m * D + 8 * lane) = pack8f(acc);
            { float v[8]; unpack8(rzq[r], v); float s = 0.f;
#pragma unroll
              for (int i = 0; i < 8; ++i) s += v[i] * v[i];
              s = wave_sum(s); const float rn = 1.0f / sqrtf(s * (1.f / QRANK) + EPS);
#pragma unroll
              for (int i = 0; i < 8; ++i) v[i] *= rn * gq[i];
              if (lane < 48) *(u32x4*)(ZQ + (size_t)m * QRANK + 8 * lane) = pack8f(v); }
            { float v[8]; unpack8(rzk[r], v); float s = 0.f;
#pragma unroll
              for (int i = 0; i < 8; ++i) s += v[i] * v[i];
              s = wave_sum(s); const float rn = 1.0f / sqrtf(s * (1.f / KVRANK) + EPS);
#pragma unroll
              for (int i = 0; i < 8; ++i) v[i] *= rn * gkv[i];
              if (lane < 32) *(u32x4*)(ZKV + (size_t)m * KVRANK + 8 * lane) = pack8f(v); }
            if (lane < 32) { float cs = 1.f, sn = 0.f;
                if (j >= L) { cs = rc[(j - L) * 32 + lane]; sn = rs[(j - L) * 32 + lane]; }
                bf16_t* ko = KPE + (size_t)m * 64; ko[rope_pos(lane)] = f2bf(k1[r] * cs - k2[r] * sn); ko[rope_pos(32 + lane)] = f2bf(k1[r] * sn + k2[r] * cs); }
        }
    }
}
__device__ __forceinline__ void phase_mid0(const P& p, const Ctx& c) {
    const bf16_t* Y = (const bf16_t*)(c.ws + B_Y); bf16_t* H2 = (bf16_t*)(c.ws + B_H2);
    for (int m0 = c.gw * 2; m0 < M; m0 += c.ngw * 2) { float xv[2][16], y[2][16];
#pragma unroll
        for (int r = 0; r < 2; ++r) { ld_f32(in_row(p, m0 + r), c.lane, xv[r]); ld_bf16(Y + (size_t)(m0 + r) * D, c.lane, y[r]); }
#pragma unroll
        for (int r = 0; r < 2; ++r) { const int m = m0 + r; float h[16]; const float* mr = mod_row(c.ws, 0, m);
            resid16(xv[r], y[r], p.ev_norm_g + D, mr + 2 * D, c.lane); st_f32(stream_row(p, c.ws, m), c.lane, xv[r]);
            normmod16(xv[r], h, p.ev_norm_g + 2 * D, mr + 3 * D, mr + 4 * D, c.lane);
#if FFN0_FP8
#pragma unroll
            for (int j2 = 0; j2 < 2; ++j2) { u32x2 w; w.x = pg8::pack4_fp8(h[j2 * 8 + 0], h[j2 * 8 + 1], h[j2 * 8 + 2], h[j2 * 8 + 3]); w.y = pg8::pack4_fp8(h[j2 * 8 + 4], h[j2 * 8 + 5], h[j2 * 8 + 6], h[j2 * 8 + 7]);
                *(u32x2*)((unsigned char*)H2 + (size_t)m * 1024 + 512 * j2 + 8 * c.lane) = w; }
#else
            st_bf16(H2 + (size_t)m * D, c.lane, h);
#endif
        } }
}
__device__ __forceinline__ void phase_end0(const P& p, const Ctx& c) {
    const bf16_t* F = (const bf16_t*)(c.ws + B_F); bf16_t* H = (bf16_t*)(c.ws + B_H1);
    for (int m0 = c.gw * 2; m0 < M; m0 += c.ngw * 2) { float xv[2][16], y[2][16];
#pragma unroll
        for (int r = 0; r < 2; ++r) { ld_f32(stream_row(p, c.ws, m0 + r), c.lane, xv[r]); ld_bf16(F + (size_t)(m0 + r) * D, c.lane, y[r]); }
#pragma unroll
        for (int r = 0; r < 2; ++r) { const int m = m0 + r; float h[16]; const float* mr = mod_row(c.ws, 0, m);
            resid16(xv[r], y[r], p.ev_norm_g + 3 * D, mr + 5 * D, c.lane);
            if ((m % S) >= L) st_f32(stream_row(p, c.ws, m), c.lane, xv[r]);
            const float* mr1 = mod_row(c.ws, 1, m); normmod16(xv[r], h, p.od_norm_g, mr1, mr1 + D, c.lane); st_bf16(H + (size_t)m * D, c.lane, h); } }
}
__device__ __forceinline__ void phase_mid1(const P& p, const Ctx& c) {
    const bf16_t* Y = (const bf16_t*)(c.ws + B_Y1); unsigned char* H8 = c.ws + B_H2TOK;
    int* rinfo = (int*)(c.ws + RT_INFO); float* rw = (float*)(c.ws + RT_W); int* wcnt = (int*)(c.ws + RT_WCNT);
    volatile LAS int* wc = (volatile LAS int*)(c.lds) + c.wave * 8; const int lane = c.lane;
    for (int ch = blockIdx.x; ch < NCH; ch += gridDim.x) {
        if (lane < 8) wc[lane] = 0;
        for (int i0 = 0; i0 < 32; i0 += 2) {
            const int tok0 = ch * 256 + c.wave * 32 + i0; const int b = tok0 / T;
            float xv[2][16], y[2][16];
#pragma unroll
            for (int r = 0; r < 2; ++r) { const int tok = tok0 + r, t = tok % T; ld_f32(p.out + (size_t)tok * D, lane, xv[r]); ld_bf16(Y + ((size_t)b * S + L + t) * D, lane, y[r]); }
            const float* mr = (const float*)(c.ws + WS_MODV) + ((size_t)33 + b) * 6144;
            int e0[2], e1[2]; float w0[2], w1[2];
#pragma unroll
            for (int r = 0; r < 2; ++r) { const int tok = tok0 + r; float h[16];
                resid16(xv[r], y[r], p.od_norm_g + D, mr + 2 * D, lane); st_f32(p.out + (size_t)tok * D, lane, xv[r]);
                normmod16(xv[r], h, p.od_norm_g + 2 * D, mr + 3 * D, mr + 4 * D, lane);
#pragma unroll
                for (int j2 = 0; j2 < 2; ++j2) { u32x2 w; w.x = pg8::pack4_fp8(h[j2 * 8 + 0], h[j2 * 8 + 1], h[j2 * 8 + 2], h[j2 * 8 + 3]); w.y = pg8::pack4_fp8(h[j2 * 8 + 4], h[j2 * 8 + 5], h[j2 * 8 + 6], h[j2 * 8 + 7]);
                    *(u32x2*)(H8 + (size_t)tok * 1024 + 512 * j2 + 8 * lane) = w; }
                float lg[NE];
#pragma unroll
                for (int e = 0; e < NE; ++e) lg[e] = 0.f;
#pragma unroll
                for (int j2 = 0; j2 < 2; ++j2)
#pragma unroll
                    for (int i8 = 0; i8 < 8; ++i8) { const float* rr = p.od_router + (size_t)(512 * j2 + 8 * lane + i8) * NE; const f32x4 r0 = *(const f32x4*)rr, r1 = *(const f32x4*)(rr + 4); const float hv = h[j2 * 8 + i8];
#pragma unroll
                        for (int e = 0; e < 4; ++e) { lg[e] = fmaf(hv, r0[e], lg[e]); lg[4 + e] = fmaf(hv, r1[e], lg[4 + e]); } }
#pragma unroll
                for (int e = 0; e < NE; ++e) lg[e] = wave_sum(lg[e]);
                int a0 = 0; float v0 = lg[0];
#pragma unroll
                for (int e = 1; e < NE; ++e) if (lg[e] > v0) { v0 = lg[e]; a0 = e; }
                int a1 = -1; float v1 = -3.0e38f;
#pragma unroll
                for (int e = 0; e < NE; ++e) if (e != a0 && lg[e] > v1) { v1 = lg[e]; a1 = e; }
                const float p1 = expf(v1 - v0); e0[r] = a0; e1[r] = a1; w0[r] = 1.f / (1.f + p1); w1[r] = p1 / (1.f + p1); }
            if (lane == 0) {
#pragma unroll
                for (int r = 0; r < 2; ++r) { const int tok = tok0 + r; const int r0 = wc[e0[r]], r1 = wc[e1[r]]; wc[e0[r]] = r0 + 1; wc[e1[r]] = r1 + 1;
                    *(int4*)(rinfo + (size_t)tok * 4) = make_int4(e0[r], e1[r], r0, r1); *(float2*)(rw + (size_t)tok * 2) = make_float2(w0[r], w1[r]); } }
        }
        asm volatile("s_waitcnt lgkmcnt(0)" ::: "memory");
        if (lane < 8) wcnt[(ch * 8 + c.wave) * 8 + lane] = wc[lane];
    }
}
__device__ __forceinline__ void phase_gather(const P& p, const Ctx& c) {
    const int* rinfo = (const int*)(c.ws + RT_INFO); const int* wcnt = (const int*)(c.ws + RT_WCNT); int* tpos = (int*)(c.ws + RT_POS); int* toffg = (int*)(c.ws + RT_TOFF);
    const unsigned char* H8 = c.ws + B_H2TOK; unsigned char* HS = c.ws + B_H2S;
    LAS int* wpre = (LAS int*)c.lds;
    LAS int* csum = wpre + NCH * 64;
    LAS int* cpre = csum + NCH * 8;
    LAS int* eoff = cpre + NCH * 8;
    for (int i = c.tid; i < NCH * 8; i += 512) { const int ch = i >> 3, e = i & 7; int run = 0;
        for (int w = 0; w < 8; ++w) { wpre[(ch * 8 + w) * 8 + e] = run; run += wcnt[(ch * 8 + w) * 8 + e]; }
        csum[i] = run; }
    __syncthreads();
    if (c.tid < 8) { int run = 0; for (int ch = 0; ch < NCH; ++ch) { cpre[ch * 8 + c.tid] = run; run += csum[ch * 8 + c.tid]; } eoff[16 + c.tid] = run; }
    __syncthreads();
    if (c.tid == 0) { int o = 0; for (int e = 0; e < NE; ++e) { eoff[e] = o; o += (eoff[16 + e] + 255) & ~255; } eoff[NE] = o;
        if (blockIdx.x == 0) { for (int e = 0; e <= NE; ++e) toffg[e] = eoff[e] >> 8; } }
    __syncthreads();
    for (int t0 = c.gw * 2; t0 < ML; t0 += c.ngw * 2) { u32x4 a[2]; int p0[2], p1[2];
#pragma unroll
        for (int r = 0; r < 2; ++r) { const int tok = t0 + r; a[r] = *(const u32x4*)(H8 + (size_t)tok * 1024 + 16 * c.lane);
            const int4 ri = *(const int4*)(rinfo + (size_t)tok * 4); const int ch = tok >> 8, w = (tok >> 5) & 7;
            p0[r] = eoff[ri.x] + cpre[ch * 8 + ri.x] + wpre[(ch * 8 + w) * 8 + ri.x] + ri.z; p1[r] = eoff[ri.y] + cpre[ch * 8 + ri.y] + wpre[(ch * 8 + w) * 8 + ri.y] + ri.w; }
#pragma unroll
        for (int r = 0; r < 2; ++r) { const int tok = t0 + r; if (c.lane == 0) *(int2*)(tpos + (size_t)tok * 2) = make_int2(p0[r], p1[r]);
            *(u32x4*)(HS + (size_t)p0[r] * 1024 + 16 * c.lane) = a[r]; *(u32x4*)(HS + (size_t)p1[r] * 1024 + 16 * c.lane) = a[r]; } }
    for (int i = c.gw; i < NE * 256; i += c.ngw) { const int e = i >> 8, r = i & 255; const int n = eoff[16 + e], pad = ((n + 255) & ~255) - n;
        if (r < pad) { const u32x4 z = {0u, 0u, 0u, 0u}; *(u32x4*)(HS + (size_t)(eoff[e] + n + r) * 1024 + 16 * c.lane) = z; } }
}
__device__ __forceinline__ void phase_final(const P& p, const Ctx& c) {
    const bf16_t* FS = (const bf16_t*)(c.ws + B_FS); const int* tpos = (const int*)(c.ws + RT_POS); const float* rw = (const float*)(c.ws + RT_W);
    for (int t0 = c.gw * 2; t0 < ML; t0 += c.ngw * 2) { float xv[2][16], f0[2][16], f1[2][16]; float2 w[2];
#pragma unroll
        for (int r = 0; r < 2; ++r) { const int tok = t0 + r; const int2 ps = *(const int2*)(tpos + (size_t)tok * 2); w[r] = *(const float2*)(rw + (size_t)tok * 2);
            ld_f32(p.out + (size_t)tok * D, c.lane, xv[r]); ld_bf16(FS + (size_t)ps.x * D, c.lane, f0[r]); ld_bf16(FS + (size_t)ps.y * D, c.lane, f1[r]); }
#pragma unroll
        for (int r = 0; r < 2; ++r) { const int tok = t0 + r, b = tok / T;
#pragma unroll
            for (int i = 0; i < 16; ++i) f0[r][i] = w[r].x * f0[r][i] + w[r].y * f1[r][i];
            const float* mr = (const float*)(c.ws + WS_MODV) + ((size_t)33 + b) * 6144;
            resid16(xv[r], f0[r], p.od_norm_g + 3 * D, mr + 5 * D, c.lane); st_f32(p.out + (size_t)tok * D, c.lane, xv[r]); } }
}
constexpr int LDS_BYTES = 147456;
constexpr int LDS_MISC = 131072 + 2048;
constexpr int NPH = 19;

__device__ __forceinline__ void attn_mla_phase(const Ctx& c) {
    const bf16_t* Q0 = (const bf16_t*)(c.ws + B_Q0); const bf16_t* KN = (const bf16_t*)(c.ws + B_K0N); const bf16_t* KPE = (const bf16_t*)(c.ws + B_KPE); const bf16_t* V0 = (const bf16_t*)(c.ws + B_V0);
    bf16_t* AO = (bf16_t*)(c.ws + B_AOUT0);
    constexpr int NU_LAT = NB * MLA_H * 8, NU = NU_LAT + NB * MLA_H;
    const int G = gridDim.x, vcu = (G % 8 == 0) ? ((int)blockIdx.x % 8) * (G / 8) + (int)blockIdx.x / 8 : (int)blockIdx.x;
#pragma unroll 1
    for (int u = vcu; u < NU; u += G) {
        int b, h, row0, seq;
        if (u < NU_LAT) { b = u / 32; h = (u >> 3) & 3; row0 = b * S + L + (u & 7) * 256; seq = S; } else { const int v = u - NU_LAT; b = v >> 2; h = v & 3; row0 = b * S; seq = L; }
        const att::KSrc ks{KN + (size_t)b * S * 512 + h * 128, 512, KPE + (size_t)b * S * 64, 64};
        const att::AOut ao{AO + (size_t)row0 * D + SCW + h * 128, D, nullptr, nullptr, 0.f, 0};
        att::attn_body_np<192>(Q0 + (size_t)row0 * 768 + h * MLA_QK, 768, ks, V0 + (size_t)b * S * 512 + h * 128, 512, seq, (char*)c.lds, ao);
    }
}
template <int VAR>
__device__ __forceinline__ void attn_diff_phase(const P& p, const Ctx& c) {
    const bf16_t* Q1 = (const bf16_t*)(c.ws + B_QKV1); const bf16_t* K1 = Q1 + (size_t)M * 768; const bf16_t* V1 = K1 + (size_t)M * 768; bf16_t* AO = (bf16_t*)(c.ws + B_AOUT1);
    float* stash = (float*)(c.ws + WS_STASH) + (size_t)blockIdx.x * 32768;
    float d01 = p.od_lambda[c.lane] * p.od_lambda[64 + c.lane], d23 = p.od_lambda[128 + c.lane] * p.od_lambda[192 + c.lane];
    d01 = wave_sum(d01); d23 = wave_sum(d23); const float lam = expf(d01) - expf(d23) + LAM_INIT;
    constexpr int NU = NB * DIFF_H * 8;
    const int G = gridDim.x, vcu = (G % 8 == 0) ? ((int)blockIdx.x % 8) * (G / 8) + (int)blockIdx.x / 8 : (int)blockIdx.x;
#pragma unroll 1
    for (int i2 = 2 * vcu; i2 < 2 * NU; i2 = (i2 & 1) ? i2 + 2 * G - 1 : i2 + 1) {
        const int it = i2 >> 1, sub = i2 & 1; const int b = it / 48, h = (it >> 3) % 6, row0 = b * S + L + (it & 7) * 256;
        const att::KSrc ks{K1 + (size_t)b * S * 768 + h * 128 + sub * 64, 768, nullptr, 0};
        const att::AOut ao{AO + (size_t)row0 * D + h * 128, D, stash, p.od_subln_g, lam, sub};
        att::attn_body<64, 2, 1, VAR>(Q1 + (size_t)row0 * 768 + h * 128 + sub * 64, 768, ks, V1 + (size_t)b * S * 768 + h * 128, 768, S, (char*)c.lds, ao);
    }
}
__device__ __forceinline__ void moe_load_toff(const Ctx& c, pg8::SchedMoe& Sm) {
    const int* toffg = (const int*)(c.ws + RT_TOFF);
#pragma unroll
    for (int e = 0; e <= NE; ++e) Sm.toff[e] = __builtin_amdgcn_readfirstlane(toffg[e]);
}

__global__ void __launch_bounds__(512, 2) fwd(P p) {
    extern __shared__ __attribute__((aligned(16))) unsigned char lds_[];
    Ctx c; c.lds = (LAS unsigned char*)lds_; c.ws = p.ws; c.tid = threadIdx.x; c.lane = c.tid & 63; c.wave = __builtin_amdgcn_readfirstlane(c.tid >> 6);
    c.gw = blockIdx.x * 8 + c.wave; c.ngw = gridDim.x * 8;
    volatile LAS unsigned* misc = (volatile LAS unsigned*)(c.lds + LDS_MISC);
    if (c.tid < 8) misc[c.tid] = 0u;
    __syncthreads();
    const int lo = p.ph_lo, hi = p.ph_hi;
    XcdBarrier bar; bar.bar = (unsigned*)(c.ws + WS_CTL) + CW_BAR; bar.x = 0; bar.st = misc;
    if (hi - lo > 1) bar = xcd_barrier_post((unsigned*)(c.ws + WS_CTL) + CW_BAR, misc);
#ifdef PH_ONLY
#define IN(k) ((k) == PH_ONLY)
#else
#define IN(k) (lo <= (k) && (k) < hi)
#endif
#define SEAM(k) do { if (IN(k) && IN((k) + 1)) xcd_barrier(bar); } while (0)
    LAS unsigned char* lds = c.lds;
    const float* rc = (const float*)(c.ws + WS_ROPE); const float* rs = rc + 2048 * 32;

#ifndef EPI_SKIP
#define EPI_SKIP 0
#endif
#ifndef REPEAT_MASK
#define REPEAT_MASK 0u
#endif
#define REP(k) (((unsigned)(REPEAT_MASK) >> (k)) & 1u)
#define PHASE(k, ...) do { if (IN(k)) { { const int rp_ = 0; (void)rp_; __VA_ARGS__ } if (REP(k)) { xcd_barrier(bar); { const int rp_ = 1; (void)rp_; __VA_ARGS__ } } } SEAM(k); } while (0)
#ifndef P0_REP_PARTS
#define P0_REP_PARTS 7
#endif
    PHASE(0, { phase_prologue(p, c, rp_ ? P0_REP_PARTS : 7, rp_); });
    PHASE(1, { phase_norm0(p, c); });
    PHASE(2, { pg8::Gemm g{D, D, D}; pg8::SchedPlain Sc; Sc.init(c.ws + B_H, D, c.ws + W_IN0, D, M / 256, 9, false); pg8::EpiPlain E{(bf16_t*)(c.ws + B_Z), 2304}; pg8::gemm_phase(lds, g, Sc, E); });
    PHASE(3, { phase_even_elem(p, c); });
    PHASE(4, {
        { pg8::Gemm g{QRANK, QRANK, QRANK}; pg8::SchedPlain Sc; Sc.init(c.ws + B_ZQN, QRANK, c.ws + W_UQ, QRANK, M / 256, 3, false); pg8::EpiQ0 E{(bf16_t*)(c.ws + B_Q0), rc, rs}; pg8::gemm_phase(lds, g, Sc, E); }
        { pg8::Gemm g{KVRANK, KVRANK, KVRANK}; pg8::SchedPlain Sc; Sc.init(c.ws + B_ZKVN, KVRANK, c.ws + W_UKV, KVRANK, M / 256, 4, false); pg8::EpiKV0 E{(bf16_t*)(c.ws + B_K0N), (bf16_t*)(c.ws + B_V0)}; pg8::gemm_phase(lds, g, Sc, E); }
    });
    PHASE(5, { attn_mla_phase(c); });
    PHASE(6, { pg8::Gemm g{D, D, D}; pg8::SchedPlain Sc; Sc.init(c.ws + B_AOUT0, D, c.ws + W_OUT0, D, M / 256, 4, false); pg8::EpiPlain E{(bf16_t*)(c.ws + B_Y), D}; pg8::gemm_phase(lds, g, Sc, E); });
    PHASE(7, { phase_mid0(p, c); });
#if FFN0_FP8
    PHASE(8, { pg8::Gemm g{512, 512, 512, 0x7f7f7f7f, 0x7a7a7a7a}; pg8::SchedPlain Sc; Sc.init(c.ws + B_H2, 512, c.ws + W_GU0, 512, M / 256, 22, false); pg8::EpiSwiglu8 E{c.ws + B_ACT, FF, 8.f}; pg8::gemm_phase<pg8::EpiSwiglu8, pg8::SchedPlain, true>(lds, g, Sc, E); });
    PHASE(9, { pg8::Gemm g{FF / 2, FF / 2, FF / 2, 0x7c7c7c7c, 0x79797979}; pg8::SchedPlain Sc; Sc.init(c.ws + B_ACT, FF / 2, c.ws + W_DN0, FF / 2, M / 256, 4, false); pg8::EpiPlain E{(bf16_t*)(c.ws + B_F), D}; pg8::gemm_phase<pg8::EpiPlain, pg8::SchedPlain, true>(lds, g, Sc, E); });
#else
    PHASE(8, { pg8::Gemm g{D, D, D}; pg8::SchedPlain Sc; Sc.init(c.ws + B_H2, D, c.ws + W_GU0, D, M / 256, 22, false); pg8::EpiSwiglu E{(bf16_t*)(c.ws + B_ACT), FF, (rp_ == 0 && REP(8)) ? EPI_SKIP : 0}; pg8::gemm_phase(lds, g, Sc, E); });
    PHASE(9, { pg8::Gemm g{FF, FF, FF}; pg8::SchedPlain Sc; Sc.init(c.ws + B_ACT, FF, c.ws + W_DN0, FF, M / 256, 4, false); pg8::EpiPlain E{(bf16_t*)(c.ws + B_F), D}; pg8::gemm_phase(lds, g, Sc, E); });
#endif
    PHASE(10, { phase_end0(p, c); });
    PHASE(11, {
        { pg8::Gemm g{D, D, D}; pg8::SchedPlain Sc; Sc.init(c.ws + B_H1, D, c.ws + W_IN1, D, M / 256, 9, false); pg8::EpiQKV1 E{(bf16_t*)(c.ws + B_QKV1), (size_t)M * 768, rc, rs}; pg8::gemm_phase(lds, g, Sc, E); }
        { pg8::Gemm g{D, D, D}; pg8::SchedF1 Sc{(const char*)(c.ws + W_FOLD), (const char*)(c.ws + B_H1), NB * 8, (int)gridDim.x, (int)blockIdx.x}; pg8::EpiGT E{(bf16_t*)(c.ws + B_GT)}; pg8::gemm_phase(lds, g, Sc, E); }
    });
    PHASE(12, {
        { pg8::Gemm g{4096, 4096, 4096}; pg8::SchedF2 Sc{(const char*)(c.ws + W_DFT), (const char*)(c.ws + B_GT), (int)gridDim.x, (int)blockIdx.x}; pg8::EpiPlain E{(bf16_t*)(c.ws + B_AOUT1) + DIFFW, D}; pg8::gemm_phase(lds, g, Sc, E); }
#ifndef ATT_VAR
#define ATT_VAR 0
#endif
        if (rp_ == 0 && REP(12)) attn_diff_phase<ATT_VAR>(p, c); else attn_diff_phase<0>(p, c);
    });
    PHASE(13, { pg8::Gemm g{D, D, D}; pg8::SchedPlain Sc; Sc.init(c.ws + B_AOUT1, D, c.ws + W_OUT1, D, NB * 8, 4, true); pg8::EpiPlain E{(bf16_t*)(c.ws + B_Y1), D}; pg8::gemm_phase(lds, g, Sc, E); });
    PHASE(14, { phase_mid1(p, c); });
    PHASE(15, { phase_gather(p, c); });
    PHASE(16, { pg8::SchedMoe Sm; moe_load_toff(c, Sm);
        Sm.A = (const char*)(c.ws + B_H2S); Sm.W = (const char*)(c.ws + W_GU1); Sm.at = (size_t)256 * 1024; Sm.bt = (size_t)256 * 1024; Sm.estride = (size_t)5632 * 1024; Sm.t0 = 0; Sm.nT = Sm.toff[NE]; Sm.nN = 22; Sm.G = gridDim.x; Sm.c = blockIdx.x;
        pg8::Gemm g{512, 512, 512, 0x7f7f7f7f, 0x7a7a7a7a}; pg8::EpiSwiglu8 E{c.ws + B_ACTM, FF, 8.f}; pg8::gemm_phase<pg8::EpiSwiglu8, pg8::SchedMoe, true>(lds, g, Sm, E); });
    PHASE(17, { pg8::SchedMoe Sm; moe_load_toff(c, Sm);
        Sm.A = (const char*)(c.ws + B_ACTM); Sm.W = (const char*)(c.ws + W_DN1); Sm.at = (size_t)256 * FF; Sm.bt = (size_t)256 * FF; Sm.estride = (size_t)1024 * 2816; Sm.t0 = 0; Sm.nT = Sm.toff[NE]; Sm.nN = 4; Sm.G = gridDim.x; Sm.c = blockIdx.x;
        pg8::Gemm g{FF / 2, FF / 2, FF / 2, 0x7c7c7c7c, 0x79797979}; pg8::EpiPlain E{(bf16_t*)(c.ws + B_FS), D}; pg8::gemm_phase<pg8::EpiPlain, pg8::SchedMoe, true>(lds, g, Sm, E); });
    PHASE(18, { phase_final(p, c); });
#undef PHASE
#undef REP
#undef IN
#undef SEAM
}
}
#ifndef CHECK_MODE
#define CHECK_MODE 0
#endif
#ifndef ONE_LAUNCH
#define ONE_LAUNCH 1
#endif

static fp::P make_params(void* const* d_in, void* d_out, void* d_ws) {
    fp::P p{}; const float** q = (const float**)&p; for (int i = 0; i < 28; ++i) q[i] = (const float*)d_in[i];
    p.out = (float*)d_out; p.ws = (unsigned char*)d_ws; p.ph_lo = 0; p.ph_hi = fp::NPH; return p;
}
static int fast_grid() {
    static int grid = 0;
    if (grid == 0) {
        int dev = 0, cus = 0;
        if (hipGetDevice(&dev) != hipSuccess || hipDeviceGetAttribute(&cus, hipDeviceAttributeMultiprocessorCount, dev) != hipSuccess) { grid = -1; return grid; }
        if (hipFuncSetAttribute((const void*)fp::fwd, hipFuncAttributeMaxDynamicSharedMemorySize, fp::LDS_BYTES) != hipSuccess) { grid = -1; return grid; }
        int per_cu = 0; (void)hipOccupancyMaxActiveBlocksPerMultiprocessor(&per_cu, (const void*)fp::fwd, 512, fp::LDS_BYTES); (void)hipGetLastError();
        if (per_cu < 1) fprintf(stderr, "occupancy query reports %d blocks per CU\n", per_cu);
        grid = cus > 256 ? 256 : cus;
    }
    return grid;
}
static void fast_forward(void* const* d_in, void* d_out, void* d_ws, hipStream_t stream, int ph_end, bool one_launch) {
    const int grid = fast_grid(); if (grid <= 0) return;
    (void)hipMemsetAsync((char*)d_ws + fp::WS_CTL, 0, fp::CTL_BYTES, stream);
    fp::P p = make_params(d_in, d_out, d_ws);
    if (one_launch) { p.ph_lo = 0; p.ph_hi = ph_end; hipLaunchKernelGGL(fp::fwd, dim3(grid), dim3(512), fp::LDS_BYTES, stream, p); }
    else for (int k = 0; k < ph_end; ++k) { p.ph_lo = k; p.ph_hi = k + 1; hipLaunchKernelGGL(fp::fwd, dim3(grid), dim3(512), fp::LDS_BYTES, stream, p); }
}

#if CHECK_MODE
namespace chk {
using namespace cfg;
__device__ __forceinline__ int rope_pos(int e) { return e < 32 ? 8 * (e >> 2) + (e & 3) : 8 * ((e - 32) >> 2) + 4 + (e & 3); }
__global__ void k_cmp(const void* fast, int fast_bf16, int ldf, int fcol0, const float* ref, int ldr, int rcol0, int rows, int cols, int rowmode, int perm, float* acc) {
    float sd = 0.f, sr = 0.f;
    for (long i = (long)blockIdx.x * 256 + threadIdx.x; i < (long)rows * cols; i += (long)gridDim.x * 256) {
        const int r = (int)(i / cols), ci = (int)(i % cols); int rr = r, fr = r;
        if (rowmode == 1 && (r % S) < L) continue;
        if (rowmode == 3 && (r % S) >= L) continue;
        if (rowmode == 2) { rr = (r / T) * S + L + (r % T); }
        int fc = ci;
        if (perm == 1) { const int h = ci / 192, w = ci % 192; fc = w < 128 ? ci : h * 192 + 128 + rope_pos(w - 128); }
        if (perm == 2) { fc = (ci & ~63) + rope_pos(ci & 63); }
        if (perm == 3) { fc = rope_pos(ci); }
        const float rv = ref[(long)rr * ldr + rcol0 + ci];
        const float fv = fast_bf16 ? __uint_as_float(((unsigned)((const unsigned short*)fast)[(long)fr * ldf + fcol0 + fc]) << 16) : ((const float*)fast)[(long)fr * ldf + fcol0 + fc];
        const float d = fv - rv; sd += d * d; sr += rv * rv;
    }
    for (int o = 32; o >= 1; o >>= 1) { sd += __shfl_xor(sd, o); sr += __shfl_xor(sr, o); }
    if ((threadIdx.x & 63) == 0) { atomicAdd(acc, sd); atomicAdd(acc + 1, sr); }
}
__global__ void k_cmp_gt(const unsigned short* gt, const float* gcs, int nb, float* acc) {
    float sd = 0.f, sr = 0.f;
    for (long i = (long)blockIdx.x * 256 + threadIdx.x; i < (long)nb * 2 * T * 256; i += (long)gridDim.x * 256) {
        const int c = (int)(i % 256); const int t = (int)((i / 256) % T); const int part = (int)((i / (256L * T)) % 2); const int b = (int)(i / (256L * T * 2));
        const float rv = gcs[i]; const float fv = __uint_as_float(((unsigned)gt[(((long)b * 256 + c) * 2 + part) * T + t]) << 16);
        const float d = fv - rv; sd += d * d; sr += rv * rv; }
    for (int o = 32; o >= 1; o >>= 1) { sd += __shfl_xor(sd, o); sr += __shfl_xor(sr, o); }
    if ((threadIdx.x & 63) == 0) { atomicAdd(acc, sd); atomicAdd(acc + 1, sr); }
}
__global__ void k_encode(const float* acc, int nchecks, float tol, const float* x, float* out, long n) {
    int code = 0;
    for (int k = 0; k < nchecks; ++k) { const float sd = acc[2 * k], sr = acc[2 * k + 1]; if (!(sd <= tol * sr) || !(sr > 0.f)) { code = k + 1; break; } }
    const float s = 1.f + (float)code;
    for (long i = (long)blockIdx.x * 256 + threadIdx.x; i < n; i += (long)gridDim.x * 256) out[i] = x[i] * s;
}
}
#endif

extern "C" void kernel_launch(void* const* d_in, const int* in_sizes, int n_in, void* d_out, int out_size, void* d_ws, size_t ws_size, hipStream_t stream) {
    (void)in_sizes; (void)n_in; (void)out_size;
#if CHECK_MODE
    using namespace cfg; using fp::M; using fp::ML;
    const nv::In I = nv::make_in(d_in);
    nv::Scratch s; char* nbase = (char*)d_ws + ((fp::AR_END + 4095) / 4096) * 4096;
    size_t need = nv::Scratch::carve(s, nbase, NB);
    float* snap0 = (float*)(nbase + need); need += (size_t)M * D * 4;
    float* snap1 = (float*)(nbase + need); need += (size_t)M * D * 4;
    float* snap2 = (float*)(nbase + need); need += (size_t)M * D * 4;
    float* acc = (float*)(nbase + need); need += 4096;
    if ((size_t)(nbase - (char*)d_ws) + need > ws_size) { fprintf(stderr, "check build: ws too small\n"); return; }
    nv::global_setup(stream, I, s);
    nv::forward_chunk(stream, I, s, 0, NB, nullptr, CHECK_MODE == 1 ? 3 : 7, snap0, snap1, snap2);
    fast_forward(d_in, d_out, d_ws, stream, CHECK_MODE == 1 ? 10 : fp::NPH, ONE_LAUNCH != 0);
    (void)hipMemsetAsync(acc, 0, 4096, stream);
    unsigned char* ws = (unsigned char*)d_ws; int k = 0;
#define CMP(fast, isbf, ldf, fc0, ref, ldr, rc0, rows, cols, rowmode, perm) do { hipLaunchKernelGGL(chk::k_cmp, dim3(512), dim3(256), 0, stream, (const void*)(fast), isbf, ldf, fc0, ref, ldr, rc0, rows, cols, rowmode, perm, acc + 2 * k); ++k; } while (0)
#if CHECK_MODE == 1
    CMP(ws + fp::WS_MODV, 0, 6144, 0, s.mod0, 6144, 0, 33, 6144, 0, 0);
    CMP(ws + fp::WS_MODV + (size_t)33 * 6144 * 4, 0, 6144, 0, s.mod1, 6144, 0, 33, 6144, 0, 0);
    CMP(ws + fp::B_H, 1, D, 0, snap0, D, 0, M, D, 0, 0);
    CMP(ws + fp::B_Z, 1, 2304, 0, s.z, EVEN_IN, 0, M, EVEN_IN, 0, 0);
    CMP(ws + fp::B_AOUT0, 1, D, 0, s.aout, D, 0, M, SCW, 0, 0);
    CMP(ws + fp::B_ZQN, 1, QRANK, 0, s.zqn, QRANK, 0, M, QRANK, 0, 0);
    CMP(ws + fp::B_ZKVN, 1, KVRANK, 0, s.zkvn, KVRANK, 0, M, KVRANK, 0, 0);
    CMP(ws + fp::B_KPE, 1, 64, 0, s.Kf, 768, 128, M, 64, 0, 3);
    CMP(ws + fp::B_Q0, 1, 768, 0, s.Qf, 768, 0, M, 768, 0, 1);
    for (int h = 0; h < 4; ++h) CMP(ws + fp::B_K0N, 1, 512, h * 128, s.Kf, 768, h * 192, M, 128, 0, 0);
    CMP(ws + fp::B_V0, 1, 512, 0, s.Vf, 512, 0, M, 512, 0, 0);
    CMP(ws + fp::B_AOUT0, 1, D, SCW, s.aout, D, SCW, M, 512, 1, 0);
    CMP(ws + fp::B_AOUT0, 1, D, SCW, s.aout, D, SCW, M, 512, 3, 0);
    CMP(ws + fp::B_Y, 1, D, 0, s.y, D, 0, M, D, 0, 0);
    CMP(d_out, 0, D, 0, s.xs, D, 0, ML, D, 2, 0);
    CMP(ws + fp::B_H2, 1, D, 0, s.h, D, 0, M, D, 0, 0);
    CMP(ws + fp::B_ACT, 1, FF, 0, s.act, FF, 0, M, FF, 0, 0);
    CMP(ws + fp::B_F, 1, D, 0, s.f, D, 0, M, D, 0, 0);
#else
    CMP(ws + fp::B_H1, 1, D, 0, snap1, D, 0, M, D, 0, 0);
    CMP(ws + fp::B_QKV1, 1, 768, 0, s.Qf, 768, 0, M, 768, 0, 2);
    CMP(ws + fp::B_QKV1 + (size_t)M * 1536, 1, 768, 0, s.Kf, 768, 0, M, 768, 0, 2);
    CMP(ws + fp::B_QKV1 + (size_t)M * 3072, 1, 768, 0, s.z, ODD_IN, 2 * DIFFW, M, 768, 0, 0);
    hipLaunchKernelGGL(chk::k_cmp_gt, dim3(512), dim3(256), 0, stream, (const unsigned short*)(ws + fp::B_GT), s.gcs, NB, acc + 2 * k); ++k;
    CMP(ws + fp::B_AOUT1, 1, D, DIFFW, s.aout, D, DIFFW, M, FNW, 1, 0);
    CMP(ws + fp::B_AOUT1, 1, D, 0, s.aout, D, 0, M, DIFFW, 1, 0);
    CMP(ws + fp::B_Y1, 1, D, 0, s.y, D, 0, M, D, 1, 0);
    CMP(d_out, 0, D, 0, s.xs, D, 0, ML, D, 2, 0);
#endif
#undef CMP
    hipLaunchKernelGGL(chk::k_encode, dim3(2048), dim3(256), 0, stream, acc, k, 2e-3f, (const float*)d_in[0], (float*)d_out, (long)FULLB * T * D);
#else
    if (ws_size < fp::AR_END) { fprintf(stderr, "kernel_launch: workspace too small: need %zu have %zu\n", (size_t)fp::AR_END, ws_size); return; }
    fast_forward(d_in, d_out, d_ws, stream, fp::NPH, ONE_LAUNCH != 0);
#endif
}
```

```cpp
#include <hip/hip_runtime.h>
#include <cstdio>
#include <cstdint>
#include <cmath>

#ifndef CFG_NB
#define CFG_NB 32
#endif
namespace cfg {
constexpr int NB = CFG_NB;
constexpr int FULLB = 32;
constexpr int D = 1024, T = 2048, L = 256, S = T + L;
constexpr int GW = 64;
constexpr float EPS = 1e-6f;
constexpr int SCW = 512, SCIN = 1536;
constexpr int MLA_H = 4, MLA_NOPE = 128, MLA_ROPE = 64, MLA_V = 128, MLA_QK = 192, QRANK = 384, KVRANK = 256;
constexpr int EVEN_IN = 2240;
constexpr int DIFFW = 768, DIFF_H = 6, DIFF_HD = 64;
constexpr int FNW = 256, FNG = 4, FNGD = 64, ODD_IN = 2560;
constexpr int FF = 2816, NE = 8;
constexpr float LAM_INIT = 0.35550906759096944f;
}
namespace fp {
using namespace cfg;
#define LAS __attribute__((address_space(3)))
#define GAS __attribute__((address_space(1)))
typedef unsigned short bf16_t;
typedef short bf16x8 __attribute__((ext_vector_type(8)));
typedef short s16x4 __attribute__((ext_vector_type(4)));
typedef float f32x4 __attribute__((ext_vector_type(4)));
typedef float f32x2 __attribute__((ext_vector_type(2)));
typedef float f32x16 __attribute__((ext_vector_type(16)));
typedef unsigned u32x4 __attribute__((ext_vector_type(4)));
typedef unsigned u32x2 __attribute__((ext_vector_type(2)));

__device__ __forceinline__ unsigned cvt_pk_bf16(float lo, float hi) { unsigned r; asm volatile("v_cvt_pk_bf16_f32 %0, %1, %2" : "=v"(r) : "v"(lo), "v"(hi)); return r; }
__device__ __forceinline__ float bf2f(unsigned short b) { return __uint_as_float(((unsigned)b) << 16); }
__device__ __forceinline__ float bflo(unsigned w) { return __uint_as_float(w << 16); }
__device__ __forceinline__ float bfhi(unsigned w) { return __uint_as_float(w & 0xffff0000u); }
__device__ __forceinline__ unsigned short f2bf(float f) { return (unsigned short)(cvt_pk_bf16(f, 0.f) & 0xffffu); }
__device__ __forceinline__ float wave_sum(float v) {
    v += __builtin_bit_cast(float, __builtin_amdgcn_update_dpp(0, __builtin_bit_cast(int, v), 0xB1, 0xF, 0xF, true));
    v += __builtin_bit_cast(float, __builtin_amdgcn_update_dpp(0, __builtin_bit_cast(int, v), 0x4E, 0xF, 0xF, true));
    v += __builtin_bit_cast(float, __builtin_amdgcn_update_dpp(0, __builtin_bit_cast(int, v), 0x141, 0xF, 0xF, true));
    v += __builtin_bit_cast(float, __builtin_amdgcn_update_dpp(0, __builtin_bit_cast(int, v), 0x140, 0xF, 0xF, true));
    const int vi = __builtin_bit_cast(int, v);
    const float r0 = __builtin_bit_cast(float, __builtin_amdgcn_readlane(vi, 0)), r1 = __builtin_bit_cast(float, __builtin_amdgcn_readlane(vi, 16)),
                r2 = __builtin_bit_cast(float, __builtin_amdgcn_readlane(vi, 32)), r3 = __builtin_bit_cast(float, __builtin_amdgcn_readlane(vi, 48));
    return (r0 + r1) + (r2 + r3);
}
__device__ __forceinline__ float wave_max(float v) {
    v = fmaxf(v, __builtin_bit_cast(float, __builtin_amdgcn_update_dpp(0, __builtin_bit_cast(int, v), 0xB1, 0xF, 0xF, true)));
    v = fmaxf(v, __builtin_bit_cast(float, __builtin_amdgcn_update_dpp(0, __builtin_bit_cast(int, v), 0x4E, 0xF, 0xF, true)));
    v = fmaxf(v, __builtin_bit_cast(float, __builtin_amdgcn_update_dpp(0, __builtin_bit_cast(int, v), 0x141, 0xF, 0xF, true)));
    v = fmaxf(v, __builtin_bit_cast(float, __builtin_amdgcn_update_dpp(0, __builtin_bit_cast(int, v), 0x140, 0xF, 0xF, true)));
    const int vi = __builtin_bit_cast(int, v);
    const float r0 = __builtin_bit_cast(float, __builtin_amdgcn_readlane(vi, 0)), r1 = __builtin_bit_cast(float, __builtin_amdgcn_readlane(vi, 16)),
                r2 = __builtin_bit_cast(float, __builtin_amdgcn_readlane(vi, 32)), r3 = __builtin_bit_cast(float, __builtin_amdgcn_readlane(vi, 48));
    return fmaxf(fmaxf(r0, r1), fmaxf(r2, r3));
}
__device__ __forceinline__ unsigned pack4_i8(float a, float b, float c, float d) {
    const int ia = (int)rintf(a), ib = (int)rintf(b), ic = (int)rintf(c), id = (int)rintf(d);
    return (unsigned)(ia & 0xff) | ((unsigned)(ib & 0xff) << 8) | ((unsigned)(ic & 0xff) << 16) | ((unsigned)id << 24); }
__device__ __forceinline__ float quant_row_i8(const float (&v)[16], u32x2 (&q)[2]) {
    float am = 0.f;
#pragma unroll
    for (int i = 0; i < 16; ++i) am = fmaxf(am, fabsf(v[i]));
    am = wave_max(am); const float scale = am > 0.f ? am * (1.f / 127.f) : 1.f, inv = 1.f / scale;
#pragma unroll
    for (int j2 = 0; j2 < 2; ++j2) { q[j2].x = pack4_i8(v[j2 * 8 + 0] * inv, v[j2 * 8 + 1] * inv, v[j2 * 8 + 2] * inv, v[j2 * 8 + 3] * inv); q[j2].y = pack4_i8(v[j2 * 8 + 4] * inv, v[j2 * 8 + 5] * inv, v[j2 * 8 + 6] * inv, v[j2 * 8 + 7] * inv); }
    return scale;
}
__device__ __forceinline__ float silu_f(float v) { return v / (1.f + __expf(-v)); }

#define XB_TMO      128
#define XB_XCNT(j)  (256  + 64 * (j))
#define XB_XSUB(j)  (1280 + 64 * (j))
#define XB_XGEN(j)  (2304 + 64 * (j))
#define XB_TOP      3328
#define XB_TOPGEN   3392
#define XCD_BAR_WORDS 3456
#define XB_SPIN_CAP (1u << 18)
__device__ __forceinline__ unsigned xb_ld(unsigned* p)              { return __hip_atomic_load(p, __ATOMIC_RELAXED, __HIP_MEMORY_SCOPE_AGENT); }
__device__ __forceinline__ unsigned xb_add(unsigned* p, unsigned v) { return __hip_atomic_fetch_add(p, v, __ATOMIC_RELAXED, __HIP_MEMORY_SCOPE_AGENT); }
__device__ __forceinline__ unsigned xb_xcc_id() { return (unsigned)__builtin_amdgcn_s_getreg((3 << 11) | 20) & 0xFu; }
#define XB_SPIN(cond, bar) do { unsigned _sp = 0; while (cond) { __builtin_amdgcn_s_sleep(1); \
    if ((++_sp & 255u) == 0u) { if (xb_ld(&(bar)[XB_TMO])) break; if (_sp > XB_SPIN_CAP) { atomicAdd(&(bar)[XB_TMO], 1u); break; } } } } while (0)
struct XcdBarrier { unsigned* bar; unsigned x; volatile LAS unsigned* st; };
__device__ __forceinline__ XcdBarrier xcd_barrier_post(unsigned* bar, volatile LAS unsigned* st) {
    XcdBarrier b; b.bar = bar; b.x = xb_xcc_id(); b.st = st;
    if (threadIdx.x == 0) (void)xb_add(&bar[XB_XCNT(b.x)], 1u);
    return b;
}
__device__ __forceinline__ void xcd_barrier_complete(unsigned* bar, unsigned x, unsigned& nloc, unsigned& nx) {
    const unsigned G = gridDim.x * gridDim.y * gridDim.z;
    unsigned sum, cnt, mine, sp = 0u;
    for (;;) {
        sum = 0u; cnt = 0u; mine = 0u;
#pragma unroll
        for (unsigned j = 0; j < 16; ++j) { const unsigned c = xb_ld(&bar[XB_XCNT(j)]); sum += c; cnt += (c > 0u) ? 1u : 0u; mine = (j == x) ? c : mine; }
        if (sum == G) break;
        __builtin_amdgcn_s_sleep(1);
        if ((++sp & 255u) == 0u) { if (xb_ld(&bar[XB_TMO])) break; if (sp > XB_SPIN_CAP) { atomicAdd(&bar[XB_TMO], 1u); break; } }
    }
    nloc = mine > 0u ? mine : 1u; nx = cnt > 0u ? cnt : 1u;
}
__device__ __forceinline__ void xcd_barrier(const XcdBarrier& b) {
    asm volatile("s_waitcnt vmcnt(0)" ::: "memory");
    __syncthreads();
    if (threadIdx.x == 0) {
        unsigned* bar = b.bar;
        __builtin_amdgcn_s_waitcnt(0);
        unsigned nloc = b.st[0], nx = b.st[1];
        if (nloc == 0u) { xcd_barrier_complete(bar, b.x, nloc, nx); b.st[0] = nloc; b.st[1] = nx; }
        const unsigned old = xb_add(&bar[XB_XSUB(b.x)], 1u);
        const unsigned gen = old / nloc;
        if (old + 1u == (gen + 1u) * nloc) {
            __builtin_amdgcn_fence(__ATOMIC_RELEASE, "agent");
            asm volatile("s_waitcnt vmcnt(0)" ::: "memory");
            const unsigned og = xb_add(&bar[XB_TOP], 1u);
            const unsigned tg = og / nx;
            if (og + 1u == (tg + 1u) * nx) xb_add(&bar[XB_TOPGEN], 1u);
            else XB_SPIN(xb_ld(&bar[XB_TOPGEN]) == tg, bar);
            __builtin_amdgcn_fence(__ATOMIC_ACQUIRE, "agent");
            xb_add(&bar[XB_XGEN(b.x)], 1u);
            asm volatile("s_waitcnt vmcnt(0)" ::: "memory");
        } else {
            XB_SPIN(xb_ld(&bar[XB_XGEN(b.x)]) == gen, bar);
            __builtin_amdgcn_fence(__ATOMIC_ACQUIRE, "agent");
            asm volatile("s_waitcnt vmcnt(0)" ::: "memory");
        }
    }
    __syncthreads();
}

namespace pg8 {
constexpr int BM = 256, BK = 64, HALF = 128, HTB = HALF * BK * 2, STAGE_BYTES = 8 * HTB, NXCD = 8, WGM = 8;
__host__ __device__ __forceinline__ int lds_byte(int r, int c) { const int st = (r >> 4) * 2 + (c >> 5), rr = r & 15, cc = c & 31, ob = rr * 64 + cc * 2; return st * 1024 + (ob ^ (((ob >> 9) & 1) << 5)); }
__host__ __device__ __forceinline__ void stage_rc(int b, int& R, int& C) { const int st = b / 1024, sb = b % 1024, swz = sb ^ (((sb >> 9) & 1) << 5); R = (st >> 1) * 16 + swz / 64; C = (st & 1) * 32 + (swz % 64) / 2; }
__host__ __device__ __forceinline__ int perm32(int rho) { const int n = rho >> 4, i = rho & 15; return 8 * (i >> 2) + 4 * n + (i & 3); }
struct Unit { const char* a; const char* b; int pm, pn, e; };
struct Gemm { int lda, ldb, K; int sa = 0x7f7f7f7f, sb = 0x7f7f7f7f, sb1 = 0; };
typedef int i32x8 __attribute__((ext_vector_type(8)));
typedef int i32x4 __attribute__((ext_vector_type(4)));
__device__ __forceinline__ bool tile_of(int i, int G, int c, int nM, int nN, int& pm, int& pn) {
    const int nwg = nM * nN; const long Lq = (long)i * G + c; if (Lq >= nwg) return false;
    int wgid = (int)Lq; { const int q = nwg / NXCD, r = nwg % NXCD, xcd = wgid % NXCD, off = wgid / NXCD; wgid = (xcd < r ? xcd * (q + 1) : r * (q + 1) + (xcd - r) * q) + off; }
    const int nig = WGM * nN, gid = wgid / nig, fm = gid * WGM, gsz = (nM - fm) < WGM ? (nM - fm) : WGM;
    pm = fm + ((wgid % nig) % gsz); pn = (wgid % nig) / gsz; return true;
}
template <class...> struct epi_void { typedef void type; };
template <class E, class = void> struct EpiHasPre { static constexpr bool value = false; };
template <class E> struct EpiHasPre<E, typename epi_void<decltype(E::HAS_PRE)>::type> { static constexpr bool value = E::HAS_PRE; };
template <class S, class = void> struct SchedHasNt { static constexpr bool value = false; };
template <class S> struct SchedHasNt<S, typename epi_void<decltype(S::HAS_NT)>::type> { static constexpr bool value = S::HAS_NT; };
template <class E, bool H> struct EpiPreOf { struct type {}; };
template <class E> struct EpiPreOf<E, true> { using type = typename E::Pre; };
struct RopeF { float inv[4]; bool rowf; };
__device__ __forceinline__ RopeF rope_freqs(int f0) { RopeF r; r.rowf = f0 < 16;
#pragma unroll
    for (int j = 0; j < 4; ++j) r.inv[j] = __builtin_amdgcn_exp2f(-(float)((f0 + j) & 15) * 0.8304820237218407f) * 0.15915494309189535f;
    return r; }
__device__ __forceinline__ void rope_cs4(const RopeF& rf, int t, f32x4& cs, f32x4& sn) { const float pos = (float)(rf.rowf ? (t >> 6) : (t & 63));
#pragma unroll
    for (int j = 0; j < 4; ++j) { const float x = __builtin_amdgcn_fractf(pos * rf.inv[j]); cs[j] = __builtin_amdgcn_cosf(x); sn[j] = __builtin_amdgcn_sinf(x); } }
__device__ __forceinline__ const char* uni_ptr(const char* p) { const unsigned long long v = (unsigned long long)p; const unsigned lo = __builtin_amdgcn_readfirstlane((unsigned)v), hi = __builtin_amdgcn_readfirstlane((unsigned)(v >> 32)); return (const char*)(((unsigned long long)hi << 32) | lo); }
__device__ __forceinline__ void uni_unit(Unit& u) { u.a = uni_ptr(u.a); u.b = uni_ptr(u.b); u.pm = __builtin_amdgcn_readfirstlane(u.pm); u.pn = __builtin_amdgcn_readfirstlane(u.pn); u.e = __builtin_amdgcn_readfirstlane(u.e); }
template <class Epi, class Sched, int MODE = 0>
__device__ __forceinline__ void gemm_phase(LAS unsigned char* lds, const Gemm g, const Sched& S, const Epi& E) {
    const int tid = threadIdx.x, wid = __builtin_amdgcn_readfirstlane(tid >> 6), lane = tid & 63, wr = wid >> 2, wc = wid & 3, fr = lane & 15, fq = lane >> 4;
    constexpr bool FP8 = MODE == 1, I8 = MODE == 2;
    const int K = g.K, nt = K / BK;
    unsigned voffA[2], voffB[2];
#pragma unroll
    for (int i = 0; i < 2; ++i) { int R, C; stage_rc(tid * 16 + i * 8192, R, C); const int Rb = Epi::PERM ? ((R & ~31) + perm32(R & 31)) : R;
        voffA[i] = (unsigned)(R * g.lda + C) * 2u; voffB[i] = (unsigned)(Rb * g.ldb + C) * 2u; }
    const size_t kstep = (size_t)(BK * 2);
    const size_t hstepA = (size_t)HALF * g.lda * 2, hstepB = (size_t)HALF * g.ldb * 2;
    const unsigned ldsw = (unsigned)wid * 1024u;
    const int aoff = lds_byte(wr * 64 + fr, fq * 8), boff = lds_byte(wc * 32 + fr, fq * 8);
#define PG8_SA(b, h) (((b) * 2 + (h)) * HTB)
#define PG8_SB(b, h) ((4 + (b) * 2 + (h)) * HTB)
#define PG8_STAGE(bufoff, gbase, voff) do { const char* _gb = (const char*)(gbase); asm volatile("" : "+s"(_gb));     \
        _Pragma("unroll") for (int _i = 0; _i < 2; ++_i) \
        __builtin_amdgcn_global_load_lds((const unsigned*)(_gb + (voff)[_i]), (LAS unsigned*)(lds + (bufoff) + ldsw + _i * 8192), 16, 0, 0); } while (0)
#define PG8_CAT(x0, x1) __builtin_shufflevector(x0, x1, 0, 1, 2, 3, 4, 5, 6, 7)
#define PG8_LDA(dst, b, h) do { if constexpr (FP8) { _Pragma("unroll") for (int m = 0; m < 4; ++m) dst##8[m] = PG8_CAT(*(const LAS i32x4*)(lds + PG8_SA(b, h) + aoff + m * 2048), *(const LAS i32x4*)(lds + PG8_SA(b, h) + aoff + m * 2048 + 1024)); } \
        else { _Pragma("unroll") for (int m = 0; m < 4; ++m) _Pragma("unroll") for (int k = 0; k < 2; ++k) dst[m][k] = *(const LAS bf16x8*)(lds + PG8_SA(b, h) + aoff + m * 2048 + k * 1024); } } while (0)
#define PG8_LDB(dst, b, h) do { if constexpr (FP8) { _Pragma("unroll") for (int n = 0; n < 2; ++n) dst##8[n] = PG8_CAT(*(const LAS i32x4*)(lds + PG8_SB(b, h) + boff + n * 2048), *(const LAS i32x4*)(lds + PG8_SB(b, h) + boff + n * 2048 + 1024)); } \
        else { _Pragma("unroll") for (int n = 0; n < 2; ++n) _Pragma("unroll") for (int k = 0; k < 2; ++k) dst[n][k] = *(const LAS bf16x8*)(lds + PG8_SB(b, h) + boff + n * 2048 + k * 1024); } } while (0)
#define PG8_MMA(ai, bj, At, Bt) do { __builtin_amdgcn_s_setprio(1); \
        if constexpr (FP8) { _Pragma("unroll") for (int m = 0; m < 4; ++m) _Pragma("unroll") for (int n = 0; n < 2; ++n) \
            asm volatile("v_mfma_scale_f32_16x16x128_f8f6f4 %0, %1, %2, %0, %3, %4 op_sel_hi:[0,0,0]" : "+v"(acc[ai][bj][m][n]) : "v"(Bt##8[n]), "v"(At##8[m]), "v"(sbv[bj]), "v"(g.sa));   } \
        else if constexpr (I8) { _Pragma("unroll") for (int m = 0; m < 4; ++m) _Pragma("unroll") for (int n = 0; n < 2; ++n) _Pragma("unroll") for (int k = 0; k < 2; ++k) \
            acc[ai][bj][m][n] = __builtin_bit_cast(f32x4, __builtin_amdgcn_mfma_i32_16x16x64_i8(__builtin_bit_cast(i32x4, Bt[n][k]), __builtin_bit_cast(i32x4, At[m][k]), __builtin_bit_cast(i32x4, acc[ai][bj][m][n]), 0, 0, 0)); } \
        else { _Pragma("unroll") for (int m = 0; m < 4; ++m) _Pragma("unroll") for (int n = 0; n < 2; ++n) _Pragma("unroll") for (int k = 0; k < 2; ++k) \
            acc[ai][bj][m][n] = __builtin_amdgcn_mfma_f32_16x16x32_bf16(Bt[n][k], At[m][k], acc[ai][bj][m][n], 0, 0, 0); } \
        __builtin_amdgcn_s_setprio(0); } while (0)
#define PG8_WAIT_V(n) asm volatile("s_waitcnt vmcnt(" #n ")" ::: "memory")
#define PG8_WAIT_L(n) asm volatile("s_waitcnt lgkmcnt(" #n ")" ::: "memory")
#define PG8_BAR __builtin_amdgcn_s_barrier()
#define PG8_SCHED __builtin_amdgcn_sched_barrier(0)
    const int sbv[2] = {g.sb, g.sb1 ? g.sb1 : g.sb};
    constexpr bool HASP = EpiHasPre<Epi>::value; typename EpiPreOf<Epi, HASP>::type pre;
    Unit cur, nxt; int ui = 0;
    if (!S.next(0, cur)) return;
    uni_unit(cur);
    constexpr bool HASNT = SchedHasNt<Sched>::value; int ntc = nt; if constexpr (HASNT) ntc = S.nt_of(cur);
    f32x4 acc[2][2][4][2];
#pragma unroll
    for (int a = 0; a < 2; ++a)
#pragma unroll
        for (int b = 0; b < 2; ++b)
#pragma unroll
            for (int m = 0; m < 4; ++m)
#pragma unroll
                for (int n = 0; n < 2; ++n) acc[a][b][m][n] = (f32x4){0.f, 0.f, 0.f, 0.f};
    bf16x8 At[4][2], B0[2][2], B1[2][2]; i32x8 At8[4], B08[2], B18[2];
    const char* cA = cur.a; const char* cB = cur.b;
    PG8_STAGE(PG8_SB(0, 0), cB, voffB); PG8_STAGE(PG8_SA(0, 0), cA, voffA); PG8_STAGE(PG8_SB(0, 1), cB + hstepB, voffB); PG8_STAGE(PG8_SA(0, 1), cA + hstepA, voffA);
    if (wr == 1) PG8_BAR;
    PG8_WAIT_V(4); PG8_BAR;
    PG8_STAGE(PG8_SB(1, 0), cB + kstep, voffB); PG8_STAGE(PG8_SA(1, 0), cA + kstep, voffA); PG8_STAGE(PG8_SB(1, 1), cB + hstepB + kstep, voffB);
    PG8_WAIT_V(6); PG8_BAR;
    for (;;) {
        const bool has_next = S.next(ui + 1, nxt); if (has_next) uni_unit(nxt);
        const char* nA = has_next ? nxt.a : cA; const char* nB = has_next ? nxt.b : cB;
#pragma unroll 1
        for (int t = 0; t < ntc; t += 2) {
            const bool last = (t == ntc - 2);
            if constexpr (HASP) { if (last) E.prefetch(cur, wr, wc, fr, fq, pre); }
            const char* a1 = cA + (size_t)(t + 1) * kstep;
            const char* a2 = last ? nA : cA + (size_t)(t + 2) * kstep; const char* b2 = last ? nB : cB + (size_t)(t + 2) * kstep;
            const char* a3 = a2 + kstep; const char* b3 = b2 + kstep;
            PG8_LDB(B0, 0, 0); PG8_SCHED; PG8_LDA(At, 0, 0); PG8_STAGE(PG8_SA(1, 1), a1 + hstepA, voffA);
            PG8_WAIT_L(8); PG8_BAR; PG8_WAIT_L(0); PG8_MMA(0, 0, At, B0); PG8_BAR; PG8_SCHED;
            PG8_LDB(B1, 0, 1); PG8_STAGE(PG8_SB(0, 0), b2, voffB);
            PG8_BAR; PG8_WAIT_L(0); PG8_MMA(0, 1, At, B1); PG8_BAR;
            PG8_LDA(At, 0, 1); PG8_STAGE(PG8_SA(0, 0), a2, voffA);
            PG8_BAR; PG8_WAIT_L(0); PG8_MMA(1, 0, At, B0); PG8_BAR; PG8_SCHED;
            PG8_STAGE(PG8_SB(0, 1), b2 + hstepB, voffB);
            PG8_WAIT_V(6); PG8_BAR; PG8_MMA(1, 1, At, B1); PG8_BAR;
            PG8_LDB(B0, 1, 0); PG8_SCHED; PG8_LDA(At, 1, 0); PG8_STAGE(PG8_SA(0, 1), a2 + hstepA, voffA);
            PG8_WAIT_L(8); PG8_BAR; PG8_WAIT_L(0); PG8_MMA(0, 0, At, B0); PG8_BAR; PG8_SCHED;
            PG8_LDB(B1, 1, 1); PG8_STAGE(PG8_SB(1, 0), b3, voffB);
            PG8_BAR; PG8_WAIT_L(0); PG8_MMA(0, 1, At, B1); PG8_BAR;
            PG8_LDA(At, 1, 1); PG8_STAGE(PG8_SA(1, 0), a3, voffA);
            PG8_BAR; PG8_WAIT_L(0); PG8_MMA(1, 0, At, B0); PG8_BAR; PG8_SCHED;
            PG8_STAGE(PG8_SB(1, 1), b3 + hstepB, voffB);
            PG8_WAIT_V(6); PG8_BAR; PG8_MMA(1, 1, At, B1); PG8_BAR;
        }
        if constexpr (FP8) asm volatile("s_nop 15\n\ts_nop 7" ::: "memory");
        if constexpr (HASP) E(acc, cur, wr, wc, fr, fq, pre); else E(acc, cur, wr, wc, fr, fq);
        if (!has_next) break;
#pragma unroll
        for (int a = 0; a < 2; ++a)
#pragma unroll
            for (int b = 0; b < 2; ++b)
#pragma unroll
                for (int m = 0; m < 4; ++m)
#pragma unroll
                    for (int n = 0; n < 2; ++n) acc[a][b][m][n] = (f32x4){0.f, 0.f, 0.f, 0.f};
        cur = nxt; cA = nA; cB = nB; ++ui; if constexpr (HASNT) ntc = S.nt_of(cur);
    }
    PG8_WAIT_V(0);
    if (wr == 0) PG8_BAR;
    PG8_BAR;
#undef PG8_SA
#undef PG8_SB
#undef PG8_STAGE
#undef PG8_LDA
#undef PG8_LDB
#undef PG8_MMA
#undef PG8_CAT
#undef PG8_WAIT_V
#undef PG8_WAIT_L
#undef PG8_BAR
#undef PG8_SCHED
}

struct SchedPlain {
    const char* A; const char* Bt; size_t at, bt; int nM, nN, G, c; bool latM;
    __device__ __forceinline__ void init(const void* A_, int lda, const void* Bt_, int ldb, int nM_, int nN_, bool latM_) {
        A = (const char*)A_; Bt = (const char*)Bt_; at = (size_t)256 * lda * 2; bt = (size_t)256 * ldb * 2; nM = nM_; nN = nN_; G = gridDim.x; c = blockIdx.x; latM = latM_; }
    __device__ __forceinline__ bool next(int i, Unit& u) const {
        int pm, pn; if (!tile_of(i, G, c, nM, nN, pm, pn)) return false;
        if (latM) pm = (pm >> 3) * 9 + 1 + (pm & 7);
        u.pm = pm; u.pn = pn; u.e = 0; u.a = A + (size_t)pm * at; u.b = Bt + (size_t)pn * bt; return true; }
};
struct SchedTailK2 {
    const char* A; const char* Bt; size_t at, bt, khb; int G, c;
    __device__ __forceinline__ bool next(int i, Unit& u) const {
        const int L_ = i * G + c; if (L_ >= 256) return false; const int pm = 256 + (L_ >> 3), pn = (L_ >> 1) & 3, kh = L_ & 1;
        u.pm = pm; u.pn = pn; u.e = kh; u.a = A + (size_t)pm * at + (size_t)kh * khb; u.b = Bt + (size_t)pn * bt + (size_t)kh * khb; return true; }
};
struct SchedTailParts {
    static constexpr bool HAS_NT = true;
    const char* A; const char* Bt; size_t at, bt; int pm0, nTail, nN, NP, t0, t1, G, c;
    __device__ __forceinline__ bool next(int i, Unit& u) const {
        const int L_ = i * G + c; if (L_ >= nTail * nN * NP) return false; const int part = L_ % NP, rest = L_ / NP, pn = rest % nN, pm = pm0 + rest / nN; const size_t ko = (size_t)part * t0 * 128;
        u.pm = pm; u.pn = pn; u.e = part; u.a = A + (size_t)pm * at + ko; u.b = Bt + (size_t)pn * bt + ko; return true; }
    __device__ __forceinline__ int nt_of(const Unit& u) const { return u.e == NP - 1 ? t1 : t0; }
};
struct SchedQKV1 {
    const char* A; const char* Bt; int G, c; int rowb = D * 2;
    __device__ __forceinline__ bool next(int i, Unit& u) const {
        const int L_ = i * G + c; constexpr int NLAT = NB * 8 * 9, NCTX = NB * 6; int pm, pn;
        if (L_ < NLAT) { if (!tile_of(i, G, c, NB * 8, 9, pm, pn)) return false; pm = (pm >> 3) * 9 + 1 + (pm & 7); }
        else { const int v = L_ - NLAT; if (v >= NCTX) return false; pm = (v / 6) * 9; pn = 3 + v % 6; }
        u.pm = pm; u.pn = pn; u.e = 0; u.a = A + (size_t)pm * 256 * rowb; u.b = Bt + (size_t)pn * 256 * rowb; return true; }
};
struct SchedF1 {
    const char* A; const char* H; int nN, G, c; int rowb = D * 2;
    __device__ __forceinline__ bool next(int i, Unit& u) const {
        int pm, pn; if (!tile_of(i, G, c, 2, nN, pm, pn)) return false;
        u.pm = pm; u.pn = pn; u.e = 0; u.a = A + (size_t)pm * 256 * rowb; u.b = H + (size_t)((pn >> 3) * 9 + 1 + (pn & 7)) * 256 * rowb; return true; }
};
struct SchedF2 {
    const char* Dft; const char* GT; int G, c;
    __device__ __forceinline__ bool next(int i, Unit& u) const {
        const int L_ = i * G + c; if (L_ >= NB * 8) return false; const int b = L_ >> 3, kt = L_ & 7;
        u.pm = b * 9 + 1 + kt; u.pn = 0; u.e = 0; u.a = Dft + (size_t)kt * 256 * 4096 * 2; u.b = GT + (size_t)b * 256 * 4096 * 2; return true; }
};
struct SchedMoe {
    const char* A; const char* W; size_t at, bt, estride; int t0, nT, nN, G, c; int toff[NE + 1];
    __device__ __forceinline__ bool next(int i, Unit& u) const {
        int pm, pn; if (!tile_of(i, G, c, nT, nN, pm, pn)) return false; pm += t0;
        int e = 0;
#pragma unroll
        for (int j = 1; j < NE; ++j) e += (pm >= toff[j]) ? 1 : 0;
        u.pm = pm; u.pn = pn; u.e = e; u.a = A + (size_t)pm * at; u.b = W + (size_t)e * estride + (size_t)pn * bt; return true; }
};

struct SchedMoeTail {
    static constexpr bool HAS_NT = true;
    const char* A; const char* W; size_t at, bt, estride; int pm0, nTail, nN, t0, t1, G, c; int toff[NE + 1];
    __device__ __forceinline__ bool next(int i, Unit& u) const {
        const int L_ = i * G + c; if (L_ >= nTail * nN * 4) return false; const int part = L_ & 3, rest = L_ >> 2, pn = rest % nN, pm = pm0 + rest / nN; const size_t ko = (size_t)part * t0 * 128;
        int e = 0;
#pragma unroll
        for (int j = 1; j < NE; ++j) e += (pm >= toff[j]) ? 1 : 0;
        u.pm = pm; u.pn = pn; u.e = part; u.a = A + (size_t)pm * at + ko; u.b = W + (size_t)e * estride + (size_t)pn * bt + ko; return true; }
    __device__ __forceinline__ int nt_of(const Unit& u) const { return u.e == 3 ? t1 : t0; }
};

#define EPI_LOOP_ROWS for (int ai = 0; ai < 2; ++ai) _Pragma("unroll") for (int m = 0; m < 4; ++m)
__device__ __forceinline__ u32x4 pack8(const f32x4 a, const f32x4 b) { u32x4 w; w.x = cvt_pk_bf16(a[0], a[1]); w.y = cvt_pk_bf16(a[2], a[3]); w.z = cvt_pk_bf16(b[0], b[1]); w.w = cvt_pk_bf16(b[2], b[3]); return w; }
struct EpiPlain {
    static constexpr bool PERM = true; bf16_t* O; int ldo;
    __device__ __forceinline__ void operator()(const f32x4 (&acc)[2][2][4][2], const Unit& u, int wr, int wc, int fr, int fq) const {
        const int row0 = u.pm * BM + wr * 64 + fr, col0 = u.pn * BM + wc * 32 + 8 * fq;
#pragma unroll
        EPI_LOOP_ROWS { bf16_t* rowp = O + (size_t)(row0 + ai * HALF + m * 16) * ldo + col0;
#pragma unroll
            for (int bj = 0; bj < 2; ++bj) *(u32x4*)(rowp + bj * HALF) = pack8(acc[ai][bj][m][0], acc[ai][bj][m][1]); }
    }
};
struct EpiPlainK2 {
    static constexpr bool PERM = true; bf16_t* O0; bf16_t* O1; int ldo;
    __device__ __forceinline__ void operator()(const f32x4 (&acc)[2][2][4][2], const Unit& u, int wr, int wc, int fr, int fq) const {
        const int row0 = u.pm * BM + wr * 64 + fr, col0 = u.pn * BM + wc * 32 + 8 * fq; bf16_t* base = u.e ? O1 - (size_t)65536 * ldo : O0;
#pragma unroll
        EPI_LOOP_ROWS { bf16_t* rowp = base + (size_t)(row0 + ai * HALF + m * 16) * ldo + col0;
#pragma unroll
            for (int bj = 0; bj < 2; ++bj) *(u32x4*)(rowp + bj * HALF) = pack8(acc[ai][bj][m][0], acc[ai][bj][m][1]); }
    }
};
struct EpiPlainParts {
    static constexpr bool PERM = true; bf16_t* O0; bf16_t* X; int ldo, row0x, xrows;
    __device__ __forceinline__ void operator()(const f32x4 (&acc)[2][2][4][2], const Unit& u, int wr, int wc, int fr, int fq) const {
        const int row0 = u.pm * BM + wr * 64 + fr, col0 = u.pn * BM + wc * 32 + 8 * fq; bf16_t* base = u.e ? X + ((size_t)(u.e - 1) * xrows - row0x) * ldo : O0;
#pragma unroll
        EPI_LOOP_ROWS { bf16_t* rowp = base + (size_t)(row0 + ai * HALF + m * 16) * ldo + col0;
#pragma unroll
            for (int bj = 0; bj < 2; ++bj) *(u32x4*)(rowp + bj * HALF) = pack8(acc[ai][bj][m][0], acc[ai][bj][m][1]); }
    }
};
__device__ __forceinline__ f32x2 swiglu2(f32x2 g, f32x2 up) {
    const f32x2 t = g * (-1.4426950408889634f); f32x2 e; e.x = __builtin_amdgcn_exp2f(t.x); e.y = __builtin_amdgcn_exp2f(t.y);
    const f32x2 d = e + 1.0f; f32x2 r; r.x = __builtin_amdgcn_rcpf(d.x); r.y = __builtin_amdgcn_rcpf(d.y);
    return (g * r) * up; }
__device__ __forceinline__ f32x2 swiglu2f(f32x2 gs, f32x2 ups) {
    f32x2 e; e.x = __builtin_amdgcn_exp2f(-gs.x); e.y = __builtin_amdgcn_exp2f(-gs.y);
    const f32x2 d = e + 1.0f; f32x2 r; r.x = __builtin_amdgcn_rcpf(d.x); r.y = __builtin_amdgcn_rcpf(d.y);
    return (gs * r) * ups; }
struct EpiSwiglu {
    static constexpr bool PERM = true; bf16_t* O; int ldo; int skip = 0;
    __device__ __forceinline__ void operator()(const f32x4 (&acc)[2][2][4][2], const Unit& u, int wr, int wc, int fr, int fq) const {
        if (skip) {
#pragma unroll
            for (int ai = 0; ai < 2; ++ai)
#pragma unroll
                for (int bj = 0; bj < 2; ++bj)
#pragma unroll
                    for (int m = 0; m < 4; ++m) { asm volatile("" :: "v"(acc[ai][bj][m][0]), "v"(acc[ai][bj][m][1])); }
            return; }
        const int row0 = u.pm * BM + wr * 64 + fr, col0 = u.pn * 128 + 8 * (4 * wc + fq);
#pragma unroll
        EPI_LOOP_ROWS { bf16_t* rowp = O + (size_t)(row0 + ai * HALF + m * 16) * ldo + col0; u32x4 w;
#pragma unroll
            for (int n = 0; n < 2; ++n) { const f32x4 g = acc[ai][0][m][n], up = acc[ai][1][m][n];
                const f32x2 a0 = swiglu2((f32x2){g[0], g[1]}, (f32x2){up[0], up[1]}), a1 = swiglu2((f32x2){g[2], g[3]}, (f32x2){up[2], up[3]});
                w[2 * n] = cvt_pk_bf16(a0.x, a0.y); w[2 * n + 1] = cvt_pk_bf16(a1.x, a1.y); }
            *(u32x4*)rowp = w; }
    }
};
__device__ __forceinline__ unsigned pack4_fp8(float a, float b, float c, float d) {
    a = __builtin_amdgcn_fmed3f(a, -448.f, 448.f); b = __builtin_amdgcn_fmed3f(b, -448.f, 448.f); c = __builtin_amdgcn_fmed3f(c, -448.f, 448.f); d = __builtin_amdgcn_fmed3f(d, -448.f, 448.f);
    int p = __builtin_amdgcn_cvt_pk_fp8_f32(a, b, 0, false); p = __builtin_amdgcn_cvt_pk_fp8_f32(c, d, p, true); return (unsigned)p; }
struct EpiSwiglu8 {
    static constexpr bool PERM = true; unsigned char* O; int ldo; float oscale; int skip = 0;
    __device__ __forceinline__ void operator()(const f32x4 (&acc)[2][2][4][2], const Unit& u, int wr, int wc, int fr, int fq) const {
        if (skip) {
#pragma unroll
            for (int ai = 0; ai < 2; ++ai)
#pragma unroll
                for (int bj = 0; bj < 2; ++bj)
#pragma unroll
                    for (int m = 0; m < 4; ++m) { asm volatile("" :: "v"(acc[ai][bj][m][0]), "v"(acc[ai][bj][m][1])); }
            return; }
        const int row0 = u.pm * BM + wr * 64 + fr, col0 = u.pn * 128 + 8 * (4 * wc + fq);
#pragma unroll
        EPI_LOOP_ROWS { unsigned char* rowp = O + (size_t)(row0 + ai * HALF + m * 16) * ldo + col0; u32x2 w;
#pragma unroll
            for (int n = 0; n < 2; ++n) { const f32x4 g = acc[ai][0][m][n], up = acc[ai][1][m][n];
                const f32x2 a0 = swiglu2f((f32x2){g[0], g[1]}, (f32x2){up[0], up[1]}), a1 = swiglu2f((f32x2){g[2], g[3]}, (f32x2){up[2], up[3]});
                w[n] = pack4_fp8(a0.x, a0.y, a1.x, a1.y); }
            *(u32x2*)rowp = w; }
    }
};
__device__ __forceinline__ f32x4 cvt_i4(const f32x4 a, const float sr, const f32x4 sw) { const i32x4 i = __builtin_bit_cast(i32x4, a); return (f32x4){(float)i[0] * sr * sw[0], (float)i[1] * sr * sw[1], (float)i[2] * sr * sw[2], (float)i[3] * sr * sw[3]}; }
struct PreSc { f32x4 w[2][2]; float sr[2][4]; };
struct EpiPlainI8 {
    static constexpr bool PERM = true, HAS_PRE = true; typedef PreSc Pre; bf16_t* O; int ldo; const float* sa; const float* sw;
    __device__ __forceinline__ void prefetch(const Unit& u, int wr, int wc, int fr, int fq, Pre& p) const {
        const int row0 = u.pm * BM + wr * 64 + fr, col0 = u.pn * BM + wc * 32 + 8 * fq;
#pragma unroll
        for (int bj = 0; bj < 2; ++bj)
#pragma unroll
            for (int n = 0; n < 2; ++n) p.w[bj][n] = *(const f32x4*)(sw + col0 + bj * HALF + 4 * n);
#pragma unroll
        for (int ai = 0; ai < 2; ++ai)
#pragma unroll
            for (int m = 0; m < 4; ++m) p.sr[ai][m] = sa[row0 + ai * HALF + m * 16]; }
    __device__ __forceinline__ void operator()(const f32x4 (&acc)[2][2][4][2], const Unit& u, int wr, int wc, int fr, int fq, const Pre& p) const {
        const int row0 = u.pm * BM + wr * 64 + fr, col0 = u.pn * BM + wc * 32 + 8 * fq;
#pragma unroll
        EPI_LOOP_ROWS { const int row = row0 + ai * HALF + m * 16; const float sr = p.sr[ai][m]; bf16_t* rowp = O + (size_t)row * ldo + col0;
#pragma unroll
            for (int bj = 0; bj < 2; ++bj) *(u32x4*)(rowp + bj * HALF) = pack8(cvt_i4(acc[ai][bj][m][0], sr, p.w[bj][0]), cvt_i4(acc[ai][bj][m][1], sr, p.w[bj][1])); }
    }
};
struct EpiQKV1I8 {
    static constexpr bool PERM = true, HAS_PRE = true; typedef PreSc Pre; bf16_t* O; size_t tstride; const float* sa; const float* sw;
    __device__ __forceinline__ void prefetch(const Unit& u, int wr, int wc, int fr, int fq, Pre& p) const {
        const int row0 = u.pm * BM + wr * 64 + fr, pc0 = u.pn * BM + wc * 32 + 8 * fq;
#pragma unroll
        for (int bj = 0; bj < 2; ++bj)
#pragma unroll
            for (int n = 0; n < 2; ++n) p.w[bj][n] = *(const f32x4*)(sw + pc0 + bj * HALF + 4 * n);
#pragma unroll
        for (int ai = 0; ai < 2; ++ai)
#pragma unroll
            for (int m = 0; m < 4; ++m) p.sr[ai][m] = sa[row0 + ai * HALF + m * 16]; }
    __device__ __forceinline__ void operator()(const f32x4 (&acc)[2][2][4][2], const Unit& u, int wr, int wc, int fr, int fq, const Pre& p) const {
        const int which = u.pn / 3; const int row0 = u.pm * BM + wr * 64 + fr, col0 = (u.pn % 3) * BM + wc * 32 + 8 * fq; const int pj = u.pm % 9; const bool rope = (pj != 0) && which < 2;
        const int t0 = (pj - 1) * 256 + wr * 64 + fr; bf16_t* base = O + (size_t)which * tstride; const RopeF rf = rope_freqs(((col0 & 63) >> 3) * 4);
#pragma unroll
        EPI_LOOP_ROWS { const int row = row0 + ai * HALF + m * 16; const int t = t0 + ai * HALF + m * 16; const float sr = p.sr[ai][m]; bf16_t* rowp = base + (size_t)row * 768 + col0;
            f32x4 cs, sn; if (rope) rope_cs4(rf, t, cs, sn);
#pragma unroll
            for (int bj = 0; bj < 2; ++bj) { f32x4 v0 = cvt_i4(acc[ai][bj][m][0], sr, p.w[bj][0]), v1 = cvt_i4(acc[ai][bj][m][1], sr, p.w[bj][1]);
                if (rope) { const f32x4 o1 = v0 * cs - v1 * sn, o2 = v0 * sn + v1 * cs; v0 = o1; v1 = o2; }
                *(u32x4*)(rowp + bj * HALF) = pack8(v0, v1); } }
    }
};
struct EpiGTI8 {
    static constexpr bool PERM = true, HAS_PRE = true; typedef PreSc Pre; bf16_t* O; const float* swf; const float* sa;
    __device__ __forceinline__ void prefetch(const Unit& u, int wr, int wc, int fr, int fq, Pre& p) const {
        const int b = u.pn >> 3, tt = u.pn & 7, part = u.pm; const int c0 = wr * 64 + fr, t0 = tt * 256 + wc * 32 + 8 * fq; const float* sap = sa + (size_t)b * S + L + t0;
#pragma unroll
        for (int bj = 0; bj < 2; ++bj)
#pragma unroll
            for (int n = 0; n < 2; ++n) p.w[bj][n] = *(const f32x4*)(sap + bj * HALF + 4 * n);
#pragma unroll
        for (int ai = 0; ai < 2; ++ai)
#pragma unroll
            for (int m = 0; m < 4; ++m) p.sr[ai][m] = swf[part * 256 + c0 + ai * HALF + m * 16]; }
    __device__ __forceinline__ void operator()(const f32x4 (&acc)[2][2][4][2], const Unit& u, int wr, int wc, int fr, int fq, const Pre& p) const {
        const int b = u.pn >> 3, tt = u.pn & 7, part = u.pm; const int c0 = wr * 64 + fr, t0 = tt * 256 + wc * 32 + 8 * fq;
#pragma unroll
        EPI_LOOP_ROWS { const int c = c0 + ai * HALF + m * 16; const float sr = p.sr[ai][m]; bf16_t* rowp = O + ((size_t)(b * 256 + c) * 2 + part) * 2048 + t0;
#pragma unroll
            for (int bj = 0; bj < 2; ++bj) *(u32x4*)(rowp + bj * HALF) = pack8(cvt_i4(acc[ai][bj][m][0], sr, p.w[bj][0]), cvt_i4(acc[ai][bj][m][1], sr, p.w[bj][1])); }
    }
};
struct PreSw { f32x4 wg[2], wu[2]; float sr[2][4]; };
struct EpiSwigluI8 {
    static constexpr bool PERM = true, HAS_PRE = true; typedef PreSw Pre; void* O; int ldo; const float* sa; const float* sw; int sw_estride; float oscale; bool out8;
    __device__ __forceinline__ void prefetch(const Unit& u, int wr, int wc, int fr, int fq, Pre& p) const {
        const int row0 = u.pm * BM + wr * 64 + fr; const float* swp = sw + (size_t)u.e * sw_estride + u.pn * BM + wc * 32 + 8 * fq;
#pragma unroll
        for (int n = 0; n < 2; ++n) { p.wg[n] = *(const f32x4*)(swp + 4 * n); p.wu[n] = *(const f32x4*)(swp + HALF + 4 * n); }
#pragma unroll
        for (int ai = 0; ai < 2; ++ai)
#pragma unroll
            for (int m = 0; m < 4; ++m) p.sr[ai][m] = sa[row0 + ai * HALF + m * 16]; }
    __device__ __forceinline__ void operator()(const f32x4 (&acc)[2][2][4][2], const Unit& u, int wr, int wc, int fr, int fq, const Pre& p) const {
        const int row0 = u.pm * BM + wr * 64 + fr, col0 = u.pn * 128 + 8 * (4 * wc + fq);
#pragma unroll
        EPI_LOOP_ROWS { const int row = row0 + ai * HALF + m * 16; const float sr = p.sr[ai][m]; unsigned pk[4];
#pragma unroll
            for (int n = 0; n < 2; ++n) { const f32x4 g = cvt_i4(acc[ai][0][m][n], sr, p.wg[n]), up = cvt_i4(acc[ai][1][m][n], sr, p.wu[n]);
                const f32x2 a0 = swiglu2f((f32x2){g[0], g[1]}, (f32x2){up[0], up[1]}), a1 = swiglu2f((f32x2){g[2], g[3]}, (f32x2){up[2], up[3]});
                if (out8) { pk[n] = pack4_fp8(a0.x, a0.y, a1.x, a1.y); } else { pk[2 * n] = cvt_pk_bf16(a0.x, a0.y); pk[2 * n + 1] = cvt_pk_bf16(a1.x, a1.y); } }
            if (out8) *(u32x2*)((unsigned char*)O + (size_t)row * ldo + col0) = (u32x2){pk[0], pk[1]}; else *(u32x4*)((bf16_t*)O + (size_t)row * ldo + col0) = (u32x4){pk[0], pk[1], pk[2], pk[3]}; }
    }
};
constexpr float QSC_MLA = 0.07216878364870322f * 1.4426950408889634f, QSC_DIFF = 0.125f * 1.4426950408889634f;
struct EpiQ0 {
    static constexpr bool PERM = true; bf16_t* O; const float* rc; const float* rs;
    __device__ __forceinline__ void operator()(const f32x4 (&acc)[2][2][4][2], const Unit& u, int wr, int wc, int fr, int fq) const {
        const int row0 = u.pm * BM + wr * 64 + fr, col0 = u.pn * BM + wc * 32 + 8 * fq; const int pj = u.pm % 9; const bool lat = pj != 0; const int t0 = (pj - 1) * 256 + wr * 64 + fr;
#pragma unroll
        EPI_LOOP_ROWS { const int row = row0 + ai * HALF + m * 16; const int t = t0 + ai * HALF + m * 16; bf16_t* rowp = O + (size_t)row * 768 + col0;
#pragma unroll
            for (int bj = 0; bj < 2; ++bj) { const int cb = col0 + bj * HALF, within = cb % MLA_QK; f32x4 v0 = acc[ai][bj][m][0], v1 = acc[ai][bj][m][1];
                if (lat && within >= MLA_NOPE) { const RopeF rf = rope_freqs(((within - MLA_NOPE) >> 3) * 4); f32x4 cs, sn; rope_cs4(rf, t, cs, sn);
                    const f32x4 o1 = v0 * cs - v1 * sn, o2 = v0 * sn + v1 * cs; v0 = o1; v1 = o2; }
                *(u32x4*)(rowp + bj * HALF) = pack8(v0 * QSC_MLA, v1 * QSC_MLA); }
            asm volatile("" ::: "memory"); }
    }
};
struct EpiKV0 {
    static constexpr bool PERM = true; bf16_t* Kn; bf16_t* V;
    __device__ __forceinline__ void operator()(const f32x4 (&acc)[2][2][4][2], const Unit& u, int wr, int wc, int fr, int fq) const {
        const int row0 = u.pm * BM + wr * 64 + fr, col0 = u.pn * 128 + wc * 32 + 8 * fq;
#pragma unroll
        EPI_LOOP_ROWS { const size_t ro = (size_t)(row0 + ai * HALF + m * 16) * 512 + col0;
            *(u32x4*)(Kn + ro) = pack8(acc[ai][0][m][0], acc[ai][0][m][1]); *(u32x4*)(V + ro) = pack8(acc[ai][1][m][0], acc[ai][1][m][1]); }
    }
};
struct EpiQKV1 {
    static constexpr bool PERM = true; bf16_t* O; size_t tstride; const float* rc; const float* rs;
    __device__ __forceinline__ void operator()(const f32x4 (&acc)[2][2][4][2], const Unit& u, int wr, int wc, int fr, int fq) const {
        const int which = u.pn / 3; const int row0 = u.pm * BM + wr * 64 + fr, col0 = (u.pn % 3) * BM + wc * 32 + 8 * fq; const int pj = u.pm % 9; const bool rope = (pj != 0) && which < 2;
        const int t0 = (pj - 1) * 256 + wr * 64 + fr; bf16_t* base = O + (size_t)which * tstride;
#pragma unroll
        EPI_LOOP_ROWS { const int row = row0 + ai * HALF + m * 16; const int t = t0 + ai * HALF + m * 16; bf16_t* rowp = base + (size_t)row * 768 + col0;
#pragma unroll
            for (int bj = 0; bj < 2; ++bj) { const int cb = col0 + bj * HALF; f32x4 v0 = acc[ai][bj][m][0], v1 = acc[ai][bj][m][1];
                if (rope) { const int f0 = ((cb & 63) >> 3) * 4; const f32x4 cs = *(const f32x4*)(rc + t * 32 + f0), sn = *(const f32x4*)(rs + t * 32 + f0);
                    const f32x4 o1 = v0 * cs - v1 * sn, o2 = v0 * sn + v1 * cs; v0 = o1; v1 = o2; }
                *(u32x4*)(rowp + bj * HALF) = pack8(v0, v1); }
            asm volatile("" ::: "memory"); }
    }
};
struct EpiGT {
    static constexpr bool PERM = true; bf16_t* O;
    __device__ __forceinline__ void operator()(const f32x4 (&acc)[2][2][4][2], const Unit& u, int wr, int wc, int fr, int fq) const {
        const int b = u.pn >> 3, tt = u.pn & 7, part = u.pm; const int c0 = wr * 64 + fr, t0 = tt * 256 + wc * 32 + 8 * fq;
#pragma unroll
        EPI_LOOP_ROWS { const int c = c0 + ai * HALF + m * 16; bf16_t* rowp = O + ((size_t)(b * 256 + c) * 2 + part) * 2048 + t0;
#pragma unroll
            for (int bj = 0; bj < 2; ++bj) *(u32x4*)(rowp + bj * HALF) = pack8(acc[ai][bj][m][0], acc[ai][bj][m][1]); }
    }
};
}
namespace att {
constexpr int NW = 8, QBLK = 32, KVBLK = 64, DV = 128;
constexpr float THR = 8.f;
constexpr size_t SHM_V = KVBLK * DV * 2;
template <int DQK> struct Cf {
    static constexpr int ND = DQK / 16, KC = DQK / 64, CPR = DQK / 8;
    static constexpr size_t SHM_K = (size_t)KVBLK * DQK * 2;
    static constexpr float SCALE = DQK == 192 ? 0.07216878364870322f : 0.125f;
    static constexpr size_t LDS_BYTES = 2 * SHM_V + 2 * SHM_K + NW * 64 * 4;
};
#define SBAR() __builtin_amdgcn_sched_barrier(0)
__device__ __forceinline__ int crow(int r, int hi) { return (r & 3) + 8 * (r >> 2) + 4 * hi; }
template <int DQK> __device__ __forceinline__ int kswz(int row, int colB) { return row * (DQK * 2) + (colB ^ (((row >> 1) & 7) << 4)); }

constexpr float THR2 = THR * 1.4426950408889634f;
template <int DQK, int VAR = 0, bool FIRST = false>
__device__ __forceinline__ void partialSM(f32x16& p0, f32x16& p1, f32x16& mC, float& alpha) {
    if constexpr (VAR == 3 || VAR == 7 || VAR == 9) { alpha = 1.f; return; }
    float pmax = p0[0];
#pragma unroll
    for (int r = 1; r < 16; ++r) pmax = fmaxf(pmax, p0[r]);
#pragma unroll
    for (int r = 0; r < 16; ++r) pmax = fmaxf(pmax, p1[r]);
    { auto rr = __builtin_amdgcn_permlane32_swap(__float_as_uint(pmax), __float_as_uint(pmax), false, false);
      pmax = fmaxf(__uint_as_float(rr[0]), __uint_as_float(rr[1])); }
    if (!FIRST && __builtin_expect(__all(pmax <= THR2), 1)) alpha = 1.f;
    else { const float d = FIRST ? pmax : fmaxf(pmax, 0.f); alpha = FIRST ? 1.f : __builtin_amdgcn_exp2f(-d); const float nm = mC[0] - d;
#pragma unroll
        for (int r = 0; r < 16; ++r) { p0[r] -= d; p1[r] -= d; if constexpr (DQK == 64) mC[r] -= d; else mC[r] = nm; } }
#pragma unroll
    for (int r = 0; r < 16; ++r) p0[r] = VAR == 2 ? p0[r] : __builtin_amdgcn_exp2f(p0[r]);
}
template <int VAR = 0>
__device__ __forceinline__ void finishSM(f32x16& p0, f32x16& p1, float alpha, float& l_reg, bf16x8& pa0, bf16x8& pa1, bf16x8& pa2, bf16x8& pa3) {
    float ps = 0;
    if constexpr (VAR != 3 && VAR != 7 && VAR != 9) {
#pragma unroll
    for (int r = 0; r < 16; ++r) p1[r] = VAR == 2 ? p1[r] : __builtin_amdgcn_exp2f(p1[r]);
#pragma unroll
    for (int r = 0; r < 16; ++r) ps += p0[r];
#pragma unroll
    for (int r = 0; r < 16; ++r) ps += p1[r];
    }
    { auto rr = __builtin_amdgcn_permlane32_swap(__float_as_uint(ps), __float_as_uint(ps), false, false);
      ps = __uint_as_float(rr[0]) + __uint_as_float(rr[1]); }
    l_reg = l_reg * alpha + ps;
#define PK4(P, BASE, OUT) do { unsigned a0 = cvt_pk_bf16(P[BASE + 0], P[BASE + 1]), a1 = cvt_pk_bf16(P[BASE + 2], P[BASE + 3]);   \
    unsigned b0 = cvt_pk_bf16(P[BASE + 4], P[BASE + 5]), b1 = cvt_pk_bf16(P[BASE + 6], P[BASE + 7]);                              \
    auto r0 = __builtin_amdgcn_permlane32_swap(a0, b0, false, false); auto r1 = __builtin_amdgcn_permlane32_swap(a1, b1, false, false); \
    u32x4 w = {r0[0], r1[0], r0[1], r1[1]}; OUT = *reinterpret_cast<bf16x8*>(&w); } while (0)
    PK4(p0, 0, pa0); PK4(p0, 8, pa1); PK4(p1, 0, pa2); PK4(p1, 8, pa3);
#undef PK4
}
struct KFrag { bf16x8 b0[4], b1[4]; };
__device__ __forceinline__ void qkt_ld(KFrag& f, const char* Ks, int r32, int hi) {
#pragma unroll
    for (int d0 = 0; d0 < 4; ++d0) { const int cb = (d0 * 16 + hi * 8) * 2; f.b0[d0] = *reinterpret_cast<const bf16x8*>(Ks + kswz<64>(r32, cb)); f.b1[d0] = *reinterpret_cast<const bf16x8*>(Ks + kswz<64>(32 + r32, cb)); }
}
#define PK4H(P, BASE, OUT) do { unsigned a0 = cvt_pk_bf16(P[BASE + 0], P[BASE + 1]), a1 = cvt_pk_bf16(P[BASE + 2], P[BASE + 3]);   \
    unsigned b0 = cvt_pk_bf16(P[BASE + 4], P[BASE + 5]), b1 = cvt_pk_bf16(P[BASE + 6], P[BASE + 7]);                              \
    auto r0 = __builtin_amdgcn_permlane32_swap(a0, b0, false, false); auto r1 = __builtin_amdgcn_permlane32_swap(a1, b1, false, false); \
    u32x4 w = {r0[0], r1[0], r0[1], r1[1]}; OUT = *reinterpret_cast<bf16x8*>(&w); } while (0)
__device__ __forceinline__ f32x16 mfma_c(bf16x8 a, bf16x8 b, const f32x16& c) { f32x16 d; asm volatile("v_mfma_f32_32x32x16_bf16 %0, %1, %2, %3" : "=&v"(d) : "v"(a), "v"(b), "v"(c)); return d; }
__device__ __forceinline__ void qkt_mf(f32x16& p0, f32x16& p1, const KFrag& f, const bf16x8* qr, const f32x16& mC) {
    p0 = mfma_c(f.b0[0], qr[0], mC); p1 = mfma_c(f.b1[0], qr[0], mC);
#pragma unroll
    for (int d0 = 1; d0 < 4; ++d0) { p0 = __builtin_amdgcn_mfma_f32_32x32x16_bf16(f.b0[d0], qr[d0], p0, 0, 0, 0); p1 = __builtin_amdgcn_mfma_f32_32x32x16_bf16(f.b1[d0], qr[d0], p1, 0, 0, 0); }
}
template <int DQK, int NQR, int VAR = 0>
__device__ __forceinline__ void qkt(f32x16& p0, f32x16& p1, const char* Ks, const bf16x8* qr, const char* ql, int r32, int hi, const f32x16& mC) {
    if constexpr (VAR == 5) { p0 = mC; p1 = mC; return; }
#pragma unroll
    for (int d0 = 0; d0 < Cf<DQK>::ND; ++d0) { const int cb = (d0 * 16 + hi * 8) * 2;
        bf16x8 b0, b1;
        if constexpr (VAR == 7 || VAR == 9) { b0 = qr[d0]; b1 = qr[(d0 + 1) % Cf<DQK>::ND]; asm volatile("" : "+v"(b0), "+v"(b1)); }
        else { b0 = *reinterpret_cast<const bf16x8*>(Ks + kswz<DQK>(r32, cb)); b1 = *reinterpret_cast<const bf16x8*>(Ks + kswz<DQK>(32 + r32, cb)); }
        bf16x8 qf; if (d0 < NQR) qf = qr[d0]; else qf = *reinterpret_cast<const bf16x8*>(ql + (d0 - NQR) * 1024);
        if constexpr (VAR == 4) { if (d0 == 0) { p0 = mC; p1 = mC; } p0[d0] += __builtin_bit_cast(float, (int)b0[0] + (int)qf[0]); p1[d0] += __builtin_bit_cast(float, (int)b1[0]); }
        else if (d0 == 0 && DQK == 64) { p0 = mfma_c(b0, qf, mC); p1 = mfma_c(b1, qf, mC); }
        else if (d0 == 0) { p0 = __builtin_amdgcn_mfma_f32_32x32x16_bf16(b0, qf, mC, 0, 0, 0); p1 = __builtin_amdgcn_mfma_f32_32x32x16_bf16(b1, qf, mC, 0, 0, 0); }
        else { p0 = __builtin_amdgcn_mfma_f32_32x32x16_bf16(b0, qf, p0, 0, 0, 0);
        p1 = __builtin_amdgcn_mfma_f32_32x32x16_bf16(b1, qf, p1, 0, 0, 0); } }
}
__device__ __forceinline__ int v_st(int k, int c) { const int kk = (k & ~0xC) | ((k & 4) << 1) | ((k & 8) >> 1); return ((kk >> 3) * 4 + (c >> 5)) * 512 + ((kk & 7) * 32 + (c & 31)) * 2; }
__device__ __forceinline__ int v_rd_base(int lane) { return ((lane & 3) << 3) | (((lane >> 2) & 3) << 6) | (((lane >> 4) & 1) << 5) | (((lane >> 5) & 1) << 8); }
constexpr int v_rd_off(int d0, int ks, int half) { return d0 * 512 + ks * 4096 + half * 2048; }
template <int OFF> __device__ __forceinline__ s16x4 tr_read(int vb) {
    s16x4 r; asm volatile("ds_read_b64_tr_b16 %0, %1 offset:%2" : "=&v"(r) : "v"(vb), "i"(OFF) : "memory"); return r;
}
struct VFrag { s16x4 l0, h0, l1, h1, l2, h2, l3, h3; };
template <int D0> __device__ __forceinline__ void pv_rd(VFrag& f, int vb) {
    f.l0 = tr_read<v_rd_off(D0, 0, 0)>(vb); f.h0 = tr_read<v_rd_off(D0, 0, 1)>(vb); f.l1 = tr_read<v_rd_off(D0, 1, 0)>(vb); f.h1 = tr_read<v_rd_off(D0, 1, 1)>(vb);
    f.l2 = tr_read<v_rd_off(D0, 2, 0)>(vb); f.h2 = tr_read<v_rd_off(D0, 2, 1)>(vb); f.l3 = tr_read<v_rd_off(D0, 3, 0)>(vb); f.h3 = tr_read<v_rd_off(D0, 3, 1)>(vb);
}
template <int VAR = 0>
__device__ __forceinline__ void pv_mf(f32x16& od, const VFrag& f, bf16x8 pa0, bf16x8 pa1, bf16x8 pa2, bf16x8 pa3) {
    if constexpr (VAR == 4) { od[0] += __builtin_bit_cast(float, (int)f.l0[0] + (int)f.h3[0] + (int)pa0[0] + (int)pa3[0]); return; }
#define PK(L_, H_) (bf16x8){L_[0], L_[1], L_[2], L_[3], H_[0], H_[1], H_[2], H_[3]}
    od = __builtin_amdgcn_mfma_f32_32x32x16_bf16(pa0, PK(f.l0, f.h0), od, 0, 0, 0);
    od = __builtin_amdgcn_mfma_f32_32x32x16_bf16(pa1, PK(f.l1, f.h1), od, 0, 0, 0);
    od = __builtin_amdgcn_mfma_f32_32x32x16_bf16(pa2, PK(f.l2, f.h2), od, 0, 0, 0);
    od = __builtin_amdgcn_mfma_f32_32x32x16_bf16(pa3, PK(f.l3, f.h3), od, 0, 0, 0);
#undef PK
}
#ifndef ATT_SG
#define ATT_SG 0
#endif
#ifndef ATT_NOALT
#define ATT_NOALT 1
#endif
__device__ __forceinline__ s16x4 tr_ld(int addr) { return __builtin_amdgcn_ds_read_tr16_b64_v4i16((__attribute__((address_space(3))) s16x4*)(unsigned)addr); }
__device__ __forceinline__ void pv_sg(f32x16* o, int vb, bf16x8 pa0, bf16x8 pa1, bf16x8 pa2, bf16x8 pa3) {
#define PKS(L_, H_) (bf16x8){L_[0], L_[1], L_[2], L_[3], H_[0], H_[1], H_[2], H_[3]}
#pragma unroll
    for (int d0 = 0; d0 < 4; ++d0) {
        const s16x4 l0 = tr_ld(vb + v_rd_off(d0, 0, 0)), h0 = tr_ld(vb + v_rd_off(d0, 0, 1)), l1 = tr_ld(vb + v_rd_off(d0, 1, 0)), h1 = tr_ld(vb + v_rd_off(d0, 1, 1));
        const s16x4 l2 = tr_ld(vb + v_rd_off(d0, 2, 0)), h2 = tr_ld(vb + v_rd_off(d0, 2, 1)), l3 = tr_ld(vb + v_rd_off(d0, 3, 0)), h3 = tr_ld(vb + v_rd_off(d0, 3, 1));
        o[d0] = __builtin_amdgcn_mfma_f32_32x32x16_bf16(pa0, PKS(l0, h0), o[d0], 0, 0, 0);
        o[d0] = __builtin_amdgcn_mfma_f32_32x32x16_bf16(pa1, PKS(l1, h1), o[d0], 0, 0, 0);
        o[d0] = __builtin_amdgcn_mfma_f32_32x32x16_bf16(pa2, PKS(l2, h2), o[d0], 0, 0, 0);
        o[d0] = __builtin_amdgcn_mfma_f32_32x32x16_bf16(pa3, PKS(l3, h3), o[d0], 0, 0, 0); }
#undef PKS
}
#define SG_QK_SM() do { __builtin_amdgcn_sched_group_barrier(0x100, 8, 0); _Pragma("unroll") for (int i_ = 0; i_ < 8; ++i_) { __builtin_amdgcn_sched_group_barrier(0x008, 1, 0); __builtin_amdgcn_sched_group_barrier(0x002, 10, 0); } } while (0)
#define SG_PV_SM() do { __builtin_amdgcn_sched_group_barrier(0x100, 8, 0); _Pragma("unroll") for (int i_ = 0; i_ < 16; ++i_) { __builtin_amdgcn_sched_group_barrier(0x008, 1, 0); __builtin_amdgcn_sched_group_barrier(0x002, 5, 0); if (i_ < 12) __builtin_amdgcn_sched_group_barrier(0x100, 2, 0); } } while (0)
template <int VAR = 0>
__device__ __forceinline__ void pv_d0(f32x16* o, int vb, bf16x8 pa0, bf16x8 pa1, bf16x8 pa2, bf16x8 pa3) {
    if constexpr (VAR == 5) { o[0][0] += __builtin_bit_cast(float, (int)pa0[0] + (int)pa1[0] + (int)pa2[0] + (int)pa3[0]); return; }
    if constexpr (VAR == 7 || VAR == 9) { bf16x8 x = pa0; asm volatile("" : "+v"(x));
#pragma unroll
        for (int d = 0; d < 4; ++d) { o[d] = __builtin_amdgcn_mfma_f32_32x32x16_bf16(pa0, x, o[d], 0, 0, 0); o[d] = __builtin_amdgcn_mfma_f32_32x32x16_bf16(pa1, x, o[d], 0, 0, 0); o[d] = __builtin_amdgcn_mfma_f32_32x32x16_bf16(pa2, x, o[d], 0, 0, 0); o[d] = __builtin_amdgcn_mfma_f32_32x32x16_bf16(pa3, x, o[d], 0, 0, 0); }
        return; }
    VFrag A, B;
    pv_rd<0>(A, vb); pv_rd<1>(B, vb);
    asm volatile("s_waitcnt lgkmcnt(8)" ::: "memory"); SBAR(); pv_mf<VAR>(o[0], A, pa0, pa1, pa2, pa3); SBAR();
    pv_rd<2>(A, vb);
    asm volatile("s_waitcnt lgkmcnt(8)" ::: "memory"); SBAR(); pv_mf<VAR>(o[1], B, pa0, pa1, pa2, pa3); SBAR();
    pv_rd<3>(B, vb);
    asm volatile("s_waitcnt lgkmcnt(8)" ::: "memory"); SBAR(); pv_mf<VAR>(o[2], A, pa0, pa1, pa2, pa3); SBAR();
    asm volatile("s_waitcnt lgkmcnt(0)" ::: "memory"); SBAR(); pv_mf<VAR>(o[3], B, pa0, pa1, pa2, pa3);
}

template <int DQK>
__device__ __forceinline__ void pv_partial(f32x16* o, int vb, bf16x8 pa0, bf16x8 pa1, bf16x8 pa2, bf16x8 pa3, f32x16& p0, f32x16& p1, f32x16& mC, float& alpha, float& ps0) {
    VFrag A, B;
    pv_rd<0>(A, vb); pv_rd<1>(B, vb);
    asm volatile("s_waitcnt lgkmcnt(8)" ::: "memory"); SBAR(); pv_mf<0>(o[0], A, pa0, pa1, pa2, pa3);
    float pmax = p0[0];
#pragma unroll
    for (int r = 1; r < 16; ++r) pmax = fmaxf(pmax, p0[r]);
#pragma unroll
    for (int r = 0; r < 16; ++r) pmax = fmaxf(pmax, p1[r]);
    { auto rr = __builtin_amdgcn_permlane32_swap(__float_as_uint(pmax), __float_as_uint(pmax), false, false);
      pmax = fmaxf(__uint_as_float(rr[0]), __uint_as_float(rr[1])); }
    asm volatile("" : "+v"(pmax));
    SBAR();
    pv_rd<2>(A, vb);
    if (__builtin_expect(__all(pmax <= THR2), 1)) alpha = 1.f;
    else { const float d = fmaxf(pmax, 0.f); alpha = __builtin_amdgcn_exp2f(-d);
#pragma unroll
        for (int r = 0; r < 16; ++r) { p0[r] -= d; p1[r] -= d; mC[r] -= d; } }
#define EXPP(x_) do { float e_ = __builtin_amdgcn_exp2f(x_); asm volatile("" : "+v"(e_)); x_ = e_; } while (0)
    asm volatile("s_waitcnt lgkmcnt(8)" ::: "memory"); SBAR(); pv_mf<0>(o[1], B, pa0, pa1, pa2, pa3);
#pragma unroll
    for (int r = 0; r < 11; ++r) EXPP(p0[r]);
    SBAR();
    pv_rd<3>(B, vb);
    asm volatile("s_waitcnt lgkmcnt(8)" ::: "memory"); SBAR(); pv_mf<0>(o[2], A, pa0, pa1, pa2, pa3);
#pragma unroll
    for (int r = 11; r < 16; ++r) EXPP(p0[r]);
#pragma unroll
    for (int r = 0; r < 6; ++r) EXPP(p1[r]);
    SBAR();
    asm volatile("s_waitcnt lgkmcnt(0)" ::: "memory"); SBAR(); pv_mf<0>(o[3], B, pa0, pa1, pa2, pa3);
#pragma unroll
    for (int r = 6; r < 16; ++r) EXPP(p1[r]);
    float ps = 0.f;
#pragma unroll
    for (int r = 0; r < 16; ++r) ps += p0[r];
    asm volatile("" : "+v"(ps)); ps0 = ps;
    SBAR();
#undef EXPP
}
__device__ __forceinline__ void finishSM2(f32x16& p0, f32x16& p1, float ps0, float alpha, float& l_reg, bf16x8& pa0, bf16x8& pa1, bf16x8& pa2, bf16x8& pa3) {
    float ps = ps0;
#pragma unroll
    for (int r = 0; r < 16; ++r) ps += p1[r];
    { auto rr = __builtin_amdgcn_permlane32_swap(__float_as_uint(ps), __float_as_uint(ps), false, false);
      ps = __uint_as_float(rr[0]) + __uint_as_float(rr[1]); }
    l_reg = l_reg * alpha + ps;
    PK4H(p0, 0, pa0); PK4H(p0, 8, pa1); PK4H(p1, 0, pa2); PK4H(p1, 8, pa3);
}

struct KSrc { const bf16_t* ka; int lda; const bf16_t* kb; int ldb; };
struct AOut {
    bf16_t* O; int ldo; float* stash; const float* subg; float lam; int sub;
};
template <int DQK, int SDEPTH, int MODE, int VAR, bool ALT>
__device__ __forceinline__ void attn_body_impl(const bf16_t* __restrict__ Qb, int ldq, const KSrc ks, const bf16_t* __restrict__ Vh, int ldv, int seq, char* lds, const AOut ao) {
    using C = Cf<DQK>; constexpr int ND = C::ND, KC = C::KC, CPR = C::CPR, CA = DQK == 192 ? 16 : CPR; constexpr size_t SHM_K = C::SHM_K;
    int tid_ = threadIdx.x; asm volatile("" : "+v"(tid_));
    const int tid = tid_, wid = tid >> 6, lane = tid & 63, r32 = lane & 31, hi = lane >> 5;
    char* V_lds = lds; char* K_lds = lds + 2 * SHM_V;
    float* ws = (float*)(lds + 2 * SHM_V + 2 * SHM_K) + wid * 64; float* li_l = ws; float* al_l = ws + 32;
    constexpr int NQR = ND;
    char* ql = lds + 2 * SHM_V + 2 * SHM_K + NW * 64 * 4 + wid * 4096 + lane * 16;
    float l_reg = 0; f32x16 o[4] = {}, mC = {}; bf16x8 qr[NQR];
    const bf16_t* Qw = Qb + (long)(wid * QBLK + r32) * ldq + hi * 8;
#pragma unroll
    for (int d0 = 0; d0 < ND; ++d0) { const bf16x8 qv = *reinterpret_cast<const bf16x8*>(Qw + d0 * 16); if (d0 < NQR) qr[d0] = qv; else *reinterpret_cast<bf16x8*>(ql + (d0 - NQR) * 1024) = qv; }
    const int sr = tid >> 4, sc = (tid & 15) * 8, vst0 = v_st(sr, sc), vst1 = v_st(32 + sr, sc);
    const int vb0 = (int)(uintptr_t)V_lds + v_rd_base(lane);
    const bf16_t* kptr[KC]; int kstride[KC]; int klds[KC];
#pragma unroll
    for (int i = 0; i < KC; ++i) { const int q = tid + 512 * i, row = q / CPR, c8 = q % CPR; klds[i] = kswz<DQK>(row, c8 * 16);
        if (c8 < CA) { kptr[i] = ks.ka + (long)row * ks.lda + c8 * 8; kstride[i] = ks.lda; } else { kptr[i] = ks.kb + (long)row * ks.ldb + (c8 - CA) * 8; kstride[i] = ks.ldb; } }
    struct Slot { bf16x8 vs0, vs1; bf16x8 kk[KC]; } sl[SDEPTH];
#define SLOAD(i_, k0_) do { if constexpr (VAR == 1 || VAR == 9) break; sl[i_].vs0 = *reinterpret_cast<const bf16x8*>(&Vh[(long)((k0_) + sr) * ldv + sc]); sl[i_].vs1 = *reinterpret_cast<const bf16x8*>(&Vh[(long)((k0_) + 32 + sr) * ldv + sc]); \
    _Pragma("unroll") for (int c_ = 0; c_ < KC; ++c_) sl[i_].kk[c_] = *reinterpret_cast<const bf16x8*>(kptr[c_] + (long)(k0_) * kstride[c_]); } while (0)
#define SWRITE(b_, i_) do { if constexpr (VAR == 1 || VAR == 9) break; *(bf16x8*)(V_lds + (b_) * SHM_V + vst0) = sl[i_].vs0; *(bf16x8*)(V_lds + (b_) * SHM_V + vst1) = sl[i_].vs1; \
    _Pragma("unroll") for (int c_ = 0; c_ < KC; ++c_) *(bf16x8*)(K_lds + (b_) * SHM_K + klds[c_]) = sl[i_].kk[c_]; } while (0)
#define SWAIT() do { if constexpr (SDEPTH == 2) { if constexpr (KC == 3) asm volatile("s_waitcnt vmcnt(5)" ::: "memory"); else asm volatile("s_waitcnt vmcnt(3)" ::: "memory"); } \
    else asm volatile("s_waitcnt vmcnt(0)" ::: "memory"); } while (0)
#define RESC(a_) do { if (__any((a_) < 1.f)) { if (hi == 0) al_l[r32] = (a_); asm volatile("s_waitcnt lgkmcnt(0)" ::: "memory"); \
    _Pragma("unroll") for (int d_ = 0; d_ < 4; ++d_) _Pragma("unroll") for (int r_ = 0; r_ < 16; ++r_) o[d_][r_] *= al_l[crow(r_, hi)]; } } while (0)
    f32x16 pA0, pA1, pB0, pB1; float alA, alB; bf16x8 pa0, pa1, pa2, pa3; const int NT = seq / KVBLK;
    constexpr int SE = 0, SO = SDEPTH - 1;
    SLOAD(SE, 0); asm volatile("s_waitcnt vmcnt(0)" ::: "memory"); SWRITE(0, SE); __syncthreads();
    qkt<DQK, NQR, VAR>(pA0, pA1, K_lds, qr, ql, r32, hi, mC); partialSM<DQK, VAR, true>(pA0, pA1, mC, alA);
    SLOAD(SO, KVBLK); if constexpr (SDEPTH == 2) { if (2 < NT) SLOAD(SE, 2 * KVBLK); }
    SWAIT(); SWRITE(1, SO); __syncthreads();
    constexpr bool alt = ALT;
#if ATT_SG
    (void)alt;
    for (int j = 1; j + 1 < NT; j += 2) {
        SBAR(); qkt<DQK, NQR, VAR>(pB0, pB1, K_lds + SHM_K, qr, ql, r32, hi, mC); finishSM<VAR>(pA0, pA1, alA, l_reg, pa0, pa1, pa2, pa3); SG_QK_SM(); SBAR();
        SLOAD(SO, (j + SDEPTH) * KVBLK); SBAR();
        pv_sg(o, vb0, pa0, pa1, pa2, pa3); partialSM<DQK, VAR>(pB0, pB1, mC, alB); SG_PV_SM(); SBAR();
        __syncthreads(); SWAIT(); SWRITE(0, SE);
        RESC(alB); __syncthreads();
        SBAR(); qkt<DQK, NQR, VAR>(pA0, pA1, K_lds, qr, ql, r32, hi, mC); finishSM<VAR>(pB0, pB1, alB, l_reg, pa0, pa1, pa2, pa3); SG_QK_SM(); SBAR();
        if (SDEPTH == 1 || j + 3 < NT) SLOAD(SE, (j + 1 + SDEPTH) * KVBLK); SBAR();
        pv_sg(o, vb0 + (int)SHM_V, pa0, pa1, pa2, pa3); partialSM<DQK, VAR>(pA0, pA1, mC, alA); SG_PV_SM(); SBAR();
        __syncthreads(); SWAIT(); SWRITE(1, SO);
        RESC(alA); __syncthreads();
    }
#else
    for (int j = 1; j + 1 < NT; j += 2) {
        if constexpr (!alt) {
            SBAR(); qkt<DQK, NQR, VAR>(pB0, pB1, K_lds + SHM_K, qr, ql, r32, hi, mC);
            finishSM<VAR>(pA0, pA1, alA, l_reg, pa0, pa1, pa2, pa3); SBAR();
            SLOAD(SO, (j + SDEPTH) * KVBLK); SBAR();
            pv_d0<VAR>(o, vb0, pa0, pa1, pa2, pa3); partialSM<DQK, VAR>(pB0, pB1, mC, alB);
        } else {
            SBAR(); finishSM<VAR>(pA0, pA1, alA, l_reg, pa0, pa1, pa2, pa3); SBAR();
            qkt<DQK, NQR, VAR>(pB0, pB1, K_lds + SHM_K, qr, ql, r32, hi, mC); SBAR();
            SLOAD(SO, (j + SDEPTH) * KVBLK); SBAR();
            partialSM<DQK, VAR>(pB0, pB1, mC, alB); SBAR(); pv_d0<VAR>(o, vb0, pa0, pa1, pa2, pa3);
        }
        if constexpr (VAR != 6 && VAR != 9) __syncthreads(); SWAIT(); SWRITE(0, SE);
        RESC(alB); if constexpr (VAR != 6 && VAR != 9) __syncthreads();
        if constexpr (!alt) {
            SBAR(); qkt<DQK, NQR, VAR>(pA0, pA1, K_lds, qr, ql, r32, hi, mC);
            finishSM<VAR>(pB0, pB1, alB, l_reg, pa0, pa1, pa2, pa3); SBAR();
            if (SDEPTH == 1 || j + 3 < NT) SLOAD(SE, (j + 1 + SDEPTH) * KVBLK); SBAR();
            pv_d0<VAR>(o, vb0 + (int)SHM_V, pa0, pa1, pa2, pa3); partialSM<DQK, VAR>(pA0, pA1, mC, alA);
        } else {
            SBAR(); finishSM<VAR>(pB0, pB1, alB, l_reg, pa0, pa1, pa2, pa3); SBAR();
            qkt<DQK, NQR, VAR>(pA0, pA1, K_lds, qr, ql, r32, hi, mC); SBAR();
            if (SDEPTH == 1 || j + 3 < NT) SLOAD(SE, (j + 1 + SDEPTH) * KVBLK); SBAR();
            partialSM<DQK, VAR>(pA0, pA1, mC, alA); SBAR(); pv_d0<VAR>(o, vb0 + (int)SHM_V, pa0, pa1, pa2, pa3);
        }
        if constexpr (VAR != 6 && VAR != 9) __syncthreads(); SWAIT(); SWRITE(1, SO);
        RESC(alA); if constexpr (VAR != 6 && VAR != 9) __syncthreads();
    }
#endif
    SBAR(); qkt<DQK, NQR, VAR>(pB0, pB1, K_lds + SHM_K, qr, ql, r32, hi, mC);
    finishSM<VAR>(pA0, pA1, alA, l_reg, pa0, pa1, pa2, pa3); SBAR();
    pv_d0<VAR>(o, vb0, pa0, pa1, pa2, pa3); partialSM<DQK, VAR>(pB0, pB1, mC, alB);
    __syncthreads(); RESC(alB);
    finishSM<VAR>(pB0, pB1, alB, l_reg, pa0, pa1, pa2, pa3); SBAR();
    pv_d0<VAR>(o, vb0 + (int)SHM_V, pa0, pa1, pa2, pa3);
    if (hi == 0) li_l[r32] = l_reg; asm volatile("s_waitcnt lgkmcnt(0)" ::: "memory");
    float rli[16];
#pragma unroll
    for (int r = 0; r < 16; ++r) rli[r] = __builtin_amdgcn_rcpf(li_l[crow(r, hi)]);
    if constexpr (MODE == 0) {
        bf16_t* Ow = ao.O + (long)(wid * QBLK) * ao.ldo;
#pragma unroll
        for (int r = 0; r < 16; ++r) { const int orow = crow(r, hi);
#pragma unroll
            for (int d0 = 0; d0 < 4; ++d0) Ow[(long)orow * ao.ldo + d0 * 32 + r32] = f2bf(o[d0][r] * rli[r]); }
    } else {
        float* st = ao.stash + (wid * 64) * 64 + lane;
        if (ao.sub == 0) {
#pragma unroll
            for (int r = 0; r < 16; ++r)
#pragma unroll
                for (int d0 = 0; d0 < 4; ++d0) st[(r * 4 + d0) * 64] = o[d0][r] * rli[r];
        } else {
            const float lam = ao.lam; float sg[4];
#pragma unroll
            for (int d0 = 0; d0 < 4; ++d0) sg[d0] = ao.subg[d0 * 32 + r32] * (1.f - LAM_INIT);
            bf16_t* Ow = ao.O + (long)(wid * QBLK) * ao.ldo;
#pragma unroll
            for (int r = 0; r < 16; ++r) { float ss = 0.f;
#pragma unroll
                for (int d0 = 0; d0 < 4; ++d0) { const float v = st[(r * 4 + d0) * 64] - lam * (o[d0][r] * rli[r]); o[d0][r] = v; ss += v * v; }
                ss += __shfl_xor(ss, 1); ss += __shfl_xor(ss, 2); ss += __shfl_xor(ss, 4); ss += __shfl_xor(ss, 8); ss += __shfl_xor(ss, 16);
                const float rn = 1.0f / sqrtf(ss * (1.f / 128.f) + EPS); const int orow = crow(r, hi);
#pragma unroll
                for (int d0 = 0; d0 < 4; ++d0) Ow[(long)orow * ao.ldo + d0 * 32 + r32] = f2bf(o[d0][r] * rn * sg[d0]); }
        }
    }
    asm volatile("s_waitcnt vmcnt(0) lgkmcnt(0)" ::: "memory");
    __syncthreads();
#undef SLOAD
#undef SWRITE
#undef SWAIT
#undef RESC
}
template <int DQK, int SDEPTH, int MODE, int VAR = 0>
__device__ __forceinline__ void attn_body(const bf16_t* __restrict__ Qb, int ldq, const KSrc ks, const bf16_t* __restrict__ Vh, int ldv, int seq, char* lds, const AOut ao) {
    if (__builtin_amdgcn_readfirstlane((int)threadIdx.x >> 8) == 0) attn_body_impl<DQK, SDEPTH, MODE, VAR, false>(Qb, ldq, ks, Vh, ldv, seq, lds, ao);
    else attn_body_impl<DQK, SDEPTH, MODE, VAR, true>(Qb, ldq, ks, Vh, ldv, seq, lds, ao);
}
template <int MODE, bool ALT>
__device__ __forceinline__ void attn_dma_impl(const bf16_t* __restrict__ Qb, int ldq, const bf16_t* __restrict__ Kh, int ldk, const bf16_t* __restrict__ Vh, int ldv, int seq, char* lds, const AOut ao) {
    constexpr int DQK = 64, ND = 4, SV = 16384, SK = 8192, KOFF = 3 * SV, WSOFF = 3 * SV + 3 * SK;
    int tid_ = threadIdx.x; asm volatile("" : "+v"(tid_));
    const int tid = tid_, wid = tid >> 6, lane = tid & 63, r32 = lane & 31, hi = lane >> 5;
    const unsigned widu = (unsigned)__builtin_amdgcn_readfirstlane(wid), ldsb = (unsigned)(uintptr_t)lds;
    float* ws = (float*)(lds + WSOFF) + wid * 64; float* li_l = ws; float* al_l = ws + 32;
    float l_reg = 0; f32x16 o[4] = {}, mC = {}; bf16x8 qr[ND];
    const bf16_t* Qw = Qb + (long)(wid * QBLK + r32) * ldq + hi * 8;
#pragma unroll
    for (int d0 = 0; d0 < ND; ++d0) qr[d0] = *reinterpret_cast<const bf16x8*>(Qw + d0 * 16);
    const int vb0 = (int)ldsb + v_rd_base(lane);
    const int pk = wid * 64 + lane, krow = pk >> 3, kc8 = (pk & 7) ^ ((krow >> 1) & 7);
    const unsigned koff = (unsigned)(krow * ldk + kc8 * 8) * 2u; unsigned voff[2];
#pragma unroll
    for (int i = 0; i < 2; ++i) { const int pv = (wid + 8 * i) * 64 + lane, kk = ((pv >> 7) << 3) | ((pv >> 2) & 7), k = (kk & ~0xC) | ((kk & 4) << 1) | ((kk & 8) >> 1), cc = (((pv >> 5) & 3) << 5) | ((pv & 3) << 3);
        voff[i] = (unsigned)(k * ldv + cc) * 2u; }
    const size_t kstep = (size_t)64 * ldk * 2, vstep = (size_t)64 * ldv * 2;
#define DMA_K(t_) do { const char* g_ = (const char*)Kh + (size_t)(t_) * kstep; asm volatile("" : "+s"(g_)); \
    __builtin_amdgcn_global_load_lds((const unsigned*)(g_ + koff), (LAS unsigned*)(ldsb + KOFF + ((t_) % 3) * SK + widu * 1024u), 16, 0, 0); } while (0)
#define DMA_V(t_) do { const char* g_ = (const char*)Vh + (size_t)(t_) * vstep; asm volatile("" : "+s"(g_)); \
    __builtin_amdgcn_global_load_lds((const unsigned*)(g_ + voff[0]), (LAS unsigned*)(ldsb + ((t_) % 3) * SV + widu * 1024u), 16, 0, 0); \
    __builtin_amdgcn_global_load_lds((const unsigned*)(g_ + voff[1]), (LAS unsigned*)(ldsb + ((t_) % 3) * SV + (widu + 8u) * 1024u), 16, 0, 0); } while (0)
#define SYNC(n_) do { asm volatile("s_waitcnt vmcnt(" #n_ ") lgkmcnt(0)" ::: "memory"); __builtin_amdgcn_s_barrier(); asm volatile("" ::: "memory"); } while (0)
#define KS(t_) (lds + KOFF + ((t_) % 3) * SK)
#define VS(t_) (vb0 + ((t_) % 3) * SV)
#define RESC(a_) do { if (__any((a_) < 1.f)) { if (hi == 0) al_l[r32] = (a_); asm volatile("s_waitcnt lgkmcnt(0)" ::: "memory"); \
    _Pragma("unroll") for (int d_ = 0; d_ < 4; ++d_) _Pragma("unroll") for (int r_ = 0; r_ < 16; ++r_) o[d_][r_] *= al_l[crow(r_, hi)]; } } while (0)
    f32x16 pA0, pA1, pB0, pB1; float alA, alB, psA = 0.f, psB = 0.f; bf16x8 pa0, pa1, pa2, pa3; const int NT = seq / KVBLK; KFrag kf;
    DMA_K(0); DMA_V(0); DMA_K(1);
    SYNC(3);
    DMA_K(2); DMA_V(1);
    qkt<DQK, ND, 0>(pA0, pA1, KS(0), qr, nullptr, r32, hi, mC); partialSM<DQK, 0, true>(pA0, pA1, mC, alA);
    if constexpr (!ALT) {
#pragma unroll
        for (int r = 0; r < 16; ++r) { pA1[r] = __builtin_amdgcn_exp2f(pA1[r]); psA += pA0[r]; } }
    SYNC(3);
    constexpr bool alt = ALT;
#pragma unroll 1
    for (int j = 1; j + 1 < NT; j += 2) {
        DMA_K(j + 2); DMA_V(j + 1);
        if constexpr (!alt) {
            qkt_ld(kf, KS(j), r32, hi); SBAR(); qkt_mf(pB0, pB1, kf, qr, mC);
            finishSM2(pA0, pA1, psA, alA, l_reg, pa0, pa1, pa2, pa3); SBAR();
            pv_partial<DQK>(o, VS(j - 1), pa0, pa1, pa2, pa3, pB0, pB1, mC, alB, psB);
        } else {
            qkt_ld(kf, KS(j), r32, hi); SBAR(); finishSM<0>(pA0, pA1, alA, l_reg, pa0, pa1, pa2, pa3); SBAR();
            qkt_mf(pB0, pB1, kf, qr, mC); SBAR();
            partialSM<DQK, 0>(pB0, pB1, mC, alB); SBAR(); pv_d0<0>(o, VS(j - 1), pa0, pa1, pa2, pa3);
        }
        RESC(alB); SYNC(3);
        const bool more = j + 3 < NT;
        if (more) DMA_K(j + 3);
        DMA_V(j + 2);
        if constexpr (!alt) {
            qkt_ld(kf, KS(j + 1), r32, hi); SBAR(); qkt_mf(pA0, pA1, kf, qr, mC);
            finishSM2(pB0, pB1, psB, alB, l_reg, pa0, pa1, pa2, pa3); SBAR();
            pv_partial<DQK>(o, VS(j), pa0, pa1, pa2, pa3, pA0, pA1, mC, alA, psA);
        } else {
            qkt_ld(kf, KS(j + 1), r32, hi); SBAR(); finishSM<0>(pB0, pB1, alB, l_reg, pa0, pa1, pa2, pa3); SBAR();
            qkt_mf(pA0, pA1, kf, qr, mC); SBAR();
            partialSM<DQK, 0>(pA0, pA1, mC, alA); SBAR(); pv_d0<0>(o, VS(j), pa0, pa1, pa2, pa3);
        }
        RESC(alA); if (more) SYNC(3); else SYNC(0);
    }
    SBAR(); qkt<DQK, ND, 0>(pB0, pB1, KS(NT - 1), qr, nullptr, r32, hi, mC);
    finishSM2(pA0, pA1, psA, alA, l_reg, pa0, pa1, pa2, pa3); SBAR();
    pv_partial<DQK>(o, VS(NT - 2), pa0, pa1, pa2, pa3, pB0, pB1, mC, alB, psB);
    RESC(alB);
    finishSM2(pB0, pB1, psB, alB, l_reg, pa0, pa1, pa2, pa3); SBAR();
    pv_d0<0>(o, VS(NT - 1), pa0, pa1, pa2, pa3);
    if (hi == 0) li_l[r32] = l_reg; asm volatile("s_waitcnt lgkmcnt(0)" ::: "memory");
    float rli[16];
#pragma unroll
    for (int r = 0; r < 16; ++r) rli[r] = __builtin_amdgcn_rcpf(li_l[crow(r, hi)]);
    if constexpr (MODE == 0) {
        bf16_t* Ow = ao.O + (long)(wid * QBLK) * ao.ldo;
#pragma unroll
        for (int r = 0; r < 16; ++r) { const int orow = crow(r, hi);
#pragma unroll
            for (int d0 = 0; d0 < 4; ++d0) Ow[(long)orow * ao.ldo + d0 * 32 + r32] = f2bf(o[d0][r] * rli[r]); }
    } else {
        float* st = ao.stash + (wid * 64) * 64 + lane;
        if (ao.sub == 0) {
#pragma unroll
            for (int r = 0; r < 16; ++r)
#pragma unroll
                for (int d0 = 0; d0 < 4; ++d0) st[(r * 4 + d0) * 64] = o[d0][r] * rli[r];
        } else {
            const float lam = ao.lam; float sg[4];
#pragma unroll
            for (int d0 = 0; d0 < 4; ++d0) sg[d0] = ao.subg[d0 * 32 + r32] * (1.f - LAM_INIT);
            bf16_t* Ow = ao.O + (long)(wid * QBLK) * ao.ldo;
#pragma unroll
            for (int r = 0; r < 16; ++r) { float ss = 0.f;
#pragma unroll
                for (int d0 = 0; d0 < 4; ++d0) { const float v = st[(r * 4 + d0) * 64] - lam * (o[d0][r] * rli[r]); o[d0][r] = v; ss += v * v; }
                ss += __shfl_xor(ss, 1); ss += __shfl_xor(ss, 2); ss += __shfl_xor(ss, 4); ss += __shfl_xor(ss, 8); ss += __shfl_xor(ss, 16);
                const float rn = 1.0f / sqrtf(ss * (1.f / 128.f) + EPS); const int orow = crow(r, hi);
#pragma unroll
                for (int d0 = 0; d0 < 4; ++d0) Ow[(long)orow * ao.ldo + d0 * 32 + r32] = f2bf(o[d0][r] * rn * sg[d0]); }
        }
    }
    asm volatile("s_waitcnt vmcnt(0) lgkmcnt(0)" ::: "memory");
    __syncthreads();
#undef DMA_K
#undef DMA_V
#undef SYNC
#undef KS
#undef VS
#undef RESC
}
template <int MODE>
__device__ __forceinline__ void attn_body_dma(const bf16_t* __restrict__ Qb, int ldq, const bf16_t* __restrict__ Kh, int ldk, const bf16_t* __restrict__ Vh, int ldv, int seq, char* lds, const AOut ao) {
#if ATT_NOALT
    attn_dma_impl<MODE, false>(Qb, ldq, Kh, ldk, Vh, ldv, seq, lds, ao);
#else
    if (__builtin_amdgcn_readfirstlane((int)threadIdx.x >> 8) == 0) attn_dma_impl<MODE, false>(Qb, ldq, Kh, ldk, Vh, ldv, seq, lds, ao);
    else attn_dma_impl<MODE, true>(Qb, ldq, Kh, ldk, Vh, ldv, seq, lds, ao);
#endif
}
template <int DQK>
__device__ __forceinline__ void attn_body_np(const bf16_t* __restrict__ Qb, int ldq, const KSrc ks, const bf16_t* __restrict__ Vh, int ldv, int seq, char* lds, const AOut ao) {
    using C = Cf<DQK>; constexpr int ND = C::ND, KC = C::KC, CPR = C::CPR, CA = DQK == 192 ? 16 : CPR; constexpr size_t SHM_K = C::SHM_K;
    int tid_ = threadIdx.x; asm volatile("" : "+v"(tid_));
    const int tid = tid_, wid = tid >> 6, lane = tid & 63, r32 = lane & 31, hi = lane >> 5;
    char* V_lds = lds; char* K_lds = lds + 2 * SHM_V;
    float* ws = (float*)(lds + 2 * SHM_V + 2 * SHM_K) + wid * 64; float* li_l = ws; float* al_l = ws + 32;
    float l_reg = 0; f32x16 o[4] = {}, mC = {}; bf16x8 qr[ND];
    const bf16_t* Qw = Qb + (long)(wid * QBLK + r32) * ldq + hi * 8;
#pragma unroll
    for (int d0 = 0; d0 < ND; ++d0) qr[d0] = *reinterpret_cast<const bf16x8*>(Qw + d0 * 16);
    const int sr = tid >> 4, sc = (tid & 15) * 8, vst0 = v_st(sr, sc), vst1 = v_st(32 + sr, sc);
    const int vb0 = (int)(uintptr_t)V_lds + v_rd_base(lane);
    const char* kbase = (const char*)ks.ka < (const char*)ks.kb ? (const char*)ks.ka : (const char*)ks.kb;
    unsigned koff[KC], kstride[KC]; int klds[KC];
#pragma unroll
    for (int i = 0; i < KC; ++i) { const int q = tid + 512 * i, row = q / CPR, c8 = q % CPR; klds[i] = kswz<DQK>(row, c8 * 16);
        if (c8 < CA) { koff[i] = (unsigned)((const char*)(ks.ka + (long)row * ks.lda + c8 * 8) - kbase); kstride[i] = (unsigned)ks.lda * 2u; }
        else { koff[i] = (unsigned)((const char*)(ks.kb + (long)row * ks.ldb + (c8 - CA) * 8) - kbase); kstride[i] = (unsigned)ks.ldb * 2u; } }
    const unsigned voff0 = (unsigned)(sr * ldv + sc) * 2u, voff1 = voff0 + (unsigned)ldv * 64u;
    bf16x8 vs0, vs1, kk[KC];
#define SLOAD1(k0_) do { const char* vb_ = (const char*)Vh + (size_t)(k0_) * (size_t)(ldv * 2); vs0 = *reinterpret_cast<const bf16x8*>(vb_ + voff0); vs1 = *reinterpret_cast<const bf16x8*>(vb_ + voff1); \
    _Pragma("unroll") for (int c_ = 0; c_ < KC; ++c_) kk[c_] = *reinterpret_cast<const bf16x8*>(kbase + (koff[c_] + (unsigned)(k0_) * kstride[c_])); } while (0)
#define SWRITE1(b_) do { *(bf16x8*)(V_lds + (b_) * SHM_V + vst0) = vs0; *(bf16x8*)(V_lds + (b_) * SHM_V + vst1) = vs1; \
    _Pragma("unroll") for (int c_ = 0; c_ < KC; ++c_) *(bf16x8*)(K_lds + (b_) * SHM_K + klds[c_]) = kk[c_]; } while (0)
    f32x16 p0, p1; float al; bf16x8 pa0, pa1, pa2, pa3; const int NT = seq / KVBLK;
    SLOAD1(0); asm volatile("s_waitcnt vmcnt(0)" ::: "memory"); SWRITE1(0); SLOAD1(KVBLK); __syncthreads();
#pragma unroll 1
    for (int j = 0; j < NT; ++j) {
        const int buf = j & 1;
        SBAR(); qkt<DQK, ND>(p0, p1, K_lds + buf * SHM_K, qr, nullptr, r32, hi, mC);
        if (j == 0) partialSM<DQK, 0, true>(p0, p1, mC, al); else partialSM<DQK>(p0, p1, mC, al);
        if (__any(al < 1.f)) { if (hi == 0) al_l[r32] = al; asm volatile("s_waitcnt lgkmcnt(0)" ::: "memory");
#pragma unroll
            for (int d_ = 0; d_ < 4; ++d_)
#pragma unroll
                for (int r_ = 0; r_ < 16; ++r_) o[d_][r_] *= al_l[crow(r_, hi)]; }
        finishSM(p0, p1, al, l_reg, pa0, pa1, pa2, pa3); SBAR();
        if (j + 1 < NT) { asm volatile("s_waitcnt vmcnt(0)" ::: "memory"); SWRITE1(buf ^ 1); if (j + 2 < NT) SLOAD1((j + 2) * KVBLK); }
        SBAR();
        pv_d0(o, vb0 + buf * (int)SHM_V, pa0, pa1, pa2, pa3);
        __syncthreads();
    }
#undef SLOAD1
#undef SWRITE1
    if (hi == 0) li_l[r32] = l_reg; asm volatile("s_waitcnt lgkmcnt(0)" ::: "memory");
    float rli[16];
#pragma unroll
    for (int r = 0; r < 16; ++r) rli[r] = __builtin_amdgcn_rcpf(li_l[crow(r, hi)]);
    bf16_t* Ow = ao.O + (long)(wid * QBLK) * ao.ldo;
#pragma unroll
    for (int r = 0; r < 16; ++r) { const int orow = crow(r, hi);
#pragma unroll
        for (int d0 = 0; d0 < 4; ++d0) Ow[(long)orow * ao.ldo + d0 * 32 + r32] = f2bf(o[d0][r] * rli[r]); }
    asm volatile("s_waitcnt vmcnt(0) lgkmcnt(0)" ::: "memory");
    __syncthreads();
}
}
constexpr int M = NB * S, ML = NB * T;
constexpr int NCH = ML / 256;
constexpr int MAXT = 2 * ML / 256 + NE;
constexpr size_t al256(size_t x) { return (x + 255) / 256 * 256; }
constexpr size_t WS_CTL = 0, CTL_BYTES = 1u << 20;
constexpr int CW_BAR = 4096;
constexpr int CW_TICKET = 64;
constexpr size_t WS_MODV = WS_CTL + CTL_BYTES;
constexpr size_t WS_ROPE = WS_MODV + al256((size_t)2 * 33 * 6144 * 4);
constexpr size_t WS_W = WS_ROPE + 2 * 2048 * 32 * 4;
constexpr size_t W_IN0 = WS_W, W_UQ = W_IN0 + (size_t)2304 * 1024 * 2, W_UKV = W_UQ + (size_t)768 * 384 * 2, W_OUT0 = W_UKV + (size_t)1024 * 256 * 2,
    W_GU0 = W_OUT0 + (size_t)1024 * 1024 * 2, W_DN0 = W_GU0 + (size_t)5632 * 1024 * 2, W_IN1 = W_DN0 + (size_t)1024 * 2816 * 2, W_FOLD = W_IN1 + (size_t)2304 * 1024 * 2,
    W_OUT1 = W_FOLD + (size_t)512 * 1024 * 2, W_GU1 = W_OUT1 + (size_t)1024 * 1024 * 2, W_DN1 = W_GU1 + (size_t)NE * 5632 * 1024, W_DFT = W_DN1 + (size_t)NE * 1024 * 2816,
    WS_WEND = W_DFT + (size_t)2048 * 4096 * 2;
constexpr size_t WS_CTXS = WS_WEND;
constexpr size_t WS_STASH = WS_CTXS;
constexpr size_t CTXS_BYTES = ((size_t)NB * L * D * 4 > (size_t)256 * 131072) ? (size_t)NB * L * D * 4 : (size_t)256 * 131072;
constexpr size_t WS_ROUTE = WS_CTXS + CTXS_BYTES;
constexpr size_t RT_INFO = WS_ROUTE, RT_W = RT_INFO + (size_t)ML * 16, RT_POS = RT_W + (size_t)ML * 8, RT_WCNT = RT_POS + (size_t)ML * 8, RT_TOFF = RT_WCNT + (size_t)NCH * 64 * 4, WS_RTEND = al256(RT_TOFF + 256);
constexpr size_t W8_IN0 = WS_RTEND, W8_GU0 = W8_IN0 + (size_t)2304 * 1024, W8_IN1 = W8_GU0 + (size_t)5632 * 1024, W8_FOLD = W8_IN1 + (size_t)2304 * 1024, W8_END = W8_FOLD + (size_t)512 * 1024;
constexpr size_t SW_IN0 = W8_END, SW_GU0 = SW_IN0 + 2304 * 4, SW_IN1 = SW_GU0 + 5632 * 4, SW_FOLD = SW_IN1 + 2304 * 4, SW_GU1 = SW_FOLD + 512 * 4, SW_END = SW_GU1 + (size_t)NE * 5632 * 4;
constexpr size_t SA_ROW = al256(SW_END), SA_TOK = SA_ROW + (size_t)M * 4, SA_SORT = SA_TOK + (size_t)ML * 4, WS_I8END = al256(SA_SORT + ((size_t)2 * ML + NE * 256) * 4);
constexpr size_t AR = WS_I8END;
constexpr size_t SROWS = (size_t)2 * ML + NE * 256;
constexpr size_t H2S_BYTES = SROWS * 1024, FS_BYTES = SROWS * 2048, ACTM_BYTES = (size_t)MAXT * 256 * 2816, GT_BYTES = (size_t)NB * 256 * 4096 * 2;
#if CFG_NB >= 32
constexpr size_t AR_A = AR, AR_B = AR + (size_t)M * 2048, AR_C = AR + (size_t)M * 4096, AR_D = AR_C + (size_t)M * 5632;
constexpr size_t AR_END = AR_D + (size_t)M * 1280;
constexpr size_t B_H = AR_A, B_Q0 = AR_A, B_Y = AR_A, B_F = AR_A, B_AOUT1 = AR_A, B_H2TOK = AR_A, B_FS = AR_A;
constexpr size_t B_AOUT0 = AR_B, B_H2 = AR_B, B_H1 = AR_B, B_Y1 = AR_B;
constexpr size_t B_Z = AR_C, B_KPE = AR_C + (size_t)M * 4608, B_K0N = AR_C, B_V0 = AR_C + (size_t)M * 1024, B_ACT = AR_C,
    B_QKV1 = AR_C, B_GT = AR_C + (size_t)M * 4608, B_ACTM = AR_C, B_TMPW = AR_C;
static_assert((size_t)NE * 5632 * 1024 * 2 <= (size_t)M * 5632, "TMPW fits C");
constexpr size_t B_ZQN = AR_D, B_ZKVN = AR_D + (size_t)M * 768, B_H2S = AR_B, B_XS_HI = AR_D, B_PART1 = AR_D + (size_t)(ML / 2) * 2048;
constexpr bool SPLIT_TAIL = true;
static_assert((size_t)(ML / 2) * 2048 + (size_t)(M - 65536) * 2048 <= (size_t)M * 1280, "PART1 fits D");
static_assert(H2S_BYTES <= (size_t)M * 2048 && (size_t)(ML / 2) * 2048 <= (size_t)M * 1280, "h2s fits B, XS_HI fits D");
static_assert(FS_BYTES <= (size_t)M * 4096, "f_sorted fits A+B");
static_assert(ACTM_BYTES <= (size_t)M * 5632, "MoE act fits C");
static_assert(GT_BYTES <= (size_t)M * 1024, "GT fits the tail of C");
constexpr size_t B_FSX = AR_END;
static_assert(B_FSX + (size_t)3 * 1792 * 2048 <= ((size_t)1 << 30), "workspace map exceeds 1 GiB");
#else
constexpr size_t B_FSX = 0;
constexpr bool SPLIT_TAIL = false;
constexpr size_t B_H = AR, B_Z = B_H + (size_t)M * 2048, B_KPE = B_Z + (size_t)M * 4608, B_AOUT0 = B_KPE + (size_t)M * 128, B_ZQN = B_AOUT0 + (size_t)M * 2048, B_ZKVN = B_ZQN + (size_t)M * 768,
    B_Q0 = B_ZKVN + (size_t)M * 512, B_K0N = B_Q0 + (size_t)M * 1536, B_V0 = B_K0N + (size_t)M * 1024, B_Y = B_V0 + (size_t)M * 1024, B_H2 = B_Y + (size_t)M * 2048, B_ACT = B_H2 + (size_t)M * 2048,
    B_F = B_ACT + (size_t)M * 5632, B_H1 = B_F + (size_t)M * 2048, B_QKV1 = B_H1 + (size_t)M * 2048, B_GT = B_QKV1 + (size_t)M * 4608, B_AOUT1 = B_GT + GT_BYTES, B_Y1 = B_AOUT1 + (size_t)M * 2048,
    B_H2TOK = B_Y1 + (size_t)M * 2048, B_H2S = B_H2TOK + (size_t)ML * 1024, B_ACTM = B_H2S + H2S_BYTES, B_FS = B_ACTM + ACTM_BYTES, B_XS_HI = B_FS + FS_BYTES, B_PART1 = B_XS_HI, B_TMPW = B_XS_HI + (size_t)(ML / 2) * 2048, AR_END = B_TMPW + (size_t)NE * 5632 * 1024 * 2;
#endif

#ifndef DN0_FP8
#define DN0_FP8 1
#endif
#ifndef FFN0_FP8
#define FFN0_FP8 0
#endif
#ifndef MOE_I8
#define MOE_I8 0
#endif
#ifndef USE_I8
#define USE_I8 1
#endif
struct P {
    const float *x, *c, *ctx, *c_ctx, *ev_mod_w, *ev_mod_b, *ev_norm_g, *ev_w_in, *ev_conv_w, *ev_q_norm_g, *ev_w_uq, *ev_kv_norm_g, *ev_w_ukv, *ev_w_out,
        *ev_ffn_gate, *ev_ffn_up, *ev_ffn_down, *od_mod_w, *od_mod_b, *od_norm_g, *od_w_in, *od_lambda, *od_subln_g, *od_w_out, *od_router, *od_exp_gate, *od_exp_up, *od_exp_down;
    float* out; unsigned char* ws; int ph_lo, ph_hi;
};

__device__ __forceinline__ void ld_f32(const float* p, int lane, float (&v)[16]) {
#pragma unroll
    for (int j2 = 0; j2 < 2; ++j2) { const f32x4 a = *(const f32x4*)(p + 512 * j2 + 8 * lane), b = *(const f32x4*)(p + 512 * j2 + 8 * lane + 4);
#pragma unroll
        for (int i = 0; i < 4; ++i) { v[j2 * 8 + i] = a[i]; v[j2 * 8 + 4 + i] = b[i]; } }
}
__device__ __forceinline__ void st_f32(float* p, int lane, const float (&v)[16]) {
#pragma unroll
    for (int j2 = 0; j2 < 2; ++j2) { f32x4 a, b;
#pragma unroll
        for (int i = 0; i < 4; ++i) { a[i] = v[j2 * 8 + i]; b[i] = v[j2 * 8 + 4 + i]; }
        *(f32x4*)(p + 512 * j2 + 8 * lane) = a; *(f32x4*)(p + 512 * j2 + 8 * lane + 4) = b; }
}
__device__ __forceinline__ void unpack8(const u32x4 w, float* v) { v[0] = bflo(w.x); v[1] = bfhi(w.x); v[2] = bflo(w.y); v[3] = bfhi(w.y); v[4] = bflo(w.z); v[5] = bfhi(w.z); v[6] = bflo(w.w); v[7] = bfhi(w.w); }
__device__ __forceinline__ u32x4 pack8f(const float* v) { u32x4 w; w.x = cvt_pk_bf16(v[0], v[1]); w.y = cvt_pk_bf16(v[2], v[3]); w.z = cvt_pk_bf16(v[4], v[5]); w.w = cvt_pk_bf16(v[6], v[7]); return w; }
__device__ __forceinline__ void ld_bf16(const bf16_t* p, int lane, float (&v)[16]) {
#pragma unroll
    for (int j2 = 0; j2 < 2; ++j2) { const u32x4 w = *(const u32x4*)(p + 512 * j2 + 8 * lane); unpack8(w, &v[j2 * 8]); }
}
__device__ __forceinline__ void st_bf16(bf16_t* p, int lane, const float (&v)[16]) {
#pragma unroll
    for (int j2 = 0; j2 < 2; ++j2) *(u32x4*)(p + 512 * j2 + 8 * lane) = pack8f(&v[j2 * 8]);
}
__device__ __forceinline__ float sumsq16(const float (&v)[16]) { float s = 0.f;
#pragma unroll
    for (int i = 0; i < 16; ++i) s += v[i] * v[i];
    return wave_sum(s); }
__device__ __forceinline__ void resid16(float (&xv)[16], const float (&y)[16], const float* g, const float* gate, int lane) {
    const float ry = 1.0f / sqrtf(sumsq16(y) * (1.f / D) + EPS); float gv[16], tv[16]; ld_f32(g, lane, gv); ld_f32(gate, lane, tv);
#pragma unroll
    for (int i = 0; i < 16; ++i) xv[i] += tv[i] * (y[i] * ry * gv[i]);
}
__device__ __forceinline__ void normmod16(const float (&xv)[16], float (&h)[16], const float* g, const float* shift, const float* scale, int lane) {
    const float rx = 1.0f / sqrtf(sumsq16(xv) * (1.f / D) + EPS); float gv[16], sh[16], sc[16]; ld_f32(g, lane, gv); ld_f32(shift, lane, sh); ld_f32(scale, lane, sc);
#pragma unroll
    for (int i = 0; i < 16; ++i) h[i] = xv[i] * rx * gv[i] * (1.f + sc[i]) + sh[i];
}
__device__ __forceinline__ void resid16r(float (&xv)[16], const float (&y)[16], const float (&gv)[16], const float (&tv)[16]) {
    const float ry = 1.0f / sqrtf(sumsq16(y) * (1.f / D) + EPS);
#pragma unroll
    for (int i = 0; i < 16; ++i) xv[i] += tv[i] * (y[i] * ry * gv[i]);
}
__device__ __forceinline__ void normmod16r(const float (&xv)[16], float (&h)[16], const float (&gv)[16], const float (&sh)[16], const float (&sc)[16]) {
    const float rx = 1.0f / sqrtf(sumsq16(xv) * (1.f / D) + EPS);
#pragma unroll
    for (int i = 0; i < 16; ++i) h[i] = xv[i] * rx * gv[i] * (1.f + sc[i]) + sh[i];
}
__device__ __forceinline__ void st_i8row(unsigned char* dst, float* sc, int row, int lane, const float (&h)[16]) {
    u32x2 q[2]; const float scl = quant_row_i8(h, q);
#pragma unroll
    for (int j2 = 0; j2 < 2; ++j2) *(u32x2*)(dst + (size_t)row * 1024 + 512 * j2 + 8 * lane) = q[j2];
    if (lane == 0) sc[row] = scl;
}
__device__ __forceinline__ void wave_rows_(int gw, int ngw, int n, int& r0, int& r1) { const int per = (((n + ngw - 1) / ngw) + 1) & ~1; r0 = gw * per; r1 = r0 + per < n ? r0 + per : n; if (r0 > n) r0 = n; }
#define wave_rows(c, n, r0, r1) wave_rows_((c).gw, (c).ngw, n, r0, r1)
__device__ __forceinline__ int mod_key(int m) { const int b = m / S, j = m % S; return j < L ? 32 : b; }
__device__ __forceinline__ int rope_pos(int e) { return e < 32 ? 8 * (e >> 2) + (e & 3) : 8 * ((e - 32) >> 2) + 4 + (e & 3); }
__device__ __forceinline__ int rope_elem(int s) { const int i = s >> 3, j = s & 7; return j < 4 ? 4 * i + j : 32 + 4 * i + (j - 4); }

struct Ctx {
    LAS unsigned char* lds; unsigned char* ws; int tid, lane, wave, gw, ngw;
};

constexpr int P0_PITCH = 65, P0_SCR_BYTES = 64 * P0_PITCH * 4;
template <int MAP, bool OUT8 = false>
__device__ __forceinline__ void p0_item(const float* W, const float* W2, int ldw, int nvalid, int K, bf16_t* WT, LAS float* scr, int item, int nblk, int lane, float wscale = 1.f) {
    const int kb = item / nblk, nb = item % nblk, k0 = 64 * kb, n0 = 64 * nb; const int q = lane & 15, kr = lane >> 4; const int np = n0 + 4 * q;
    const float* src = W; int col = np;
    if (MAP == 0) { if (np >= nvalid) col = -1; }
    if (MAP == 1) { const int h = np / MLA_QK, w = np % MLA_QK; col = w < MLA_NOPE ? np : h * MLA_QK + MLA_NOPE + rope_elem(w - MLA_NOPE); }
    if (MAP == 2) { const int tl = np >> 8, cc = np & 255, bj = cc >> 7, wcq = (cc & 127) >> 3, nn = (cc & 7) >> 2; col = tl * 128 + 8 * wcq + 4 * nn; if (bj) src = W2; }
    if (MAP == 3) { col = np < 2 * DIFFW ? (np & ~63) + rope_elem(np & 63) : np; }
    f32x4 v[16];
#pragma unroll
    for (int i = 0; i < 16; ++i) v[i] = col >= 0 ? *(const f32x4*)(src + (size_t)(k0 + kr + 4 * i) * ldw + col) : (f32x4){0.f, 0.f, 0.f, 0.f};
#pragma unroll
    for (int i = 0; i < 16; ++i)
#pragma unroll
        for (int j = 0; j < 4; ++j) scr[(4 * q + j) * P0_PITCH + kr + 4 * i] = v[i][j];
    asm volatile("s_waitcnt lgkmcnt(0)" ::: "memory");
    const int c = lane & 7;
#pragma unroll
    for (int jj = 0; jj < 8; ++jj) { const int n = (lane >> 3) + 8 * jj; const LAS float* s = scr + n * P0_PITCH + 8 * c;
        if constexpr (OUT8) { u32x2 o; o.x = pg8::pack4_fp8(s[0] * wscale, s[1] * wscale, s[2] * wscale, s[3] * wscale); o.y = pg8::pack4_fp8(s[4] * wscale, s[5] * wscale, s[6] * wscale, s[7] * wscale);
            *(u32x2*)((unsigned char*)WT + (size_t)(n0 + n) * K + k0 + 8 * c) = o; }
        else { u32x4 o; o.x = cvt_pk_bf16(s[0], s[1]); o.y = cvt_pk_bf16(s[2], s[3]); o.z = cvt_pk_bf16(s[4], s[5]); o.w = cvt_pk_bf16(s[6], s[7]);
            *(u32x4*)(WT + (size_t)(n0 + n) * K + k0 + 8 * c) = o; } }
    asm volatile("s_waitcnt lgkmcnt(0)" ::: "memory");
}
struct P0Desc { const float* src; const float* src2; unsigned char* dst; int ldw, nvalid, K, nblk, map, out8, item; float scale; };
__device__ __forceinline__ void p0_load(const P0Desc& d, int lane, f32x4 (&v)[16]) {
    const int kb = d.item / d.nblk, nb = d.item % d.nblk, k0 = 64 * kb, n0 = 64 * nb; const int q = lane & 15, kr = lane >> 4; const int np = n0 + 4 * q;
    const float* src = d.src; int col = np;
    if (d.map == 0) { if (np >= d.nvalid) col = -1; }
    else if (d.map == 1) { const int h = np / MLA_QK, w = np % MLA_QK; col = w < MLA_NOPE ? np : h * MLA_QK + MLA_NOPE + rope_elem(w - MLA_NOPE); }
    else if (d.map == 2) { const int tl = np >> 8, cc = np & 255, bj = cc >> 7, wcq = (cc & 127) >> 3, nn = (cc & 7) >> 2; col = tl * 128 + 8 * wcq + 4 * nn; if (bj) src = d.src2; }
    else { col = np < 2 * DIFFW ? (np & ~63) + rope_elem(np & 63) : np; }
#pragma unroll
    for (int i = 0; i < 16; ++i) v[i] = col >= 0 ? *(const f32x4*)(src + (size_t)(k0 + kr + 4 * i) * d.ldw + col) : (f32x4){0.f, 0.f, 0.f, 0.f};
}
__device__ __forceinline__ void p0_store(const P0Desc& d, int lane, LAS float* scr, const f32x4 (&v)[16]) {
    const int kb = d.item / d.nblk, nb = d.item % d.nblk, k0 = 64 * kb, n0 = 64 * nb; const int q = lane & 15, kr = lane >> 4;
#pragma unroll
    for (int i = 0; i < 16; ++i)
#pragma unroll
        for (int j = 0; j < 4; ++j) scr[(4 * q + j) * P0_PITCH + kr + 4 * i] = v[i][j];
    asm volatile("s_waitcnt lgkmcnt(0)" ::: "memory");
    const int c = lane & 7; float ws_ = d.scale; if (d.map == 2 && d.out8) ws_ *= ((n0 & 255) >> 7) ? 0.6931471805599453f : 1.4426950408889634f;
#pragma unroll
    for (int jj = 0; jj < 8; ++jj) { const int n = (lane >> 3) + 8 * jj; const LAS float* s = scr + n * P0_PITCH + 8 * c;
        if (d.out8) { u32x2 o; o.x = pg8::pack4_fp8(s[0] * ws_, s[1] * ws_, s[2] * ws_, s[3] * ws_); o.y = pg8::pack4_fp8(s[4] * ws_, s[5] * ws_, s[6] * ws_, s[7] * ws_);
            *(u32x2*)(d.dst + (size_t)(n0 + n) * d.K + k0 + 8 * c) = o; }
        else { u32x4 o; o.x = cvt_pk_bf16(s[0], s[1]); o.y = cvt_pk_bf16(s[2], s[3]); o.z = cvt_pk_bf16(s[4], s[5]); o.w = cvt_pk_bf16(s[6], s[7]);
            *(u32x4*)((bf16_t*)d.dst + (size_t)(n0 + n) * d.K + k0 + 8 * c) = o; } }
    asm volatile("s_waitcnt lgkmcnt(0)" ::: "memory");
}
__device__ __forceinline__ void p0_fold_item(const float* W, bf16_t* WT, LAS float* scr, const LAS float* tab, int item, int lane) {
    const int kb = item / 16, nb = item % 16, k0 = 64 * kb, n0 = 32 * nb; const int r = n0 + (lane & 31), part = r >> 8, g = (r >> 6) & 3, l = r & 63;
    for (int i = 0; i < 32; ++i) { const int kk = 2 * i + (lane >> 5); const float* wr = W + (size_t)(k0 + kk) * ODD_IN + 3 * DIFFW + g * 64; float a = 0.f;
        for (int j = 0; j < 64; ++j) a += wr[j] * tab[part * 64 + ((l * j) & 63)];
        scr[kk * 33 + (lane & 31)] = a; }
    asm volatile("s_waitcnt lgkmcnt(0)" ::: "memory");
    const int c = lane & 7;
#pragma unroll
    for (int j = 0; j < 4; ++j) { const int n = (lane >> 3) + 8 * j; const LAS float* s = scr + (8 * c) * 33 + n;
        u32x4 o; o.x = cvt_pk_bf16(s[0 * 33], s[1 * 33]); o.y = cvt_pk_bf16(s[2 * 33], s[3 * 33]); o.z = cvt_pk_bf16(s[4 * 33], s[5 * 33]); o.w = cvt_pk_bf16(s[6 * 33], s[7 * 33]);
        *(u32x4*)(WT + (size_t)(n0 + n) * D + k0 + 8 * c) = o; }
    asm volatile("s_waitcnt lgkmcnt(0)" ::: "memory");
}
__device__ __forceinline__ void fmac_s(float& a, float x, float y) { asm("v_fmac_f32 %0, %1, %2" : "+v"(a) : "v"(x), "v"(y)); }
__device__ __forceinline__ void p0_mod_unit(const P& p, const Ctx& c, int u) {
    const int layer = u / 128, col0 = (u % 128) * 48; const float* W = layer ? p.od_mod_w : p.ev_mod_w; const float* bias = layer ? p.od_mod_b : p.ev_mod_b;
    float* mod = (float*)(c.ws + WS_MODV) + (size_t)layer * 33 * 6144;
    LAS float* sc = (LAS float*)c.lds;
    LAS float* red = (LAS float*)(c.lds + 73728);
    const int nl = c.tid & 15, kg = c.tid >> 4; float acc[3][33];
#pragma unroll
    for (int j = 0; j < 3; ++j)
#pragma unroll
        for (int r = 0; r < 33; ++r) acc[j][r] = 0.f;
    for (int ch = 0; ch < 2; ++ch) {
        const char* wb = (const char*)(W + (size_t)ch * 512 * 6144 + col0); const unsigned lo = (unsigned)(kg * 16 * 6144 + nl) * 4u; float wv[3][16];
#pragma unroll
        for (int kk = 0; kk < 16; ++kk) { const char* wk = wb + (size_t)kk * 6144 * 4;
#pragma unroll
            for (int j = 0; j < 3; ++j) wv[j][kk] = *(const float*)(wk + (lo + 64u * j)); }
        __syncthreads();
#pragma unroll 4
        for (int e = c.tid; e < 36 * 512; e += 512) { const int kk = e & 511, r = e >> 9; float v = 0.f;
            if (r < 33) { const float cv = r < 32 ? p.c[r * D + ch * 512 + kk] : p.c_ctx[ch * 512 + kk]; v = cv * __builtin_amdgcn_rcpf(1.f + __builtin_amdgcn_exp2f(-1.4426950408889634f * cv)); }
            sc[kk * 36 + r] = v; }
        __syncthreads();
#pragma unroll
        for (int kk = 0; kk < 16; ++kk) { const LAS f32x4* s4 = (const LAS f32x4*)(sc + (kg * 16 + kk) * 36);
#pragma unroll
            for (int q = 0; q < 8; ++q) { const f32x4 sv = s4[q];
#pragma unroll
                for (int i = 0; i < 4; ++i)
#pragma unroll
                    for (int j = 0; j < 3; ++j) fmac_s(acc[j][q * 4 + i], sv[i], wv[j][kk]); }
            const float s32 = s4[8][0];
#pragma unroll
            for (int j = 0; j < 3; ++j) fmac_s(acc[j][32], s32, wv[j][kk]); }
    }
#pragma unroll
    for (int j = 0; j < 3; ++j)
#pragma unroll
        for (int r = 0; r < 33; ++r) { float v = acc[j][r];
            { auto rr = __builtin_amdgcn_permlane16_swap(__float_as_uint(v), __float_as_uint(v), false, false); v = __uint_as_float(rr[0]) + __uint_as_float(rr[1]); }
            { auto rr = __builtin_amdgcn_permlane32_swap(__float_as_uint(v), __float_as_uint(v), false, false); v = __uint_as_float(rr[0]) + __uint_as_float(rr[1]); }
            acc[j][r] = v; }
    if ((c.lane >> 4) == 0) {
#pragma unroll
        for (int j = 0; j < 3; ++j)
#pragma unroll
            for (int r = 0; r < 33; ++r) red[(c.wave * 33 + r) * 48 + nl + 16 * j] = acc[j][r]; }
    __syncthreads();
    for (int o = c.tid; o < 33 * 48; o += 512) { const int r = o / 48, n = o % 48; float v = bias[col0 + n];
#pragma unroll
        for (int q = 0; q < 8; ++q) v += red[(q * 33 + r) * 48 + n];
        mod[(size_t)r * 6144 + col0 + n] = v; }
    __syncthreads();
}
__device__ __forceinline__ void phase_prologue(const P& p, const Ctx& c, int parts, int rp = 0) {
    if (parts & 1) for (int u = blockIdx.x; u < 256; u += gridDim.x) p0_mod_unit(p, c, u);
    __syncthreads();
    LAS float* tab = (LAS float*)(c.lds + 8 * P0_SCR_BYTES + 512);
    if (c.tid < 64) { const float a = (float)c.tid * (6.283185307179586f / 64.f); tab[c.tid] = cosf(a); tab[64 + c.tid] = sinf(a); }
    __syncthreads();
    LAS float* scr = (LAS float*)(c.lds + c.wave * P0_SCR_BYTES);
    constexpr int I0 = 16 * 36, I1 = 6 * 12, I2 = 4 * 16, I3 = 16 * 16, I4 = 16 * 88, I5 = 44 * 16, I6 = 16 * 36, I7 = 16 * 16, I8 = NE * I4, I9 = NE * I5, I10 = 16 * 16;
    constexpr int NITEMS = I0 + I1 + I2 + I3 + I4 + I5 + I6 + I7 + I8 + I9 + I10;
    (void)rp;
    constexpr int NTR = NITEMS - I10;
    auto resolve = [&](int it, P0Desc& d) {
        int r = it; d.src2 = nullptr; d.out8 = 0; d.scale = 1.f; d.map = 0;
        if (r < I0) { d.src = p.ev_w_in; d.ldw = EVEN_IN; d.nvalid = EVEN_IN; d.K = D; d.dst = c.ws + W_IN0; d.nblk = 36; d.item = r; return; } r -= I0;
        if (r < I1) { d.src = p.ev_w_uq; d.ldw = 768; d.nvalid = 768; d.K = QRANK; d.dst = c.ws + W_UQ; d.nblk = 12; d.map = 1; d.item = r; return; } r -= I1;
        if (r < I2) { d.src = p.ev_w_ukv; d.ldw = 1024; d.nvalid = 1024; d.K = KVRANK; d.dst = c.ws + W_UKV; d.nblk = 16; d.item = r; return; } r -= I2;
        if (r < I3) { d.src = p.ev_w_out; d.ldw = D; d.nvalid = D; d.K = D; d.dst = c.ws + W_OUT0; d.nblk = 16; d.item = r; return; } r -= I3;
        if (r < I4) { d.src = p.ev_ffn_gate; d.src2 = p.ev_ffn_up; d.ldw = FF; d.nvalid = FF; d.K = D; d.dst = c.ws + W_GU0; d.nblk = 88; d.map = 2; d.item = r; if (FFN0_FP8 && !USE_I8) { d.out8 = 1; d.scale = 32.f; } return; } r -= I4;
        if (r < I5) { d.src = p.ev_ffn_down; d.ldw = D; d.nvalid = D; d.K = FF; d.dst = c.ws + W_DN0; d.nblk = 16; d.item = r; if ((FFN0_FP8 && !USE_I8) || (DN0_FP8 && USE_I8)) { d.out8 = 1; d.scale = 64.f; } return; } r -= I5;
        if (r < I6) { d.src = p.od_w_in; d.ldw = ODD_IN; d.nvalid = ODD_IN; d.K = D; d.dst = c.ws + W_IN1; d.nblk = 36; d.map = 3; d.item = r; return; } r -= I6;
        if (r < I7) { d.src = p.od_w_out; d.ldw = D; d.nvalid = D; d.K = D; d.dst = c.ws + W_OUT1; d.nblk = 16; d.item = r; return; } r -= I7;
        if (r < I8) { const int e = r / I4; d.src = p.od_exp_gate + (size_t)e * D * FF; d.src2 = p.od_exp_up + (size_t)e * D * FF; d.ldw = FF; d.nvalid = FF; d.K = D; d.nblk = 88; d.map = 2; d.item = r % I4;
            if (MOE_I8) { d.dst = c.ws + B_TMPW + (size_t)e * 5632 * 1024 * 2; } else { d.dst = c.ws + W_GU1 + (size_t)e * 5632 * 1024; d.out8 = 1; d.scale = 32.f; } return; } r -= I8;
        { const int e = r / I5; d.src = p.od_exp_down + (size_t)e * FF * D; d.ldw = D; d.nvalid = D; d.K = FF; d.dst = c.ws + W_DN1 + (size_t)e * 1024 * 2816; d.nblk = 16; d.item = r % I5; d.out8 = 1; d.scale = 64.f; }
    };
    if (parts & 2) {
        int it = c.gw; P0Desc dA, dB; f32x4 vA[16], vB[16];
        if (it < NTR) { resolve(it, dA); p0_load(dA, c.lane, vA);
            for (;;) {
                int it1 = it + c.ngw; bool h1 = it1 < NTR; if (h1) { resolve(it1, dB); p0_load(dB, c.lane, vB); }
                p0_store(dA, c.lane, scr, vA); if (!h1) break; it = it1;
                it1 = it + c.ngw; h1 = it1 < NTR; if (h1) { resolve(it1, dA); p0_load(dA, c.lane, vA); }
                p0_store(dB, c.lane, scr, vB); if (!h1) break; it = it1;
            } }
        for (int f = c.gw; f < I10; f += c.ngw) p0_fold_item(p.od_w_in, (bf16_t*)(c.ws + W_FOLD), scr, tab, f, c.lane);
    }
    if (parts & 4) { bf16_t* dft = (bf16_t*)(c.ws + W_DFT); const int gt = blockIdx.x * 512 + c.tid, ngt = gridDim.x * 512; const float scl = 0.0027621358640099515f;
      for (int i8 = gt; i8 < 2048 * 4096 / 8; i8 += ngt) { const int k = i8 >> 9, tt0 = (i8 & 511) * 8; float v[8];
#pragma unroll
          for (int j = 0; j < 8; ++j) { const int tt = tt0 + j, t = tt & 2047, q = (k * t) & 2047; const float a = (float)q * (6.283185307179586f / 2048.f); v[j] = (tt < 2048 ? cosf(a) : -sinf(a)) * scl; }
          *(u32x4*)(dft + (size_t)i8 * 8) = pack8f(v); } }
    if (parts & 4) { float* rc = (float*)(c.ws + WS_ROPE); float* rs = rc + 2048 * 32; const int gt = blockIdx.x * 512 + c.tid, ngt = gridDim.x * 512;
      for (int i = gt; i < 2048 * 32; i += ngt) { const int t = i >> 5, f = i & 31; const int pos = f < 16 ? t / GW : t % GW; const float inv = powf(10000.f, -(float)(f & 15) / 16.f);
          const float ang = (float)pos * inv; rc[i] = cosf(ang); rs[i] = sinf(ang); } }
}

__device__ __forceinline__ const float* in_row(const P& p, int m) { const int b = m / S, j = m % S; return j < L ? p.ctx + ((size_t)b * L + j) * D : p.x + ((size_t)b * T + (j - L)) * D; }
__device__ __forceinline__ bf16_t* lat_stream(const P& p, unsigned char* ws, int tok) {
    return tok < ML / 2 ? (bf16_t*)((unsigned char*)p.out + ((size_t)128 << 20)) + (size_t)tok * D : (bf16_t*)(ws + B_XS_HI) + (size_t)(tok - ML / 2) * D; }
__device__ __forceinline__ float* ctx_stream(unsigned char* ws, int m) { const int b = m / S, j = m % S; return (float*)(ws + WS_CTXS) + ((size_t)b * L + j) * D; }
__device__ __forceinline__ int tok_of(int m) { return (m / S) * T + (m % S) - L; }
__device__ __forceinline__ float* stream_row_unused(const P& p, unsigned char* ws, int m) { const int b = m / S, j = m % S; return j < L ? (float*)(ws + WS_CTXS) + ((size_t)b * L + j) * D : p.out + ((size_t)b * T + (j - L)) * D; }
__device__ __forceinline__ const float* mod_row(unsigned char* ws, int layer, int m) { const int b = m / S, j = m % S; return (const float*)(ws + WS_MODV) + ((size_t)layer * 33 + (j < L ? 32 : b)) * 6144; }

__device__ __forceinline__ void quant_weight_row(const bf16_t* src, unsigned char* dst, float* sc, int row, int lane, float mul = 1.f) {
    float v[16]; ld_bf16(src + (size_t)row * D, lane, v); u32x2 q[2]; const float scale = quant_row_i8(v, q);
#pragma unroll
    for (int j2 = 0; j2 < 2; ++j2) *(u32x2*)(dst + (size_t)row * D + 512 * j2 + 8 * lane) = q[j2];
    if (lane == 0) sc[row] = scale * mul;
}
__device__ __forceinline__ void phase_quant_weights(const Ctx& c) {
#if USE_I8
    constexpr int R0 = 5632, R1 = R0 + 2304, R2 = R1 + 2304, R3 = R2 + 512, R4 = R3 + (MOE_I8 ? NE * 5632 : 0);
    for (int r = c.gw; r < R4; r += c.ngw) {
        if (r < R0) quant_weight_row((const bf16_t*)(c.ws + W_GU0), c.ws + W8_GU0, (float*)(c.ws + SW_GU0), r, c.lane, (r & 255) < 128 ? 1.4426950408889634f : 0.6931471805599453f * (DN0_FP8 ? 8.f : 1.f));
        else if (r < R1) quant_weight_row((const bf16_t*)(c.ws + W_IN0), c.ws + W8_IN0, (float*)(c.ws + SW_IN0), r - R0, c.lane);
        else if (r < R2) quant_weight_row((const bf16_t*)(c.ws + W_IN1), c.ws + W8_IN1, (float*)(c.ws + SW_IN1), r - R1, c.lane, r - R1 < DIFFW ? pg8::QSC_DIFF : 1.f);
        else if (r < R3) quant_weight_row((const bf16_t*)(c.ws + W_FOLD), c.ws + W8_FOLD, (float*)(c.ws + SW_FOLD), r - R2, c.lane);
        else if (MOE_I8) quant_weight_row((const bf16_t*)(c.ws + B_TMPW), c.ws + W_GU1, (float*)(c.ws + SW_GU1), r - R3, c.lane, ((r - R3) & 255) < 128 ? 1.4426950408889634f : 0.6931471805599453f * 8.f); }
#endif
}
__device__ __forceinline__ void phase_norm0(const P& p, const Ctx& c) {
    bf16_t* H = (bf16_t*)(c.ws + B_H); int r0, r1; wave_rows(c, M, r0, r1);
    float g0[16], sh[16], sc[16]; ld_f32(p.ev_norm_g, c.lane, g0); int key = -1;
    for (int m0 = r0; m0 < r1; m0 += 2) { float xv[2][16];
#pragma unroll
        for (int r = 0; r < 2; ++r) ld_f32(in_row(p, m0 + r), c.lane, xv[r]);
#pragma unroll
        for (int r = 0; r < 2; ++r) { const int m = m0 + r; float h[16]; const int k = mod_key(m);
            if (k != key) { key = k; const float* mr = (const float*)(c.ws + WS_MODV) + (size_t)k * 6144; ld_f32(mr, c.lane, sh); ld_f32(mr + D, c.lane, sc); }
            normmod16r(xv[r], h, g0, sh, sc);
#if USE_I8
            st_i8row((unsigned char*)H, (float*)(c.ws + SA_ROW), m, c.lane, h);
#else
            st_bf16(H + (size_t)m * D, c.lane, h);
#endif
        } }
}
__device__ __forceinline__ void phase_even_elem(const P& p, const Ctx& c) {
    const bf16_t* Z = (const bf16_t*)(c.ws + B_Z); bf16_t* AO = (bf16_t*)(c.ws + B_AOUT0); bf16_t* ZQ = (bf16_t*)(c.ws + B_ZQN); bf16_t* ZKV = (bf16_t*)(c.ws + B_ZKVN); bf16_t* KPE = (bf16_t*)(c.ws + B_KPE);
    const float* rc = (const float*)(c.ws + WS_ROPE); const float* rs = rc + 2048 * 32; const int lane = c.lane;
    float cw[3][8];
#pragma unroll
    for (int t = 0; t < 3; ++t) { const f32x4 w0 = *(const f32x4*)(p.ev_conv_w + t * SCW + 8 * lane), w1 = *(const f32x4*)(p.ev_conv_w + t * SCW + 8 * lane + 4);
#pragma unroll
        for (int i = 0; i < 4; ++i) { cw[t][i] = w0[i]; cw[t][4 + i] = w1[i]; } }
    float gq[8], gkv[8];
    { const int lq = lane < 48 ? lane : 0, lk = lane < 32 ? lane : 0;
      const f32x4 a0 = *(const f32x4*)(p.ev_q_norm_g + 8 * lq), a1 = *(const f32x4*)(p.ev_q_norm_g + 8 * lq + 4), b0 = *(const f32x4*)(p.ev_kv_norm_g + 8 * lk), b1 = *(const f32x4*)(p.ev_kv_norm_g + 8 * lk + 4);
#pragma unroll
      for (int i = 0; i < 4; ++i) { gq[i] = a0[i]; gq[4 + i] = a1[i]; gkv[i] = b0[i]; gkv[4 + i] = b1[i]; } }
    for (int m0 = c.gw * 4; m0 < M; m0 += c.ngw * 4) {
        const int j0 = m0 % S; const int lo = j0 < L ? 0 : L, hi = j0 < L ? L : S; const bf16_t* z0 = Z + (size_t)m0 * 2304;
        u32x4 rcg[6], ruu[6], rbg[4], rzq[4], rzk[4]; float k1[4], k2[4];
#pragma unroll
        for (int r = 0; r < 6; ++r) { const int jj = j0 + r - 1; const bool ok = jj >= lo && jj < hi; const bf16_t* zn = z0 + (long)(r - 1) * 2304;
            rcg[r] = ok ? *(const u32x4*)(zn + SCW + 8 * lane) : (u32x4){0u, 0u, 0u, 0u}; ruu[r] = ok ? *(const u32x4*)(zn + 2 * SCW + 8 * lane) : (u32x4){0u, 0u, 0u, 0u}; }
#pragma unroll
        for (int r = 0; r < 4; ++r) { const bf16_t* zr = z0 + (size_t)r * 2304; rbg[r] = *(const u32x4*)(zr + 8 * lane);
            rzq[r] = lane < 48 ? *(const u32x4*)(zr + SCIN + 8 * lane) : (u32x4){0u, 0u, 0u, 0u}; rzk[r] = lane < 32 ? *(const u32x4*)(zr + SCIN + QRANK + 8 * lane) : (u32x4){0u, 0u, 0u, 0u};
            const bf16_t* kp = zr + SCIN + QRANK + KVRANK; k1[r] = bf2f(kp[lane & 31]); k2[r] = bf2f(kp[32 + (lane & 31)]); }
        float prod[6][8];
#pragma unroll
        for (int r = 0; r < 6; ++r) { float a[8], b[8]; unpack8(rcg[r], a); unpack8(ruu[r], b);
#pragma unroll
            for (int i = 0; i < 8; ++i) prod[r][i] = a[i] * b[i]; }
#pragma unroll
        for (int r = 0; r < 4; ++r) { const int m = m0 + r, j = j0 + r; float bg[8], acc[8]; unpack8(rbg[r], bg);
#pragma unroll
            for (int i = 0; i < 8; ++i) acc[i] = bg[i] * (cw[0][i] * prod[r][i] + cw[1][i] * prod[r + 1][i] + cw[2][i] * prod[r + 2][i]);
            *(u32x4*)(AO + (size_t)m * D + 8 * lane) = pack8f(acc);
            { float v[8]; unpack8(rzq[r], v); float s = 0.f;
#pragma unroll
              for (int i = 0; i < 8; ++i) s += v[i] * v[i];
              s = wave_sum(s); const float rn = 1.0f / sqrtf(s * (1.f / QRANK) + EPS);
#pragma unroll
              for (int i = 0; i < 8; ++i) v[i] *= rn * gq[i];
              if (lane < 48) *(u32x4*)(ZQ + (size_t)m * QRANK + 8 * lane) = pack8f(v); }
            { float v[8]; unpack8(rzk[r], v); float s = 0.f;
#pragma unroll
              for (int i = 0; i < 8; ++i) s += v[i] * v[i];
              s = wave_sum(s); const float rn = 1.0f / sqrtf(s * (1.f / KVRANK) + EPS);
#pragma unroll
              for (int i = 0; i < 8; ++i) v[i] *= rn * gkv[i];
              if (lane < 32) *(u32x4*)(ZKV + (size_t)m * KVRANK + 8 * lane) = pack8f(v); }
            if (lane < 32) { float cs = 1.f, sn = 0.f;
                if (j >= L) { cs = rc[(j - L) * 32 + lane]; sn = rs[(j - L) * 32 + lane]; }
                bf16_t* ko = KPE + (size_t)m * 64; ko[rope_pos(lane)] = f2bf(k1[r] * cs - k2[r] * sn); ko[rope_pos(32 + lane)] = f2bf(k1[r] * sn + k2[r] * cs); }
        }
    }
}
__device__ __forceinline__ void phase_mid0(const P& p, const Ctx& c, bool split) {
    const bf16_t* Y = (const bf16_t*)(c.ws + B_Y); bf16_t* H2 = (bf16_t*)(c.ws + B_H2); int r0, r1; wave_rows(c, M, r0, r1);
    float ng1[16], ng2[16], gt[16], sh[16], sc[16]; ld_f32(p.ev_norm_g + D, c.lane, ng1); ld_f32(p.ev_norm_g + 2 * D, c.lane, ng2); int key = -1;
    for (int m0 = r0; m0 < r1; m0 += 2) { float xv[2][16], y[2][16];
#pragma unroll
        for (int r = 0; r < 2; ++r) { ld_f32(in_row(p, m0 + r), c.lane, xv[r]); ld_bf16(Y + (size_t)(m0 + r) * D, c.lane, y[r]);
            if (split && m0 + r >= 65536) { float y1[16]; ld_bf16((const bf16_t*)(c.ws + B_PART1) + (size_t)(m0 + r - 65536) * D, c.lane, y1);
#pragma unroll
                for (int i = 0; i < 16; ++i) y[r][i] += y1[i]; } }
#pragma unroll
        for (int r = 0; r < 2; ++r) { const int m = m0 + r; float h[16]; const int k = mod_key(m);
            if (k != key) { key = k; const float* mr = (const float*)(c.ws + WS_MODV) + (size_t)k * 6144; ld_f32(mr + 2 * D, c.lane, gt); ld_f32(mr + 3 * D, c.lane, sh); ld_f32(mr + 4 * D, c.lane, sc); }
            resid16r(xv[r], y[r], ng1, gt); if ((m % S) >= L) st_bf16(lat_stream(p, c.ws, tok_of(m)), c.lane, xv[r]); else st_f32(ctx_stream(c.ws, m), c.lane, xv[r]);
            normmod16r(xv[r], h, ng2, sh, sc);
#if USE_I8
            st_i8row((unsigned char*)H2, (float*)(c.ws + SA_ROW), m, c.lane, h);
#else
            st_bf16(H2 + (size_t)m * D, c.lane, h);
#endif
        } }
}
__device__ __forceinline__ void phase_end0(const P& p, const Ctx& c, bool split) {
    const bf16_t* F = (const bf16_t*)(c.ws + B_F); bf16_t* H = (bf16_t*)(c.ws + B_H1); int r0, r1; wave_rows(c, M, r0, r1);
    float ng3[16], ng0[16], gt[16], sh[16], sc[16]; ld_f32(p.ev_norm_g + 3 * D, c.lane, ng3); ld_f32(p.od_norm_g, c.lane, ng0); int key = -1;
    for (int m0 = r0; m0 < r1; m0 += 2) { float xv[2][16], y[2][16];
#pragma unroll
        for (int r = 0; r < 2; ++r) { const int m = m0 + r; if ((m % S) >= L) ld_bf16(lat_stream(p, c.ws, tok_of(m)), c.lane, xv[r]); else ld_f32(ctx_stream(c.ws, m), c.lane, xv[r]); ld_bf16(F + (size_t)m * D, c.lane, y[r]);
            if (split && m >= 65536) { float y1[16]; ld_bf16((const bf16_t*)(c.ws + B_PART1) + (size_t)(m - 65536) * D, c.lane, y1);
#pragma unroll
                for (int i = 0; i < 16; ++i) y[r][i] += y1[i]; } }
#pragma unroll
        for (int r = 0; r < 2; ++r) { const int m = m0 + r; float h[16]; const int k = mod_key(m);
            if (k != key) { key = k; const float* mr = (const float*)(c.ws + WS_MODV) + (size_t)k * 6144; const float* mr1 = mr + (size_t)33 * 6144; ld_f32(mr + 5 * D, c.lane, gt); ld_f32(mr1, c.lane, sh); ld_f32(mr1 + D, c.lane, sc); }
            resid16r(xv[r], y[r], ng3, gt);
            if ((m % S) >= L) st_bf16(lat_stream(p, c.ws, tok_of(m)), c.lane, xv[r]);
            normmod16r(xv[r], h, ng0, sh, sc);
#if USE_I8
            st_i8row((unsigned char*)H, (float*)(c.ws + SA_ROW), m, c.lane, h);
#else
            st_bf16(H + (size_t)m * D, c.lane, h);
#endif
        } }
}
__device__ __forceinline__ void phase_mid1(const P& p, const Ctx& c) {
    const bf16_t* Y = (const bf16_t*)(c.ws + B_Y1); unsigned char* H8 = c.ws + B_H2TOK;
    int* rinfo = (int*)(c.ws + RT_INFO); float* rw = (float*)(c.ws + RT_W); int* wcnt = (int*)(c.ws + RT_WCNT);
    volatile LAS int* wc = (volatile LAS int*)(c.lds) + c.wave * 8; const int lane = c.lane;
    LAS float* rtr = (LAS float*)(c.lds + 1024);
    for (int i = c.tid; i < D * NE; i += 512) rtr[(i & 7) * D + (i >> 3)] = p.od_router[i];
    __syncthreads();
    float ng1[16], ng2[16], gt[16], sh[16], sc[16]; ld_f32(p.od_norm_g + D, lane, ng1); ld_f32(p.od_norm_g + 2 * D, lane, ng2); int key = -1;
    for (int ch = blockIdx.x; ch < NCH; ch += gridDim.x) {
        if (lane < 8) wc[lane] = 0;
        const int b = (ch * 256) / T;
        if (b != key) { key = b; const float* mr = (const float*)(c.ws + WS_MODV) + ((size_t)33 + b) * 6144; ld_f32(mr + 2 * D, lane, gt); ld_f32(mr + 3 * D, lane, sh); ld_f32(mr + 4 * D, lane, sc); }
        for (int i0 = 0; i0 < 32; i0 += 2) {
            const int tok0 = ch * 256 + c.wave * 32 + i0;
            float xv[2][16], y[2][16];
#pragma unroll
            for (int r = 0; r < 2; ++r) { const int tok = tok0 + r, t = tok % T; ld_bf16(lat_stream(p, c.ws, tok), lane, xv[r]); ld_bf16(Y + ((size_t)b * S + L + t) * D, lane, y[r]); }
            int e0[2], e1[2]; float w0[2], w1[2];
#pragma unroll
            for (int r = 0; r < 2; ++r) { const int tok = tok0 + r; float h[16];
                resid16r(xv[r], y[r], ng1, gt); st_bf16(lat_stream(p, c.ws, tok), lane, xv[r]);
                normmod16r(xv[r], h, ng2, sh, sc);
#if MOE_I8
                st_i8row(H8, (float*)(c.ws + SA_TOK), tok, lane, h);
#else
#pragma unroll
                for (int j2 = 0; j2 < 2; ++j2) { u32x2 w; w.x = pg8::pack4_fp8(h[j2 * 8 + 0], h[j2 * 8 + 1], h[j2 * 8 + 2], h[j2 * 8 + 3]); w.y = pg8::pack4_fp8(h[j2 * 8 + 4], h[j2 * 8 + 5], h[j2 * 8 + 6], h[j2 * 8 + 7]);
                    *(u32x2*)(H8 + (size_t)tok * 1024 + 512 * j2 + 8 * lane) = w; }
#endif
                float lg[NE];
#pragma unroll
                for (int e = 0; e < NE; ++e) { float a = 0.f;
#pragma unroll
                    for (int j2 = 0; j2 < 2; ++j2) { const LAS f32x4* rp = (const LAS f32x4*)(rtr + e * D + 512 * j2 + 8 * lane); const f32x4 r0 = rp[0], r1 = rp[1];
#pragma unroll
                        for (int i = 0; i < 4; ++i) { a = fmaf(h[j2 * 8 + i], r0[i], a); a = fmaf(h[j2 * 8 + 4 + i], r1[i], a); } }
                    lg[e] = wave_sum(a); }
                int a0 = 0; float v0 = lg[0];
#pragma unroll
                for (int e = 1; e < NE; ++e) if (lg[e] > v0) { v0 = lg[e]; a0 = e; }
                int a1 = -1; float v1 = -3.0e38f;
#pragma unroll
                for (int e = 0; e < NE; ++e) if (e != a0 && lg[e] > v1) { v1 = lg[e]; a1 = e; }
                const float p1 = expf(v1 - v0); e0[r] = a0; e1[r] = a1; w0[r] = 1.f / (1.f + p1); w1[r] = p1 / (1.f + p1); }
            if (lane == 0) {
#pragma unroll
                for (int r = 0; r < 2; ++r) { const int tok = tok0 + r; const int r0 = wc[e0[r]], r1 = wc[e1[r]]; wc[e0[r]] = r0 + 1; wc[e1[r]] = r1 + 1;
                    *(int4*)(rinfo + (size_t)tok * 4) = make_int4(e0[r], e1[r], r0, r1); *(float2*)(rw + (size_t)tok * 2) = make_float2(w0[r], w1[r]); } }
        }
        asm volatile("s_waitcnt lgkmcnt(0)" ::: "memory");
        if (lane < 8) wcnt[(ch * 8 + c.wave) * 8 + lane] = wc[lane];
    }
}
__device__ __forceinline__ void phase_gather(const P& p, const Ctx& c) {
    const int* rinfo = (const int*)(c.ws + RT_INFO); const int* wcnt = (const int*)(c.ws + RT_WCNT); int* tpos = (int*)(c.ws + RT_POS); int* toffg = (int*)(c.ws + RT_TOFF);
    const unsigned char* H8 = c.ws + B_H2TOK; unsigned char* HS = c.ws + B_H2S;
    LAS int* wpre = (LAS int*)c.lds;
    LAS int* csum = wpre + NCH * 64;
    LAS int* cpre = csum + NCH * 8;
    LAS int* eoff = cpre + NCH * 8;
    for (int i = c.tid; i < NCH * 8; i += 512) { const int ch = i >> 3, e = i & 7; int run = 0;
        for (int w = 0; w < 8; ++w) { wpre[(ch * 8 + w) * 8 + e] = run; run += wcnt[(ch * 8 + w) * 8 + e]; }
        csum[i] = run; }
    __syncthreads();
    if (c.tid < 8) { int run = 0; for (int ch = 0; ch < NCH; ++ch) { cpre[ch * 8 + c.tid] = run; run += csum[ch * 8 + c.tid]; } eoff[16 + c.tid] = run; }
    __syncthreads();
    if (c.tid == 0) { int o = 0; for (int e = 0; e < NE; ++e) { eoff[e] = o; o += (eoff[16 + e] + 255) & ~255; } eoff[NE] = o;
        if (blockIdx.x == 0) { for (int e = 0; e <= NE; ++e) toffg[e] = eoff[e] >> 8; } }
    __syncthreads();
    for (int t0 = c.gw * 2; t0 < ML; t0 += c.ngw * 2) { u32x4 a[2]; int p0[2], p1[2];
#pragma unroll
        for (int r = 0; r < 2; ++r) { const int tok = t0 + r; a[r] = *(const u32x4*)(H8 + (size_t)tok * 1024 + 16 * c.lane);
            const int4 ri = *(const int4*)(rinfo + (size_t)tok * 4); const int ch = tok >> 8, w = (tok >> 5) & 7;
            p0[r] = eoff[ri.x] + cpre[ch * 8 + ri.x] + wpre[(ch * 8 + w) * 8 + ri.x] + ri.z; p1[r] = eoff[ri.y] + cpre[ch * 8 + ri.y] + wpre[(ch * 8 + w) * 8 + ri.y] + ri.w; }
#pragma unroll
        for (int r = 0; r < 2; ++r) { const int tok = t0 + r; if (c.lane == 0) { *(int2*)(tpos + (size_t)tok * 2) = make_int2(p0[r], p1[r]);
#if MOE_I8
                const float scl = ((const float*)(c.ws + SA_TOK))[tok]; ((float*)(c.ws + SA_SORT))[p0[r]] = scl; ((float*)(c.ws + SA_SORT))[p1[r]] = scl;
#endif
            }
            *(u32x4*)(HS + (size_t)p0[r] * 1024 + 16 * c.lane) = a[r]; *(u32x4*)(HS + (size_t)p1[r] * 1024 + 16 * c.lane) = a[r]; } }
    for (int i = c.gw; i < NE * 256; i += c.ngw) { const int e = i >> 8, r = i & 255; const int n = eoff[16 + e], pad = ((n + 255) & ~255) - n;
        if (r < pad) { const u32x4 z = {0u, 0u, 0u, 0u}; *(u32x4*)(HS + (size_t)(eoff[e] + n + r) * 1024 + 16 * c.lane) = z;
#if MOE_I8
            if (c.lane == 0) ((float*)(c.ws + SA_SORT))[eoff[e] + n + r] = 0.f;
#endif
        } }
}
__device__ __forceinline__ void phase_final(const P& p, const Ctx& c, int tlo, int thi, bool tails) {
    const bf16_t* FS = (const bf16_t*)(c.ws + B_FS); const bf16_t* FX = (const bf16_t*)(c.ws + B_FSX); const int* tpos = (const int*)(c.ws + RT_POS); const float* rw = (const float*)(c.ws + RT_W);
    int r0, r1; wave_rows(c, thi - tlo, r0, r1); float ng3[16], gt[16]; ld_f32(p.od_norm_g + 3 * D, c.lane, ng3); int key = -1;
    for (int t0 = tlo + r0; t0 < tlo + r1; t0 += 2) { float xv[2][16], f0[2][16], f1[2][16]; float2 w[2];
#pragma unroll
        for (int r = 0; r < 2; ++r) { const int tok = t0 + r; const int2 ps = *(const int2*)(tpos + (size_t)tok * 2); w[r] = *(const float2*)(rw + (size_t)tok * 2);
            ld_bf16(lat_stream(p, c.ws, tok), c.lane, xv[r]); ld_bf16(FS + (size_t)ps.x * D, c.lane, f0[r]); ld_bf16(FS + (size_t)ps.y * D, c.lane, f1[r]);
            if (tails) {
                const int px = __builtin_amdgcn_readfirstlane(ps.x) - 131072, py = __builtin_amdgcn_readfirstlane(ps.y) - 131072;
                if (px >= 0) for (int q = 0; q < 3; ++q) { float t[16]; ld_bf16(FX + ((size_t)q * 1792 + px) * D, c.lane, t);
#pragma unroll
                    for (int i = 0; i < 16; ++i) f0[r][i] += t[i]; }
                if (py >= 0) for (int q = 0; q < 3; ++q) { float t[16]; ld_bf16(FX + ((size_t)q * 1792 + py) * D, c.lane, t);
#pragma unroll
                    for (int i = 0; i < 16; ++i) f1[r][i] += t[i]; } } }
#pragma unroll
        for (int r = 0; r < 2; ++r) { const int tok = t0 + r, b = tok / T;
#pragma unroll
            for (int i = 0; i < 16; ++i) f0[r][i] = w[r].x * f0[r][i] + w[r].y * f1[r][i];
            if (b != key) { key = b; ld_f32((const float*)(c.ws + WS_MODV) + ((size_t)33 + b) * 6144 + 5 * D, c.lane, gt); }
            resid16r(xv[r], f0[r], ng3, gt); st_f32(p.out + (size_t)tok * D, c.lane, xv[r]); } }
}
constexpr int LDS_BYTES = 147456;
constexpr int LDS_MISC = 131072 + 2048;
constexpr int NPH = 20;

__device__ __forceinline__ void attn_mla_phase(const Ctx& c) {
    const bf16_t* Q0 = (const bf16_t*)(c.ws + B_Q0); const bf16_t* KN = (const bf16_t*)(c.ws + B_K0N); const bf16_t* KPE = (const bf16_t*)(c.ws + B_KPE); const bf16_t* V0 = (const bf16_t*)(c.ws + B_V0);
    bf16_t* AO = (bf16_t*)(c.ws + B_AOUT0);
    constexpr int NU_LAT = NB * MLA_H * 8, NU = NU_LAT + NB * MLA_H;
    const int G = gridDim.x, vcu = (G % 8 == 0) ? ((int)blockIdx.x % 8) * (G / 8) + (int)blockIdx.x / 8 : (int)blockIdx.x;
#pragma unroll 1
    for (int u = vcu; u < NU; u += G) {
        int b, h, row0, seq;
        if (u < NU_LAT) { b = u / 32; h = (u >> 3) & 3; row0 = b * S + L + (u & 7) * 256; seq = S; } else { const int v = u - NU_LAT; b = v >> 2; h = v & 3; row0 = b * S; seq = L; }
        const att::KSrc ks{KN + (size_t)b * S * 512 + h * 128, 512, KPE + (size_t)b * S * 64, 64};
        const att::AOut ao{AO + (size_t)row0 * D + SCW + h * 128, D, nullptr, nullptr, 0.f, 0};
        att::attn_body_np<192>(Q0 + (size_t)row0 * 768 + h * MLA_QK, 768, ks, V0 + (size_t)b * S * 512 + h * 128, 512, seq, (char*)c.lds, ao);
    }
}
#ifndef ATT_DMA
#define ATT_DMA 1
#endif
template <int VAR>
__device__ __forceinline__ void attn_diff_phase(const P& p, const Ctx& c) {
    const bf16_t* Q1 = (const bf16_t*)(c.ws + B_QKV1); const bf16_t* K1 = Q1 + (size_t)M * 768; const bf16_t* V1 = K1 + (size_t)M * 768; bf16_t* AO = (bf16_t*)(c.ws + B_AOUT1);
    float* stash = (float*)(c.ws + WS_STASH) + (size_t)blockIdx.x * 32768;
    float d01 = p.od_lambda[c.lane] * p.od_lambda[64 + c.lane], d23 = p.od_lambda[128 + c.lane] * p.od_lambda[192 + c.lane];
    d01 = wave_sum(d01); d23 = wave_sum(d23); const float lam = expf(d01) - expf(d23) + LAM_INIT;
    constexpr int NU = NB * DIFF_H * 8;
    const int G = gridDim.x, vcu = (G % 8 == 0) ? ((int)blockIdx.x % 8) * (G / 8) + (int)blockIdx.x / 8 : (int)blockIdx.x;
#pragma unroll 1
    for (int i2 = 2 * vcu; i2 < 2 * NU; i2 = (i2 & 1) ? i2 + 2 * G - 1 : i2 + 1) {
        const int it = i2 >> 1, sub = i2 & 1; const int b = it / 48, h = (it >> 3) % 6, row0 = b * S + L + (it & 7) * 256;
        const att::KSrc ks{K1 + (size_t)b * S * 768 + h * 128 + sub * 64, 768, nullptr, 0};
        const att::AOut ao{AO + (size_t)row0 * D + h * 128, D, stash, p.od_subln_g, lam, sub};
#if ATT_DMA
        att::attn_body_dma<1>(Q1 + (size_t)row0 * 768 + h * 128 + sub * 64, 768, ks.ka, 768, V1 + (size_t)b * S * 768 + h * 128, 768, S, (char*)c.lds, ao);
#else
        att::attn_body<64, 2, 1, VAR>(Q1 + (size_t)row0 * 768 + h * 128 + sub * 64, 768, ks, V1 + (size_t)b * S * 768 + h * 128, 768, S, (char*)c.lds, ao);
#endif
    }
}
__device__ __forceinline__ void moe_load_toff(const Ctx& c, pg8::SchedMoe& Sm) {
    const int* toffg = (const int*)(c.ws + RT_TOFF);
#pragma unroll
    for (int e = 0; e <= NE; ++e) Sm.toff[e] = __builtin_amdgcn_readfirstlane(toffg[e]);
}

__global__ void __launch_bounds__(512, 2) fwd(P p) {
    extern __shared__ __attribute__((aligned(16))) unsigned char lds_[];
    Ctx c; c.lds = (LAS unsigned char*)lds_; c.ws = p.ws; c.tid = threadIdx.x; c.lane = c.tid & 63; c.wave = __builtin_amdgcn_readfirstlane(c.tid >> 6);
    c.gw = blockIdx.x * 8 + c.wave; c.ngw = gridDim.x * 8;
    volatile LAS unsigned* misc = (volatile LAS unsigned*)(c.lds + LDS_MISC);
    if (c.tid < 8) misc[c.tid] = 0u;
    __syncthreads();
    const int lo = p.ph_lo, hi = p.ph_hi;
    XcdBarrier bar; bar.bar = (unsigned*)(c.ws + WS_CTL) + CW_BAR; bar.x = 0; bar.st = misc;
    if (hi - lo > 1) bar = xcd_barrier_post((unsigned*)(c.ws + WS_CTL) + CW_BAR, misc);
#ifdef PH_ONLY
#define IN(k) ((k) == PH_ONLY)
#else
#define IN(k) (lo <= (k) && (k) < hi)
#endif
#define SEAM(k) do { if (IN(k) && IN((k) + 1)) xcd_barrier(bar); } while (0)
    LAS unsigned char* lds = c.lds;
    const float* rc = (const float*)(c.ws + WS_ROPE); const float* rs = rc + 2048 * 32;

#ifndef EPI_SKIP
#define EPI_SKIP 0
#endif
#ifndef REPEAT_MASK
#define REPEAT_MASK 0u
#endif
#define REP(k) (((unsigned)(REPEAT_MASK) >> (k)) & 1u)
#ifndef CLK_T
#define CLK_T 10
#endif
#ifndef CLK_PROBE_PH
#define CLK_PROBE_PH -1
#endif
#define CLKP0(k) long long ck0_ = 0, cr0_ = 0; if ((k) == CLK_PROBE_PH && blockIdx.x == 0 && c.tid == 0) { ck0_ = clock64(); cr0_ = wall_clock64(); }
#define CLKP1(k) if ((k) == CLK_PROBE_PH && blockIdx.x == 0 && c.tid == 0) { const long long ck1_ = clock64(), cr1_ = wall_clock64(); ((float*)(c.ws + WS_CTL))[96] = (float)(ck1_ - ck0_) / (float)(cr1_ - cr0_); }
#define PHASE(k, ...) do { if (IN(k)) { CLKP0(k) { const int rp_ = 0; (void)rp_; __VA_ARGS__ } if (REP(k)) { xcd_barrier(bar); { const int rp_ = 1; (void)rp_; __VA_ARGS__ } } CLKP1(k) } SEAM(k); } while (0)
#ifndef P0_REP_PARTS
#define P0_REP_PARTS 7
#endif
    PHASE(0, { phase_prologue(p, c, rp_ ? P0_REP_PARTS : 7, rp_); });
#ifdef EXTRA_BARS
    if (IN(1)) { for (int i_ = 0; i_ < EXTRA_BARS; ++i_) xcd_barrier(bar); }
#endif
    PHASE(1, { phase_norm0(p, c); phase_quant_weights(c); });
#if USE_I8
    PHASE(2, { pg8::Gemm g{512, 512, 512}; pg8::SchedPlain Sc; Sc.init(c.ws + B_H, 512, c.ws + W8_IN0, 512, M / 256, 9, false);
        pg8::EpiPlainI8 E{(bf16_t*)(c.ws + B_Z), 2304, (const float*)(c.ws + SA_ROW), (const float*)(c.ws + SW_IN0)}; pg8::gemm_phase<pg8::EpiPlainI8, pg8::SchedPlain, 2>(lds, g, Sc, E); });
#else
    PHASE(2, { pg8::Gemm g{D, D, D}; pg8::SchedPlain Sc; Sc.init(c.ws + B_H, D, c.ws + W_IN0, D, M / 256, 9, false); pg8::EpiPlain E{(bf16_t*)(c.ws + B_Z), 2304}; pg8::gemm_phase(lds, g, Sc, E); });
#endif
    PHASE(3, { phase_even_elem(p, c); });
    PHASE(4, {
        { pg8::Gemm g{QRANK, QRANK, QRANK}; pg8::SchedPlain Sc; Sc.init(c.ws + B_ZQN, QRANK, c.ws + W_UQ, QRANK, M / 256, 3, false); pg8::EpiQ0 E{(bf16_t*)(c.ws + B_Q0), rc, rs}; pg8::gemm_phase(lds, g, Sc, E); }
        { pg8::Gemm g{KVRANK, KVRANK, KVRANK}; pg8::SchedPlain Sc; Sc.init(c.ws + B_ZKVN, KVRANK, c.ws + W_UKV, KVRANK, M / 256, 4, false); pg8::EpiKV0 E{(bf16_t*)(c.ws + B_K0N), (bf16_t*)(c.ws + B_V0)}; pg8::gemm_phase(lds, g, Sc, E); }
    });
    PHASE(5, { attn_mla_phase(c); });
    const bool split = SPLIT_TAIL && gridDim.x == 256;
    PHASE(6, { if (split) { { pg8::Gemm g{D, D, D}; pg8::SchedPlain Sc; Sc.init(c.ws + B_AOUT0, D, c.ws + W_OUT0, D, 256, 4, false); pg8::EpiPlain E{(bf16_t*)(c.ws + B_Y), D}; pg8::gemm_phase(lds, g, Sc, E); }
            { pg8::Gemm g{D, D, D / 2}; pg8::SchedTailK2 Sc{(const char*)(c.ws + B_AOUT0), (const char*)(c.ws + W_OUT0), (size_t)256 * D * 2, (size_t)256 * D * 2, (size_t)D, (int)gridDim.x, (int)blockIdx.x};
              pg8::EpiPlainK2 E{(bf16_t*)(c.ws + B_Y), (bf16_t*)(c.ws + B_PART1), D}; pg8::gemm_phase(lds, g, Sc, E); } }
        else { pg8::Gemm g{D, D, D}; pg8::SchedPlain Sc; Sc.init(c.ws + B_AOUT0, D, c.ws + W_OUT0, D, M / 256, 4, false); pg8::EpiPlain E{(bf16_t*)(c.ws + B_Y), D}; pg8::gemm_phase(lds, g, Sc, E); } });
    PHASE(7, { phase_mid0(p, c, split); });
#if USE_I8
    PHASE(8, { pg8::Gemm g{512, 512, 512}; pg8::SchedPlain Sc; Sc.init(c.ws + B_H2, 512, c.ws + W8_GU0, 512, M / 256, 22, false);
        pg8::EpiSwigluI8 E{(void*)(c.ws + B_ACT), FF, (const float*)(c.ws + SA_ROW), (const float*)(c.ws + SW_GU0), 0, DN0_FP8 ? 8.f : 1.f, DN0_FP8 != 0}; pg8::gemm_phase<pg8::EpiSwigluI8, pg8::SchedPlain, 2>(lds, g, Sc, E); });
    PHASE(9, { if (DN0_FP8) { pg8::Gemm g{FF / 2, FF / 2, FF / 2, 0x7c7c7c7c, 0x79797979};
            { pg8::SchedPlain Sc; Sc.init(c.ws + B_ACT, FF / 2, c.ws + W_DN0, FF / 2, split ? 256 : M / 256, 4, false); pg8::EpiPlain E{(bf16_t*)(c.ws + B_F), D}; pg8::gemm_phase<pg8::EpiPlain, pg8::SchedPlain, true>(lds, g, Sc, E); }
            if (split) { pg8::SchedTailParts Sc{(const char*)(c.ws + B_ACT), (const char*)(c.ws + W_DN0), (size_t)256 * FF, (size_t)256 * FF, 256, 32, 4, 2, 12, 10, (int)gridDim.x, (int)blockIdx.x};
              pg8::EpiPlainK2 E{(bf16_t*)(c.ws + B_F), (bf16_t*)(c.ws + B_PART1), D}; pg8::gemm_phase<pg8::EpiPlainK2, pg8::SchedTailParts, true>(lds, g, Sc, E); } }
        else if (split) { { pg8::Gemm g{FF, FF, FF}; pg8::SchedPlain Sc; Sc.init(c.ws + B_ACT, FF, c.ws + W_DN0, FF, 256, 4, false); pg8::EpiPlain E{(bf16_t*)(c.ws + B_F), D}; pg8::gemm_phase(lds, g, Sc, E); }
            { pg8::Gemm g{FF, FF, FF / 2}; pg8::SchedTailK2 Sc{(const char*)(c.ws + B_ACT), (const char*)(c.ws + W_DN0), (size_t)256 * FF * 2, (size_t)256 * FF * 2, (size_t)FF, (int)gridDim.x, (int)blockIdx.x};
              pg8::EpiPlainK2 E{(bf16_t*)(c.ws + B_F), (bf16_t*)(c.ws + B_PART1), D}; pg8::gemm_phase(lds, g, Sc, E); } }
        else { pg8::Gemm g{FF, FF, FF}; pg8::SchedPlain Sc; Sc.init(c.ws + B_ACT, FF, c.ws + W_DN0, FF, M / 256, 4, false); pg8::EpiPlain E{(bf16_t*)(c.ws + B_F), D}; pg8::gemm_phase(lds, g, Sc, E); } });
#elif FFN0_FP8
    PHASE(8, { pg8::Gemm g{512, 512, 512, 0x7f7f7f7f, 0x7a7a7a7a, 0x7d7d7d7d}; pg8::SchedPlain Sc; Sc.init(c.ws + B_H2, 512, c.ws + W_GU0, 512, M / 256, 22, false); pg8::EpiSwiglu8 E{c.ws + B_ACT, FF, 8.f}; pg8::gemm_phase<pg8::EpiSwiglu8, pg8::SchedPlain, true>(lds, g, Sc, E); });
    PHASE(9, { pg8::Gemm g{FF / 2, FF / 2, FF / 2, 0x7c7c7c7c, 0x79797979}; pg8::SchedPlain Sc; Sc.init(c.ws + B_ACT, FF / 2, c.ws + W_DN0, FF / 2, M / 256, 4, false); pg8::EpiPlain E{(bf16_t*)(c.ws + B_F), D}; pg8::gemm_phase<pg8::EpiPlain, pg8::SchedPlain, true>(lds, g, Sc, E); });
#else
    PHASE(8, { pg8::Gemm g{D, D, D}; pg8::SchedPlain Sc; Sc.init(c.ws + B_H2, D, c.ws + W_GU0, D, M / 256, 22, false); pg8::EpiSwiglu E{(bf16_t*)(c.ws + B_ACT), FF, (rp_ == 0 && REP(8)) ? EPI_SKIP : 0}; pg8::gemm_phase(lds, g, Sc, E); });
    PHASE(9, { pg8::Gemm g{FF, FF, FF}; pg8::SchedPlain Sc; Sc.init(c.ws + B_ACT, FF, c.ws + W_DN0, FF, M / 256, 4, false); pg8::EpiPlain E{(bf16_t*)(c.ws + B_F), D}; pg8::gemm_phase(lds, g, Sc, E); });
#endif
    PHASE(10, { phase_end0(p, c, split); });
#if USE_I8
    PHASE(11, {
        { pg8::Gemm g{512, 512, 512}; pg8::SchedQKV1 Sc{(const char*)(c.ws + B_H1), (const char*)(c.ws + W8_IN1), (int)gridDim.x, (int)blockIdx.x, 1024};
          pg8::EpiQKV1I8 E{(bf16_t*)(c.ws + B_QKV1), (size_t)M * 768, (const float*)(c.ws + SA_ROW), (const float*)(c.ws + SW_IN1)}; pg8::gemm_phase<pg8::EpiQKV1I8, pg8::SchedQKV1, 2>(lds, g, Sc, E); }
        { pg8::Gemm g{512, 512, 512}; pg8::SchedF1 Sc{(const char*)(c.ws + W8_FOLD), (const char*)(c.ws + B_H1), NB * 8, (int)gridDim.x, (int)blockIdx.x, 1024};
          pg8::EpiGTI8 E{(bf16_t*)(c.ws + B_GT), (const float*)(c.ws + SW_FOLD), (const float*)(c.ws + SA_ROW)}; pg8::gemm_phase<pg8::EpiGTI8, pg8::SchedF1, 2>(lds, g, Sc, E); }
    });
#else
    PHASE(11, {
        { pg8::Gemm g{D, D, D}; pg8::SchedQKV1 Sc{(const char*)(c.ws + B_H1), (const char*)(c.ws + W_IN1), (int)gridDim.x, (int)blockIdx.x}; pg8::EpiQKV1 E{(bf16_t*)(c.ws + B_QKV1), (size_t)M * 768, rc, rs}; pg8::gemm_phase(lds, g, Sc, E); }
        { pg8::Gemm g{D, D, D}; pg8::SchedF1 Sc{(const char*)(c.ws + W_FOLD), (const char*)(c.ws + B_H1), NB * 8, (int)gridDim.x, (int)blockIdx.x}; pg8::EpiGT E{(bf16_t*)(c.ws + B_GT)}; pg8::gemm_phase(lds, g, Sc, E); }
    });
#endif
    PHASE(12, {
        { pg8::Gemm g{4096, 4096, 4096}; pg8::SchedF2 Sc{(const char*)(c.ws + W_DFT), (const char*)(c.ws + B_GT), (int)gridDim.x, (int)blockIdx.x}; pg8::EpiPlain E{(bf16_t*)(c.ws + B_AOUT1) + DIFFW, D}; pg8::gemm_phase(lds, g, Sc, E); }
#ifndef ATT_VAR
#define ATT_VAR 0
#endif
        if (rp_ == 0 && REP(12)) attn_diff_phase<ATT_VAR>(p, c); else attn_diff_phase<0>(p, c);
    });
    PHASE(13, { pg8::Gemm g{D, D, D}; pg8::SchedPlain Sc; Sc.init(c.ws + B_AOUT1, D, c.ws + W_OUT1, D, NB * 8, 4, true); pg8::EpiPlain E{(bf16_t*)(c.ws + B_Y1), D}; pg8::gemm_phase(lds, g, Sc, E); });
    PHASE(14, { phase_mid1(p, c); });
    PHASE(15, { phase_gather(p, c); });
#if MOE_I8
    PHASE(16, { pg8::SchedMoe Sm; moe_load_toff(c, Sm);
        Sm.A = (const char*)(c.ws + B_H2S); Sm.W = (const char*)(c.ws + W_GU1); Sm.at = (size_t)256 * 1024; Sm.bt = (size_t)256 * 1024; Sm.estride = (size_t)5632 * 1024; Sm.t0 = 0; Sm.nT = Sm.toff[NE]; Sm.nN = 22; Sm.G = gridDim.x; Sm.c = blockIdx.x;
        pg8::Gemm g{512, 512, 512}; pg8::EpiSwigluI8 E{(void*)(c.ws + B_ACTM), FF, (const float*)(c.ws + SA_SORT), (const float*)(c.ws + SW_GU1), 5632, 8.f, true}; pg8::gemm_phase<pg8::EpiSwigluI8, pg8::SchedMoe, 2>(lds, g, Sm, E); });
#else
    PHASE(16, { pg8::SchedMoe Sm; moe_load_toff(c, Sm);
        Sm.A = (const char*)(c.ws + B_H2S); Sm.W = (const char*)(c.ws + W_GU1); Sm.at = (size_t)256 * 1024; Sm.bt = (size_t)256 * 1024; Sm.estride = (size_t)5632 * 1024; Sm.t0 = 0; Sm.nT = Sm.toff[NE]; Sm.nN = 22; Sm.G = gridDim.x; Sm.c = blockIdx.x;
        pg8::Gemm g{512, 512, 512, 0x7f7f7f7f, 0x7a7a7a7a, 0x7d7d7d7d}; pg8::EpiSwiglu8 E{c.ws + B_ACTM, FF, 8.f, (rp_ == 0 && REP(16)) ? EPI_SKIP : 0}; pg8::gemm_phase<pg8::EpiSwiglu8, pg8::SchedMoe, true>(lds, g, Sm, E); });
#endif
    PHASE(17, { pg8::SchedMoe Sm; moe_load_toff(c, Sm);
        Sm.A = (const char*)(c.ws + B_ACTM); Sm.W = (const char*)(c.ws + W_DN1); Sm.at = (size_t)256 * FF; Sm.bt = (size_t)256 * FF; Sm.estride = (size_t)1024 * 2816; Sm.t0 = 0; Sm.nT = Sm.toff[NE]; Sm.nN = 4; Sm.G = gridDim.x; Sm.c = blockIdx.x;
        pg8::Gemm g{FF / 2, FF / 2, FF / 2, 0x7c7c7c7c, 0x79797979}; pg8::EpiPlain E{(bf16_t*)(c.ws + B_FS), D};
        if (split) {
            const int nT = Sm.toff[NE]; Sm.nT = nT < 512 ? nT : 512; pg8::gemm_phase<pg8::EpiPlain, pg8::SchedMoe, true>(lds, g, Sm, E);
            if (nT > 512) { pg8::SchedMoeTail St; St.A = Sm.A; St.W = Sm.W; St.at = Sm.at; St.bt = Sm.bt; St.estride = Sm.estride; St.pm0 = 512; St.nTail = (nT - 512) < 7 ? (nT - 512) : 7; St.nN = 4; St.t0 = 6; St.t1 = 4; St.G = gridDim.x; St.c = blockIdx.x;
                _Pragma("unroll") for (int e = 0; e <= NE; ++e) St.toff[e] = Sm.toff[e];
                pg8::EpiPlainParts Ep{(bf16_t*)(c.ws + B_FS), (bf16_t*)(c.ws + B_FSX), D, 131072, 1792}; pg8::gemm_phase<pg8::EpiPlainParts, pg8::SchedMoeTail, true>(lds, g, St, Ep); } }
        else pg8::gemm_phase<pg8::EpiPlain, pg8::SchedMoe, true>(lds, g, Sm, E); });
    PHASE(18, { phase_final(p, c, 0, ML / 2, split); });
    PHASE(19, { phase_final(p, c, ML / 2, ML, split); });
    if (CLK_PROBE_PH >= 0 && IN(19)) {
        xcd_barrier(bar); const float f = __hip_atomic_load((float*)(c.ws + WS_CTL) + 96, __ATOMIC_RELAXED, __HIP_MEMORY_SCOPE_AGENT); const float sc_ = 1.f + (f > (float)CLK_T ? 1.f : 0.f) + (f > 2.f * (float)CLK_T ? 1.f : 0.f);
        for (size_t i = (size_t)blockIdx.x * 512 + c.tid; i < (size_t)ML * D; i += (size_t)gridDim.x * 512) p.out[i] = p.x[i] * sc_; }
#undef PHASE
#undef REP
#undef IN
#undef SEAM
}
}
#ifndef CHECK_MODE
#define CHECK_MODE 0
#endif
#ifndef ONE_LAUNCH
#define ONE_LAUNCH 1
#endif

static fp::P make_params(void* const* d_in, void* d_out, void* d_ws) {
    fp::P p{}; const float** q = (const float**)&p; for (int i = 0; i < 28; ++i) q[i] = (const float*)d_in[i];
    p.out = (float*)d_out; p.ws = (unsigned char*)d_ws; p.ph_lo = 0; p.ph_hi = fp::NPH; return p;
}
static int fast_grid() {
    static int grid = 0;
    if (grid == 0) {
        int dev = 0, cus = 0;
        if (hipGetDevice(&dev) != hipSuccess || hipDeviceGetAttribute(&cus, hipDeviceAttributeMultiprocessorCount, dev) != hipSuccess) { grid = -1; return grid; }
        if (hipFuncSetAttribute((const void*)fp::fwd, hipFuncAttributeMaxDynamicSharedMemorySize, fp::LDS_BYTES) != hipSuccess) { grid = -1; return grid; }
        int per_cu = 0; (void)hipOccupancyMaxActiveBlocksPerMultiprocessor(&per_cu, (const void*)fp::fwd, 512, fp::LDS_BYTES); (void)hipGetLastError();
        if (per_cu < 1) fprintf(stderr, "occupancy query reports %d blocks per CU\n", per_cu);
        grid = cus > 256 ? 256 : cus;
    }
    return grid;
}
static void fast_forward(void* const* d_in, void* d_out, void* d_ws, hipStream_t stream, int ph_end, bool one_launch) {
    const int grid = fast_grid(); if (grid <= 0) return;
    (void)hipMemsetAsync((char*)d_ws + fp::WS_CTL, 0, fp::CTL_BYTES, stream);
    fp::P p = make_params(d_in, d_out, d_ws);
    if (one_launch) { p.ph_lo = 0; p.ph_hi = ph_end; hipLaunchKernelGGL(fp::fwd, dim3(grid), dim3(512), fp::LDS_BYTES, stream, p); }
    else for (int k = 0; k < ph_end; ++k) { p.ph_lo = k; p.ph_hi = k + 1; hipLaunchKernelGGL(fp::fwd, dim3(grid), dim3(512), fp::LDS_BYTES, stream, p); }
}

#if CHECK_MODE
namespace chk {
using namespace cfg;
__device__ __forceinline__ int rope_pos(int e) { return e < 32 ? 8 * (e >> 2) + (e & 3) : 8 * ((e - 32) >> 2) + 4 + (e & 3); }
__global__ void k_cmp(const void* fast, int fast_bf16, int ldf, int fcol0, const float* ref, int ldr, int rcol0, int rows, int cols, int rowmode, int perm, float* acc) {
    float sd = 0.f, sr = 0.f;
    for (long i = (long)blockIdx.x * 256 + threadIdx.x; i < (long)rows * cols; i += (long)gridDim.x * 256) {
        const int r = (int)(i / cols), ci = (int)(i % cols); int rr = r, fr = r;
        if (rowmode == 1 && (r % S) < L) continue;
        if (rowmode == 3 && (r % S) >= L) continue;
        if (rowmode == 2) { rr = (r / T) * S + L + (r % T); }
        int fc = ci;
        if (perm == 1) { const int h = ci / 192, w = ci % 192; fc = w < 128 ? ci : h * 192 + 128 + rope_pos(w - 128); }
        if (perm == 2) { fc = (ci & ~63) + rope_pos(ci & 63); }
        if (perm == 3) { fc = rope_pos(ci); }
        const float rv = ref[(long)rr * ldr + rcol0 + ci];
        const float fv = fast_bf16 ? __uint_as_float(((unsigned)((const unsigned short*)fast)[(long)fr * ldf + fcol0 + fc]) << 16) : ((const float*)fast)[(long)fr * ldf + fcol0 + fc];
        const float d = fv - rv; sd += d * d; sr += rv * rv;
    }
    for (int o = 32; o >= 1; o >>= 1) { sd += __shfl_xor(sd, o); sr += __shfl_xor(sr, o); }
    if ((threadIdx.x & 63) == 0) { atomicAdd(acc, sd); atomicAdd(acc + 1, sr); }
}
__global__ void k_cmp_gt(const unsigned short* gt, const float* gcs, int nb, float* acc) {
    float sd = 0.f, sr = 0.f;
    for (long i = (long)blockIdx.x * 256 + threadIdx.x; i < (long)nb * 2 * T * 256; i += (long)gridDim.x * 256) {
        const int c = (int)(i % 256); const int t = (int)((i / 256) % T); const int part = (int)((i / (256L * T)) % 2); const int b = (int)(i / (256L * T * 2));
        const float rv = gcs[i]; const float fv = __uint_as_float(((unsigned)gt[(((long)b * 256 + c) * 2 + part) * T + t]) << 16);
        const float d = fv - rv; sd += d * d; sr += rv * rv; }
    for (int o = 32; o >= 1; o >>= 1) { sd += __shfl_xor(sd, o); sr += __shfl_xor(sr, o); }
    if ((threadIdx.x & 63) == 0) { atomicAdd(acc, sd); atomicAdd(acc + 1, sr); }
}
__global__ void k_encode(const float* acc, int nchecks, float tol, const float* x, float* out, long n) {
    int code = 0;
    for (int k = 0; k < nchecks; ++k) { const float sd = acc[2 * k], sr = acc[2 * k + 1]; if (!(sd <= tol * sr) || !(sr > 0.f)) { code = k + 1; break; } }
    const float s = 1.f + (float)code;
    for (long i = (long)blockIdx.x * 256 + threadIdx.x; i < n; i += (long)gridDim.x * 256) out[i] = x[i] * s;
}
}
#endif

extern "C" void kernel_launch(void* const* d_in, const int* in_sizes, int n_in, void* d_out, int out_size, void* d_ws, size_t ws_size, hipStream_t stream) {
    (void)in_sizes; (void)n_in; (void)out_size;
#if CHECK_MODE
    using namespace cfg; using fp::M; using fp::ML;
    const nv::In I = nv::make_in(d_in);
    nv::Scratch s; char* nbase = (char*)d_ws + ((fp::AR_END + 4095) / 4096) * 4096;
    size_t need = nv::Scratch::carve(s, nbase, NB);
    float* snap0 = (float*)(nbase + need); need += (size_t)M * D * 4;
    float* snap1 = (float*)(nbase + need); need += (size_t)M * D * 4;
    float* snap2 = (float*)(nbase + need); need += (size_t)M * D * 4;
    float* acc = (float*)(nbase + need); need += 4096;
    if ((size_t)(nbase - (char*)d_ws) + need > ws_size) { fprintf(stderr, "check build: ws too small\n"); return; }
    nv::global_setup(stream, I, s);
    nv::forward_chunk(stream, I, s, 0, NB, nullptr, CHECK_MODE == 1 ? 3 : 7, snap0, snap1, snap2);
    fast_forward(d_in, d_out, d_ws, stream, CHECK_MODE == 1 ? 10 : fp::NPH, ONE_LAUNCH != 0);
    (void)hipMemsetAsync(acc, 0, 4096, stream);
    unsigned char* ws = (unsigned char*)d_ws; int k = 0;
#define CMP(fast, isbf, ldf, fc0, ref, ldr, rc0, rows, cols, rowmode, perm) do { hipLaunchKernelGGL(chk::k_cmp, dim3(512), dim3(256), 0, stream, (const void*)(fast), isbf, ldf, fc0, ref, ldr, rc0, rows, cols, rowmode, perm, acc + 2 * k); ++k; } while (0)
#if CHECK_MODE == 1
    CMP(ws + fp::WS_MODV, 0, 6144, 0, s.mod0, 6144, 0, 33, 6144, 0, 0);
    CMP(ws + fp::WS_MODV + (size_t)33 * 6144 * 4, 0, 6144, 0, s.mod1, 6144, 0, 33, 6144, 0, 0);
    CMP(ws + fp::B_Z, 1, 2304, 0, s.z, EVEN_IN, 0, M, EVEN_IN, 0, 0);
    CMP(ws + fp::B_AOUT0, 1, D, 0, s.aout, D, 0, M, SCW, 0, 0);
    CMP(ws + fp::B_ZQN, 1, QRANK, 0, s.zqn, QRANK, 0, M, QRANK, 0, 0);
    CMP(ws + fp::B_ZKVN, 1, KVRANK, 0, s.zkvn, KVRANK, 0, M, KVRANK, 0, 0);
    CMP(ws + fp::B_KPE, 1, 64, 0, s.Kf, 768, 128, M, 64, 0, 3);
    CMP(ws + fp::B_Q0, 1, 768, 0, s.Qf, 768, 0, M, 768, 0, 1);
    for (int h = 0; h < 4; ++h) CMP(ws + fp::B_K0N, 1, 512, h * 128, s.Kf, 768, h * 192, M, 128, 0, 0);
    CMP(ws + fp::B_V0, 1, 512, 0, s.Vf, 512, 0, M, 512, 0, 0);
    CMP(ws + fp::B_AOUT0, 1, D, SCW, s.aout, D, SCW, M, 512, 1, 0);
    CMP(ws + fp::B_AOUT0, 1, D, SCW, s.aout, D, SCW, M, 512, 3, 0);
    CMP(ws + fp::B_Y, 1, D, 0, s.y, D, 0, M, D, 0, 0);
    CMP(ws + fp::B_ACT, 1, FF, 0, s.act, FF, 0, M, FF, 0, 0);
    CMP(ws + fp::B_F, 1, D, 0, s.f, D, 0, M, D, 0, 0);
#else
    CMP(ws + fp::B_QKV1, 1, 768, 0, s.Qf, 768, 0, M, 768, 1, 2);
    CMP(ws + fp::B_QKV1 + (size_t)M * 1536, 1, 768, 0, s.Kf, 768, 0, M, 768, 0, 2);
    CMP(ws + fp::B_QKV1 + (size_t)M * 3072, 1, 768, 0, s.z, ODD_IN, 2 * DIFFW, M, 768, 0, 0);
    hipLaunchKernelGGL(chk::k_cmp_gt, dim3(512), dim3(256), 0, stream, (const unsigned short*)(ws + fp::B_GT), s.gcs, NB, acc + 2 * k); ++k;
    CMP(ws + fp::B_AOUT1, 1, D, DIFFW, s.aout, D, DIFFW, M, FNW, 1, 0);
    CMP(ws + fp::B_AOUT1, 1, D, 0, s.aout, D, 0, M, DIFFW, 1, 0);
    CMP(ws + fp::B_Y1, 1, D, 0, s.y, D, 0, M, D, 1, 0);
    CMP(d_out, 0, D, 0, s.xs, D, 0, ML, D, 2, 0);
#endif
#undef CMP
    hipLaunchKernelGGL(chk::k_encode, dim3(2048), dim3(256), 0, stream, acc, k, 2e-3f, (const float*)d_in[0], (float*)d_out, (long)FULLB * T * D);
#else
    if (ws_size < fp::AR_END) { fprintf(stderr, "kernel_launch: workspace too small: need %zu have %zu\n", (size_t)fp::AR_END, ws_size); return; }
    fast_forward(d_in, d_out, d_ws, stream, fp::NPH, ONE_LAUNCH != 0);
#endif
}
```

```cpp
#include <hip/hip_runtime.h>
#include <cstdio>
#include <cstdint>
#include <cmath>

#ifndef CFG_NB
#define CFG_NB 32
#endif
namespace cfg {
constexpr int NB = CFG_NB;
constexpr int FULLB = 32;
constexpr int D = 1024, T = 2048, L = 256, S = T + L;
constexpr int GW = 64;
constexpr float EPS = 1e-6f;
constexpr int SCW = 512, SCIN = 1536;
constexpr int MLA_H = 4, MLA_NOPE = 128, MLA_ROPE = 64, MLA_V = 128, MLA_QK = 192, QRANK = 384, KVRANK = 256;
constexpr int EVEN_IN = 2240;
constexpr int DIFFW = 768, DIFF_H = 6, DIFF_HD = 64;
constexpr int FNW = 256, FNG = 4, FNGD = 64, ODD_IN = 2560;
constexpr int FF = 2816, NE = 8;
constexpr float LAM_INIT = 0.35550906759096944f;
}
namespace fp {
using namespace cfg;
#define LAS __attribute__((address_space(3)))
#define GAS __attribute__((address_space(1)))
typedef unsigned short bf16_t;
typedef short bf16x8 __attribute__((ext_vector_type(8)));
typedef short s16x4 __attribute__((ext_vector_type(4)));
typedef float f32x4 __attribute__((ext_vector_type(4)));
typedef float f32x2 __attribute__((ext_vector_type(2)));
typedef float f32x16 __attribute__((ext_vector_type(16)));
typedef unsigned u32x4 __attribute__((ext_vector_type(4)));
typedef unsigned u32x2 __attribute__((ext_vector_type(2)));

__device__ __forceinline__ unsigned cvt_pk_bf16(float lo, float hi) { unsigned r; asm volatile("v_cvt_pk_bf16_f32 %0, %1, %2" : "=v"(r) : "v"(lo), "v"(hi)); return r; }
__device__ __forceinline__ float bf2f(unsigned short b) { return __uint_as_float(((unsigned)b) << 16); }
__device__ __forceinline__ float bflo(unsigned w) { return __uint_as_float(w << 16); }
__device__ __forceinline__ float bfhi(unsigned w) { return __uint_as_float(w & 0xffff0000u); }
__device__ __forceinline__ unsigned short f2bf(float f) { return (unsigned short)(cvt_pk_bf16(f, 0.f) & 0xffffu); }
__device__ __forceinline__ float wave_sum(float v) {
    v += __builtin_bit_cast(float, __builtin_amdgcn_update_dpp(0, __builtin_bit_cast(int, v), 0xB1, 0xF, 0xF, true));
    v += __builtin_bit_cast(float, __builtin_amdgcn_update_dpp(0, __builtin_bit_cast(int, v), 0x4E, 0xF, 0xF, true));
    v += __builtin_bit_cast(float, __builtin_amdgcn_update_dpp(0, __builtin_bit_cast(int, v), 0x141, 0xF, 0xF, true));
    v += __builtin_bit_cast(float, __builtin_amdgcn_update_dpp(0, __builtin_bit_cast(int, v), 0x140, 0xF, 0xF, true));
    const int vi = __builtin_bit_cast(int, v);
    const float r0 = __builtin_bit_cast(float, __builtin_amdgcn_readlane(vi, 0)), r1 = __builtin_bit_cast(float, __builtin_amdgcn_readlane(vi, 16)),
                r2 = __builtin_bit_cast(float, __builtin_amdgcn_readlane(vi, 32)), r3 = __builtin_bit_cast(float, __builtin_amdgcn_readlane(vi, 48));
    return (r0 + r1) + (r2 + r3);
}
__device__ __forceinline__ float wave_max(float v) {
    v = fmaxf(v, __builtin_bit_cast(float, __builtin_amdgcn_update_dpp(0, __builtin_bit_cast(int, v), 0xB1, 0xF, 0xF, true)));
    v = fmaxf(v, __builtin_bit_cast(float, __builtin_amdgcn_update_dpp(0, __builtin_bit_cast(int, v), 0x4E, 0xF, 0xF, true)));
    v = fmaxf(v, __builtin_bit_cast(float, __builtin_amdgcn_update_dpp(0, __builtin_bit_cast(int, v), 0x141, 0xF, 0xF, true)));
    v = fmaxf(v, __builtin_bit_cast(float, __builtin_amdgcn_update_dpp(0, __builtin_bit_cast(int, v), 0x140, 0xF, 0xF, true)));
    const int vi = __builtin_bit_cast(int, v);
    const float r0 = __builtin_bit_cast(float, __builtin_amdgcn_readlane(vi, 0)), r1 = __builtin_bit_cast(float, __builtin_amdgcn_readlane(vi, 16)),
                r2 = __builtin_bit_cast(float, __builtin_amdgcn_readlane(vi, 32)), r3 = __builtin_bit_cast(float, __builtin_amdgcn_readlane(vi, 48));
    return fmaxf(fmaxf(r0, r1), fmaxf(r2, r3));
}
__device__ __forceinline__ unsigned pack4_i8(float a, float b, float c, float d) {
    const int ia = (int)rintf(a), ib = (int)rintf(b), ic = (int)rintf(c), id = (int)rintf(d);
    return (unsigned)(ia & 0xff) | ((unsigned)(ib & 0xff) << 8) | ((unsigned)(ic & 0xff) << 16) | ((unsigned)id << 24); }
__device__ __forceinline__ float quant_row_i8(const float (&v)[16], u32x2 (&q)[2]) {
    float am = 0.f;
#pragma unroll
    for (int i = 0; i < 16; ++i) am = fmaxf(am, fabsf(v[i]));
    am = wave_max(am); const float scale = am > 0.f ? am * (1.f / 127.f) : 1.f, inv = 1.f / scale;
#pragma unroll
    for (int j2 = 0; j2 < 2; ++j2) { q[j2].x = pack4_i8(v[j2 * 8 + 0] * inv, v[j2 * 8 + 1] * inv, v[j2 * 8 + 2] * inv, v[j2 * 8 + 3] * inv); q[j2].y = pack4_i8(v[j2 * 8 + 4] * inv, v[j2 * 8 + 5] * inv, v[j2 * 8 + 6] * inv, v[j2 * 8 + 7] * inv); }
    return scale;
}
__device__ __forceinline__ float silu_f(float v) { return v / (1.f + __expf(-v)); }

#define XB_TMO      128
#define XB_XCNT(j)  (256  + 64 * (j))
#define XB_XSUB(j)  (1280 + 64 * (j))
#define XB_XGEN(j)  (2304 + 64 * (j))
#define XB_TOP      3328
#define XB_TOPGEN   3392
#define XCD_BAR_WORDS 3456
#define XB_SPIN_CAP (1u << 18)
__device__ __forceinline__ unsigned xb_ld(unsigned* p)              { return __hip_atomic_load(p, __ATOMIC_RELAXED, __HIP_MEMORY_SCOPE_AGENT); }
__device__ __forceinline__ unsigned xb_add(unsigned* p, unsigned v) { return __hip_atomic_fetch_add(p, v, __ATOMIC_RELAXED, __HIP_MEMORY_SCOPE_AGENT); }
__device__ __forceinline__ unsigned xb_xcc_id() { return (unsigned)__builtin_amdgcn_s_getreg((3 << 11) | 20) & 0xFu; }
#define XB_SPIN(cond, bar) do { unsigned _sp = 0; while (cond) { __builtin_amdgcn_s_sleep(1); \
    if ((++_sp & 255u) == 0u) { if (xb_ld(&(bar)[XB_TMO])) break; if (_sp > XB_SPIN_CAP) { atomicAdd(&(bar)[XB_TMO], 1u); break; } } } } while (0)
struct XcdBarrier { unsigned* bar; unsigned x; volatile LAS unsigned* st; };
__device__ __forceinline__ XcdBarrier xcd_barrier_post(unsigned* bar, volatile LAS unsigned* st) {
    XcdBarrier b; b.bar = bar; b.x = xb_xcc_id(); b.st = st;
    if (threadIdx.x == 0) (void)xb_add(&bar[XB_XCNT(b.x)], 1u);
    return b;
}
__device__ __forceinline__ void xcd_barrier_complete(unsigned* bar, unsigned x, unsigned& nloc, unsigned& nx) {
    const unsigned G = gridDim.x * gridDim.y * gridDim.z;
    unsigned sum, cnt, mine, sp = 0u;
    for (;;) {
        sum = 0u; cnt = 0u; mine = 0u;
#pragma unroll
        for (unsigned j = 0; j < 16; ++j) { const unsigned c = xb_ld(&bar[XB_XCNT(j)]); sum += c; cnt += (c > 0u) ? 1u : 0u; mine = (j == x) ? c : mine; }
        if (sum == G) break;
        __builtin_amdgcn_s_sleep(1);
        if ((++sp & 255u) == 0u) { if (xb_ld(&bar[XB_TMO])) break; if (sp > XB_SPIN_CAP) { atomicAdd(&bar[XB_TMO], 1u); break; } }
    }
    nloc = mine > 0u ? mine : 1u; nx = cnt > 0u ? cnt : 1u;
}
__device__ __forceinline__ void xcd_barrier(const XcdBarrier& b) {
    asm volatile("s_waitcnt vmcnt(0)" ::: "memory");
    __syncthreads();
    if (threadIdx.x == 0) {
        unsigned* bar = b.bar;
        __builtin_amdgcn_s_waitcnt(0);
        unsigned nloc = b.st[0], nx = b.st[1];
        if (nloc == 0u) { xcd_barrier_complete(bar, b.x, nloc, nx); b.st[0] = nloc; b.st[1] = nx; }
        const unsigned old = xb_add(&bar[XB_XSUB(b.x)], 1u);
        const unsigned gen = old / nloc;
        if (old + 1u == (gen + 1u) * nloc) {
            __builtin_amdgcn_fence(__ATOMIC_RELEASE, "agent");
            asm volatile("s_waitcnt vmcnt(0)" ::: "memory");
            const unsigned og = xb_add(&bar[XB_TOP], 1u);
            const unsigned tg = og / nx;
            if (og + 1u == (tg + 1u) * nx) xb_add(&bar[XB_TOPGEN], 1u);
            else XB_SPIN(xb_ld(&bar[XB_TOPGEN]) == tg, bar);
            __builtin_amdgcn_fence(__ATOMIC_ACQUIRE, "agent");
            xb_add(&bar[XB_XGEN(b.x)], 1u);
            asm volatile("s_waitcnt vmcnt(0)" ::: "memory");
        } else {
            XB_SPIN(xb_ld(&bar[XB_XGEN(b.x)]) == gen, bar);
            __builtin_amdgcn_fence(__ATOMIC_ACQUIRE, "agent");
            asm volatile("s_waitcnt vmcnt(0)" ::: "memory");
        }
    }
    __syncthreads();
}

namespace pg8 {
constexpr int BM = 256, BK = 64, HALF = 128, HTB = HALF * BK * 2, STAGE_BYTES = 8 * HTB, NXCD = 8, WGM = 8;
__host__ __device__ __forceinline__ int lds_byte(int r, int c) { const int st = (r >> 4) * 2 + (c >> 5), rr = r & 15, cc = c & 31, ob = rr * 64 + cc * 2; return st * 1024 + (ob ^ (((ob >> 9) & 1) << 5)); }
__host__ __device__ __forceinline__ void stage_rc(int b, int& R, int& C) { const int st = b / 1024, sb = b % 1024, swz = sb ^ (((sb >> 9) & 1) << 5); R = (st >> 1) * 16 + swz / 64; C = (st & 1) * 32 + (swz % 64) / 2; }
__host__ __device__ __forceinline__ int perm32(int rho) { const int n = rho >> 4, i = rho & 15; return 8 * (i >> 2) + 4 * n + (i & 3); }
struct Unit { const char* a; const char* b; int pm, pn, e; };
struct Gemm { int lda, ldb, K; int sa = 0x7f7f7f7f, sb = 0x7f7f7f7f, sb1 = 0; };
typedef int i32x8 __attribute__((ext_vector_type(8)));
typedef int i32x4 __attribute__((ext_vector_type(4)));
__device__ __forceinline__ bool tile_of(int i, int G, int c, int nM, int nN, int& pm, int& pn) {
    const int nwg = nM * nN; const long Lq = (long)i * G + c; if (Lq >= nwg) return false;
    int wgid = (int)Lq; { const int q = nwg / NXCD, r = nwg % NXCD, xcd = wgid % NXCD, off = wgid / NXCD; wgid = (xcd < r ? xcd * (q + 1) : r * (q + 1) + (xcd - r) * q) + off; }
    const int nig = WGM * nN, gid = wgid / nig, fm = gid * WGM, gsz = (nM - fm) < WGM ? (nM - fm) : WGM;
    pm = fm + ((wgid % nig) % gsz); pn = (wgid % nig) / gsz; return true;
}
template <class...> struct epi_void { typedef void type; };
template <class E, class = void> struct EpiHasPre { static constexpr bool value = false; };
template <class E> struct EpiHasPre<E, typename epi_void<decltype(E::HAS_PRE)>::type> { static constexpr bool value = E::HAS_PRE; };
template <class S, class = void> struct SchedHasNt { static constexpr bool value = false; };
template <class S> struct SchedHasNt<S, typename epi_void<decltype(S::HAS_NT)>::type> { static constexpr bool value = S::HAS_NT; };
template <class E, bool H> struct EpiPreOf { struct type {}; };
template <class E> struct EpiPreOf<E, true> { using type = typename E::Pre; };
struct RopeF { float inv[4]; bool rowf; };
__device__ __forceinline__ RopeF rope_freqs(int f0) { RopeF r; r.rowf = f0 < 16;
#pragma unroll
    for (int j = 0; j < 4; ++j) r.inv[j] = __builtin_amdgcn_exp2f(-(float)((f0 + j) & 15) * 0.8304820237218407f) * 0.15915494309189535f;
    return r; }
__device__ __forceinline__ void rope_cs4(const RopeF& rf, int t, f32x4& cs, f32x4& sn) { const float pos = (float)(rf.rowf ? (t >> 6) : (t & 63));
#pragma unroll
    for (int j = 0; j < 4; ++j) { const float x = __builtin_amdgcn_fractf(pos * rf.inv[j]); cs[j] = __builtin_amdgcn_cosf(x); sn[j] = __builtin_amdgcn_sinf(x); } }
__device__ __forceinline__ const char* uni_ptr(const char* p) { const unsigned long long v = (unsigned long long)p; const unsigned lo = __builtin_amdgcn_readfirstlane((unsigned)v), hi = __builtin_amdgcn_readfirstlane((unsigned)(v >> 32)); return (const char*)(((unsigned long long)hi << 32) | lo); }
__device__ __forceinline__ void uni_unit(Unit& u) { u.a = uni_ptr(u.a); u.b = uni_ptr(u.b); u.pm = __builtin_amdgcn_readfirstlane(u.pm); u.pn = __builtin_amdgcn_readfirstlane(u.pn); u.e = __builtin_amdgcn_readfirstlane(u.e); }
template <class Epi, class Sched, int MODE = 0>
__device__ __forceinline__ void gemm_phase(LAS unsigned char* lds, const Gemm g, const Sched& S, const Epi& E) {
    const int tid = threadIdx.x, wid = __builtin_amdgcn_readfirstlane(tid >> 6), lane = tid & 63, wr = wid >> 2, wc = wid & 3, fr = lane & 15, fq = lane >> 4;
    constexpr bool FP8 = MODE == 1, I8 = MODE == 2;
    const int K = g.K, nt = K / BK;
    unsigned voffA[2], voffB[2];
#pragma unroll
    for (int i = 0; i < 2; ++i) { int R, C; stage_rc(tid * 16 + i * 8192, R, C); const int Rb = Epi::PERM ? ((R & ~31) + perm32(R & 31)) : R;
        voffA[i] = (unsigned)(R * g.lda + C) * 2u; voffB[i] = (unsigned)(Rb * g.ldb + C) * 2u; }
    const size_t kstep = (size_t)(BK * 2);
    const size_t hstepA = (size_t)HALF * g.lda * 2, hstepB = (size_t)HALF * g.ldb * 2;
    const unsigned ldsw = (unsigned)wid * 1024u;
    const int aoff = lds_byte(wr * 64 + fr, fq * 8), boff = lds_byte(wc * 32 + fr, fq * 8);
#define PG8_SA(b, h) (((b) * 2 + (h)) * HTB)
#define PG8_SB(b, h) ((4 + (b) * 2 + (h)) * HTB)
#define PG8_STAGE(bufoff, gbase, voff) do { const char* _gb = (const char*)(gbase); asm volatile("" : "+s"(_gb));     \
        _Pragma("unroll") for (int _i = 0; _i < 2; ++_i) \
        __builtin_amdgcn_global_load_lds((const unsigned*)(_gb + (voff)[_i]), (LAS unsigned*)(lds + (bufoff) + ldsw + _i * 8192), 16, 0, 0); } while (0)
#define PG8_CAT(x0, x1) __builtin_shufflevector(x0, x1, 0, 1, 2, 3, 4, 5, 6, 7)
#define PG8_LDA(dst, b, h) do { if constexpr (FP8) { _Pragma("unroll") for (int m = 0; m < 4; ++m) dst##8[m] = PG8_CAT(*(const LAS i32x4*)(lds + PG8_SA(b, h) + aoff + m * 2048), *(const LAS i32x4*)(lds + PG8_SA(b, h) + aoff + m * 2048 + 1024)); } \
        else { _Pragma("unroll") for (int m = 0; m < 4; ++m) _Pragma("unroll") for (int k = 0; k < 2; ++k) dst[m][k] = *(const LAS bf16x8*)(lds + PG8_SA(b, h) + aoff + m * 2048 + k * 1024); } } while (0)
#define PG8_LDB(dst, b, h) do { if constexpr (FP8) { _Pragma("unroll") for (int n = 0; n < 2; ++n) dst##8[n] = PG8_CAT(*(const LAS i32x4*)(lds + PG8_SB(b, h) + boff + n * 2048), *(const LAS i32x4*)(lds + PG8_SB(b, h) + boff + n * 2048 + 1024)); } \
        else { _Pragma("unroll") for (int n = 0; n < 2; ++n) _Pragma("unroll") for (int k = 0; k < 2; ++k) dst[n][k] = *(const LAS bf16x8*)(lds + PG8_SB(b, h) + boff + n * 2048 + k * 1024); } } while (0)
#define PG8_MMA(ai, bj, At, Bt) do { __builtin_amdgcn_s_setprio(1); \
        if constexpr (FP8) { _Pragma("unroll") for (int m = 0; m < 4; ++m) _Pragma("unroll") for (int n = 0; n < 2; ++n) \
            asm volatile("v_mfma_scale_f32_16x16x128_f8f6f4 %0, %1, %2, %0, %3, %4 op_sel_hi:[0,0,0]" : "+v"(acc[ai][bj][m][n]) : "v"(Bt##8[n]), "v"(At##8[m]), "v"(sbv[bj]), "v"(g.sa));   } \
        else if constexpr (I8) { _Pragma("unroll") for (int m = 0; m < 4; ++m) _Pragma("unroll") for (int n = 0; n < 2; ++n) _Pragma("unroll") for (int k = 0; k < 2; ++k) \
            acc[ai][bj][m][n] = __builtin_bit_cast(f32x4, __builtin_amdgcn_mfma_i32_16x16x64_i8(__builtin_bit_cast(i32x4, Bt[n][k]), __builtin_bit_cast(i32x4, At[m][k]), __builtin_bit_cast(i32x4, acc[ai][bj][m][n]), 0, 0, 0)); } \
        else { _Pragma("unroll") for (int m = 0; m < 4; ++m) _Pragma("unroll") for (int n = 0; n < 2; ++n) _Pragma("unroll") for (int k = 0; k < 2; ++k) \
            acc[ai][bj][m][n] = __builtin_amdgcn_mfma_f32_16x16x32_bf16(Bt[n][k], At[m][k], acc[ai][bj][m][n], 0, 0, 0); } \
        __builtin_amdgcn_s_setprio(0); } while (0)
#define PG8_WAIT_V(n) asm volatile("s_waitcnt vmcnt(" #n ")" ::: "memory")
#define PG8_WAIT_L(n) asm volatile("s_waitcnt lgkmcnt(" #n ")" ::: "memory")
#define PG8_BAR __builtin_amdgcn_s_barrier()
#define PG8_SCHED __builtin_amdgcn_sched_barrier(0)
    const int sbv[2] = {g.sb, g.sb1 ? g.sb1 : g.sb};
    constexpr bool HASP = EpiHasPre<Epi>::value; typename EpiPreOf<Epi, HASP>::type pre;
    Unit cur, nxt; int ui = 0;
    if (!S.next(0, cur)) return;
    uni_unit(cur);
    constexpr bool HASNT = SchedHasNt<Sched>::value; int ntc = nt; if constexpr (HASNT) ntc = S.nt_of(cur);
    f32x4 acc[2][2][4][2];
#pragma unroll
    for (int a = 0; a < 2; ++a)
#pragma unroll
        for (int b = 0; b < 2; ++b)
#pragma unroll
            for (int m = 0; m < 4; ++m)
#pragma unroll
                for (int n = 0; n < 2; ++n) acc[a][b][m][n] = (f32x4){0.f, 0.f, 0.f, 0.f};
    bf16x8 At[4][2], B0[2][2], B1[2][2]; i32x8 At8[4], B08[2], B18[2];
    const char* cA = cur.a; const char* cB = cur.b;
    PG8_STAGE(PG8_SB(0, 0), cB, voffB); PG8_STAGE(PG8_SA(0, 0), cA, voffA); PG8_STAGE(PG8_SB(0, 1), cB + hstepB, voffB); PG8_STAGE(PG8_SA(0, 1), cA + hstepA, voffA);
    if (wr == 1) PG8_BAR;
    PG8_WAIT_V(4); PG8_BAR;
    PG8_STAGE(PG8_SB(1, 0), cB + kstep, voffB); PG8_STAGE(PG8_SA(1, 0), cA + kstep, voffA); PG8_STAGE(PG8_SB(1, 1), cB + hstepB + kstep, voffB);
    PG8_WAIT_V(6); PG8_BAR;
    for (;;) {
        const bool has_next = S.next(ui + 1, nxt); if (has_next) uni_unit(nxt);
        const char* nA = has_next ? nxt.a : cA; const char* nB = has_next ? nxt.b : cB;
#pragma unroll 1
        for (int t = 0; t < ntc; t += 2) {
            const bool last = (t == ntc - 2);
            if constexpr (HASP) { if (last) E.prefetch(cur, wr, wc, fr, fq, pre); }
            const char* a1 = cA + (size_t)(t + 1) * kstep;
            const char* a2 = last ? nA : cA + (size_t)(t + 2) * kstep; const char* b2 = last ? nB : cB + (size_t)(t + 2) * kstep;
            const char* a3 = a2 + kstep; const char* b3 = b2 + kstep;
            PG8_LDB(B0, 0, 0); PG8_SCHED; PG8_LDA(At, 0, 0); PG8_STAGE(PG8_SA(1, 1), a1 + hstepA, voffA);
            PG8_WAIT_L(8); PG8_BAR; PG8_WAIT_L(0); PG8_MMA(0, 0, At, B0); PG8_BAR; PG8_SCHED;
            PG8_LDB(B1, 0, 1); PG8_STAGE(PG8_SB(0, 0), b2, voffB);
            PG8_BAR; PG8_WAIT_L(0); PG8_MMA(0, 1, At, B1); PG8_BAR;
            PG8_LDA(At, 0, 1); PG8_STAGE(PG8_SA(0, 0), a2, voffA);
            PG8_BAR; PG8_WAIT_L(0); PG8_MMA(1, 0, At, B0); PG8_BAR; PG8_SCHED;
            PG8_STAGE(PG8_SB(0, 1), b2 + hstepB, voffB);
            PG8_WAIT_V(6); PG8_BAR; PG8_MMA(1, 1, At, B1); PG8_BAR;
            PG8_LDB(B0, 1, 0); PG8_SCHED; PG8_LDA(At, 1, 0); PG8_STAGE(PG8_SA(0, 1), a2 + hstepA, voffA);
            PG8_WAIT_L(8); PG8_BAR; PG8_WAIT_L(0); PG8_MMA(0, 0, At, B0); PG8_BAR; PG8_SCHED;
            PG8_LDB(B1, 1, 1); PG8_STAGE(PG8_SB(1, 0), b3, voffB);
            PG8_BAR; PG8_WAIT_L(0); PG8_MMA(0, 1, At, B1); PG8_BAR;
            PG8_LDA(At, 1, 1); PG8_STAGE(PG8_SA(1, 0), a3, voffA);
            PG8_BAR; PG8_WAIT_L(0); PG8_MMA(1, 0, At, B0); PG8_BAR; PG8_SCHED;
            PG8_STAGE(PG8_SB(1, 1), b3 + hstepB, voffB);
            PG8_WAIT_V(6); PG8_BAR; PG8_MMA(1, 1, At, B1); PG8_BAR;
        }
        if constexpr (FP8) asm volatile("s_nop 15\n\ts_nop 7" ::: "memory");
        if constexpr (HASP) E(acc, cur, wr, wc, fr, fq, pre); else E(acc, cur, wr, wc, fr, fq);
        if (!has_next) break;
#pragma unroll
        for (int a = 0; a < 2; ++a)
#pragma unroll
            for (int b = 0; b < 2; ++b)
#pragma unroll
                for (int m = 0; m < 4; ++m)
#pragma unroll
                    for (int n = 0; n < 2; ++n) acc[a][b][m][n] = (f32x4){0.f, 0.f, 0.f, 0.f};
        cur = nxt; cA = nA; cB = nB; ++ui; if constexpr (HASNT) ntc = S.nt_of(cur);
    }
    PG8_WAIT_V(0);
    if (wr == 0) PG8_BAR;
    PG8_BAR;
#undef PG8_SA
#undef PG8_SB
#undef PG8_STAGE
#undef PG8_LDA
#undef PG8_LDB
#undef PG8_MMA
#undef PG8_CAT
#undef PG8_WAIT_V
#undef PG8_WAIT_L
#undef PG8_BAR
#undef PG8_SCHED
}

struct SchedPlain {
    const char* A; const char* Bt; size_t at, bt; int nM, nN, G, c; bool latM;
    __device__ __forceinline__ void init(const void* A_, int lda, const void* Bt_, int ldb, int nM_, int nN_, bool latM_) {
        A = (const char*)A_; Bt = (const char*)Bt_; at = (size_t)256 * lda * 2; bt = (size_t)256 * ldb * 2; nM = nM_; nN = nN_; G = gridDim.x; c = blockIdx.x; latM = latM_; }
    __device__ __forceinline__ bool next(int i, Unit& u) const {
        int pm, pn; if (!tile_of(i, G, c, nM, nN, pm, pn)) return false;
        if (latM) pm = (pm >> 3) * 9 + 1 + (pm & 7);
        u.pm = pm; u.pn = pn; u.e = 0; u.a = A + (size_t)pm * at; u.b = Bt + (size_t)pn * bt; return true; }
};
struct SchedTailK2 {
    const char* A; const char* Bt; size_t at, bt, khb; int G, c;
    __device__ __forceinline__ bool next(int i, Unit& u) const {
        const int L_ = i * G + c; if (L_ >= 256) return false; const int pm = 256 + (L_ >> 3), pn = (L_ >> 1) & 3, kh = L_ & 1;
        u.pm = pm; u.pn = pn; u.e = kh; u.a = A + (size_t)pm * at + (size_t)kh * khb; u.b = Bt + (size_t)pn * bt + (size_t)kh * khb; return true; }
};
struct SchedTailParts {
    static constexpr bool HAS_NT = true;
    const char* A; const char* Bt; size_t at, bt; int pm0, nTail, nN, NP, t0, t1, G, c;
    __device__ __forceinline__ bool next(int i, Unit& u) const {
        const int L_ = i * G + c; if (L_ >= nTail * nN * NP) return false; const int part = L_ % NP, rest = L_ / NP, pn = rest % nN, pm = pm0 + rest / nN; const size_t ko = (size_t)part * t0 * 128;
        u.pm = pm; u.pn = pn; u.e = part; u.a = A + (size_t)pm * at + ko; u.b = Bt + (size_t)pn * bt + ko; return true; }
    __device__ __forceinline__ int nt_of(const Unit& u) const { return u.e == NP - 1 ? t1 : t0; }
};
struct SchedQKV1 {
    const char* A; const char* Bt; int G, c; int rowb = D * 2;
    __device__ __forceinline__ bool next(int i, Unit& u) const {
        const int L_ = i * G + c; constexpr int NLAT = NB * 8 * 9, NCTX = NB * 6; int pm, pn;
        if (L_ < NLAT) { if (!tile_of(i, G, c, NB * 8, 9, pm, pn)) return false; pm = (pm >> 3) * 9 + 1 + (pm & 7); }
        else { const int v = L_ - NLAT; if (v >= NCTX) return false; pm = (v / 6) * 9; pn = 3 + v % 6; }
        u.pm = pm; u.pn = pn; u.e = 0; u.a = A + (size_t)pm * 256 * rowb; u.b = Bt + (size_t)pn * 256 * rowb; return true; }
};
struct SchedF1 {
    const char* A; const char* H; int nN, G, c; int rowb = D * 2;
    __device__ __forceinline__ bool next(int i, Unit& u) const {
        int pm, pn; if (!tile_of(i, G, c, 2, nN, pm, pn)) return false;
        u.pm = pm; u.pn = pn; u.e = 0; u.a = A + (size_t)pm * 256 * rowb; u.b = H + (size_t)((pn >> 3) * 9 + 1 + (pn & 7)) * 256 * rowb; return true; }
};
struct SchedF2 {
    const char* Dft; const char* GT; int G, c;
    __device__ __forceinline__ bool next(int i, Unit& u) const {
        const int L_ = i * G + c; if (L_ >= NB * 8) return false; const int b = L_ >> 3, kt = L_ & 7;
        u.pm = b * 9 + 1 + kt; u.pn = 0; u.e = 0; u.a = Dft + (size_t)kt * 256 * 4096 * 2; u.b = GT + (size_t)b * 256 * 4096 * 2; return true; }
};
struct SchedMoe {
    const char* A; const char* W; size_t at, bt, estride; int t0, nT, nN, G, c; int toff[NE + 1];
    __device__ __forceinline__ bool next(int i, Unit& u) const {
        int pm, pn; if (!tile_of(i, G, c, nT, nN, pm, pn)) return false; pm += t0;
        int e = 0;
#pragma unroll
        for (int j = 1; j < NE; ++j) e += (pm >= toff[j]) ? 1 : 0;
        u.pm = pm; u.pn = pn; u.e = e; u.a = A + (size_t)pm * at; u.b = W + (size_t)e * estride + (size_t)pn * bt; return true; }
};

struct SchedMoeTail {
    static constexpr bool HAS_NT = true;
    const char* A; const char* W; size_t at, bt, estride; int pm0, nTail, nN, t0, t1, G, c; int toff[NE + 1];
    __device__ __forceinline__ bool next(int i, Unit& u) const {
        const int L_ = i * G + c; if (L_ >= nTail * nN * 4) return false; const int part = L_ & 3, rest = L_ >> 2, pn = rest % nN, pm = pm0 + rest / nN; const size_t ko = (size_t)part * t0 * 128;
        int e = 0;
#pragma unroll
        for (int j = 1; j < NE; ++j) e += (pm >= toff[j]) ? 1 : 0;
        u.pm = pm; u.pn = pn; u.e = part; u.a = A + (size_t)pm * at + ko; u.b = W + (size_t)e * estride + (size_t)pn * bt + ko; return true; }
    __device__ __forceinline__ int nt_of(const Unit& u) const { return u.e == 3 ? t1 : t0; }
};

#define EPI_LOOP_ROWS for (int ai = 0; ai < 2; ++ai) _Pragma("unroll") for (int m = 0; m < 4; ++m)
__device__ __forceinline__ u32x4 pack8(const f32x4 a, const f32x4 b) { u32x4 w; w.x = cvt_pk_bf16(a[0], a[1]); w.y = cvt_pk_bf16(a[2], a[3]); w.z = cvt_pk_bf16(b[0], b[1]); w.w = cvt_pk_bf16(b[2], b[3]); return w; }
struct EpiPlain {
    static constexpr bool PERM = true; bf16_t* O; int ldo;
    __device__ __forceinline__ void operator()(const f32x4 (&acc)[2][2][4][2], const Unit& u, int wr, int wc, int fr, int fq) const {
        const int row0 = u.pm * BM + wr * 64 + fr, col0 = u.pn * BM + wc * 32 + 8 * fq;
#pragma unroll
        EPI_LOOP_ROWS { bf16_t* rowp = O + (size_t)(row0 + ai * HALF + m * 16) * ldo + col0;
#pragma unroll
            for (int bj = 0; bj < 2; ++bj) *(u32x4*)(rowp + bj * HALF) = pack8(acc[ai][bj][m][0], acc[ai][bj][m][1]); }
    }
};
struct EpiPlainK2 {
    static constexpr bool PERM = true; bf16_t* O0; bf16_t* O1; int ldo;
    __device__ __forceinline__ void operator()(const f32x4 (&acc)[2][2][4][2], const Unit& u, int wr, int wc, int fr, int fq) const {
        const int row0 = u.pm * BM + wr * 64 + fr, col0 = u.pn * BM + wc * 32 + 8 * fq; bf16_t* base = u.e ? O1 - (size_t)65536 * ldo : O0;
#pragma unroll
        EPI_LOOP_ROWS { bf16_t* rowp = base + (size_t)(row0 + ai * HALF + m * 16) * ldo + col0;
#pragma unroll
            for (int bj = 0; bj < 2; ++bj) *(u32x4*)(rowp + bj * HALF) = pack8(acc[ai][bj][m][0], acc[ai][bj][m][1]); }
    }
};
struct EpiPlainParts {
    static constexpr bool PERM = true; bf16_t* O0; bf16_t* X; int ldo, row0x, xrows;
    __device__ __forceinline__ void operator()(const f32x4 (&acc)[2][2][4][2], const Unit& u, int wr, int wc, int fr, int fq) const {
        const int row0 = u.pm * BM + wr * 64 + fr, col0 = u.pn * BM + wc * 32 + 8 * fq; bf16_t* base = u.e ? X + ((size_t)(u.e - 1) * xrows - row0x) * ldo : O0;
#pragma unroll
        EPI_LOOP_ROWS { bf16_t* rowp = base + (size_t)(row0 + ai * HALF + m * 16) * ldo + col0;
#pragma unroll
            for (int bj = 0; bj < 2; ++bj) *(u32x4*)(rowp + bj * HALF) = pack8(acc[ai][bj][m][0], acc[ai][bj][m][1]); }
    }
};
__device__ __forceinline__ f32x2 swiglu2(f32x2 g, f32x2 up) {
    const f32x2 t = g * (-1.4426950408889634f); f32x2 e; e.x = __builtin_amdgcn_exp2f(t.x); e.y = __builtin_amdgcn_exp2f(t.y);
    const f32x2 d = e + 1.0f; f32x2 r; r.x = __builtin_amdgcn_rcpf(d.x); r.y = __builtin_amdgcn_rcpf(d.y);
    return (g * r) * up; }
__device__ __forceinline__ f32x2 swiglu2f(f32x2 gs, f32x2 ups) {
    f32x2 e; e.x = __builtin_amdgcn_exp2f(-gs.x); e.y = __builtin_amdgcn_exp2f(-gs.y);
    const f32x2 d = e + 1.0f; f32x2 r; r.x = __builtin_amdgcn_rcpf(d.x); r.y = __builtin_amdgcn_rcpf(d.y);
    return (gs * r) * ups; }
struct EpiSwiglu {
    static constexpr bool PERM = true; bf16_t* O; int ldo; int skip = 0;
    __device__ __forceinline__ void operator()(const f32x4 (&acc)[2][2][4][2], const Unit& u, int wr, int wc, int fr, int fq) const {
        if (skip) {
#pragma unroll
            for (int ai = 0; ai < 2; ++ai)
#pragma unroll
                for (int bj = 0; bj < 2; ++bj)
#pragma unroll
                    for (int m = 0; m < 4; ++m) { asm volatile("" :: "v"(acc[ai][bj][m][0]), "v"(acc[ai][bj][m][1])); }
            return; }
        const int row0 = u.pm * BM + wr * 64 + fr, col0 = u.pn * 128 + 8 * (4 * wc + fq);
#pragma unroll
        EPI_LOOP_ROWS { bf16_t* rowp = O + (size_t)(row0 + ai * HALF + m * 16) * ldo + col0; u32x4 w;
#pragma unroll
            for (int n = 0; n < 2; ++n) { const f32x4 g = acc[ai][0][m][n], up = acc[ai][1][m][n];
                const f32x2 a0 = swiglu2((f32x2){g[0], g[1]}, (f32x2){up[0], up[1]}), a1 = swiglu2((f32x2){g[2], g[3]}, (f32x2){up[2], up[3]});
                w[2 * n] = cvt_pk_bf16(a0.x, a0.y); w[2 * n + 1] = cvt_pk_bf16(a1.x, a1.y); }
            *(u32x4*)rowp = w; }
    }
};
__device__ __forceinline__ unsigned pack4_fp8(float a, float b, float c, float d) {
    a = __builtin_amdgcn_fmed3f(a, -448.f, 448.f); b = __builtin_amdgcn_fmed3f(b, -448.f, 448.f); c = __builtin_amdgcn_fmed3f(c, -448.f, 448.f); d = __builtin_amdgcn_fmed3f(d, -448.f, 448.f);
    int p = __builtin_amdgcn_cvt_pk_fp8_f32(a, b, 0, false); p = __builtin_amdgcn_cvt_pk_fp8_f32(c, d, p, true); return (unsigned)p; }
struct EpiSwiglu8 {
    static constexpr bool PERM = true; unsigned char* O; int ldo; float oscale; int skip = 0;
    __device__ __forceinline__ void operator()(const f32x4 (&acc)[2][2][4][2], const Unit& u, int wr, int wc, int fr, int fq) const {
        if (skip) {
#pragma unroll
            for (int ai = 0; ai < 2; ++ai)
#pragma unroll
                for (int bj = 0; bj < 2; ++bj)
#pragma unroll
                    for (int m = 0; m < 4; ++m) { asm volatile("" :: "v"(acc[ai][bj][m][0]), "v"(acc[ai][bj][m][1])); }
            return; }
        const int row0 = u.pm * BM + wr * 64 + fr, col0 = u.pn * 128 + 8 * (4 * wc + fq);
#pragma unroll
        EPI_LOOP_ROWS { unsigned char* rowp = O + (size_t)(row0 + ai * HALF + m * 16) * ldo + col0; u32x2 w;
#pragma unroll
            for (int n = 0; n < 2; ++n) { const f32x4 g = acc[ai][0][m][n], up = acc[ai][1][m][n];
                const f32x2 a0 = swiglu2f((f32x2){g[0], g[1]}, (f32x2){up[0], up[1]}), a1 = swiglu2f((f32x2){g[2], g[3]}, (f32x2){up[2], up[3]});
                w[n] = pack4_fp8(a0.x, a0.y, a1.x, a1.y); }
            *(u32x2*)rowp = w; }
    }
};
__device__ __forceinline__ f32x4 cvt_i4(const f32x4 a, const float sr, const f32x4 sw) { const i32x4 i = __builtin_bit_cast(i32x4, a); return (f32x4){(float)i[0] * sr * sw[0], (float)i[1] * sr * sw[1], (float)i[2] * sr * sw[2], (float)i[3] * sr * sw[3]}; }
struct PreSc { f32x4 w[2][2]; float sr[2][4]; };
struct EpiPlainI8 {
    static constexpr bool PERM = true, HAS_PRE = true; typedef PreSc Pre; bf16_t* O; int ldo; const float* sa; const float* sw;
    __device__ __forceinline__ void prefetch(const Unit& u, int wr, int wc, int fr, int fq, Pre& p) const {
        const int row0 = u.pm * BM + wr * 64 + fr, col0 = u.pn * BM + wc * 32 + 8 * fq;
#pragma unroll
        for (int bj = 0; bj < 2; ++bj)
#pragma unroll
            for (int n = 0; n < 2; ++n) p.w[bj][n] = *(const f32x4*)(sw + col0 + bj * HALF + 4 * n);
#pragma unroll
        for (int ai = 0; ai < 2; ++ai)
#pragma unroll
            for (int m = 0; m < 4; ++m) p.sr[ai][m] = sa[row0 + ai * HALF + m * 16]; }
    __device__ __forceinline__ void operator()(const f32x4 (&acc)[2][2][4][2], const Unit& u, int wr, int wc, int fr, int fq, const Pre& p) const {
        const int row0 = u.pm * BM + wr * 64 + fr, col0 = u.pn * BM + wc * 32 + 8 * fq;
#pragma unroll
        EPI_LOOP_ROWS { const int row = row0 + ai * HALF + m * 16; const float sr = p.sr[ai][m]; bf16_t* rowp = O + (size_t)row * ldo + col0;
#pragma unroll
            for (int bj = 0; bj < 2; ++bj) *(u32x4*)(rowp + bj * HALF) = pack8(cvt_i4(acc[ai][bj][m][0], sr, p.w[bj][0]), cvt_i4(acc[ai][bj][m][1], sr, p.w[bj][1])); }
    }
};
struct EpiQKV1I8 {
    static constexpr bool PERM = true, HAS_PRE = true; typedef PreSc Pre; bf16_t* O; size_t tstride; const float* sa; const float* sw;
    __device__ __forceinline__ void prefetch(const Unit& u, int wr, int wc, int fr, int fq, Pre& p) const {
        const int row0 = u.pm * BM + wr * 64 + fr, pc0 = u.pn * BM + wc * 32 + 8 * fq;
#pragma unroll
        for (int bj = 0; bj < 2; ++bj)
#pragma unroll
            for (int n = 0; n < 2; ++n) p.w[bj][n] = *(const f32x4*)(sw + pc0 + bj * HALF + 4 * n);
#pragma unroll
        for (int ai = 0; ai < 2; ++ai)
#pragma unroll
            for (int m = 0; m < 4; ++m) p.sr[ai][m] = sa[row0 + ai * HALF + m * 16]; }
    __device__ __forceinline__ void operator()(const f32x4 (&acc)[2][2][4][2], const Unit& u, int wr, int wc, int fr, int fq, const Pre& p) const {
        const int which = u.pn / 3; const int row0 = u.pm * BM + wr * 64 + fr, col0 = (u.pn % 3) * BM + wc * 32 + 8 * fq; const int pj = u.pm % 9; const bool rope = (pj != 0) && which < 2;
        const int t0 = (pj - 1) * 256 + wr * 64 + fr; bf16_t* base = O + (size_t)which * tstride; const RopeF rf = rope_freqs(((col0 & 63) >> 3) * 4);
#pragma unroll
        EPI_LOOP_ROWS { const int row = row0 + ai * HALF + m * 16; const int t = t0 + ai * HALF + m * 16; const float sr = p.sr[ai][m]; bf16_t* rowp = base + (size_t)row * 768 + col0;
            f32x4 cs, sn; if (rope) rope_cs4(rf, t, cs, sn);
#pragma unroll
            for (int bj = 0; bj < 2; ++bj) { f32x4 v0 = cvt_i4(acc[ai][bj][m][0], sr, p.w[bj][0]), v1 = cvt_i4(acc[ai][bj][m][1], sr, p.w[bj][1]);
                if (rope) { const f32x4 o1 = v0 * cs - v1 * sn, o2 = v0 * sn + v1 * cs; v0 = o1; v1 = o2; }
                *(u32x4*)(rowp + bj * HALF) = pack8(v0, v1); } }
    }
};
struct EpiGTI8 {
    static constexpr bool PERM = true, HAS_PRE = true; typedef PreSc Pre; bf16_t* O; const float* swf; const float* sa;
    __device__ __forceinline__ void prefetch(const Unit& u, int wr, int wc, int fr, int fq, Pre& p) const {
        const int b = u.pn >> 3, tt = u.pn & 7, part = u.pm; const int c0 = wr * 64 + fr, t0 = tt * 256 + wc * 32 + 8 * fq; const float* sap = sa + (size_t)b * S + L + t0;
#pragma unroll
        for (int bj = 0; bj < 2; ++bj)
#pragma unroll
            for (int n = 0; n < 2; ++n) p.w[bj][n] = *(const f32x4*)(sap + bj * HALF + 4 * n);
#pragma unroll
        for (int ai = 0; ai < 2; ++ai)
#pragma unroll
            for (int m = 0; m < 4; ++m) p.sr[ai][m] = swf[part * 256 + c0 + ai * HALF + m * 16]; }
    __device__ __forceinline__ void operator()(const f32x4 (&acc)[2][2][4][2], const Unit& u, int wr, int wc, int fr, int fq, const Pre& p) const {
        const int b = u.pn >> 3, tt = u.pn & 7, part = u.pm; const int c0 = wr * 64 + fr, t0 = tt * 256 + wc * 32 + 8 * fq;
#pragma unroll
        EPI_LOOP_ROWS { const int c = c0 + ai * HALF + m * 16; const float sr = p.sr[ai][m]; bf16_t* rowp = O + ((size_t)(b * 256 + c) * 2 + part) * 2048 + t0;
#pragma unroll
            for (int bj = 0; bj < 2; ++bj) *(u32x4*)(rowp + bj * HALF) = pack8(cvt_i4(acc[ai][bj][m][0], sr, p.w[bj][0]), cvt_i4(acc[ai][bj][m][1], sr, p.w[bj][1])); }
    }
};
struct PreSw { f32x4 wg[2], wu[2]; float sr[2][4]; };
struct EpiSwigluI8 {
    static constexpr bool PERM = true, HAS_PRE = true; typedef PreSw Pre; void* O; int ldo; const float* sa; const float* sw; int sw_estride; float oscale; bool out8;
    __device__ __forceinline__ void prefetch(const Unit& u, int wr, int wc, int fr, int fq, Pre& p) const {
        const int row0 = u.pm * BM + wr * 64 + fr; const float* swp = sw + (size_t)u.e * sw_estride + u.pn * BM + wc * 32 + 8 * fq;
#pragma unroll
        for (int n = 0; n < 2; ++n) { p.wg[n] = *(const f32x4*)(swp + 4 * n); p.wu[n] = *(const f32x4*)(swp + HALF + 4 * n); }
#pragma unroll
        for (int ai = 0; ai < 2; ++ai)
#pragma unroll
            for (int m = 0; m < 4; ++m) p.sr[ai][m] = sa[row0 + ai * HALF + m * 16]; }
    __device__ __forceinline__ void operator()(const f32x4 (&acc)[2][2][4][2], const Unit& u, int wr, int wc, int fr, int fq, const Pre& p) const {
        const int row0 = u.pm * BM + wr * 64 + fr, col0 = u.pn * 128 + 8 * (4 * wc + fq);
#pragma unroll
        EPI_LOOP_ROWS { const int row = row0 + ai * HALF + m * 16; const float sr = p.sr[ai][m]; unsigned pk[4];
#pragma unroll
            for (int n = 0; n < 2; ++n) { const f32x4 g = cvt_i4(acc[ai][0][m][n], sr, p.wg[n]), up = cvt_i4(acc[ai][1][m][n], sr, p.wu[n]);
                const f32x2 a0 = swiglu2f((f32x2){g[0], g[1]}, (f32x2){up[0], up[1]}), a1 = swiglu2f((f32x2){g[2], g[3]}, (f32x2){up[2], up[3]});
                if (out8) { pk[n] = pack4_fp8(a0.x, a0.y, a1.x, a1.y); } else { pk[2 * n] = cvt_pk_bf16(a0.x, a0.y); pk[2 * n + 1] = cvt_pk_bf16(a1.x, a1.y); } }
            if (out8) *(u32x2*)((unsigned char*)O + (size_t)row * ldo + col0) = (u32x2){pk[0], pk[1]}; else *(u32x4*)((bf16_t*)O + (size_t)row * ldo + col0) = (u32x4){pk[0], pk[1], pk[2], pk[3]}; }
    }
};
constexpr float QSC_MLA = 0.07216878364870322f * 1.4426950408889634f, QSC_DIFF = 0.125f * 1.4426950408889634f;
struct EpiQ0 {
    static constexpr bool PERM = true; bf16_t* O; const float* rc; const float* rs;
    __device__ __forceinline__ void operator()(const f32x4 (&acc)[2][2][4][2], const Unit& u, int wr, int wc, int fr, int fq) const {
        const int row0 = u.pm * BM + wr * 64 + fr, col0 = u.pn * BM + wc * 32 + 8 * fq; const int pj = u.pm % 9; const bool lat = pj != 0; const int t0 = (pj - 1) * 256 + wr * 64 + fr;
#pragma unroll
        EPI_LOOP_ROWS { const int row = row0 + ai * HALF + m * 16; const int t = t0 + ai * HALF + m * 16; bf16_t* rowp = O + (size_t)row * 768 + col0;
#pragma unroll
            for (int bj = 0; bj < 2; ++bj) { const int cb = col0 + bj * HALF, within = cb % MLA_QK; f32x4 v0 = acc[ai][bj][m][0], v1 = acc[ai][bj][m][1];
                if (lat && within >= MLA_NOPE) { const RopeF rf = rope_freqs(((within - MLA_NOPE) >> 3) * 4); f32x4 cs, sn; rope_cs4(rf, t, cs, sn);
                    const f32x4 o1 = v0 * cs - v1 * sn, o2 = v0 * sn + v1 * cs; v0 = o1; v1 = o2; }
                *(u32x4*)(rowp + bj * HALF) = pack8(v0 * QSC_MLA, v1 * QSC_MLA); }
            asm volatile("" ::: "memory"); }
    }
};
struct EpiKV0 {
    static constexpr bool PERM = true; bf16_t* Kn; bf16_t* V;
    __device__ __forceinline__ void operator()(const f32x4 (&acc)[2][2][4][2], const Unit& u, int wr, int wc, int fr, int fq) const {
        const int row0 = u.pm * BM + wr * 64 + fr, col0 = u.pn * 128 + wc * 32 + 8 * fq;
#pragma unroll
        EPI_LOOP_ROWS { const size_t ro = (size_t)(row0 + ai * HALF + m * 16) * 512 + col0;
            *(u32x4*)(Kn + ro) = pack8(acc[ai][0][m][0], acc[ai][0][m][1]); *(u32x4*)(V + ro) = pack8(acc[ai][1][m][0], acc[ai][1][m][1]); }
    }
};
struct EpiQKV1 {
    static constexpr bool PERM = true; bf16_t* O; size_t tstride; const float* rc; const float* rs;
    __device__ __forceinline__ void operator()(const f32x4 (&acc)[2][2][4][2], const Unit& u, int wr, int wc, int fr, int fq) const {
        const int which = u.pn / 3; const int row0 = u.pm * BM + wr * 64 + fr, col0 = (u.pn % 3) * BM + wc * 32 + 8 * fq; const int pj = u.pm % 9; const bool rope = (pj != 0) && which < 2;
        const int t0 = (pj - 1) * 256 + wr * 64 + fr; bf16_t* base = O + (size_t)which * tstride;
#pragma unroll
        EPI_LOOP_ROWS { const int row = row0 + ai * HALF + m * 16; const int t = t0 + ai * HALF + m * 16; bf16_t* rowp = base + (size_t)row * 768 + col0;
#pragma unroll
            for (int bj = 0; bj < 2; ++bj) { const int cb = col0 + bj * HALF; f32x4 v0 = acc[ai][bj][m][0], v1 = acc[ai][bj][m][1];
                if (rope) { const int f0 = ((cb & 63) >> 3) * 4; const f32x4 cs = *(const f32x4*)(rc + t * 32 + f0), sn = *(const f32x4*)(rs + t * 32 + f0);
                    const f32x4 o1 = v0 * cs - v1 * sn, o2 = v0 * sn + v1 * cs; v0 = o1; v1 = o2; }
                *(u32x4*)(rowp + bj * HALF) = pack8(v0, v1); }
            asm volatile("" ::: "memory"); }
    }
};
struct EpiGT {
    static constexpr bool PERM = true; bf16_t* O;
    __device__ __forceinline__ void operator()(const f32x4 (&acc)[2][2][4][2], const Unit& u, int wr, int wc, int fr, int fq) const {
        const int b = u.pn >> 3, tt = u.pn & 7, part = u.pm; const int c0 = wr * 64 + fr, t0 = tt * 256 + wc * 32 + 8 * fq;
#pragma unroll
        EPI_LOOP_ROWS { const int c = c0 + ai * HALF + m * 16; bf16_t* rowp = O + ((size_t)(b * 256 + c) * 2 + part) * 2048 + t0;
#pragma unroll
            for (int bj = 0; bj < 2; ++bj) *(u32x4*)(rowp + bj * HALF) = pack8(acc[ai][bj][m][0], acc[ai][bj][m][1]); }
    }
};
}
namespace att {
constexpr int NW = 8, QBLK = 32, KVBLK = 64, DV = 128;
constexpr float THR = 8.f;
constexpr size_t SHM_V = KVBLK * DV * 2;
template <int DQK> struct Cf {
    static constexpr int ND = DQK / 16, KC = DQK / 64, CPR = DQK / 8;
    static constexpr size_t SHM_K = (size_t)KVBLK * DQK * 2;
    static constexpr float SCALE = DQK == 192 ? 0.07216878364870322f : 0.125f;
    static constexpr size_t LDS_BYTES = 2 * SHM_V + 2 * SHM_K + NW * 64 * 4;
};
#define SBAR() __builtin_amdgcn_sched_barrier(0)
__device__ __forceinline__ int crow(int r, int hi) { return (r & 3) + 8 * (r >> 2) + 4 * hi; }
template <int DQK> __device__ __forceinline__ int kswz(int row, int colB) { return row * (DQK * 2) + (colB ^ (((row >> 1) & 7) << 4)); }

constexpr float THR2 = THR * 1.4426950408889634f;
template <int DQK, int VAR = 0, bool FIRST = false>
__device__ __forceinline__ void partialSM(f32x16& p0, f32x16& p1, f32x16& mC, float& alpha) {
    if constexpr (VAR == 3 || VAR == 7 || VAR == 9) { alpha = 1.f; return; }
    float pmax = p0[0];
#pragma unroll
    for (int r = 1; r < 16; ++r) pmax = fmaxf(pmax, p0[r]);
#pragma unroll
    for (int r = 0; r < 16; ++r) pmax = fmaxf(pmax, p1[r]);
    { auto rr = __builtin_amdgcn_permlane32_swap(__float_as_uint(pmax), __float_as_uint(pmax), false, false);
      pmax = fmaxf(__uint_as_float(rr[0]), __uint_as_float(rr[1])); }
    if (!FIRST && __builtin_expect(__all(pmax <= THR2), 1)) alpha = 1.f;
    else { const float d = FIRST ? pmax : fmaxf(pmax, 0.f); alpha = FIRST ? 1.f : __builtin_amdgcn_exp2f(-d); const float nm = mC[0] - d;
#pragma unroll
        for (int r = 0; r < 16; ++r) { p0[r] -= d; p1[r] -= d; if constexpr (DQK == 64) mC[r] -= d; else mC[r] = nm; } }
#pragma unroll
    for (int r = 0; r < 16; ++r) p0[r] = VAR == 2 ? p0[r] : __builtin_amdgcn_exp2f(p0[r]);
}
template <int VAR = 0>
__device__ __forceinline__ void finishSM(f32x16& p0, f32x16& p1, float alpha, float& l_reg, bf16x8& pa0, bf16x8& pa1, bf16x8& pa2, bf16x8& pa3) {
    float ps = 0;
    if constexpr (VAR != 3 && VAR != 7 && VAR != 9) {
#pragma unroll
    for (int r = 0; r < 16; ++r) p1[r] = VAR == 2 ? p1[r] : __builtin_amdgcn_exp2f(p1[r]);
#pragma unroll
    for (int r = 0; r < 16; ++r) ps += p0[r];
#pragma unroll
    for (int r = 0; r < 16; ++r) ps += p1[r];
    }
    { auto rr = __builtin_amdgcn_permlane32_swap(__float_as_uint(ps), __float_as_uint(ps), false, false);
      ps = __uint_as_float(rr[0]) + __uint_as_float(rr[1]); }
    l_reg = l_reg * alpha + ps;
#define PK4(P, BASE, OUT) do { unsigned a0 = cvt_pk_bf16(P[BASE + 0], P[BASE + 1]), a1 = cvt_pk_bf16(P[BASE + 2], P[BASE + 3]);   \
    unsigned b0 = cvt_pk_bf16(P[BASE + 4], P[BASE + 5]), b1 = cvt_pk_bf16(P[BASE + 6], P[BASE + 7]);                              \
    auto r0 = __builtin_amdgcn_permlane32_swap(a0, b0, false, false); auto r1 = __builtin_amdgcn_permlane32_swap(a1, b1, false, false); \
    u32x4 w = {r0[0], r1[0], r0[1], r1[1]}; OUT = *reinterpret_cast<bf16x8*>(&w); } while (0)
    PK4(p0, 0, pa0); PK4(p0, 8, pa1); PK4(p1, 0, pa2); PK4(p1, 8, pa3);
#undef PK4
}
struct KFrag { bf16x8 b0[4], b1[4]; };
__device__ __forceinline__ void qkt_ld(KFrag& f, const char* Ks, int r32, int hi) {
#pragma unroll
    for (int d0 = 0; d0 < 4; ++d0) { const int cb = (d0 * 16 + hi * 8) * 2; f.b0[d0] = *reinterpret_cast<const bf16x8*>(Ks + kswz<64>(r32, cb)); f.b1[d0] = *reinterpret_cast<const bf16x8*>(Ks + kswz<64>(32 + r32, cb)); }
}
#define PK4H(P, BASE, OUT) do { unsigned a0 = cvt_pk_bf16(P[BASE + 0], P[BASE + 1]), a1 = cvt_pk_bf16(P[BASE + 2], P[BASE + 3]);   \
    unsigned b0 = cvt_pk_bf16(P[BASE + 4], P[BASE + 5]), b1 = cvt_pk_bf16(P[BASE + 6], P[BASE + 7]);                              \
    auto r0 = __builtin_amdgcn_permlane32_swap(a0, b0, false, false); auto r1 = __builtin_amdgcn_permlane32_swap(a1, b1, false, false); \
    u32x4 w = {r0[0], r1[0], r0[1], r1[1]}; OUT = *reinterpret_cast<bf16x8*>(&w); } while (0)
__device__ __forceinline__ f32x16 mfma_c(bf16x8 a, bf16x8 b, const f32x16& c) { f32x16 d; asm volatile("v_mfma_f32_32x32x16_bf16 %0, %1, %2, %3" : "=&v"(d) : "v"(a), "v"(b), "v"(c)); return d; }
__device__ __forceinline__ void qkt_mf(f32x16& p0, f32x16& p1, const KFrag& f, const bf16x8* qr, const f32x16& mC) {
    p0 = mfma_c(f.b0[0], qr[0], mC); p1 = mfma_c(f.b1[0], qr[0], mC);
#pragma unroll
    for (int d0 = 1; d0 < 4; ++d0) { p0 = __builtin_amdgcn_mfma_f32_32x32x16_bf16(f.b0[d0], qr[d0], p0, 0, 0, 0); p1 = __builtin_amdgcn_mfma_f32_32x32x16_bf16(f.b1[d0], qr[d0], p1, 0, 0, 0); }
}
template <int DQK, int NQR, int VAR = 0>
__device__ __forceinline__ void qkt(f32x16& p0, f32x16& p1, const char* Ks, const bf16x8* qr, const char* ql, int r32, int hi, const f32x16& mC) {
    if constexpr (VAR == 5) { p0 = mC; p1 = mC; return; }
#pragma unroll
    for (int d0 = 0; d0 < Cf<DQK>::ND; ++d0) { const int cb = (d0 * 16 + hi * 8) * 2;
        bf16x8 b0, b1;
        if constexpr (VAR == 7 || VAR == 9) { b0 = qr[d0]; b1 = qr[(d0 + 1) % Cf<DQK>::ND]; asm volatile("" : "+v"(b0), "+v"(b1)); }
        else { b0 = *reinterpret_cast<const bf16x8*>(Ks + kswz<DQK>(r32, cb)); b1 = *reinterpret_cast<const bf16x8*>(Ks + kswz<DQK>(32 + r32, cb)); }
        bf16x8 qf; if (d0 < NQR) qf = qr[d0]; else qf = *reinterpret_cast<const bf16x8*>(ql + (d0 - NQR) * 1024);
        if constexpr (VAR == 4) { if (d0 == 0) { p0 = mC; p1 = mC; } p0[d0] += __builtin_bit_cast(float, (int)b0[0] + (int)qf[0]); p1[d0] += __builtin_bit_cast(float, (int)b1[0]); }
        else if (d0 == 0 && DQK == 64) { p0 = mfma_c(b0, qf, mC); p1 = mfma_c(b1, qf, mC); }
        else if (d0 == 0) { p0 = __builtin_amdgcn_mfma_f32_32x32x16_bf16(b0, qf, mC, 0, 0, 0); p1 = __builtin_amdgcn_mfma_f32_32x32x16_bf16(b1, qf, mC, 0, 0, 0); }
        else { p0 = __builtin_amdgcn_mfma_f32_32x32x16_bf16(b0, qf, p0, 0, 0, 0);
        p1 = __builtin_amdgcn_mfma_f32_32x32x16_bf16(b1, qf, p1, 0, 0, 0); } }
}
__device__ __forceinline__ int v_st(int k, int c) { const int kk = (k & ~0xC) | ((k & 4) << 1) | ((k & 8) >> 1); return ((kk >> 3) * 4 + (c >> 5)) * 512 + ((kk & 7) * 32 + (c & 31)) * 2; }
__device__ __forceinline__ int v_rd_base(int lane) { return ((lane & 3) << 3) | (((lane >> 2) & 3) << 6) | (((lane >> 4) & 1) << 5) | (((lane >> 5) & 1) << 8); }
constexpr int v_rd_off(int d0, int ks, int half) { return d0 * 512 + ks * 4096 + half * 2048; }
template <int OFF> __device__ __forceinline__ s16x4 tr_read(int vb) {
    s16x4 r; asm volatile("ds_read_b64_tr_b16 %0, %1 offset:%2" : "=&v"(r) : "v"(vb), "i"(OFF) : "memory"); return r;
}
struct VFrag { s16x4 l0, h0, l1, h1, l2, h2, l3, h3; };
template <int D0> __device__ __forceinline__ void pv_rd(VFrag& f, int vb) {
    f.l0 = tr_read<v_rd_off(D0, 0, 0)>(vb); f.h0 = tr_read<v_rd_off(D0, 0, 1)>(vb); f.l1 = tr_read<v_rd_off(D0, 1, 0)>(vb); f.h1 = tr_read<v_rd_off(D0, 1, 1)>(vb);
    f.l2 = tr_read<v_rd_off(D0, 2, 0)>(vb); f.h2 = tr_read<v_rd_off(D0, 2, 1)>(vb); f.l3 = tr_read<v_rd_off(D0, 3, 0)>(vb); f.h3 = tr_read<v_rd_off(D0, 3, 1)>(vb);
}
template <int VAR = 0>
__device__ __forceinline__ void pv_mf(f32x16& od, const VFrag& f, bf16x8 pa0, bf16x8 pa1, bf16x8 pa2, bf16x8 pa3) {
    if constexpr (VAR == 4) { od[0] += __builtin_bit_cast(float, (int)f.l0[0] + (int)f.h3[0] + (int)pa0[0] + (int)pa3[0]); return; }
#define PK(L_, H_) (bf16x8){L_[0], L_[1], L_[2], L_[3], H_[0], H_[1], H_[2], H_[3]}
    od = __builtin_amdgcn_mfma_f32_32x32x16_bf16(pa0, PK(f.l0, f.h0), od, 0, 0, 0);
    od = __builtin_amdgcn_mfma_f32_32x32x16_bf16(pa1, PK(f.l1, f.h1), od, 0, 0, 0);
    od = __builtin_amdgcn_mfma_f32_32x32x16_bf16(pa2, PK(f.l2, f.h2), od, 0, 0, 0);
    od = __builtin_amdgcn_mfma_f32_32x32x16_bf16(pa3, PK(f.l3, f.h3), od, 0, 0, 0);
#undef PK
}
#ifndef ATT_SG
#define ATT_SG 0
#endif
#ifndef ATT_NOALT
#define ATT_NOALT 1
#endif
__device__ __forceinline__ s16x4 tr_ld(int addr) { return __builtin_amdgcn_ds_read_tr16_b64_v4i16((__attribute__((address_space(3))) s16x4*)(unsigned)addr); }
__device__ __forceinline__ void pv_sg(f32x16* o, int vb, bf16x8 pa0, bf16x8 pa1, bf16x8 pa2, bf16x8 pa3) {
#define PKS(L_, H_) (bf16x8){L_[0], L_[1], L_[2], L_[3], H_[0], H_[1], H_[2], H_[3]}
#pragma unroll
    for (int d0 = 0; d0 < 4; ++d0) {
        const s16x4 l0 = tr_ld(vb + v_rd_off(d0, 0, 0)), h0 = tr_ld(vb + v_rd_off(d0, 0, 1)), l1 = tr_ld(vb + v_rd_off(d0, 1, 0)), h1 = tr_ld(vb + v_rd_off(d0, 1, 1));
        const s16x4 l2 = tr_ld(vb + v_rd_off(d0, 2, 0)), h2 = tr_ld(vb + v_rd_off(d0, 2, 1)), l3 = tr_ld(vb + v_rd_off(d0, 3, 0)), h3 = tr_ld(vb + v_rd_off(d0, 3, 1));
        o[d0] = __builtin_amdgcn_mfma_f32_32x32x16_bf16(pa0, PKS(l0, h0), o[d0], 0, 0, 0);
        o[d0] = __builtin_amdgcn_mfma_f32_32x32x16_bf16(pa1, PKS(l1, h1), o[d0], 0, 0, 0);
        o[d0] = __builtin_amdgcn_mfma_f32_32x32x16_bf16(pa2, PKS(l2, h2), o[d0], 0, 0, 0);
        o[d0] = __builtin_amdgcn_mfma_f32_32x32x16_bf16(pa3, PKS(l3, h3), o[d0], 0, 0, 0); }
#undef PKS
}
#define SG_QK_SM() do { __builtin_amdgcn_sched_group_barrier(0x100, 8, 0); _Pragma("unroll") for (int i_ = 0; i_ < 8; ++i_) { __builtin_amdgcn_sched_group_barrier(0x008, 1, 0); __builtin_amdgcn_sched_group_barrier(0x002, 10, 0); } } while (0)
#define SG_PV_SM() do { __builtin_amdgcn_sched_group_barrier(0x100, 8, 0); _Pragma("unroll") for (int i_ = 0; i_ < 16; ++i_) { __builtin_amdgcn_sched_group_barrier(0x008, 1, 0); __builtin_amdgcn_sched_group_barrier(0x002, 5, 0); if (i_ < 12) __builtin_amdgcn_sched_group_barrier(0x100, 2, 0); } } while (0)
template <int VAR = 0>
__device__ __forceinline__ void pv_d0(f32x16* o, int vb, bf16x8 pa0, bf16x8 pa1, bf16x8 pa2, bf16x8 pa3) {
    if constexpr (VAR == 5) { o[0][0] += __builtin_bit_cast(float, (int)pa0[0] + (int)pa1[0] + (int)pa2[0] + (int)pa3[0]); return; }
    if constexpr (VAR == 7 || VAR == 9) { bf16x8 x = pa0; asm volatile("" : "+v"(x));
#pragma unroll
        for (int d = 0; d < 4; ++d) { o[d] = __builtin_amdgcn_mfma_f32_32x32x16_bf16(pa0, x, o[d], 0, 0, 0); o[d] = __builtin_amdgcn_mfma_f32_32x32x16_bf16(pa1, x, o[d], 0, 0, 0); o[d] = __builtin_amdgcn_mfma_f32_32x32x16_bf16(pa2, x, o[d], 0, 0, 0); o[d] = __builtin_amdgcn_mfma_f32_32x32x16_bf16(pa3, x, o[d], 0, 0, 0); }
        return; }
    VFrag A, B;
    pv_rd<0>(A, vb); pv_rd<1>(B, vb);
    asm volatile("s_waitcnt lgkmcnt(8)" ::: "memory"); SBAR(); pv_mf<VAR>(o[0], A, pa0, pa1, pa2, pa3); SBAR();
    pv_rd<2>(A, vb);
    asm volatile("s_waitcnt lgkmcnt(8)" ::: "memory"); SBAR(); pv_mf<VAR>(o[1], B, pa0, pa1, pa2, pa3); SBAR();
    pv_rd<3>(B, vb);
    asm volatile("s_waitcnt lgkmcnt(8)" ::: "memory"); SBAR(); pv_mf<VAR>(o[2], A, pa0, pa1, pa2, pa3); SBAR();
    asm volatile("s_waitcnt lgkmcnt(0)" ::: "memory"); SBAR(); pv_mf<VAR>(o[3], B, pa0, pa1, pa2, pa3);
}

template <int DQK>
__device__ __forceinline__ void pv_partial(f32x16* o, int vb, bf16x8 pa0, bf16x8 pa1, bf16x8 pa2, bf16x8 pa3, f32x16& p0, f32x16& p1, f32x16& mC, float& alpha, float& ps0) {
    VFrag A, B;
    pv_rd<0>(A, vb); pv_rd<1>(B, vb);
    asm volatile("s_waitcnt lgkmcnt(8)" ::: "memory"); SBAR(); pv_mf<0>(o[0], A, pa0, pa1, pa2, pa3);
    float pmax = p0[0];
#pragma unroll
    for (int r = 1; r < 16; ++r) pmax = fmaxf(pmax, p0[r]);
#pragma unroll
    for (int r = 0; r < 16; ++r) pmax = fmaxf(pmax, p1[r]);
    { auto rr = __builtin_amdgcn_permlane32_swap(__float_as_uint(pmax), __float_as_uint(pmax), false, false);
      pmax = fmaxf(__uint_as_float(rr[0]), __uint_as_float(rr[1])); }
    asm volatile("" : "+v"(pmax));
    SBAR();
    pv_rd<2>(A, vb);
    if (__builtin_expect(__all(pmax <= THR2), 1)) alpha = 1.f;
    else { const float d = fmaxf(pmax, 0.f); alpha = __builtin_amdgcn_exp2f(-d);
#pragma unroll
        for (int r = 0; r < 16; ++r) { p0[r] -= d; p1[r] -= d; mC[r] -= d; } }
#define EXPP(x_) do { float e_ = __builtin_amdgcn_exp2f(x_); asm volatile("" : "+v"(e_)); x_ = e_; } while (0)
    asm volatile("s_waitcnt lgkmcnt(8)" ::: "memory"); SBAR(); pv_mf<0>(o[1], B, pa0, pa1, pa2, pa3);
#pragma unroll
    for (int r = 0; r < 11; ++r) EXPP(p0[r]);
    SBAR();
    pv_rd<3>(B, vb);
    asm volatile("s_waitcnt lgkmcnt(8)" ::: "memory"); SBAR(); pv_mf<0>(o[2], A, pa0, pa1, pa2, pa3);
#pragma unroll
    for (int r = 11; r < 16; ++r) EXPP(p0[r]);
#pragma unroll
    for (int r = 0; r < 6; ++r) EXPP(p1[r]);
    SBAR();
    asm volatile("s_waitcnt lgkmcnt(0)" ::: "memory"); SBAR(); pv_mf<0>(o[3], B, pa0, pa1, pa2, pa3);
#pragma unroll
    for (int r = 6; r < 16; ++r) EXPP(p1[r]);
    float ps = 0.f;
#pragma unroll
    for (int r = 0; r < 16; ++r) ps += p0[r];
    asm volatile("" : "+v"(ps)); ps0 = ps;
    SBAR();
#undef EXPP
}
__device__ __forceinline__ void finishSM2(f32x16& p0, f32x16& p1, float ps0, float alpha, float& l_reg, bf16x8& pa0, bf16x8& pa1, bf16x8& pa2, bf16x8& pa3) {
    float ps = ps0;
#pragma unroll
    for (int r = 0; r < 16; ++r) ps += p1[r];
    { auto rr = __builtin_amdgcn_permlane32_swap(__float_as_uint(ps), __float_as_uint(ps), false, false);
      ps = __uint_as_float(rr[0]) + __uint_as_float(rr[1]); }
    l_reg = l_reg * alpha + ps;
    PK4H(p0, 0, pa0); PK4H(p0, 8, pa1); PK4H(p1, 0, pa2); PK4H(p1, 8, pa3);
}

struct KSrc { const bf16_t* ka; int lda; const bf16_t* kb; int ldb; };
struct AOut {
    bf16_t* O; int ldo; float* stash; const float* subg; float lam; int sub;
};
template <int DQK, int SDEPTH, int MODE, int VAR, bool ALT>
__device__ __forceinline__ void attn_body_impl(const bf16_t* __restrict__ Qb, int ldq, const KSrc ks, const bf16_t* __restrict__ Vh, int ldv, int seq, char* lds, const AOut ao) {
    using C = Cf<DQK>; constexpr int ND = C::ND, KC = C::KC, CPR = C::CPR, CA = DQK == 192 ? 16 : CPR; constexpr size_t SHM_K = C::SHM_K;
    int tid_ = threadIdx.x; asm volatile("" : "+v"(tid_));
    const int tid = tid_, wid = tid >> 6, lane = tid & 63, r32 = lane & 31, hi = lane >> 5;
    char* V_lds = lds; char* K_lds = lds + 2 * SHM_V;
    float* ws = (float*)(lds + 2 * SHM_V + 2 * SHM_K) + wid * 64; float* li_l = ws; float* al_l = ws + 32;
    constexpr int NQR = ND;
    char* ql = lds + 2 * SHM_V + 2 * SHM_K + NW * 64 * 4 + wid * 4096 + lane * 16;
    float l_reg = 0; f32x16 o[4] = {}, mC = {}; bf16x8 qr[NQR];
    const bf16_t* Qw = Qb + (long)(wid * QBLK + r32) * ldq + hi * 8;
#pragma unroll
    for (int d0 = 0; d0 < ND; ++d0) { const bf16x8 qv = *reinterpret_cast<const bf16x8*>(Qw + d0 * 16); if (d0 < NQR) qr[d0] = qv; else *reinterpret_cast<bf16x8*>(ql + (d0 - NQR) * 1024) = qv; }
    const int sr = tid >> 4, sc = (tid & 15) * 8, vst0 = v_st(sr, sc), vst1 = v_st(32 + sr, sc);
    const int vb0 = (int)(uintptr_t)V_lds + v_rd_base(lane);
    const bf16_t* kptr[KC]; int kstride[KC]; int klds[KC];
#pragma unroll
    for (int i = 0; i < KC; ++i) { const int q = tid + 512 * i, row = q / CPR, c8 = q % CPR; klds[i] = kswz<DQK>(row, c8 * 16);
        if (c8 < CA) { kptr[i] = ks.ka + (long)row * ks.lda + c8 * 8; kstride[i] = ks.lda; } else { kptr[i] = ks.kb + (long)row * ks.ldb + (c8 - CA) * 8; kstride[i] = ks.ldb; } }
    struct Slot { bf16x8 vs0, vs1; bf16x8 kk[KC]; } sl[SDEPTH];
#define SLOAD(i_, k0_) do { if constexpr (VAR == 1 || VAR == 9) break; sl[i_].vs0 = *reinterpret_cast<const bf16x8*>(&Vh[(long)((k0_) + sr) * ldv + sc]); sl[i_].vs1 = *reinterpret_cast<const bf16x8*>(&Vh[(long)((k0_) + 32 + sr) * ldv + sc]); \
    _Pragma("unroll") for (int c_ = 0; c_ < KC; ++c_) sl[i_].kk[c_] = *reinterpret_cast<const bf16x8*>(kptr[c_] + (long)(k0_) * kstride[c_]); } while (0)
#define SWRITE(b_, i_) do { if constexpr (VAR == 1 || VAR == 9) break; *(bf16x8*)(V_lds + (b_) * SHM_V + vst0) = sl[i_].vs0; *(bf16x8*)(V_lds + (b_) * SHM_V + vst1) = sl[i_].vs1; \
    _Pragma("unroll") for (int c_ = 0; c_ < KC; ++c_) *(bf16x8*)(K_lds + (b_) * SHM_K + klds[c_]) = sl[i_].kk[c_]; } while (0)
#define SWAIT() do { if constexpr (SDEPTH == 2) { if constexpr (KC == 3) asm volatile("s_waitcnt vmcnt(5)" ::: "memory"); else asm volatile("s_waitcnt vmcnt(3)" ::: "memory"); } \
    else asm volatile("s_waitcnt vmcnt(0)" ::: "memory"); } while (0)
#define RESC(a_) do { if (__any((a_) < 1.f)) { if (hi == 0) al_l[r32] = (a_); asm volatile("s_waitcnt lgkmcnt(0)" ::: "memory"); \
    _Pragma("unroll") for (int d_ = 0; d_ < 4; ++d_) _Pragma("unroll") for (int r_ = 0; r_ < 16; ++r_) o[d_][r_] *= al_l[crow(r_, hi)]; } } while (0)
    f32x16 pA0, pA1, pB0, pB1; float alA, alB; bf16x8 pa0, pa1, pa2, pa3; const int NT = seq / KVBLK;
    constexpr int SE = 0, SO = SDEPTH - 1;
    SLOAD(SE, 0); asm volatile("s_waitcnt vmcnt(0)" ::: "memory"); SWRITE(0, SE); __syncthreads();
    qkt<DQK, NQR, VAR>(pA0, pA1, K_lds, qr, ql, r32, hi, mC); partialSM<DQK, VAR, true>(pA0, pA1, mC, alA);
    SLOAD(SO, KVBLK); if constexpr (SDEPTH == 2) { if (2 < NT) SLOAD(SE, 2 * KVBLK); }
    SWAIT(); SWRITE(1, SO); __syncthreads();
    constexpr bool alt = ALT;
#if ATT_SG
    (void)alt;
    for (int j = 1; j + 1 < NT; j += 2) {
        SBAR(); qkt<DQK, NQR, VAR>(pB0, pB1, K_lds + SHM_K, qr, ql, r32, hi, mC); finishSM<VAR>(pA0, pA1, alA, l_reg, pa0, pa1, pa2, pa3); SG_QK_SM(); SBAR();
        SLOAD(SO, (j + SDEPTH) * KVBLK); SBAR();
        pv_sg(o, vb0, pa0, pa1, pa2, pa3); partialSM<DQK, VAR>(pB0, pB1, mC, alB); SG_PV_SM(); SBAR();
        __syncthreads(); SWAIT(); SWRITE(0, SE);
        RESC(alB); __syncthreads();
        SBAR(); qkt<DQK, NQR, VAR>(pA0, pA1, K_lds, qr, ql, r32, hi, mC); finishSM<VAR>(pB0, pB1, alB, l_reg, pa0, pa1, pa2, pa3); SG_QK_SM(); SBAR();
        if (SDEPTH == 1 || j + 3 < NT) SLOAD(SE, (j + 1 + SDEPTH) * KVBLK); SBAR();
        pv_sg(o, vb0 + (int)SHM_V, pa0, pa1, pa2, pa3); partialSM<DQK, VAR>(pA0, pA1, mC, alA); SG_PV_SM(); SBAR();
        __syncthreads(); SWAIT(); SWRITE(1, SO);
        RESC(alA); __syncthreads();
    }
#else
    for (int j = 1; j + 1 < NT; j += 2) {
        if constexpr (!alt) {
            SBAR(); qkt<DQK, NQR, VAR>(pB0, pB1, K_lds + SHM_K, qr, ql, r32, hi, mC);
            finishSM<VAR>(pA0, pA1, alA, l_reg, pa0, pa1, pa2, pa3); SBAR();
            SLOAD(SO, (j + SDEPTH) * KVBLK); SBAR();
            pv_d0<VAR>(o, vb0, pa0, pa1, pa2, pa3); partialSM<DQK, VAR>(pB0, pB1, mC, alB);
        } else {
            SBAR(); finishSM<VAR>(pA0, pA1, alA, l_reg, pa0, pa1, pa2, pa3); SBAR();
            qkt<DQK, NQR, VAR>(pB0, pB1, K_lds + SHM_K, qr, ql, r32, hi, mC); SBAR();
            SLOAD(SO, (j + SDEPTH) * KVBLK); SBAR();
            partialSM<DQK, VAR>(pB0, pB1, mC, alB); SBAR(); pv_d0<VAR>(o, vb0, pa0, pa1, pa2, pa3);
        }
        if constexpr (VAR != 6 && VAR != 9) __syncthreads(); SWAIT(); SWRITE(0, SE);
        RESC(alB); if constexpr (VAR != 6 && VAR != 9) __syncthreads();
        if constexpr (!alt) {
            SBAR(); qkt<DQK, NQR, VAR>(pA0, pA1, K_lds, qr, ql, r32, hi, mC);
            finishSM<VAR>(pB0, pB1, alB, l_reg, pa0, pa1, pa2, pa3); SBAR();
            if (SDEPTH == 1 || j + 3 < NT) SLOAD(SE, (j + 1 + SDEPTH) * KVBLK); SBAR();
            pv_d0<VAR>(o, vb0 + (int)SHM_V, pa0, pa1, pa2, pa3); partialSM<DQK, VAR>(pA0, pA1, mC, alA);
        } else {
            SBAR(); finishSM<VAR>(pB0, pB1, alB, l_reg, pa0, pa1, pa2, pa3); SBAR();
            qkt<DQK, NQR, VAR>(pA0, pA1, K_lds, qr, ql, r32, hi, mC); SBAR();
            if (SDEPTH == 1 || j + 3 < NT) SLOAD(SE, (j + 1 + SDEPTH) * KVBLK); SBAR();
            partialSM<DQK, VAR>(pA0, pA1, mC, alA); SBAR(); pv_d0<VAR>(o, vb0 + (int)SHM_V, pa0, pa1, pa2, pa3);
        }
        if constexpr (VAR != 6 && VAR != 9) __syncthreads(); SWAIT(); SWRITE(1, SO);
        RESC(alA); if constexpr (VAR != 6 && VAR != 9) __syncthreads();
    }
#endif
    SBAR(); qkt<DQK, NQR, VAR>(pB0, pB1, K_lds + SHM_K, qr, ql, r32, hi, mC);
    finishSM<VAR>(pA0, pA1, alA, l_reg, pa0, pa1, pa2, pa3); SBAR();
    pv_d0<VAR>(o, vb0, pa0, pa1, pa2, pa3); partialSM<DQK, VAR>(pB0, pB1, mC, alB);
    __syncthreads(); RESC(alB);
    finishSM<VAR>(pB0, pB1, alB, l_reg, pa0, pa1, pa2, pa3); SBAR();
    pv_d0<VAR>(o, vb0 + (int)SHM_V, pa0, pa1, pa2, pa3);
    if (hi == 0) li_l[r32] = l_reg; asm volatile("s_waitcnt lgkmcnt(0)" ::: "memory");
    float rli[16];
#pragma unroll
    for (int r = 0; r < 16; ++r) rli[r] = __builtin_amdgcn_rcpf(li_l[crow(r, hi)]);
    if constexpr (MODE == 0) {
        bf16_t* Ow = ao.O + (long)(wid * QBLK) * ao.ldo;
#pragma unroll
        for (int r = 0; r < 16; ++r) { const int orow = crow(r, hi);
#pragma unroll
            for (int d0 = 0; d0 < 4; ++d0) Ow[(long)orow * ao.ldo + d0 * 32 + r32] = f2bf(o[d0][r] * rli[r]); }
    } else {
        float* st = ao.stash + (wid * 64) * 64 + lane;
        if (ao.sub == 0) {
#pragma unroll
            for (int r = 0; r < 16; ++r)
#pragma unroll
                for (int d0 = 0; d0 < 4; ++d0) st[(r * 4 + d0) * 64] = o[d0][r] * rli[r];
        } else {
            const float lam = ao.lam; float sg[4];
#pragma unroll
            for (int d0 = 0; d0 < 4; ++d0) sg[d0] = ao.subg[d0 * 32 + r32] * (1.f - LAM_INIT);
            bf16_t* Ow = ao.O + (long)(wid * QBLK) * ao.ldo;
#pragma unroll
            for (int r = 0; r < 16; ++r) { float ss = 0.f;
#pragma unroll
                for (int d0 = 0; d0 < 4; ++d0) { const float v = st[(r * 4 + d0) * 64] - lam * (o[d0][r] * rli[r]); o[d0][r] = v; ss += v * v; }
                ss += __shfl_xor(ss, 1); ss += __shfl_xor(ss, 2); ss += __shfl_xor(ss, 4); ss += __shfl_xor(ss, 8); ss += __shfl_xor(ss, 16);
                const float rn = 1.0f / sqrtf(ss * (1.f / 128.f) + EPS); const int orow = crow(r, hi);
#pragma unroll
                for (int d0 = 0; d0 < 4; ++d0) Ow[(long)orow * ao.ldo + d0 * 32 + r32] = f2bf(o[d0][r] * rn * sg[d0]); }
        }
    }
    asm volatile("s_waitcnt vmcnt(0) lgkmcnt(0)" ::: "memory");
    __syncthreads();
#undef SLOAD
#undef SWRITE
#undef SWAIT
#undef RESC
}
template <int DQK, int SDEPTH, int MODE, int VAR = 0>
__device__ __forceinline__ void attn_body(const bf16_t* __restrict__ Qb, int ldq, const KSrc ks, const bf16_t* __restrict__ Vh, int ldv, int seq, char* lds, const AOut ao) {
    if (__builtin_amdgcn_readfirstlane((int)threadIdx.x >> 8) == 0) attn_body_impl<DQK, SDEPTH, MODE, VAR, false>(Qb, ldq, ks, Vh, ldv, seq, lds, ao);
    else attn_body_impl<DQK, SDEPTH, MODE, VAR, true>(Qb, ldq, ks, Vh, ldv, seq, lds, ao);
}
template <int MODE, bool ALT>
__device__ __forceinline__ void attn_dma_impl(const bf16_t* __restrict__ Qb, int ldq, const bf16_t* __restrict__ Kh, int ldk, const bf16_t* __restrict__ Vh, int ldv, int seq, char* lds, const AOut ao) {
    constexpr int DQK = 64, ND = 4, SV = 16384, SK = 8192, KOFF = 3 * SV, WSOFF = 3 * SV + 3 * SK;
    int tid_ = threadIdx.x; asm volatile("" : "+v"(tid_));
    const int tid = tid_, wid = tid >> 6, lane = tid & 63, r32 = lane & 31, hi = lane >> 5;
    const unsigned widu = (unsigned)__builtin_amdgcn_readfirstlane(wid), ldsb = (unsigned)(uintptr_t)lds;
    float* ws = (float*)(lds + WSOFF) + wid * 64; float* li_l = ws; float* al_l = ws + 32;
    float l_reg = 0; f32x16 o[4] = {}, mC = {}; bf16x8 qr[ND];
    const bf16_t* Qw = Qb + (long)(wid * QBLK + r32) * ldq + hi * 8;
#pragma unroll
    for (int d0 = 0; d0 < ND; ++d0) qr[d0] = *reinterpret_cast<const bf16x8*>(Qw + d0 * 16);
    const int vb0 = (int)ldsb + v_rd_base(lane);
    const int pk = wid * 64 + lane, krow = pk >> 3, kc8 = (pk & 7) ^ ((krow >> 1) & 7);
    const unsigned koff = (unsigned)(krow * ldk + kc8 * 8) * 2u; unsigned voff[2];
#pragma unroll
    for (int i = 0; i < 2; ++i) { const int pv = (wid + 8 * i) * 64 + lane, kk = ((pv >> 7) << 3) | ((pv >> 2) & 7), k = (kk & ~0xC) | ((kk & 4) << 1) | ((kk & 8) >> 1), cc = (((pv >> 5) & 3) << 5) | ((pv & 3) << 3);
        voff[i] = (unsigned)(k * ldv + cc) * 2u; }
    const size_t kstep = (size_t)64 * ldk * 2, vstep = (size_t)64 * ldv * 2;
#define DMA_K(t_) do { const char* g_ = (const char*)Kh + (size_t)(t_) * kstep; asm volatile("" : "+s"(g_)); \
    __builtin_amdgcn_global_load_lds((const unsigned*)(g_ + koff), (LAS unsigned*)(ldsb + KOFF + ((t_) % 3) * SK + widu * 1024u), 16, 0, 0); } while (0)
#define DMA_V(t_) do { const char* g_ = (const char*)Vh + (size_t)(t_) * vstep; asm volatile("" : "+s"(g_)); \
    __builtin_amdgcn_global_load_lds((const unsigned*)(g_ + voff[0]), (LAS unsigned*)(ldsb + ((t_) % 3) * SV + widu * 1024u), 16, 0, 0); \
    __builtin_amdgcn_global_load_lds((const unsigned*)(g_ + voff[1]), (LAS unsigned*)(ldsb + ((t_) % 3) * SV + (widu + 8u) * 1024u), 16, 0, 0); } while (0)
#define SYNC(n_) do { asm volatile("s_waitcnt vmcnt(" #n_ ") lgkmcnt(0)" ::: "memory"); __builtin_amdgcn_s_barrier(); asm volatile("" ::: "memory"); } while (0)
#define KS(t_) (lds + KOFF + ((t_) % 3) * SK)
#define VS(t_) (vb0 + ((t_) % 3) * SV)
#define RESC(a_) do { if (__any((a_) < 1.f)) { if (hi == 0) al_l[r32] = (a_); asm volatile("s_waitcnt lgkmcnt(0)" ::: "memory"); \
    _Pragma("unroll") for (int d_ = 0; d_ < 4; ++d_) _Pragma("unroll") for (int r_ = 0; r_ < 16; ++r_) o[d_][r_] *= al_l[crow(r_, hi)]; } } while (0)
    f32x16 pA0, pA1, pB0, pB1; float alA, alB, psA = 0.f, psB = 0.f; bf16x8 pa0, pa1, pa2, pa3; const int NT = seq / KVBLK; KFrag kf;
    DMA_K(0); DMA_V(0); DMA_K(1);
    SYNC(3);
    DMA_K(2); DMA_V(1);
    qkt<DQK, ND, 0>(pA0, pA1, KS(0), qr, nullptr, r32, hi, mC); partialSM<DQK, 0, true>(pA0, pA1, mC, alA);
    if constexpr (!ALT) {
#pragma unroll
        for (int r = 0; r < 16; ++r) { pA1[r] = __builtin_amdgcn_exp2f(pA1[r]); psA += pA0[r]; } }
    SYNC(3);
    constexpr bool alt = ALT;
#pragma unroll 1
    for (int j = 1; j + 1 < NT; j += 2) {
        DMA_K(j + 2); DMA_V(j + 1);
        if constexpr (!alt) {
            qkt_ld(kf, KS(j), r32, hi); SBAR(); qkt_mf(pB0, pB1, kf, qr, mC);
            finishSM2(pA0, pA1, psA, alA, l_reg, pa0, pa1, pa2, pa3); SBAR();
            pv_partial<DQK>(o, VS(j - 1), pa0, pa1, pa2, pa3, pB0, pB1, mC, alB, psB);
        } else {
            qkt_ld(kf, KS(j), r32, hi); SBAR(); finishSM<0>(pA0, pA1, alA, l_reg, pa0, pa1, pa2, pa3); SBAR();
            qkt_mf(pB0, pB1, kf, qr, mC); SBAR();
            partialSM<DQK, 0>(pB0, pB1, mC, alB); SBAR(); pv_d0<0>(o, VS(j - 1), pa0, pa1, pa2, pa3);
        }
        RESC(alB); SYNC(3);
        const bool more = j + 3 < NT;
        if (more) DMA_K(j + 3);
        DMA_V(j + 2);
        if constexpr (!alt) {
            qkt_ld(kf, KS(j + 1), r32, hi); SBAR(); qkt_mf(pA0, pA1, kf, qr, mC);
            finishSM2(pB0, pB1, psB, alB, l_reg, pa0, pa1, pa2, pa3); SBAR();
            pv_partial<DQK>(o, VS(j), pa0, pa1, pa2, pa3, pA0, pA1, mC, alA, psA);
        } else {
            qkt_ld(kf, KS(j + 1), r32, hi); SBAR(); finishSM<0>(pB0, pB1, alB, l_reg, pa0, pa1, pa2, pa3); SBAR();
            qkt_mf(pA0, pA1, kf, qr, mC); SBAR();
            partialSM<DQK, 0>(pA0, pA1, mC, alA); SBAR(); pv_d0<0>(o, VS(j), pa0, pa1, pa2, pa3);
        }
        RESC(alA); if (more) SYNC(3); else SYNC(0);
    }
    SBAR(); qkt<DQK, ND, 0>(pB0, pB1, KS(NT - 1), qr, nullptr, r32, hi, mC);
    finishSM2(pA0, pA1, psA, alA, l_reg, pa0, pa1, pa2, pa3); SBAR();
    pv_partial<DQK>(o, VS(NT - 2), pa0, pa1, pa2, pa3, pB0, pB1, mC, alB, psB);
    RESC(alB);
    finishSM2(pB0, pB1, psB, alB, l_reg, pa0, pa1, pa2, pa3); SBAR();
    pv_d0<0>(o, VS(NT - 1), pa0, pa1, pa2, pa3);
    if (hi == 0) li_l[r32] = l_reg; asm volatile("s_waitcnt lgkmcnt(0)" ::: "memory");
    float rli[16];
#pragma unroll
    for (int r = 0; r < 16; ++r) rli[r] = __builtin_amdgcn_rcpf(li_l[crow(r, hi)]);
    if constexpr (MODE == 0) {
        bf16_t* Ow = ao.O + (long)(wid * QBLK) * ao.ldo;
#pragma unroll
        for (int r = 0; r < 16; ++r) { const int orow = crow(r, hi);
#pragma unroll
            for (int d0 = 0; d0 < 4; ++d0) Ow[(long)orow * ao.ldo + d0 * 32 + r32] = f2bf(o[d0][r] * rli[r]); }
    } else {
        float* st = ao.stash + (wid * 64) * 64 + lane;
        if (ao.sub == 0) {
#pragma unroll
            for (int r = 0; r < 16; ++r)
#pragma unroll
                for (int d0 = 0; d0 < 4; ++d0) st[(r * 4 + d0) * 64] = o[d0][r] * rli[r];
        } else {
            const float lam = ao.lam; float sg[4];
#pragma unroll
            for (int d0 = 0; d0 < 4; ++d0) sg[d0] = ao.subg[d0 * 32 + r32] * (1.f - LAM_INIT);
            bf16_t* Ow = ao.O + (long)(wid * QBLK) * ao.ldo;
#pragma unroll
            for (int r = 0; r < 16; ++r) { float ss = 0.f;
#pragma unroll
                for (int d0 = 0; d0 < 4; ++d0) { const float v = st[(r * 4 + d0) * 64] - lam * (o[d0][r] * rli[r]); o[d0][r] = v; ss += v * v; }
                ss += __shfl_xor(ss, 1); ss += __shfl_xor(ss, 2); ss += __shfl_xor(ss, 4); ss += __shfl_xor(ss, 8); ss += __shfl_xor(ss, 16);
                const float rn = 1.0f / sqrtf(ss * (1.f / 128.f) + EPS); const int orow = crow(r, hi);
#pragma unroll
                for (int d0 = 0; d0 < 4; ++d0) Ow[(long)orow * ao.ldo + d0 * 32 + r32] = f2bf(o[d0][r] * rn * sg[d0]); }
        }
    }
    asm volatile("s_waitcnt vmcnt(0) lgkmcnt(0)" ::: "memory");
    __syncthreads();
#undef DMA_K
#undef DMA_V
#undef SYNC
#undef KS
#undef VS
#undef RESC
}
template <int MODE>
__device__ __forceinline__ void attn_body_dma(const bf16_t* __restrict__ Qb, int ldq, const bf16_t* __restrict__ Kh, int ldk, const bf16_t* __restrict__ Vh, int ldv, int seq, char* lds, const AOut ao) {
#if ATT_NOALT
    attn_dma_impl<MODE, false>(Qb, ldq, Kh, ldk, Vh, ldv, seq, lds, ao);
#else
    if (__builtin_amdgcn_readfirstlane((int)threadIdx.x >> 8) == 0) attn_dma_impl<MODE, false>(Qb, ldq, Kh, ldk, Vh, ldv, seq, lds, ao);
    else attn_dma_impl<MODE, true>(Qb, ldq, Kh, ldk, Vh, ldv, seq, lds, ao);
#endif
}
template <int DQK>
__device__ __forceinline__ void attn_body_np(const bf16_t* __restrict__ Qb, int ldq, const KSrc ks, const bf16_t* __restrict__ Vh, int ldv, int seq, char* lds, const AOut ao) {
    using C = Cf<DQK>; constexpr int ND = C::ND, KC = C::KC, CPR = C::CPR, CA = DQK == 192 ? 16 : CPR; constexpr size_t SHM_K = C::SHM_K;
    int tid_ = threadIdx.x; asm volatile("" : "+v"(tid_));
    const int tid = tid_, wid = tid >> 6, lane = tid & 63, r32 = lane & 31, hi = lane >> 5;
    char* V_lds = lds; char* K_lds = lds + 2 * SHM_V;
    float* ws = (float*)(lds + 2 * SHM_V + 2 * SHM_K) + wid * 64; float* li_l = ws; float* al_l = ws + 32;
    float l_reg = 0; f32x16 o[4] = {}, mC = {}; bf16x8 qr[ND];
    const bf16_t* Qw = Qb + (long)(wid * QBLK + r32) * ldq + hi * 8;
#pragma unroll
    for (int d0 = 0; d0 < ND; ++d0) qr[d0] = *reinterpret_cast<const bf16x8*>(Qw + d0 * 16);
    const int sr = tid >> 4, sc = (tid & 15) * 8, vst0 = v_st(sr, sc), vst1 = v_st(32 + sr, sc);
    const int vb0 = (int)(uintptr_t)V_lds + v_rd_base(lane);
    const char* kbase = (const char*)ks.ka < (const char*)ks.kb ? (const char*)ks.ka : (const char*)ks.kb;
    unsigned koff[KC], kstride[KC]; int klds[KC];
#pragma unroll
    for (int i = 0; i < KC; ++i) { const int q = tid + 512 * i, row = q / CPR, c8 = q % CPR; klds[i] = kswz<DQK>(row, c8 * 16);
        if (c8 < CA) { koff[i] = (unsigned)((const char*)(ks.ka + (long)row * ks.lda + c8 * 8) - kbase); kstride[i] = (unsigned)ks.lda * 2u; }
        else { koff[i] = (unsigned)((const char*)(ks.kb + (long)row * ks.ldb + (c8 - CA) * 8) - kbase); kstride[i] = (unsigned)ks.ldb * 2u; } }
    const unsigned voff0 = (unsigned)(sr * ldv + sc) * 2u, voff1 = voff0 + (unsigned)ldv * 64u;
    bf16x8 vs0, vs1, kk[KC];
#define SLOAD1(k0_) do { const char* vb_ = (const char*)Vh + (size_t)(k0_) * (size_t)(ldv * 2); vs0 = *reinterpret_cast<const bf16x8*>(vb_ + voff0); vs1 = *reinterpret_cast<const bf16x8*>(vb_ + voff1); \
    _Pragma("unroll") for (int c_ = 0; c_ < KC; ++c_) kk[c_] = *reinterpret_cast<const bf16x8*>(kbase + (koff[c_] + (unsigned)(k0_) * kstride[c_])); } while (0)
#define SWRITE1(b_) do { *(bf16x8*)(V_lds + (b_) * SHM_V + vst0) = vs0; *(bf16x8*)(V_lds + (b_) * SHM_V + vst1) = vs1; \
    _Pragma("unroll") for (int c_ = 0; c_ < KC; ++c_) *(bf16x8*)(K_lds + (b_) * SHM_K + klds[c_]) = kk[c_]; } while (0)
    f32x16 p0, p1; float al; bf16x8 pa0, pa1, pa2, pa3; const int NT = seq / KVBLK;
    SLOAD1(0); asm volatile("s_waitcnt vmcnt(0)" ::: "memory"); SWRITE1(0); SLOAD1(KVBLK); __syncthreads();
#pragma unroll 1
    for (int j = 0; j < NT; ++j) {
        const int buf = j & 1;
        SBAR(); qkt<DQK, ND>(p0, p1, K_lds + buf * SHM_K, qr, nullptr, r32, hi, mC);
        if (j == 0) partialSM<DQK, 0, true>(p0, p1, mC, al); else partialSM<DQK>(p0, p1, mC, al);
        if (__any(al < 1.f)) { if (hi == 0) al_l[r32] = al; asm volatile("s_waitcnt lgkmcnt(0)" ::: "memory");
#pragma unroll
            for (int d_ = 0; d_ < 4; ++d_)
#pragma unroll
                for (int r_ = 0; r_ < 16; ++r_) o[d_][r_] *= al_l[crow(r_, hi)]; }
        finishSM(p0, p1, al, l_reg, pa0, pa1, pa2, pa3); SBAR();
        if (j + 1 < NT) { asm volatile("s_waitcnt vmcnt(0)" ::: "memory"); SWRITE1(buf ^ 1); if (j + 2 < NT) SLOAD1((j + 2) * KVBLK); }
        SBAR();
        pv_d0(o, vb0 + buf * (int)SHM_V, pa0, pa1, pa2, pa3);
        __syncthreads();
    }
#undef SLOAD1
#undef SWRITE1
    if (hi == 0) li_l[r32] = l_reg; asm volatile("s_waitcnt lgkmcnt(0)" ::: "memory");
    float rli[16];
#pragma unroll
    for (int r = 0; r < 16; ++r) rli[r] = __builtin_amdgcn_rcpf(li_l[crow(r, hi)]);
    bf16_t* Ow = ao.O + (long)(wid * QBLK) * ao.ldo;
#pragma unroll
    for (int r = 0; r < 16; ++r) { const int orow = crow(r, hi);
#pragma unroll
        for (int d0 = 0; d0 < 4; ++d0) Ow[(long)orow * ao.ldo + d0 * 32 + r32] = f2bf(o[d0][r] * rli[r]); }
    asm volatile("s_waitcnt vmcnt(0) lgkmcnt(0)" ::: "memory");
    __syncthreads();
}
}
constexpr int M = NB * S, ML = NB * T;
constexpr int NCH = ML / 256;
constexpr int MAXT = 2 * ML / 256 + NE;
constexpr size_t al256(size_t x) { return (x + 255) / 256 * 256; }
constexpr size_t WS_CTL = 0, CTL_BYTES = 1u << 20;
constexpr int CW_BAR = 4096;
constexpr int CW_TICKET = 64;
constexpr size_t WS_MODV = WS_CTL + CTL_BYTES;
constexpr size_t WS_ROPE = WS_MODV + al256((size_t)2 * 33 * 6144 * 4);
constexpr size_t WS_W = WS_ROPE + 2 * 2048 * 32 * 4;
constexpr size_t W_IN0 = WS_W, W_UQ = W_IN0 + (size_t)2304 * 1024 * 2, W_UKV = W_UQ + (size_t)768 * 384 * 2, W_OUT0 = W_UKV + (size_t)1024 * 256 * 2,
    W_GU0 = W_OUT0 + (size_t)1024 * 1024 * 2, W_DN0 = W_GU0 + (size_t)5632 * 1024 * 2, W_IN1 = W_DN0 + (size_t)1024 * 2816 * 2, W_FOLD = W_IN1 + (size_t)2304 * 1024 * 2,
    W_OUT1 = W_FOLD + (size_t)512 * 1024 * 2, W_GU1 = W_OUT1 + (size_t)1024 * 1024 * 2, W_DN1 = W_GU1 + (size_t)NE * 5632 * 1024, W_DFT = W_DN1 + (size_t)NE * 1024 * 2816,
    WS_WEND = W_DFT + (size_t)2048 * 4096 * 2;
constexpr size_t WS_CTXS = WS_WEND;
constexpr size_t WS_STASH = WS_CTXS;
constexpr size_t CTXS_BYTES = ((size_t)NB * L * D * 4 > (size_t)256 * 131072) ? (size_t)NB * L * D * 4 : (size_t)256 * 131072;
constexpr size_t WS_ROUTE = WS_CTXS + CTXS_BYTES;
constexpr size_t RT_INFO = WS_ROUTE, RT_W = RT_INFO + (size_t)ML * 16, RT_POS = RT_W + (size_t)ML * 8, RT_WCNT = RT_POS + (size_t)ML * 8, RT_TOFF = RT_WCNT + (size_t)NCH * 64 * 4, WS_RTEND = al256(RT_TOFF + 256);
constexpr size_t W8_IN0 = WS_RTEND, W8_GU0 = W8_IN0 + (size_t)2304 * 1024, W8_IN1 = W8_GU0 + (size_t)5632 * 1024, W8_FOLD = W8_IN1 + (size_t)2304 * 1024, W8_END = W8_FOLD + (size_t)512 * 1024;
constexpr size_t SW_IN0 = W8_END, SW_GU0 = SW_IN0 + 2304 * 4, SW_IN1 = SW_GU0 + 5632 * 4, SW_FOLD = SW_IN1 + 2304 * 4, SW_GU1 = SW_FOLD + 512 * 4, SW_END = SW_GU1 + (size_t)NE * 5632 * 4;
constexpr size_t SA_ROW = al256(SW_END), SA_TOK = SA_ROW + (size_t)M * 4, SA_SORT = SA_TOK + (size_t)ML * 4, WS_I8END = al256(SA_SORT + ((size_t)2 * ML + NE * 256) * 4);
constexpr size_t AR = WS_I8END;
constexpr size_t SROWS = (size_t)2 * ML + NE * 256;
constexpr size_t H2S_BYTES = SROWS * 1024, FS_BYTES = SROWS * 2048, ACTM_BYTES = (size_t)MAXT * 256 * 2816, GT_BYTES = (size_t)NB * 256 * 4096 * 2;
#if CFG_NB >= 32
constexpr size_t AR_A = AR, AR_B = AR + (size_t)M * 2048, AR_C = AR + (size_t)M * 4096, AR_D = AR_C + (size_t)M * 5632;
constexpr size_t AR_END = AR_D + (size_t)M * 1280;
constexpr size_t B_H = AR_A, B_Q0 = AR_A, B_Y = AR_A, B_F = AR_A, B_AOUT1 = AR_A, B_H2TOK = AR_A, B_FS = AR_A;
constexpr size_t B_AOUT0 = AR_B, B_H2 = AR_B, B_H1 = AR_B, B_Y1 = AR_B;
constexpr size_t B_Z = AR_C, B_KPE = AR_C + (size_t)M * 4608, B_K0N = AR_C, B_V0 = AR_C + (size_t)M * 1024, B_ACT = AR_C,
    B_QKV1 = AR_C, B_GT = AR_C + (size_t)M * 4608, B_ACTM = AR_C, B_TMPW = AR_C;
static_assert((size_t)NE * 5632 * 1024 * 2 <= (size_t)M * 5632, "TMPW fits C");
constexpr size_t B_ZQN = AR_D, B_ZKVN = AR_D + (size_t)M * 768, B_H2S = AR_B, B_XS_HI = AR_D, B_PART1 = AR_D + (size_t)(ML / 2) * 2048;
constexpr bool SPLIT_TAIL = true;
static_assert((size_t)(ML / 2) * 2048 + (size_t)(M - 65536) * 2048 <= (size_t)M * 1280, "PART1 fits D");
static_assert(H2S_BYTES <= (size_t)M * 2048 && (size_t)(ML / 2) * 2048 <= (size_t)M * 1280, "h2s fits B, XS_HI fits D");
static_assert(FS_BYTES <= (size_t)M * 4096, "f_sorted fits A+B");
static_assert(ACTM_BYTES <= (size_t)M * 5632, "MoE act fits C");
static_assert(GT_BYTES <= (size_t)M * 1024, "GT fits the tail of C");
constexpr size_t B_FSX = AR_END;
static_assert(B_FSX + (size_t)3 * 1792 * 2048 <= ((size_t)1 << 30), "workspace map exceeds 1 GiB");
#else
constexpr size_t B_FSX = 0;
constexpr bool SPLIT_TAIL = false;
constexpr size_t B_H = AR, B_Z = B_H + (size_t)M * 2048, B_KPE = B_Z + (size_t)M * 4608, B_AOUT0 = B_KPE + (size_t)M * 128, B_ZQN = B_AOUT0 + (size_t)M * 2048, B_ZKVN = B_ZQN + (size_t)M * 768,
    B_Q0 = B_ZKVN + (size_t)M * 512, B_K0N = B_Q0 + (size_t)M * 1536, B_V0 = B_K0N + (size_t)M * 1024, B_Y = B_V0 + (size_t)M * 1024, B_H2 = B_Y + (size_t)M * 2048, B_ACT = B_H2 + (size_t)M * 2048,
    B_F = B_ACT + (size_t)M * 5632, B_H1 = B_F + (size_t)M * 2048, B_QKV1 = B_H1 + (size_t)M * 2048, B_GT = B_QKV1 + (size_t)M * 4608, B_AOUT1 = B_GT + GT_BYTES, B_Y1 = B_AOUT1 + (size_t)M * 2048,
    B_H2TOK = B_Y1 + (size_t)M * 2048, B_H2S = B_H2TOK + (size_t)ML * 1024, B_ACTM = B_H2S + H2S_BYTES, B_FS = B_ACTM + ACTM_BYTES, B_XS_HI = B_FS + FS_BYTES, B_PART1 = B_XS_HI, B_TMPW = B_XS_HI + (size_t)(ML / 2) * 2048, AR_END = B_TMPW + (size_t)NE * 5632 * 1024 * 2;
#endif

#ifndef DN0_FP8
#define DN0_FP8 1
#endif
#ifndef FFN0_FP8
#define FFN0_FP8 0
#endif
#ifndef MOE_I8
#define MOE_I8 0
#endif
#ifndef USE_I8
#define USE_I8 1
#endif
struct P {
    const float *x, *c, *ctx, *c_ctx, *ev_mod_w, *ev_mod_b, *ev_norm_g, *ev_w_in, *ev_conv_w, *ev_q_norm_g, *ev_w_uq, *ev_kv_norm_g, *ev_w_ukv, *ev_w_out,
        *ev_ffn_gate, *ev_ffn_up, *ev_ffn_down, *od_mod_w, *od_mod_b, *od_norm_g, *od_w_in, *od_lambda, *od_subln_g, *od_w_out, *od_router, *od_exp_gate, *od_exp_up, *od_exp_down;
    float* out; unsigned char* ws; int ph_lo, ph_hi;
};

__device__ __forceinline__ void ld_f32(const float* p, int lane, float (&v)[16]) {
#pragma unroll
    for (int j2 = 0; j2 < 2; ++j2) { const f32x4 a = *(const f32x4*)(p + 512 * j2 + 8 * lane), b = *(const f32x4*)(p + 512 * j2 + 8 * lane + 4);
#pragma unroll
        for (int i = 0; i < 4; ++i) { v[j2 * 8 + i] = a[i]; v[j2 * 8 + 4 + i] = b[i]; } }
}
__device__ __forceinline__ void st_f32(float* p, int lane, const float (&v)[16]) {
#pragma unroll
    for (int j2 = 0; j2 < 2; ++j2) { f32x4 a, b;
#pragma unroll
        for (int i = 0; i < 4; ++i) { a[i] = v[j2 * 8 + i]; b[i] = v[j2 * 8 + 4 + i]; }
        *(f32x4*)(p + 512 * j2 + 8 * lane) = a; *(f32x4*)(p + 512 * j2 + 8 * lane + 4) = b; }
}
__device__ __forceinline__ void unpack8(const u32x4 w, float* v) { v[0] = bflo(w.x); v[1] = bfhi(w.x); v[2] = bflo(w.y); v[3] = bfhi(w.y); v[4] = bflo(w.z); v[5] = bfhi(w.z); v[6] = bflo(w.w); v[7] = bfhi(w.w); }
__device__ __forceinline__ u32x4 pack8f(const float* v) { u32x4 w; w.x = cvt_pk_bf16(v[0], v[1]); w.y = cvt_pk_bf16(v[2], v[3]); w.z = cvt_pk_bf16(v[4], v[5]); w.w = cvt_pk_bf16(v[6], v[7]); return w; }
__device__ __forceinline__ void ld_bf16(const bf16_t* p, int lane, float (&v)[16]) {
#pragma unroll
    for (int j2 = 0; j2 < 2; ++j2) { const u32x4 w = *(const u32x4*)(p + 512 * j2 + 8 * lane); unpack8(w, &v[j2 * 8]); }
}
__device__ __forceinline__ void st_bf16(bf16_t* p, int lane, const float (&v)[16]) {
#pragma unroll
    for (int j2 = 0; j2 < 2; ++j2) *(u32x4*)(p + 512 * j2 + 8 * lane) = pack8f(&v[j2 * 8]);
}
__device__ __forceinline__ float sumsq16(const float (&v)[16]) { float s = 0.f;
#pragma unroll
    for (int i = 0; i < 16; ++i) s += v[i] * v[i];
    return wave_sum(s); }
__device__ __forceinline__ void resid16(float (&xv)[16], const float (&y)[16], const float* g, const float* gate, int lane) {
    const float ry = 1.0f / sqrtf(sumsq16(y) * (1.f / D) + EPS); float gv[16], tv[16]; ld_f32(g, lane, gv); ld_f32(gate, lane, tv);
#pragma unroll
    for (int i = 0; i < 16; ++i) xv[i] += tv[i] * (y[i] * ry * gv[i]);
}
__device__ __forceinline__ void normmod16(const float (&xv)[16], float (&h)[16], const float* g, const float* shift, const float* scale, int lane) {
    const float rx = 1.0f / sqrtf(sumsq16(xv) * (1.f / D) + EPS); float gv[16], sh[16], sc[16]; ld_f32(g, lane, gv); ld_f32(shift, lane, sh); ld_f32(scale, lane, sc);
#pragma unroll
    for (int i = 0; i < 16; ++i) h[i] = xv[i] * rx * gv[i] * (1.f + sc[i]) + sh[i];
}
__device__ __forceinline__ void resid16r(float (&xv)[16], const float (&y)[16], const float (&gv)[16], const float (&tv)[16]) {
    const float ry = 1.0f / sqrtf(sumsq16(y) * (1.f / D) + EPS);
#pragma unroll
    for (int i = 0; i < 16; ++i) xv[i] += tv[i] * (y[i] * ry * gv[i]);
}
__device__ __forceinline__ void normmod16r(const float (&xv)[16], float (&h)[16], const float (&gv)[16], const float (&sh)[16], const float (&sc)[16]) {
    const float rx = 1.0f / sqrtf(sumsq16(xv) * (1.f / D) + EPS);
#pragma unroll
    for (int i = 0; i < 16; ++i) h[i] = xv[i] * rx * gv[i] * (1.f + sc[i]) + sh[i];
}
__device__ __forceinline__ void st_i8row(unsigned char* dst, float* sc, int row, int lane, const float (&h)[16]) {
    u32x2 q[2]; const float scl = quant_row_i8(h, q);
#pragma unroll
    for (int j2 = 0; j2 < 2; ++j2) *(u32x2*)(dst + (size_t)row * 1024 + 512 * j2 + 8 * lane) = q[j2];
    if (lane == 0) sc[row] = scl;
}
__device__ __forceinline__ void wave_rows_(int gw, int ngw, int n, int& r0, int& r1) { const int per = (((n + ngw - 1) / ngw) + 1) & ~1; r0 = gw * per; r1 = r0 + per < n ? r0 + per : n; if (r0 > n) r0 = n; }
#define wave_rows(c, n, r0, r1) wave_rows_((c).gw, (c).ngw, n, r0, r1)
__device__ __forceinline__ int mod_key(int m) { const int b = m / S, j = m % S; return j < L ? 32 : b; }
__device__ __forceinline__ int rope_pos(int e) { return e < 32 ? 8 * (e >> 2) + (e & 3) : 8 * ((e - 32) >> 2) + 4 + (e & 3); }
__device__ __forceinline__ int rope_elem(int s) { const int i = s >> 3, j = s & 7; return j < 4 ? 4 * i + j : 32 + 4 * i + (j - 4); }

struct Ctx {
    LAS unsigned char* lds; unsigned char* ws; int tid, lane, wave, gw, ngw;
};

constexpr int P0_PITCH = 65, P0_SCR_BYTES = 64 * P0_PITCH * 4;
template <int MAP, bool OUT8 = false>
__device__ __forceinline__ void p0_item(const float* W, const float* W2, int ldw, int nvalid, int K, bf16_t* WT, LAS float* scr, int item, int nblk, int lane, float wscale = 1.f) {
    const int kb = item / nblk, nb = item % nblk, k0 = 64 * kb, n0 = 64 * nb; const int q = lane & 15, kr = lane >> 4; const int np = n0 + 4 * q;
    const float* src = W; int col = np;
    if (MAP == 0) { if (np >= nvalid) col = -1; }
    if (MAP == 1) { const int h = np / MLA_QK, w = np % MLA_QK; col = w < MLA_NOPE ? np : h * MLA_QK + MLA_NOPE + rope_elem(w - MLA_NOPE); }
    if (MAP == 2) { const int tl = np >> 8, cc = np & 255, bj = cc >> 7, wcq = (cc & 127) >> 3, nn = (cc & 7) >> 2; col = tl * 128 + 8 * wcq + 4 * nn; if (bj) src = W2; }
    if (MAP == 3) { col = np < 2 * DIFFW ? (np & ~63) + rope_elem(np & 63) : np; }
    f32x4 v[16];
#pragma unroll
    for (int i = 0; i < 16; ++i) v[i] = col >= 0 ? *(const f32x4*)(src + (size_t)(k0 + kr + 4 * i) * ldw + col) : (f32x4){0.f, 0.f, 0.f, 0.f};
#pragma unroll
    for (int i = 0; i < 16; ++i)
#pragma unroll
        for (int j = 0; j < 4; ++j) scr[(4 * q + j) * P0_PITCH + kr + 4 * i] = v[i][j];
    asm volatile("s_waitcnt lgkmcnt(0)" ::: "memory");
    const int c = lane & 7;
#pragma unroll
    for (int jj = 0; jj < 8; ++jj) { const int n = (lane >> 3) + 8 * jj; const LAS float* s = scr + n * P0_PITCH + 8 * c;
        if constexpr (OUT8) { u32x2 o; o.x = pg8::pack4_fp8(s[0] * wscale, s[1] * wscale, s[2] * wscale, s[3] * wscale); o.y = pg8::pack4_fp8(s[4] * wscale, s[5] * wscale, s[6] * wscale, s[7] * wscale);
            *(u32x2*)((unsigned char*)WT + (size_t)(n0 + n) * K + k0 + 8 * c) = o; }
        else { u32x4 o; o.x = cvt_pk_bf16(s[0], s[1]); o.y = cvt_pk_bf16(s[2], s[3]); o.z = cvt_pk_bf16(s[4], s[5]); o.w = cvt_pk_bf16(s[6], s[7]);
            *(u32x4*)(WT + (size_t)(n0 + n) * K + k0 + 8 * c) = o; } }
    asm volatile("s_waitcnt lgkmcnt(0)" ::: "memory");
}
struct P0Desc { const float* src; const float* src2; unsigned char* dst; int ldw, nvalid, K, nblk, map, out8, item; float scale; };
__device__ __forceinline__ void p0_load(const P0Desc& d, int lane, f32x4 (&v)[16]) {
    const int kb = d.item / d.nblk, nb = d.item % d.nblk, k0 = 64 * kb, n0 = 64 * nb; const int q = lane & 15, kr = lane >> 4; const int np = n0 + 4 * q;
    const float* src = d.src; int col = np;
    if (d.map == 0) { if (np >= d.nvalid) col = -1; }
    else if (d.map == 1) { const int h = np / MLA_QK, w = np % MLA_QK; col = w < MLA_NOPE ? np : h * MLA_QK + MLA_NOPE + rope_elem(w - MLA_NOPE); }
    else if (d.map == 2) { const int tl = np >> 8, cc = np & 255, bj = cc >> 7, wcq = (cc & 127) >> 3, nn = (cc & 7) >> 2; col = tl * 128 + 8 * wcq + 4 * nn; if (bj) src = d.src2; }
    else { col = np < 2 * DIFFW ? (np & ~63) + rope_elem(np & 63) : np; }
#pragma unroll
    for (int i = 0; i < 16; ++i) v[i] = col >= 0 ? *(const f32x4*)(src + (size_t)(k0 + kr + 4 * i) * d.ldw + col) : (f32x4){0.f, 0.f, 0.f, 0.f};
}
__device__ __forceinline__ void p0_store(const P0Desc& d, int lane, LAS float* scr, const f32x4 (&v)[16]) {
    const int kb = d.item / d.nblk, nb = d.item % d.nblk, k0 = 64 * kb, n0 = 64 * nb; const int q = lane & 15, kr = lane >> 4;
#pragma unroll
    for (int i = 0; i < 16; ++i)
#pragma unroll
        for (int j = 0; j < 4; ++j) scr[(4 * q + j) * P0_PITCH + kr + 4 * i] = v[i][j];
    asm volatile("s_waitcnt lgkmcnt(0)" ::: "memory");
    const int c = lane & 7; float ws_ = d.scale; if (d.map == 2 && d.out8) ws_ *= ((n0 & 255) >> 7) ? 0.6931471805599453f : 1.4426950408889634f;
#pragma unroll
    for (int jj = 0; jj < 8; ++jj) { const int n = (lane >> 3) + 8 * jj; const LAS float* s = scr + n * P0_PITCH + 8 * c;
        if (d.out8) { u32x2 o; o.x = pg8::pack4_fp8(s[0] * ws_, s[1] * ws_, s[2] * ws_, s[3] * ws_); o.y = pg8::pack4_fp8(s[4] * ws_, s[5] * ws_, s[6] * ws_, s[7] * ws_);
            *(u32x2*)(d.dst + (size_t)(n0 + n) * d.K + k0 + 8 * c) = o; }
        else { u32x4 o; o.x = cvt_pk_bf16(s[0], s[1]); o.y = cvt_pk_bf16(s[2], s[3]); o.z = cvt_pk_bf16(s[4], s[5]); o.w = cvt_pk_bf16(s[6], s[7]);
            *(u32x4*)((bf16_t*)d.dst + (size_t)(n0 + n) * d.K + k0 + 8 * c) = o; } }
    asm volatile("s_waitcnt lgkmcnt(0)" ::: "memory");
}
__device__ __forceinline__ void p0_fold_item(const float* W, bf16_t* WT, LAS float* scr, const LAS float* tab, int item, int lane) {
    const int kb = item / 16, nb = item % 16, k0 = 64 * kb, n0 = 32 * nb; const int r = n0 + (lane & 31), part = r >> 8, g = (r >> 6) & 3, l = r & 63;
    for (int i = 0; i < 32; ++i) { const int kk = 2 * i + (lane >> 5); const float* wr = W + (size_t)(k0 + kk) * ODD_IN + 3 * DIFFW + g * 64; float a = 0.f;
        for (int j = 0; j < 64; ++j) a += wr[j] * tab[part * 64 + ((l * j) & 63)];
        scr[kk * 33 + (lane & 31)] = a; }
    asm volatile("s_waitcnt lgkmcnt(0)" ::: "memory");
    const int c = lane & 7;
#pragma unroll
    for (int j = 0; j < 4; ++j) { const int n = (lane >> 3) + 8 * j; const LAS float* s = scr + (8 * c) * 33 + n;
        u32x4 o; o.x = cvt_pk_bf16(s[0 * 33], s[1 * 33]); o.y = cvt_pk_bf16(s[2 * 33], s[3 * 33]); o.z = cvt_pk_bf16(s[4 * 33], s[5 * 33]); o.w = cvt_pk_bf16(s[6 * 33], s[7 * 33]);
        *(u32x4*)(WT + (size_t)(n0 + n) * D + k0 + 8 * c) = o; }
    asm volatile("s_waitcnt lgkmcnt(0)" ::: "memory");
}
__device__ __forceinline__ void fmac_s(float& a, float x, float y) { asm("v_fmac_f32 %0, %1, %2" : "+v"(a) : "v"(x), "v"(y)); }
__device__ __forceinline__ void p0_mod_unit(const P& p, const Ctx& c, int u) {
    const int layer = u / 128, col0 = (u % 128) * 48; const float* W = layer ? p.od_mod_w : p.ev_mod_w; const float* bias = layer ? p.od_mod_b : p.ev_mod_b;
    float* mod = (float*)(c.ws + WS_MODV) + (size_t)layer * 33 * 6144;
    LAS float* sc = (LAS float*)c.lds;
    LAS float* red = (LAS float*)(c.lds + 73728);
    const int nl = c.tid & 15, kg = c.tid >> 4; float acc[3][33];
#pragma unroll
    for (int j = 0; j < 3; ++j)
#pragma unroll
        for (int r = 0; r < 33; ++r) acc[j][r] = 0.f;
    for (int ch = 0; ch < 2; ++ch) {
        const char* wb = (const char*)(W + (size_t)ch * 512 * 6144 + col0); const unsigned lo = (unsigned)(kg * 16 * 6144 + nl) * 4u; float wv[3][16];
#pragma unroll
        for (int kk = 0; kk < 16; ++kk) { const char* wk = wb + (size_t)kk * 6144 * 4;
#pragma unroll
            for (int j = 0; j < 3; ++j) wv[j][kk] = *(const float*)(wk + (lo + 64u * j)); }
        __syncthreads();
#pragma unroll 4
        for (int e = c.tid; e < 36 * 512; e += 512) { const int kk = e & 511, r = e >> 9; float v = 0.f;
            if (r < 33) { const float cv = r < 32 ? p.c[r * D + ch * 512 + kk] : p.c_ctx[ch * 512 + kk]; v = cv * __builtin_amdgcn_rcpf(1.f + __builtin_amdgcn_exp2f(-1.4426950408889634f * cv)); }
            sc[kk * 36 + r] = v; }
        __syncthreads();
#pragma unroll
        for (int kk = 0; kk < 16; ++kk) { const LAS f32x4* s4 = (const LAS f32x4*)(sc + (kg * 16 + kk) * 36);
#pragma unroll
            for (int q = 0; q < 8; ++q) { const f32x4 sv = s4[q];
#pragma unroll
                for (int i = 0; i < 4; ++i)
#pragma unroll
                    for (int j = 0; j < 3; ++j) fmac_s(acc[j][q * 4 + i], sv[i], wv[j][kk]); }
            const float s32 = s4[8][0];
#pragma unroll
            for (int j = 0; j < 3; ++j) fmac_s(acc[j][32], s32, wv[j][kk]); }
    }
#pragma unroll
    for (int j = 0; j < 3; ++j)
#pragma unroll
        for (int r = 0; r < 33; ++r) { float v = acc[j][r];
            { auto rr = __builtin_amdgcn_permlane16_swap(__float_as_uint(v), __float_as_uint(v), false, false); v = __uint_as_float(rr[0]) + __uint_as_float(rr[1]); }
            { auto rr = __builtin_amdgcn_permlane32_swap(__float_as_uint(v), __float_as_uint(v), false, false); v = __uint_as_float(rr[0]) + __uint_as_float(rr[1]); }
            acc[j][r] = v; }
    if ((c.lane >> 4) == 0) {
#pragma unroll
        for (int j = 0; j < 3; ++j)
#pragma unroll
            for (int r = 0; r < 33; ++r) red[(c.wave * 33 + r) * 48 + nl + 16 * j] = acc[j][r]; }
    __syncthreads();
    for (int o = c.tid; o < 33 * 48; o += 512) { const int r = o / 48, n = o % 48; float v = bias[col0 + n];
#pragma unroll
        for (int q = 0; q < 8; ++q) v += red[(q * 33 + r) * 48 + n];
        mod[(size_t)r * 6144 + col0 + n] = v; }
    __syncthreads();
}
__device__ __forceinline__ void phase_prologue(const P& p, const Ctx& c, int parts, int rp = 0) {
    if (parts & 1) for (int u = blockIdx.x; u < 256; u += gridDim.x) p0_mod_unit(p, c, u);
    __syncthreads();
    LAS float* tab = (LAS float*)(c.lds + 8 * P0_SCR_BYTES + 512);
    if (c.tid < 64) { const float a = (float)c.tid * (6.283185307179586f / 64.f); tab[c.tid] = cosf(a); tab[64 + c.tid] = sinf(a); }
    __syncthreads();
    LAS float* scr = (LAS float*)(c.lds + c.wave * P0_SCR_BYTES);
    constexpr int I0 = 16 * 36, I1 = 6 * 12, I2 = 4 * 16, I3 = 16 * 16, I4 = 16 * 88, I5 = 44 * 16, I6 = 16 * 36, I7 = 16 * 16, I8 = NE * I4, I9 = NE * I5, I10 = 16 * 16;
    constexpr int NITEMS = I0 + I1 + I2 + I3 + I4 + I5 + I6 + I7 + I8 + I9 + I10;
    (void)rp;
    constexpr int NTR = NITEMS - I10;
    auto resolve = [&](int it, P0Desc& d) {
        int r = it; d.src2 = nullptr; d.out8 = 0; d.scale = 1.f; d.map = 0;
        if (r < I0) { d.src = p.ev_w_in; d.ldw = EVEN_IN; d.nvalid = EVEN_IN; d.K = D; d.dst = c.ws + W_IN0; d.nblk = 36; d.item = r; return; } r -= I0;
        if (r < I1) { d.src = p.ev_w_uq; d.ldw = 768; d.nvalid = 768; d.K = QRANK; d.dst = c.ws + W_UQ; d.nblk = 12; d.map = 1; d.item = r; return; } r -= I1;
        if (r < I2) { d.src = p.ev_w_ukv; d.ldw = 1024; d.nvalid = 1024; d.K = KVRANK; d.dst = c.ws + W_UKV; d.nblk = 16; d.item = r; return; } r -= I2;
        if (r < I3) { d.src = p.ev_w_out; d.ldw = D; d.nvalid = D; d.K = D; d.dst = c.ws + W_OUT0; d.nblk = 16; d.item = r; return; } r -= I3;
        if (r < I4) { d.src = p.ev_ffn_gate; d.src2 = p.ev_ffn_up; d.ldw = FF; d.nvalid = FF; d.K = D; d.dst = c.ws + W_GU0; d.nblk = 88; d.map = 2; d.item = r; if (FFN0_FP8 && !USE_I8) { d.out8 = 1; d.scale = 32.f; } return; } r -= I4;
        if (r < I5) { d.src = p.ev_ffn_down; d.ldw = D; d.nvalid = D; d.K = FF; d.dst = c.ws + W_DN0; d.nblk = 16; d.item = r; if ((FFN0_FP8 && !USE_I8) || (DN0_FP8 && USE_I8)) { d.out8 = 1; d.scale = 64.f; } return; } r -= I5;
        if (r < I6) { d.src = p.od_w_in; d.ldw = ODD_IN; d.nvalid = ODD_IN; d.K = D; d.dst = c.ws + W_IN1; d.nblk = 36; d.map = 3; d.item = r; return; } r -= I6;
        if (r < I7) { d.src = p.od_w_out; d.ldw = D; d.nvalid = D; d.K = D; d.dst = c.ws + W_OUT1; d.nblk = 16; d.item = r; return; } r -= I7;
        if (r < I8) { const int e = r / I4; d.src = p.od_exp_gate + (size_t)e * D * FF; d.src2 = p.od_exp_up + (size_t)e * D * FF; d.ldw = FF; d.nvalid = FF; d.K = D; d.nblk = 88; d.map = 2; d.item = r % I4;
            if (MOE_I8) { d.dst = c.ws + B_TMPW + (size_t)e * 5632 * 1024 * 2; } else { d.dst = c.ws + W_GU1 + (size_t)e * 5632 * 1024; d.out8 = 1; d.scale = 32.f; } return; } r -= I8;
        { const int e = r / I5; d.src = p.od_exp_down + (size_t)e * FF * D; d.ldw = D; d.nvalid = D; d.K = FF; d.dst = c.ws + W_DN1 + (size_t)e * 1024 * 2816; d.nblk = 16; d.item = r % I5; d.out8 = 1; d.scale = 64.f; }
    };
    if (parts & 2) {
        int it = c.gw; P0Desc dA, dB; f32x4 vA[16], vB[16];
        if (it < NTR) { resolve(it, dA); p0_load(dA, c.lane, vA);
            for (;;) {
                int it1 = it + c.ngw; bool h1 = it1 < NTR; if (h1) { resolve(it1, dB); p0_load(dB, c.lane, vB); }
                p0_store(dA, c.lane, scr, vA); if (!h1) break; it = it1;
                it1 = it + c.ngw; h1 = it1 < NTR; if (h1) { resolve(it1, dA); p0_load(dA, c.lane, vA); }
                p0_store(dB, c.lane, scr, vB); if (!h1) break; it = it1;
            } }
        for (int f = c.gw; f < I10; f += c.ngw) p0_fold_item(p.od_w_in, (bf16_t*)(c.ws + W_FOLD), scr, tab, f, c.lane);
    }
    if (parts & 4) { bf16_t* dft = (bf16_t*)(c.ws + W_DFT); const int gt = blockIdx.x * 512 + c.tid, ngt = gridDim.x * 512; const float scl = 0.0027621358640099515f;
      for (int i8 = gt; i8 < 2048 * 4096 / 8; i8 += ngt) { const int k = i8 >> 9, tt0 = (i8 & 511) * 8; float v[8];
#pragma unroll
          for (int j = 0; j < 8; ++j) { const int tt = tt0 + j, t = tt & 2047, q = (k * t) & 2047; const float x = (float)q * (1.f / 2048.f); v[j] = (tt < 2048 ? __builtin_amdgcn_cosf(x) : -__builtin_amdgcn_sinf(x)) * scl; }
          *(u32x4*)(dft + (size_t)i8 * 8) = pack8f(v); } }
    if (parts & 4) { float* rc = (float*)(c.ws + WS_ROPE); float* rs = rc + 2048 * 32; const int gt = blockIdx.x * 512 + c.tid, ngt = gridDim.x * 512;
      for (int i = gt; i < 2048 * 32; i += ngt) { const int t = i >> 5, f = i & 31; const int pos = f < 16 ? t / GW : t % GW; const float inv = powf(10000.f, -(float)(f & 15) / 16.f);
          const float ang = (float)pos * inv; rc[i] = cosf(ang); rs[i] = sinf(ang); } }
}

__device__ __forceinline__ const float* in_row(const P& p, int m) { const int b = m / S, j = m % S; return j < L ? p.ctx + ((size_t)b * L + j) * D : p.x + ((size_t)b * T + (j - L)) * D; }
__device__ __forceinline__ bf16_t* lat_stream(const P& p, unsigned char* ws, int tok) {
    return tok < ML / 2 ? (bf16_t*)((unsigned char*)p.out + ((size_t)128 << 20)) + (size_t)tok * D : (bf16_t*)(ws + B_XS_HI) + (size_t)(tok - ML / 2) * D; }
__device__ __forceinline__ float* ctx_stream(unsigned char* ws, int m) { const int b = m / S, j = m % S; return (float*)(ws + WS_CTXS) + ((size_t)b * L + j) * D; }
__device__ __forceinline__ int tok_of(int m) { return (m / S) * T + (m % S) - L; }
__device__ __forceinline__ float* stream_row_unused(const P& p, unsigned char* ws, int m) { const int b = m / S, j = m % S; return j < L ? (float*)(ws + WS_CTXS) + ((size_t)b * L + j) * D : p.out + ((size_t)b * T + (j - L)) * D; }
__device__ __forceinline__ const float* mod_row(unsigned char* ws, int layer, int m) { const int b = m / S, j = m % S; return (const float*)(ws + WS_MODV) + ((size_t)layer * 33 + (j < L ? 32 : b)) * 6144; }

__device__ __forceinline__ void quant_weight_row(const bf16_t* src, unsigned char* dst, float* sc, int row, int lane, float mul = 1.f) {
    float v[16]; ld_bf16(src + (size_t)row * D, lane, v); u32x2 q[2]; const float scale = quant_row_i8(v, q);
#pragma unroll
    for (int j2 = 0; j2 < 2; ++j2) *(u32x2*)(dst + (size_t)row * D + 512 * j2 + 8 * lane) = q[j2];
    if (lane == 0) sc[row] = scale * mul;
}
__device__ __forceinline__ void phase_quant_weights(const Ctx& c) {
#if USE_I8
    constexpr int R0 = 5632, R1 = R0 + 2304, R2 = R1 + 2304, R3 = R2 + 512, R4 = R3 + (MOE_I8 ? NE * 5632 : 0);
    for (int r = c.gw; r < R4; r += c.ngw) {
        if (r < R0) quant_weight_row((const bf16_t*)(c.ws + W_GU0), c.ws + W8_GU0, (float*)(c.ws + SW_GU0), r, c.lane, (r & 255) < 128 ? 1.4426950408889634f : 0.6931471805599453f * (DN0_FP8 ? 8.f : 1.f));
        else if (r < R1) quant_weight_row((const bf16_t*)(c.ws + W_IN0), c.ws + W8_IN0, (float*)(c.ws + SW_IN0), r - R0, c.lane);
        else if (r < R2) quant_weight_row((const bf16_t*)(c.ws + W_IN1), c.ws + W8_IN1, (float*)(c.ws + SW_IN1), r - R1, c.lane, r - R1 < DIFFW ? pg8::QSC_DIFF : 1.f);
        else if (r < R3) quant_weight_row((const bf16_t*)(c.ws + W_FOLD), c.ws + W8_FOLD, (float*)(c.ws + SW_FOLD), r - R2, c.lane);
        else if (MOE_I8) quant_weight_row((const bf16_t*)(c.ws + B_TMPW), c.ws + W_GU1, (float*)(c.ws + SW_GU1), r - R3, c.lane, ((r - R3) & 255) < 128 ? 1.4426950408889634f : 0.6931471805599453f * 8.f); }
#endif
}
__device__ __forceinline__ void phase_norm0(const P& p, const Ctx& c) {
    bf16_t* H = (bf16_t*)(c.ws + B_H); int r0, r1; wave_rows(c, M, r0, r1);
    float g0[16], sh[16], sc[16]; ld_f32(p.ev_norm_g, c.lane, g0); int key = -1;
    for (int m0 = r0; m0 < r1; m0 += 2) { float xv[2][16];
#pragma unroll
        for (int r = 0; r < 2; ++r) ld_f32(in_row(p, m0 + r), c.lane, xv[r]);
#pragma unroll
        for (int r = 0; r < 2; ++r) { const int m = m0 + r; float h[16]; const int k = mod_key(m);
            if (k != key) { key = k; const float* mr = (const float*)(c.ws + WS_MODV) + (size_t)k * 6144; ld_f32(mr, c.lane, sh); ld_f32(mr + D, c.lane, sc); }
            normmod16r(xv[r], h, g0, sh, sc);
#if USE_I8
            st_i8row((unsigned char*)H, (float*)(c.ws + SA_ROW), m, c.lane, h);
#else
            st_bf16(H + (size_t)m * D, c.lane, h);
#endif
        } }
}
__device__ __forceinline__ void phase_even_elem(const P& p, const Ctx& c) {
    const bf16_t* Z = (const bf16_t*)(c.ws + B_Z); bf16_t* AO = (bf16_t*)(c.ws + B_AOUT0); bf16_t* ZQ = (bf16_t*)(c.ws + B_ZQN); bf16_t* ZKV = (bf16_t*)(c.ws + B_ZKVN); bf16_t* KPE = (bf16_t*)(c.ws + B_KPE);
    const float* rc = (const float*)(c.ws + WS_ROPE); const float* rs = rc + 2048 * 32; const int lane = c.lane;
    float cw[3][8];
#pragma unroll
    for (int t = 0; t < 3; ++t) { const f32x4 w0 = *(const f32x4*)(p.ev_conv_w + t * SCW + 8 * lane), w1 = *(const f32x4*)(p.ev_conv_w + t * SCW + 8 * lane + 4);
#pragma unroll
        for (int i = 0; i < 4; ++i) { cw[t][i] = w0[i]; cw[t][4 + i] = w1[i]; } }
    float gq[8], gkv[8];
    { const int lq = lane < 48 ? lane : 0, lk = lane < 32 ? lane : 0;
      const f32x4 a0 = *(const f32x4*)(p.ev_q_norm_g + 8 * lq), a1 = *(const f32x4*)(p.ev_q_norm_g + 8 * lq + 4), b0 = *(const f32x4*)(p.ev_kv_norm_g + 8 * lk), b1 = *(const f32x4*)(p.ev_kv_norm_g + 8 * lk + 4);
#pragma unroll
      for (int i = 0; i < 4; ++i) { gq[i] = a0[i]; gq[4 + i] = a1[i]; gkv[i] = b0[i]; gkv[4 + i] = b1[i]; } }
    for (int m0 = c.gw * 4; m0 < M; m0 += c.ngw * 4) {
        const int j0 = m0 % S; const int lo = j0 < L ? 0 : L, hi = j0 < L ? L : S; const bf16_t* z0 = Z + (size_t)m0 * 2304;
        u32x4 rcg[6], ruu[6], rbg[4], rzq[4], rzk[4]; float k1[4], k2[4];
#pragma unroll
        for (int r = 0; r < 6; ++r) { const int jj = j0 + r - 1; const bool ok = jj >= lo && jj < hi; const bf16_t* zn = z0 + (long)(r - 1) * 2304;
            rcg[r] = ok ? *(const u32x4*)(zn + SCW + 8 * lane) : (u32x4){0u, 0u, 0u, 0u}; ruu[r] = ok ? *(const u32x4*)(zn + 2 * SCW + 8 * lane) : (u32x4){0u, 0u, 0u, 0u}; }
#pragma unroll
        for (int r = 0; r < 4; ++r) { const bf16_t* zr = z0 + (size_t)r * 2304; rbg[r] = *(const u32x4*)(zr + 8 * lane);
            rzq[r] = lane < 48 ? *(const u32x4*)(zr + SCIN + 8 * lane) : (u32x4){0u, 0u, 0u, 0u}; rzk[r] = lane < 32 ? *(const u32x4*)(zr + SCIN + QRANK + 8 * lane) : (u32x4){0u, 0u, 0u, 0u};
            const bf16_t* kp = zr + SCIN + QRANK + KVRANK; k1[r] = bf2f(kp[lane & 31]); k2[r] = bf2f(kp[32 + (lane & 31)]); }
        float prod[6][8];
#pragma unroll
        for (int r = 0; r < 6; ++r) { float a[8], b[8]; unpack8(rcg[r], a); unpack8(ruu[r], b);
#pragma unroll
            for (int i = 0; i < 8; ++i) prod[r][i] = a[i] * b[i]; }
#pragma unroll
        for (int r = 0; r < 4; ++r) { const int m = m0 + r, j = j0 + r; float bg[8], acc[8]; unpack8(rbg[r], bg);
#pragma unroll
            for (int i = 0; i < 8; ++i) acc[i] = bg[i] * (cw[0][i] * prod[r][i] + cw[1][i] * prod[r + 1][i] + cw[2][i] * prod[r + 2][i]);
            *(u32x4*)(AO + (size_t)m * D + 8 * lane) = pack8f(acc);
            { float v[8]; unpack8(rzq[r], v); float s = 0.f;
#pragma unroll
              for (int i = 0; i < 8; ++i) s += v[i] * v[i];
              s = wave_sum(s); const float rn = 1.0f / sqrtf(s * (1.f / QRANK) + EPS);
#pragma unroll
              for (int i = 0; i < 8; ++i) v[i] *= rn * gq[i];
              if (lane < 48) *(u32x4*)(ZQ + (size_t)m * QRANK + 8 * lane) = pack8f(v); }
            { float v[8]; unpack8(rzk[r], v); float s = 0.f;
#pragma unroll
              for (int i = 0; i < 8; ++i) s += v[i] * v[i];
              s = wave_sum(s); const float rn = 1.0f / sqrtf(s * (1.f / KVRANK) + EPS);
#pragma unroll
              for (int i = 0; i < 8; ++i) v[i] *= rn * gkv[i];
              if (lane < 32) *(u32x4*)(ZKV + (size_t)m * KVRANK + 8 * lane) = pack8f(v); }
            if (lane < 32) { float cs = 1.f, sn = 0.f;
                if (j >= L) { cs = rc[(j - L) * 32 + lane]; sn = rs[(j - L) * 32 + lane]; }
                bf16_t* ko = KPE + (size_t)m * 64; ko[rope_pos(lane)] = f2bf(k1[r] * cs - k2[r] * sn); ko[rope_pos(32 + lane)] = f2bf(k1[r] * sn + k2[r] * cs); }
        }
    }
}
__device__ __forceinline__ void phase_mid0(const P& p, const Ctx& c, bool split) {
    const bf16_t* Y = (const bf16_t*)(c.ws + B_Y); bf16_t* H2 = (bf16_t*)(c.ws + B_H2); int r0, r1; wave_rows(c, M, r0, r1);
    float ng1[16], ng2[16], gt[16], sh[16], sc[16]; ld_f32(p.ev_norm_g + D, c.lane, ng1); ld_f32(p.ev_norm_g + 2 * D, c.lane, ng2); int key = -1;
    for (int m0 = r0; m0 < r1; m0 += 2) { float xv[2][16], y[2][16];
#pragma unroll
        for (int r = 0; r < 2; ++r) { ld_f32(in_row(p, m0 + r), c.lane, xv[r]); ld_bf16(Y + (size_t)(m0 + r) * D, c.lane, y[r]);
            if (split && m0 + r >= 65536) { float y1[16]; ld_bf16((const bf16_t*)(c.ws + B_PART1) + (size_t)(m0 + r - 65536) * D, c.lane, y1);
#pragma unroll
                for (int i = 0; i < 16; ++i) y[r][i] += y1[i]; } }
#pragma unroll
        for (int r = 0; r < 2; ++r) { const int m = m0 + r; float h[16]; const int k = mod_key(m);
            if (k != key) { key = k; const float* mr = (const float*)(c.ws + WS_MODV) + (size_t)k * 6144; ld_f32(mr + 2 * D, c.lane, gt); ld_f32(mr + 3 * D, c.lane, sh); ld_f32(mr + 4 * D, c.lane, sc); }
            resid16r(xv[r], y[r], ng1, gt); if ((m % S) >= L) st_bf16(lat_stream(p, c.ws, tok_of(m)), c.lane, xv[r]); else st_f32(ctx_stream(c.ws, m), c.lane, xv[r]);
            normmod16r(xv[r], h, ng2, sh, sc);
#if USE_I8
            st_i8row((unsigned char*)H2, (float*)(c.ws + SA_ROW), m, c.lane, h);
#else
            st_bf16(H2 + (size_t)m * D, c.lane, h);
#endif
        } }
}
__device__ __forceinline__ void phase_end0(const P& p, const Ctx& c, bool split) {
    const bf16_t* F = (const bf16_t*)(c.ws + B_F); bf16_t* H = (bf16_t*)(c.ws + B_H1); int r0, r1; wave_rows(c, M, r0, r1);
    float ng3[16], ng0[16], gt[16], sh[16], sc[16]; ld_f32(p.ev_norm_g + 3 * D, c.lane, ng3); ld_f32(p.od_norm_g, c.lane, ng0); int key = -1;
    for (int m0 = r0; m0 < r1; m0 += 2) { float xv[2][16], y[2][16];
#pragma unroll
        for (int r = 0; r < 2; ++r) { const int m = m0 + r; if ((m % S) >= L) ld_bf16(lat_stream(p, c.ws, tok_of(m)), c.lane, xv[r]); else ld_f32(ctx_stream(c.ws, m), c.lane, xv[r]); ld_bf16(F + (size_t)m * D, c.lane, y[r]);
            if (split && m >= 65536) { float y1[16]; ld_bf16((const bf16_t*)(c.ws + B_PART1) + (size_t)(m - 65536) * D, c.lane, y1);
#pragma unroll
                for (int i = 0; i < 16; ++i) y[r][i] += y1[i]; } }
#pragma unroll
        for (int r = 0; r < 2; ++r) { const int m = m0 + r; float h[16]; const int k = mod_key(m);
            if (k != key) { key = k; const float* mr = (const float*)(c.ws + WS_MODV) + (size_t)k * 6144; const float* mr1 = mr + (size_t)33 * 6144; ld_f32(mr + 5 * D, c.lane, gt); ld_f32(mr1, c.lane, sh); ld_f32(mr1 + D, c.lane, sc); }
            resid16r(xv[r], y[r], ng3, gt);
            if ((m % S) >= L) st_bf16(lat_stream(p, c.ws, tok_of(m)), c.lane, xv[r]);
            normmod16r(xv[r], h, ng0, sh, sc);
#if USE_I8
            st_i8row((unsigned char*)H, (float*)(c.ws + SA_ROW), m, c.lane, h);
#else
            st_bf16(H + (size_t)m * D, c.lane, h);
#endif
        } }
}
__device__ __forceinline__ void phase_mid1(const P& p, const Ctx& c) {
    const bf16_t* Y = (const bf16_t*)(c.ws + B_Y1); unsigned char* H8 = c.ws + B_H2TOK;
    int* rinfo = (int*)(c.ws + RT_INFO); float* rw = (float*)(c.ws + RT_W); int* wcnt = (int*)(c.ws + RT_WCNT);
    volatile LAS int* wc = (volatile LAS int*)(c.lds) + c.wave * 8; const int lane = c.lane;
    LAS float* rtr = (LAS float*)(c.lds + 1024);
    for (int i = c.tid; i < D * NE; i += 512) rtr[(i & 7) * D + (i >> 3)] = p.od_router[i];
    __syncthreads();
    float ng1[16], ng2[16], gt[16], sh[16], sc[16]; ld_f32(p.od_norm_g + D, lane, ng1); ld_f32(p.od_norm_g + 2 * D, lane, ng2); int key = -1;
    for (int ch = blockIdx.x; ch < NCH; ch += gridDim.x) {
        if (lane < 8) wc[lane] = 0;
        const int b = (ch * 256) / T;
        if (b != key) { key = b; const float* mr = (const float*)(c.ws + WS_MODV) + ((size_t)33 + b) * 6144; ld_f32(mr + 2 * D, lane, gt); ld_f32(mr + 3 * D, lane, sh); ld_f32(mr + 4 * D, lane, sc); }
        for (int i0 = 0; i0 < 32; i0 += 2) {
            const int tok0 = ch * 256 + c.wave * 32 + i0;
            float xv[2][16], y[2][16];
#pragma unroll
            for (int r = 0; r < 2; ++r) { const int tok = tok0 + r, t = tok % T; ld_bf16(lat_stream(p, c.ws, tok), lane, xv[r]); ld_bf16(Y + ((size_t)b * S + L + t) * D, lane, y[r]); }
            int e0[2], e1[2]; float w0[2], w1[2];
#pragma unroll
            for (int r = 0; r < 2; ++r) { const int tok = tok0 + r; float h[16];
                resid16r(xv[r], y[r], ng1, gt); st_bf16(lat_stream(p, c.ws, tok), lane, xv[r]);
                normmod16r(xv[r], h, ng2, sh, sc);
#if MOE_I8
                st_i8row(H8, (float*)(c.ws + SA_TOK), tok, lane, h);
#else
#pragma unroll
                for (int j2 = 0; j2 < 2; ++j2) { u32x2 w; w.x = pg8::pack4_fp8(h[j2 * 8 + 0], h[j2 * 8 + 1], h[j2 * 8 + 2], h[j2 * 8 + 3]); w.y = pg8::pack4_fp8(h[j2 * 8 + 4], h[j2 * 8 + 5], h[j2 * 8 + 6], h[j2 * 8 + 7]);
                    *(u32x2*)(H8 + (size_t)tok * 1024 + 512 * j2 + 8 * lane) = w; }
#endif
                float lg[NE];
#pragma unroll
                for (int e = 0; e < NE; ++e) { float a = 0.f;
#pragma unroll
                    for (int j2 = 0; j2 < 2; ++j2) { const LAS f32x4* rp = (const LAS f32x4*)(rtr + e * D + 512 * j2 + 8 * lane); const f32x4 r0 = rp[0], r1 = rp[1];
#pragma unroll
                        for (int i = 0; i < 4; ++i) { a = fmaf(h[j2 * 8 + i], r0[i], a); a = fmaf(h[j2 * 8 + 4 + i], r1[i], a); } }
                    lg[e] = wave_sum(a); }
                int a0 = 0; float v0 = lg[0];
#pragma unroll
                for (int e = 1; e < NE; ++e) if (lg[e] > v0) { v0 = lg[e]; a0 = e; }
                int a1 = -1; float v1 = -3.0e38f;
#pragma unroll
                for (int e = 0; e < NE; ++e) if (e != a0 && lg[e] > v1) { v1 = lg[e]; a1 = e; }
                const float p1 = expf(v1 - v0); e0[r] = a0; e1[r] = a1; w0[r] = 1.f / (1.f + p1); w1[r] = p1 / (1.f + p1); }
            if (lane == 0) {
#pragma unroll
                for (int r = 0; r < 2; ++r) { const int tok = tok0 + r; const int r0 = wc[e0[r]], r1 = wc[e1[r]]; wc[e0[r]] = r0 + 1; wc[e1[r]] = r1 + 1;
                    *(int4*)(rinfo + (size_t)tok * 4) = make_int4(e0[r], e1[r], r0, r1); *(float2*)(rw + (size_t)tok * 2) = make_float2(w0[r], w1[r]); } }
        }
        asm volatile("s_waitcnt lgkmcnt(0)" ::: "memory");
        if (lane < 8) wcnt[(ch * 8 + c.wave) * 8 + lane] = wc[lane];
    }
}
__device__ __forceinline__ void phase_gather(const P& p, const Ctx& c) {
    const int* rinfo = (const int*)(c.ws + RT_INFO); const int* wcnt = (const int*)(c.ws + RT_WCNT); int* tpos = (int*)(c.ws + RT_POS); int* toffg = (int*)(c.ws + RT_TOFF);
    const unsigned char* H8 = c.ws + B_H2TOK; unsigned char* HS = c.ws + B_H2S;
    LAS int* wpre = (LAS int*)c.lds;
    LAS int* csum = wpre + NCH * 64;
    LAS int* cpre = csum + NCH * 8;
    LAS int* eoff = cpre + NCH * 8;
    for (int i = c.tid; i < NCH * 8; i += 512) { const int ch = i >> 3, e = i & 7; int run = 0;
        for (int w = 0; w < 8; ++w) { wpre[(ch * 8 + w) * 8 + e] = run; run += wcnt[(ch * 8 + w) * 8 + e]; }
        csum[i] = run; }
    __syncthreads();
    if (c.tid < 8) { int run = 0; for (int ch = 0; ch < NCH; ++ch) { cpre[ch * 8 + c.tid] = run; run += csum[ch * 8 + c.tid]; } eoff[16 + c.tid] = run; }
    __syncthreads();
    if (c.tid == 0) { int o = 0; for (int e = 0; e < NE; ++e) { eoff[e] = o; o += (eoff[16 + e] + 255) & ~255; } eoff[NE] = o;
        if (blockIdx.x == 0) { for (int e = 0; e <= NE; ++e) toffg[e] = eoff[e] >> 8; } }
    __syncthreads();
    for (int t0 = c.gw * 2; t0 < ML; t0 += c.ngw * 2) { u32x4 a[2]; int p0[2], p1[2];
#pragma unroll
        for (int r = 0; r < 2; ++r) { const int tok = t0 + r; a[r] = *(const u32x4*)(H8 + (size_t)tok * 1024 + 16 * c.lane);
            const int4 ri = *(const int4*)(rinfo + (size_t)tok * 4); const int ch = tok >> 8, w = (tok >> 5) & 7;
            p0[r] = eoff[ri.x] + cpre[ch * 8 + ri.x] + wpre[(ch * 8 + w) * 8 + ri.x] + ri.z; p1[r] = eoff[ri.y] + cpre[ch * 8 + ri.y] + wpre[(ch * 8 + w) * 8 + ri.y] + ri.w; }
#pragma unroll
        for (int r = 0; r < 2; ++r) { const int tok = t0 + r; if (c.lane == 0) { *(int2*)(tpos + (size_t)tok * 2) = make_int2(p0[r], p1[r]);
#if MOE_I8
                const float scl = ((const float*)(c.ws + SA_TOK))[tok]; ((float*)(c.ws + SA_SORT))[p0[r]] = scl; ((float*)(c.ws + SA_SORT))[p1[r]] = scl;
#endif
            }
            *(u32x4*)(HS + (size_t)p0[r] * 1024 + 16 * c.lane) = a[r]; *(u32x4*)(HS + (size_t)p1[r] * 1024 + 16 * c.lane) = a[r]; } }
    for (int i = c.gw; i < NE * 256; i += c.ngw) { const int e = i >> 8, r = i & 255; const int n = eoff[16 + e], pad = ((n + 255) & ~255) - n;
        if (r < pad) { const u32x4 z = {0u, 0u, 0u, 0u}; *(u32x4*)(HS + (size_t)(eoff[e] + n + r) * 1024 + 16 * c.lane) = z;
#if MOE_I8
            if (c.lane == 0) ((float*)(c.ws + SA_SORT))[eoff[e] + n + r] = 0.f;
#endif
        } }
}
__device__ __forceinline__ void phase_final(const P& p, const Ctx& c, int tlo, int thi, bool tails) {
    const bf16_t* FS = (const bf16_t*)(c.ws + B_FS); const bf16_t* FX = (const bf16_t*)(c.ws + B_FSX); const int* tpos = (const int*)(c.ws + RT_POS); const float* rw = (const float*)(c.ws + RT_W);
    int r0, r1; wave_rows(c, thi - tlo, r0, r1); float ng3[16], gt[16]; ld_f32(p.od_norm_g + 3 * D, c.lane, ng3); int key = -1;
    for (int t0 = tlo + r0; t0 < tlo + r1; t0 += 2) { float xv[2][16], f0[2][16], f1[2][16]; float2 w[2];
#pragma unroll
        for (int r = 0; r < 2; ++r) { const int tok = t0 + r; const int2 ps = *(const int2*)(tpos + (size_t)tok * 2); w[r] = *(const float2*)(rw + (size_t)tok * 2);
            ld_bf16(lat_stream(p, c.ws, tok), c.lane, xv[r]); ld_bf16(FS + (size_t)ps.x * D, c.lane, f0[r]); ld_bf16(FS + (size_t)ps.y * D, c.lane, f1[r]);
            if (tails) {
                const int px = __builtin_amdgcn_readfirstlane(ps.x) - 131072, py = __builtin_amdgcn_readfirstlane(ps.y) - 131072;
                if (px >= 0) for (int q = 0; q < 3; ++q) { float t[16]; ld_bf16(FX + ((size_t)q * 1792 + px) * D, c.lane, t);
#pragma unroll
                    for (int i = 0; i < 16; ++i) f0[r][i] += t[i]; }
                if (py >= 0) for (int q = 0; q < 3; ++q) { float t[16]; ld_bf16(FX + ((size_t)q * 1792 + py) * D, c.lane, t);
#pragma unroll
                    for (int i = 0; i < 16; ++i) f1[r][i] += t[i]; } } }
#pragma unroll
        for (int r = 0; r < 2; ++r) { const int tok = t0 + r, b = tok / T;
#pragma unroll
            for (int i = 0; i < 16; ++i) f0[r][i] = w[r].x * f0[r][i] + w[r].y * f1[r][i];
            if (b != key) { key = b; ld_f32((const float*)(c.ws + WS_MODV) + ((size_t)33 + b) * 6144 + 5 * D, c.lane, gt); }
            resid16r(xv[r], f0[r], ng3, gt); st_f32(p.out + (size_t)tok * D, c.lane, xv[r]); } }
}
constexpr int LDS_BYTES = 147456;
constexpr int LDS_MISC = 131072 + 2048;
constexpr int NPH = 20;

__device__ __forceinline__ void attn_mla_phase(const Ctx& c) {
    const bf16_t* Q0 = (const bf16_t*)(c.ws + B_Q0); const bf16_t* KN = (const bf16_t*)(c.ws + B_K0N); const bf16_t* KPE = (const bf16_t*)(c.ws + B_KPE); const bf16_t* V0 = (const bf16_t*)(c.ws + B_V0);
    bf16_t* AO = (bf16_t*)(c.ws + B_AOUT0);
    constexpr int NU_LAT = NB * MLA_H * 8, NU = NU_LAT + NB * MLA_H;
    const int G = gridDim.x, vcu = (G % 8 == 0) ? ((int)blockIdx.x % 8) * (G / 8) + (int)blockIdx.x / 8 : (int)blockIdx.x;
#pragma unroll 1
    for (int u = vcu; u < NU; u += G) {
        int b, h, row0, seq;
        if (u < NU_LAT) { b = u / 32; h = (u >> 3) & 3; row0 = b * S + L + (u & 7) * 256; seq = S; } else { const int v = u - NU_LAT; b = v >> 2; h = v & 3; row0 = b * S; seq = L; }
        const att::KSrc ks{KN + (size_t)b * S * 512 + h * 128, 512, KPE + (size_t)b * S * 64, 64};
        const att::AOut ao{AO + (size_t)row0 * D + SCW + h * 128, D, nullptr, nullptr, 0.f, 0};
        att::attn_body_np<192>(Q0 + (size_t)row0 * 768 + h * MLA_QK, 768, ks, V0 + (size_t)b * S * 512 + h * 128, 512, seq, (char*)c.lds, ao);
    }
}
#ifndef ATT_DMA
#define ATT_DMA 1
#endif
template <int VAR>
__device__ __forceinline__ void attn_diff_phase(const P& p, const Ctx& c) {
    const bf16_t* Q1 = (const bf16_t*)(c.ws + B_QKV1); const bf16_t* K1 = Q1 + (size_t)M * 768; const bf16_t* V1 = K1 + (size_t)M * 768; bf16_t* AO = (bf16_t*)(c.ws + B_AOUT1);
    float* stash = (float*)(c.ws + WS_STASH) + (size_t)blockIdx.x * 32768;
    float d01 = p.od_lambda[c.lane] * p.od_lambda[64 + c.lane], d23 = p.od_lambda[128 + c.lane] * p.od_lambda[192 + c.lane];
    d01 = wave_sum(d01); d23 = wave_sum(d23); const float lam = expf(d01) - expf(d23) + LAM_INIT;
    constexpr int NU = NB * DIFF_H * 8;
    const int G = gridDim.x, vcu = (G % 8 == 0) ? ((int)blockIdx.x % 8) * (G / 8) + (int)blockIdx.x / 8 : (int)blockIdx.x;
#pragma unroll 1
    for (int i2 = 2 * vcu; i2 < 2 * NU; i2 = (i2 & 1) ? i2 + 2 * G - 1 : i2 + 1) {
        const int it = i2 >> 1, sub = i2 & 1; const int b = it / 48, h = (it >> 3) % 6, row0 = b * S + L + (it & 7) * 256;
        const att::KSrc ks{K1 + (size_t)b * S * 768 + h * 128 + sub * 64, 768, nullptr, 0};
        const att::AOut ao{AO + (size_t)row0 * D + h * 128, D, stash, p.od_subln_g, lam, sub};
#if ATT_DMA
        att::attn_body_dma<1>(Q1 + (size_t)row0 * 768 + h * 128 + sub * 64, 768, ks.ka, 768, V1 + (size_t)b * S * 768 + h * 128, 768, S, (char*)c.lds, ao);
#else
        att::attn_body<64, 2, 1, VAR>(Q1 + (size_t)row0 * 768 + h * 128 + sub * 64, 768, ks, V1 + (size_t)b * S * 768 + h * 128, 768, S, (char*)c.lds, ao);
#endif
    }
}
__device__ __forceinline__ void moe_load_toff(const Ctx& c, pg8::SchedMoe& Sm) {
    const int* toffg = (const int*)(c.ws + RT_TOFF);
#pragma unroll
    for (int e = 0; e <= NE; ++e) Sm.toff[e] = __builtin_amdgcn_readfirstlane(toffg[e]);
}

__global__ void __launch_bounds__(512, 2) fwd(P p) {
    extern __shared__ __attribute__((aligned(16))) unsigned char lds_[];
    Ctx c; c.lds = (LAS unsigned char*)lds_; c.ws = p.ws; c.tid = threadIdx.x; c.lane = c.tid & 63; c.wave = __builtin_amdgcn_readfirstlane(c.tid >> 6);
    c.gw = blockIdx.x * 8 + c.wave; c.ngw = gridDim.x * 8;
    volatile LAS unsigned* misc = (volatile LAS unsigned*)(c.lds + LDS_MISC);
    if (c.tid < 8) misc[c.tid] = 0u;
    __syncthreads();
    const int lo = p.ph_lo, hi = p.ph_hi;
    XcdBarrier bar; bar.bar = (unsigned*)(c.ws + WS_CTL) + CW_BAR; bar.x = 0; bar.st = misc;
    if (hi - lo > 1) bar = xcd_barrier_post((unsigned*)(c.ws + WS_CTL) + CW_BAR, misc);
#ifdef PH_ONLY
#define IN(k) ((k) == PH_ONLY)
#else
#define IN(k) (lo <= (k) && (k) < hi)
#endif
#define SEAM(k) do { if (IN(k) && IN((k) + 1)) xcd_barrier(bar); } while (0)
    LAS unsigned char* lds = c.lds;
    const float* rc = (const float*)(c.ws + WS_ROPE); const float* rs = rc + 2048 * 32;

#ifndef EPI_SKIP
#define EPI_SKIP 0
#endif
#ifndef REPEAT_MASK
#define REPEAT_MASK 0u
#endif
#define REP(k) (((unsigned)(REPEAT_MASK) >> (k)) & 1u)
#ifndef CLK_T
#define CLK_T 10
#endif
#ifndef CLK_PROBE_PH
#define CLK_PROBE_PH -1
#endif
#define CLKP0(k) long long ck0_ = 0, cr0_ = 0; if ((k) == CLK_PROBE_PH && blockIdx.x == 0 && c.tid == 0) { ck0_ = clock64(); cr0_ = wall_clock64(); }
#define CLKP1(k) if ((k) == CLK_PROBE_PH && blockIdx.x == 0 && c.tid == 0) { const long long ck1_ = clock64(), cr1_ = wall_clock64(); ((float*)(c.ws + WS_CTL))[96] = (float)(ck1_ - ck0_) / (float)(cr1_ - cr0_); }
#define PHASE(k, ...) do { if (IN(k)) { CLKP0(k) { const int rp_ = 0; (void)rp_; __VA_ARGS__ } if (REP(k)) { xcd_barrier(bar); { const int rp_ = 1; (void)rp_; __VA_ARGS__ } } CLKP1(k) } SEAM(k); } while (0)
#ifndef P0_REP_PARTS
#define P0_REP_PARTS 7
#endif
    PHASE(0, { phase_prologue(p, c, rp_ ? P0_REP_PARTS : 7, rp_); });
#ifdef EXTRA_BARS
    if (IN(1)) { for (int i_ = 0; i_ < EXTRA_BARS; ++i_) xcd_barrier(bar); }
#endif
    PHASE(1, { phase_norm0(p, c); phase_quant_weights(c); });
#if USE_I8
    PHASE(2, { pg8::Gemm g{512, 512, 512}; pg8::SchedPlain Sc; Sc.init(c.ws + B_H, 512, c.ws + W8_IN0, 512, M / 256, 9, false);
        pg8::EpiPlainI8 E{(bf16_t*)(c.ws + B_Z), 2304, (const float*)(c.ws + SA_ROW), (const float*)(c.ws + SW_IN0)}; pg8::gemm_phase<pg8::EpiPlainI8, pg8::SchedPlain, 2>(lds, g, Sc, E); });
#else
    PHASE(2, { pg8::Gemm g{D, D, D}; pg8::SchedPlain Sc; Sc.init(c.ws + B_H, D, c.ws + W_IN0, D, M / 256, 9, false); pg8::EpiPlain E{(bf16_t*)(c.ws + B_Z), 2304}; pg8::gemm_phase(lds, g, Sc, E); });
#endif
    PHASE(3, { phase_even_elem(p, c); });
    PHASE(4, {
        { pg8::Gemm g{QRANK, QRANK, QRANK}; pg8::SchedPlain Sc; Sc.init(c.ws + B_ZQN, QRANK, c.ws + W_UQ, QRANK, M / 256, 3, false); pg8::EpiQ0 E{(bf16_t*)(c.ws + B_Q0), rc, rs}; pg8::gemm_phase(lds, g, Sc, E); }
        { pg8::Gemm g{KVRANK, KVRANK, KVRANK}; pg8::SchedPlain Sc; Sc.init(c.ws + B_ZKVN, KVRANK, c.ws + W_UKV, KVRANK, M / 256, 4, false); pg8::EpiKV0 E{(bf16_t*)(c.ws + B_K0N), (bf16_t*)(c.ws + B_V0)}; pg8::gemm_phase(lds, g, Sc, E); }
    });
    PHASE(5, { attn_mla_phase(c); });
    const bool split = SPLIT_TAIL && gridDim.x == 256;
    PHASE(6, { if (split) { { pg8::Gemm g{D, D, D}; pg8::SchedPlain Sc; Sc.init(c.ws + B_AOUT0, D, c.ws + W_OUT0, D, 256, 4, false); pg8::EpiPlain E{(bf16_t*)(c.ws + B_Y), D}; pg8::gemm_phase(lds, g, Sc, E); }
            { pg8::Gemm g{D, D, D / 2}; pg8::SchedTailK2 Sc{(const char*)(c.ws + B_AOUT0), (const char*)(c.ws + W_OUT0), (size_t)256 * D * 2, (size_t)256 * D * 2, (size_t)D, (int)gridDim.x, (int)blockIdx.x};
              pg8::EpiPlainK2 E{(bf16_t*)(c.ws + B_Y), (bf16_t*)(c.ws + B_PART1), D}; pg8::gemm_phase(lds, g, Sc, E); } }
        else { pg8::Gemm g{D, D, D}; pg8::SchedPlain Sc; Sc.init(c.ws + B_AOUT0, D, c.ws + W_OUT0, D, M / 256, 4, false); pg8::EpiPlain E{(bf16_t*)(c.ws + B_Y), D}; pg8::gemm_phase(lds, g, Sc, E); } });
    PHASE(7, { phase_mid0(p, c, split); });
#if USE_I8
    PHASE(8, { pg8::Gemm g{512, 512, 512}; pg8::SchedPlain Sc; Sc.init(c.ws + B_H2, 512, c.ws + W8_GU0, 512, M / 256, 22, false);
        pg8::EpiSwigluI8 E{(void*)(c.ws + B_ACT), FF, (const float*)(c.ws + SA_ROW), (const float*)(c.ws + SW_GU0), 0, DN0_FP8 ? 8.f : 1.f, DN0_FP8 != 0}; pg8::gemm_phase<pg8::EpiSwigluI8, pg8::SchedPlain, 2>(lds, g, Sc, E); });
    PHASE(9, { if (DN0_FP8) { pg8::Gemm g{FF / 2, FF / 2, FF / 2, 0x7c7c7c7c, 0x79797979};
            { pg8::SchedPlain Sc; Sc.init(c.ws + B_ACT, FF / 2, c.ws + W_DN0, FF / 2, split ? 256 : M / 256, 4, false); pg8::EpiPlain E{(bf16_t*)(c.ws + B_F), D}; pg8::gemm_phase<pg8::EpiPlain, pg8::SchedPlain, true>(lds, g, Sc, E); }
            if (split) { pg8::SchedTailParts Sc{(const char*)(c.ws + B_ACT), (const char*)(c.ws + W_DN0), (size_t)256 * FF, (size_t)256 * FF, 256, 32, 4, 2, 12, 10, (int)gridDim.x, (int)blockIdx.x};
              pg8::EpiPlainK2 E{(bf16_t*)(c.ws + B_F), (bf16_t*)(c.ws + B_PART1), D}; pg8::gemm_phase<pg8::EpiPlainK2, pg8::SchedTailParts, true>(lds, g, Sc, E); } }
        else if (split) { { pg8::Gemm g{FF, FF, FF}; pg8::SchedPlain Sc; Sc.init(c.ws + B_ACT, FF, c.ws + W_DN0, FF, 256, 4, false); pg8::EpiPlain E{(bf16_t*)(c.ws + B_F), D}; pg8::gemm_phase(lds, g, Sc, E); }
            { pg8::Gemm g{FF, FF, FF / 2}; pg8::SchedTailK2 Sc{(const char*)(c.ws + B_ACT), (const char*)(c.ws + W_DN0), (size_t)256 * FF * 2, (size_t)256 * FF * 2, (size_t)FF, (int)gridDim.x, (int)blockIdx.x};
              pg8::EpiPlainK2 E{(bf16_t*)(c.ws + B_F), (bf16_t*)(c.ws + B_PART1), D}; pg8::gemm_phase(lds, g, Sc, E); } }
        else { pg8::Gemm g{FF, FF, FF}; pg8::SchedPlain Sc; Sc.init(c.ws + B_ACT, FF, c.ws + W_DN0, FF, M / 256, 4, false); pg8::EpiPlain E{(bf16_t*)(c.ws + B_F), D}; pg8::gemm_phase(lds, g, Sc, E); } });
#elif FFN0_FP8
    PHASE(8, { pg8::Gemm g{512, 512, 512, 0x7f7f7f7f, 0x7a7a7a7a, 0x7d7d7d7d}; pg8::SchedPlain Sc; Sc.init(c.ws + B_H2, 512, c.ws + W_GU0, 512, M / 256, 22, false); pg8::EpiSwiglu8 E{c.ws + B_ACT, FF, 8.f}; pg8::gemm_phase<pg8::EpiSwiglu8, pg8::SchedPlain, true>(lds, g, Sc, E); });
    PHASE(9, { pg8::Gemm g{FF / 2, FF / 2, FF / 2, 0x7c7c7c7c, 0x79797979}; pg8::SchedPlain Sc; Sc.init(c.ws + B_ACT, FF / 2, c.ws + W_DN0, FF / 2, M / 256, 4, false); pg8::EpiPlain E{(bf16_t*)(c.ws + B_F), D}; pg8::gemm_phase<pg8::EpiPlain, pg8::SchedPlain, true>(lds, g, Sc, E); });
#else
    PHASE(8, { pg8::Gemm g{D, D, D}; pg8::SchedPlain Sc; Sc.init(c.ws + B_H2, D, c.ws + W_GU0, D, M / 256, 22, false); pg8::EpiSwiglu E{(bf16_t*)(c.ws + B_ACT), FF, (rp_ == 0 && REP(8)) ? EPI_SKIP : 0}; pg8::gemm_phase(lds, g, Sc, E); });
    PHASE(9, { pg8::Gemm g{FF, FF, FF}; pg8::SchedPlain Sc; Sc.init(c.ws + B_ACT, FF, c.ws + W_DN0, FF, M / 256, 4, false); pg8::EpiPlain E{(bf16_t*)(c.ws + B_F), D}; pg8::gemm_phase(lds, g, Sc, E); });
#endif
    PHASE(10, { phase_end0(p, c, split); });
#if USE_I8
    PHASE(11, {
        { pg8::Gemm g{512, 512, 512}; pg8::SchedQKV1 Sc{(const char*)(c.ws + B_H1), (const char*)(c.ws + W8_IN1), (int)gridDim.x, (int)blockIdx.x, 1024};
          pg8::EpiQKV1I8 E{(bf16_t*)(c.ws + B_QKV1), (size_t)M * 768, (const float*)(c.ws + SA_ROW), (const float*)(c.ws + SW_IN1)}; pg8::gemm_phase<pg8::EpiQKV1I8, pg8::SchedQKV1, 2>(lds, g, Sc, E); }
        { pg8::Gemm g{512, 512, 512}; pg8::SchedF1 Sc{(const char*)(c.ws + W8_FOLD), (const char*)(c.ws + B_H1), NB * 8, (int)gridDim.x, (int)blockIdx.x, 1024};
          pg8::EpiGTI8 E{(bf16_t*)(c.ws + B_GT), (const float*)(c.ws + SW_FOLD), (const float*)(c.ws + SA_ROW)}; pg8::gemm_phase<pg8::EpiGTI8, pg8::SchedF1, 2>(lds, g, Sc, E); }
    });
#else
    PHASE(11, {
        { pg8::Gemm g{D, D, D}; pg8::SchedQKV1 Sc{(const char*)(c.ws + B_H1), (const char*)(c.ws + W_IN1), (int)gridDim.x, (int)blockIdx.x}; pg8::EpiQKV1 E{(bf16_t*)(c.ws + B_QKV1), (size_t)M * 768, rc, rs}; pg8::gemm_phase(lds, g, Sc, E); }
        { pg8::Gemm g{D, D, D}; pg8::SchedF1 Sc{(const char*)(c.ws + W_FOLD), (const char*)(c.ws + B_H1), NB * 8, (int)gridDim.x, (int)blockIdx.x}; pg8::EpiGT E{(bf16_t*)(c.ws + B_GT)}; pg8::gemm_phase(lds, g, Sc, E); }
    });
#endif
    PHASE(12, {
        { pg8::Gemm g{4096, 4096, 4096}; pg8::SchedF2 Sc{(const char*)(c.ws + W_DFT), (const char*)(c.ws + B_GT), (int)gridDim.x, (int)blockIdx.x}; pg8::EpiPlain E{(bf16_t*)(c.ws + B_AOUT1) + DIFFW, D}; pg8::gemm_phase(lds, g, Sc, E); }
#ifndef ATT_VAR
#define ATT_VAR 0
#endif
        if (rp_ == 0 && REP(12)) attn_diff_phase<ATT_VAR>(p, c); else attn_diff_phase<0>(p, c);
    });
    PHASE(13, { pg8::Gemm g{D, D, D}; pg8::SchedPlain Sc; Sc.init(c.ws + B_AOUT1, D, c.ws + W_OUT1, D, NB * 8, 4, true); pg8::EpiPlain E{(bf16_t*)(c.ws + B_Y1), D}; pg8::gemm_phase(lds, g, Sc, E); });
    PHASE(14, { phase_mid1(p, c); });
    PHASE(15, { phase_gather(p, c); });
#if MOE_I8
    PHASE(16, { pg8::SchedMoe Sm; moe_load_toff(c, Sm);
        Sm.A = (const char*)(c.ws + B_H2S); Sm.W = (const char*)(c.ws + W_GU1); Sm.at = (size_t)256 * 1024; Sm.bt = (size_t)256 * 1024; Sm.estride = (size_t)5632 * 1024; Sm.t0 = 0; Sm.nT = Sm.toff[NE]; Sm.nN = 22; Sm.G = gridDim.x; Sm.c = blockIdx.x;
        pg8::Gemm g{512, 512, 512}; pg8::EpiSwigluI8 E{(void*)(c.ws + B_ACTM), FF, (const float*)(c.ws + SA_SORT), (const float*)(c.ws + SW_GU1), 5632, 8.f, true}; pg8::gemm_phase<pg8::EpiSwigluI8, pg8::SchedMoe, 2>(lds, g, Sm, E); });
#else
    PHASE(16, { pg8::SchedMoe Sm; moe_load_toff(c, Sm);
        Sm.A = (const char*)(c.ws + B_H2S); Sm.W = (const char*)(c.ws + W_GU1); Sm.at = (size_t)256 * 1024; Sm.bt = (size_t)256 * 1024; Sm.estride = (size_t)5632 * 1024; Sm.t0 = 0; Sm.nT = Sm.toff[NE]; Sm.nN = 22; Sm.G = gridDim.x; Sm.c = blockIdx.x;
        pg8::Gemm g{512, 512, 512, 0x7f7f7f7f, 0x7a7a7a7a, 0x7d7d7d7d}; pg8::EpiSwiglu8 E{c.ws + B_ACTM, FF, 8.f, (rp_ == 0 && REP(16)) ? EPI_SKIP : 0}; pg8::gemm_phase<pg8::EpiSwiglu8, pg8::SchedMoe, true>(lds, g, Sm, E); });
#endif
    PHASE(17, { pg8::SchedMoe Sm; moe_load_toff(c, Sm);
        Sm.A = (const char*)(c.ws + B_ACTM); Sm.W = (const char*)(c.ws + W_DN1); Sm.at = (size_t)256 * FF; Sm.bt = (size_t)256 * FF; Sm.estride = (size_t)1024 * 2816; Sm.t0 = 0; Sm.nT = Sm.toff[NE]; Sm.nN = 4; Sm.G = gridDim.x; Sm.c = blockIdx.x;
        pg8::Gemm g{FF / 2, FF / 2, FF / 2, 0x7c7c7c7c, 0x79797979}; pg8::EpiPlain E{(bf16_t*)(c.ws + B_FS), D};
        if (split) {
            const int nT = Sm.toff[NE]; Sm.nT = nT < 512 ? nT : 512; pg8::gemm_phase<pg8::EpiPlain, pg8::SchedMoe, true>(lds, g, Sm, E);
            if (nT > 512) { pg8::SchedMoeTail St; St.A = Sm.A; St.W = Sm.W; St.at = Sm.at; St.bt = Sm.bt; St.estride = Sm.estride; St.pm0 = 512; St.nTail = (nT - 512) < 7 ? (nT - 512) : 7; St.nN = 4; St.t0 = 6; St.t1 = 4; St.G = gridDim.x; St.c = blockIdx.x;
                _Pragma("unroll") for (int e = 0; e <= NE; ++e) St.toff[e] = Sm.toff[e];
                pg8::EpiPlainParts Ep{(bf16_t*)(c.ws + B_FS), (bf16_t*)(c.ws + B_FSX), D, 131072, 1792}; pg8::gemm_phase<pg8::EpiPlainParts, pg8::SchedMoeTail, true>(lds, g, St, Ep); } }
        else pg8::gemm_phase<pg8::EpiPlain, pg8::SchedMoe, true>(lds, g, Sm, E); });
    PHASE(18, { phase_final(p, c, 0, ML / 2, split); });
    PHASE(19, { phase_final(p, c, ML / 2, ML, split); });
    if (CLK_PROBE_PH >= 0 && IN(19)) {
        xcd_barrier(bar); const float f = __hip_atomic_load((float*)(c.ws + WS_CTL) + 96, __ATOMIC_RELAXED, __HIP_MEMORY_SCOPE_AGENT); const float sc_ = 1.f + (f > (float)CLK_T ? 1.f : 0.f) + (f > 2.f * (float)CLK_T ? 1.f : 0.f);
        for (size_t i = (size_t)blockIdx.x * 512 + c.tid; i < (size_t)ML * D; i += (size_t)gridDim.x * 512) p.out[i] = p.x[i] * sc_; }
#undef PHASE
#undef REP
#undef IN
#undef SEAM
}
}
#ifndef CHECK_MODE
#define CHECK_MODE 0
#endif
#ifndef ONE_LAUNCH
#define ONE_LAUNCH 1
#endif

static fp::P make_params(void* const* d_in, void* d_out, void* d_ws) {
    fp::P p{}; const float** q = (const float**)&p; for (int i = 0; i < 28; ++i) q[i] = (const float*)d_in[i];
    p.out = (float*)d_out; p.ws = (unsigned char*)d_ws; p.ph_lo = 0; p.ph_hi = fp::NPH; return p;
}
static int fast_grid() {
    static int grid = 0;
    if (grid == 0) {
        int dev = 0, cus = 0;
        if (hipGetDevice(&dev) != hipSuccess || hipDeviceGetAttribute(&cus, hipDeviceAttributeMultiprocessorCount, dev) != hipSuccess) { grid = -1; return grid; }
        if (hipFuncSetAttribute((const void*)fp::fwd, hipFuncAttributeMaxDynamicSharedMemorySize, fp::LDS_BYTES) != hipSuccess) { grid = -1; return grid; }
        int per_cu = 0; (void)hipOccupancyMaxActiveBlocksPerMultiprocessor(&per_cu, (const void*)fp::fwd, 512, fp::LDS_BYTES); (void)hipGetLastError();
        if (per_cu < 1) fprintf(stderr, "occupancy query reports %d blocks per CU\n", per_cu);
        grid = cus > 256 ? 256 : cus;
    }
    return grid;
}
static void fast_forward(void* const* d_in, void* d_out, void* d_ws, hipStream_t stream, int ph_end, bool one_launch) {
    const int grid = fast_grid(); if (grid <= 0) return;
    (void)hipMemsetAsync((char*)d_ws + fp::WS_CTL, 0, fp::CTL_BYTES, stream);
    fp::P p = make_params(d_in, d_out, d_ws);
    if (one_launch) { p.ph_lo = 0; p.ph_hi = ph_end; hipLaunchKernelGGL(fp::fwd, dim3(grid), dim3(512), fp::LDS_BYTES, stream, p); }
    else for (int k = 0; k < ph_end; ++k) { p.ph_lo = k; p.ph_hi = k + 1; hipLaunchKernelGGL(fp::fwd, dim3(grid), dim3(512), fp::LDS_BYTES, stream, p); }
}

#if CHECK_MODE
namespace chk {
using namespace cfg;
__device__ __forceinline__ int rope_pos(int e) { return e < 32 ? 8 * (e >> 2) + (e & 3) : 8 * ((e - 32) >> 2) + 4 + (e & 3); }
__global__ void k_cmp(const void* fast, int fast_bf16, int ldf, int fcol0, const float* ref, int ldr, int rcol0, int rows, int cols, int rowmode, int perm, float* acc) {
    float sd = 0.f, sr = 0.f;
    for (long i = (long)blockIdx.x * 256 + threadIdx.x; i < (long)rows * cols; i += (long)gridDim.x * 256) {
        const int r = (int)(i / cols), ci = (int)(i % cols); int rr = r, fr = r;
        if (rowmode == 1 && (r % S) < L) continue;
        if (rowmode == 3 && (r % S) >= L) continue;
        if (rowmode == 2) { rr = (r / T) * S + L + (r % T); }
        int fc = ci;
        if (perm == 1) { const int h = ci / 192, w = ci % 192; fc = w < 128 ? ci : h * 192 + 128 + rope_pos(w - 128); }
        if (perm == 2) { fc = (ci & ~63) + rope_pos(ci & 63); }
        if (perm == 3) { fc = rope_pos(ci); }
        const float rv = ref[(long)rr * ldr + rcol0 + ci];
        const float fv = fast_bf16 ? __uint_as_float(((unsigned)((const unsigned short*)fast)[(long)fr * ldf + fcol0 + fc]) << 16) : ((const float*)fast)[(long)fr * ldf + fcol0 + fc];
        const float d = fv - rv; sd += d * d; sr += rv * rv;
    }
    for (int o = 32; o >= 1; o >>= 1) { sd += __shfl_xor(sd, o); sr += __shfl_xor(sr, o); }
    if ((threadIdx.x & 63) == 0) { atomicAdd(acc, sd); atomicAdd(acc + 1, sr); }
}
__global__ void k_cmp_gt(const unsigned short* gt, const float* gcs, int nb, float* acc) {
    float sd = 0.f, sr = 0.f;
    for (long i = (long)blockIdx.x * 256 + threadIdx.x; i < (long)nb * 2 * T * 256; i += (long)gridDim.x * 256) {
        const int c = (int)(i % 256); const int t = (int)((i / 256) % T); const int part = (int)((i / (256L * T)) % 2); const int b = (int)(i / (256L * T * 2));
        const float rv = gcs[i]; const float fv = __uint_as_float(((unsigned)gt[(((long)b * 256 + c) * 2 + part) * T + t]) << 16);
        const float d = fv - rv; sd += d * d; sr += rv * rv; }
    for (int o = 32; o >= 1; o >>= 1) { sd += __shfl_xor(sd, o); sr += __shfl_xor(sr, o); }
    if ((threadIdx.x & 63) == 0) { atomicAdd(acc, sd); atomicAdd(acc + 1, sr); }
}
__global__ void k_encode(const float* acc, int nchecks, float tol, const float* x, float* out, long n) {
    int code = 0;
    for (int k = 0; k < nchecks; ++k) { const float sd = acc[2 * k], sr = acc[2 * k + 1]; if (!(sd <= tol * sr) || !(sr > 0.f)) { code = k + 1; break; } }
    const float s = 1.f + (float)code;
    for (long i = (long)blockIdx.x * 256 + threadIdx.x; i < n; i += (long)gridDim.x * 256) out[i] = x[i] * s;
}
}
#endif

extern "C" void kernel_launch(void* const* d_in, const int* in_sizes, int n_in, void* d_out, int out_size, void* d_ws, size_t ws_size, hipStream_t stream) {
    (void)in_sizes; (void)n_in; (void)out_size;
#if CHECK_MODE
    using namespace cfg; using fp::M; using fp::ML;
    const nv::In I = nv::make_in(d_in);
    nv::Scratch s; char* nbase = (char*)d_ws + ((fp::AR_END + 4095) / 4096) * 4096;
    size_t need = nv::Scratch::carve(s, nbase, NB);
    float* snap0 = (float*)(nbase + need); need += (size_t)M * D * 4;
    float* snap1 = (float*)(nbase + need); need += (size_t)M * D * 4;
    float* snap2 = (float*)(nbase + need); need += (size_t)M * D * 4;
    float* acc = (float*)(nbase + need); need += 4096;
    if ((size_t)(nbase - (char*)d_ws) + need > ws_size) { fprintf(stderr, "check build: ws too small\n"); return; }
    nv::global_setup(stream, I, s);
    nv::forward_chunk(stream, I, s, 0, NB, nullptr, CHECK_MODE == 1 ? 3 : 7, snap0, snap1, snap2);
    fast_forward(d_in, d_out, d_ws, stream, CHECK_MODE == 1 ? 10 : fp::NPH, ONE_LAUNCH != 0);
    (void)hipMemsetAsync(acc, 0, 4096, stream);
    unsigned char* ws = (unsigned char*)d_ws; int k = 0;
#define CMP(fast, isbf, ldf, fc0, ref, ldr, rc0, rows, cols, rowmode, perm) do { hipLaunchKernelGGL(chk::k_cmp, dim3(512), dim3(256), 0, stream, (const void*)(fast), isbf, ldf, fc0, ref, ldr, rc0, rows, cols, rowmode, perm, acc + 2 * k); ++k; } while (0)
#if CHECK_MODE == 1
    CMP(ws + fp::WS_MODV, 0, 6144, 0, s.mod0, 6144, 0, 33, 6144, 0, 0);
    CMP(ws + fp::WS_MODV + (size_t)33 * 6144 * 4, 0, 6144, 0, s.mod1, 6144, 0, 33, 6144, 0, 0);
    CMP(ws + fp::B_Z, 1, 2304, 0, s.z, EVEN_IN, 0, M, EVEN_IN, 0, 0);
    CMP(ws + fp::B_AOUT0, 1, D, 0, s.aout, D, 0, M, SCW, 0, 0);
    CMP(ws + fp::B_ZQN, 1, QRANK, 0, s.zqn, QRANK, 0, M, QRANK, 0, 0);
    CMP(ws + fp::B_ZKVN, 1, KVRANK, 0, s.zkvn, KVRANK, 0, M, KVRANK, 0, 0);
    CMP(ws + fp::B_KPE, 1, 64, 0, s.Kf, 768, 128, M, 64, 0, 3);
    CMP(ws + fp::B_Q0, 1, 768, 0, s.Qf, 768, 0, M, 768, 0, 1);
    for (int h = 0; h < 4; ++h) CMP(ws + fp::B_K0N, 1, 512, h * 128, s.Kf, 768, h * 192, M, 128, 0, 0);
    CMP(ws + fp::B_V0, 1, 512, 0, s.Vf, 512, 0, M, 512, 0, 0);
    CMP(ws + fp::B_AOUT0, 1, D, SCW, s.aout, D, SCW, M, 512, 1, 0);
    CMP(ws + fp::B_AOUT0, 1, D, SCW, s.aout, D, SCW, M, 512, 3, 0);
    CMP(ws + fp::B_Y, 1, D, 0, s.y, D, 0, M, D, 0, 0);
    CMP(ws + fp::B_ACT, 1, FF, 0, s.act, FF, 0, M, FF, 0, 0);
    CMP(ws + fp::B_F, 1, D, 0, s.f, D, 0, M, D, 0, 0);
#else
    CMP(ws + fp::B_QKV1, 1, 768, 0, s.Qf, 768, 0, M, 768, 1, 2);
    CMP(ws + fp::B_QKV1 + (size_t)M * 1536, 1, 768, 0, s.Kf, 768, 0, M, 768, 0, 2);
    CMP(ws + fp::B_QKV1 + (size_t)M * 3072, 1, 768, 0, s.z, ODD_IN, 2 * DIFFW, M, 768, 0, 0);
    hipLaunchKernelGGL(chk::k_cmp_gt, dim3(512), dim3(256), 0, stream, (const unsigned short*)(ws + fp::B_GT), s.gcs, NB, acc + 2 * k); ++k;
    CMP(ws + fp::B_AOUT1, 1, D, DIFFW, s.aout, D, DIFFW, M, FNW, 1, 0);
    CMP(ws + fp::B_AOUT1, 1, D, 0, s.aout, D, 0, M, DIFFW, 1, 0);
    CMP(ws + fp::B_Y1, 1, D, 0, s.y, D, 0, M, D, 1, 0);
    CMP(d_out, 0, D, 0, s.xs, D, 0, ML, D, 2, 0);
#endif
#undef CMP
    hipLaunchKernelGGL(chk::k_encode, dim3(2048), dim3(256), 0, stream, acc, k, 2e-3f, (const float*)d_in[0], (float*)d_out, (long)FULLB * T * D);
#else
    if (ws_size < fp::AR_END + ((size_t)12 << 20)) { fprintf(stderr, "kernel_launch: workspace too small: need %zu have %zu\n", (size_t)fp::AR_END + ((size_t)12 << 20), ws_size); return; }
    fast_forward(d_in, d_out, d_ws, stream, fp::NPH, ONE_LAUNCH != 0);
#endif
}
```

```cpp
#include <hip/hip_runtime.h>
#include <cstdio>
#include <cstdint>
#include <cmath>

#ifndef CFG_NB
#define CFG_NB 32
#endif
namespace cfg {
constexpr int NB = CFG_NB;
constexpr int FULLB = 32;
constexpr int D = 1024, T = 2048, L = 256, S = T + L;
constexpr int GW = 64;
constexpr float EPS = 1e-6f;
constexpr int SCW = 512, SCIN = 1536;
constexpr int MLA_H = 4, MLA_NOPE = 128, MLA_ROPE = 64, MLA_V = 128, MLA_QK = 192, QRANK = 384, KVRANK = 256;
constexpr int EVEN_IN = 2240;
constexpr int DIFFW = 768, DIFF_H = 6, DIFF_HD = 64;
constexpr int FNW = 256, FNG = 4, FNGD = 64, ODD_IN = 2560;
constexpr int FF = 2816, NE = 8;
constexpr float LAM_INIT = 0.35550906759096944f;
}
namespace fp {
using namespace cfg;
#define LAS __attribute__((address_space(3)))
#define GAS __attribute__((address_space(1)))
typedef unsigned short bf16_t;
typedef short bf16x8 __attribute__((ext_vector_type(8)));
typedef short s16x4 __attribute__((ext_vector_type(4)));
typedef float f32x4 __attribute__((ext_vector_type(4)));
typedef float f32x2 __attribute__((ext_vector_type(2)));
typedef float f32x16 __attribute__((ext_vector_type(16)));
typedef unsigned u32x4 __attribute__((ext_vector_type(4)));
typedef unsigned u32x2 __attribute__((ext_vector_type(2)));

__device__ __forceinline__ unsigned cvt_pk_bf16(float lo, float hi) { unsigned r; asm volatile("v_cvt_pk_bf16_f32 %0, %1, %2" : "=v"(r) : "v"(lo), "v"(hi)); return r; }
__device__ __forceinline__ float bf2f(unsigned short b) { return __uint_as_float(((unsigned)b) << 16); }
__device__ __forceinline__ float bflo(unsigned w) { return __uint_as_float(w << 16); }
__device__ __forceinline__ float bfhi(unsigned w) { return __uint_as_float(w & 0xffff0000u); }
__device__ __forceinline__ unsigned short f2bf(float f) { return (unsigned short)(cvt_pk_bf16(f, 0.f) & 0xffffu); }
__device__ __forceinline__ float wave_sum(float v) {
    v += __builtin_bit_cast(float, __builtin_amdgcn_update_dpp(0, __builtin_bit_cast(int, v), 0xB1, 0xF, 0xF, true));
    v += __builtin_bit_cast(float, __builtin_amdgcn_update_dpp(0, __builtin_bit_cast(int, v), 0x4E, 0xF, 0xF, true));
    v += __builtin_bit_cast(float, __builtin_amdgcn_update_dpp(0, __builtin_bit_cast(int, v), 0x141, 0xF, 0xF, true));
    v += __builtin_bit_cast(float, __builtin_amdgcn_update_dpp(0, __builtin_bit_cast(int, v), 0x140, 0xF, 0xF, true));
    const int vi = __builtin_bit_cast(int, v);
    const float r0 = __builtin_bit_cast(float, __builtin_amdgcn_readlane(vi, 0)), r1 = __builtin_bit_cast(float, __builtin_amdgcn_readlane(vi, 16)),
                r2 = __builtin_bit_cast(float, __builtin_amdgcn_readlane(vi, 32)), r3 = __builtin_bit_cast(float, __builtin_amdgcn_readlane(vi, 48));
    return (r0 + r1) + (r2 + r3);
}
__device__ __forceinline__ float wave_max(float v) {
    v = fmaxf(v, __builtin_bit_cast(float, __builtin_amdgcn_update_dpp(0, __builtin_bit_cast(int, v), 0xB1, 0xF, 0xF, true)));
    v = fmaxf(v, __builtin_bit_cast(float, __builtin_amdgcn_update_dpp(0, __builtin_bit_cast(int, v), 0x4E, 0xF, 0xF, true)));
    v = fmaxf(v, __builtin_bit_cast(float, __builtin_amdgcn_update_dpp(0, __builtin_bit_cast(int, v), 0x141, 0xF, 0xF, true)));
    v = fmaxf(v, __builtin_bit_cast(float, __builtin_amdgcn_update_dpp(0, __builtin_bit_cast(int, v), 0x140, 0xF, 0xF, true)));
    const int vi = __builtin_bit_cast(int, v);
    const float r0 = __builtin_bit_cast(float, __builtin_amdgcn_readlane(vi, 0)), r1 = __builtin_bit_cast(float, __builtin_amdgcn_readlane(vi, 16)),
                r2 = __builtin_bit_cast(float, __builtin_amdgcn_readlane(vi, 32)), r3 = __builtin_bit_cast(float, __builtin_amdgcn_readlane(vi, 48));
    return fmaxf(fmaxf(r0, r1), fmaxf(r2, r3));
}
__device__ __forceinline__ unsigned pack4_i8(float a, float b, float c, float d) {
    const int ia = (int)rintf(a), ib = (int)rintf(b), ic = (int)rintf(c), id = (int)rintf(d);
    return (unsigned)(ia & 0xff) | ((unsigned)(ib & 0xff) << 8) | ((unsigned)(ic & 0xff) << 16) | ((unsigned)id << 24); }
__device__ __forceinline__ float quant_row_i8(const float (&v)[16], u32x2 (&q)[2]) {
    float am = 0.f;
#pragma unroll
    for (int i = 0; i < 16; ++i) am = fmaxf(am, fabsf(v[i]));
    am = wave_max(am); const float scale = am > 0.f ? am * (1.f / 127.f) : 1.f, inv = 1.f / scale;
#pragma unroll
    for (int j2 = 0; j2 < 2; ++j2) { q[j2].x = pack4_i8(v[j2 * 8 + 0] * inv, v[j2 * 8 + 1] * inv, v[j2 * 8 + 2] * inv, v[j2 * 8 + 3] * inv); q[j2].y = pack4_i8(v[j2 * 8 + 4] * inv, v[j2 * 8 + 5] * inv, v[j2 * 8 + 6] * inv, v[j2 * 8 + 7] * inv); }
    return scale;
}
__device__ __forceinline__ float silu_f(float v) { return v / (1.f + __expf(-v)); }

#define XB_TMO      128
#define XB_XCNT(j)  (256  + 64 * (j))
#define XB_XSUB(j)  (1280 + 64 * (j))
#define XB_XGEN(j)  (2304 + 64 * (j))
#define XB_TOP      3328
#define XB_TOPGEN   3392
#define XCD_BAR_WORDS 3456
#define XB_SPIN_CAP (1u << 18)
__device__ __forceinline__ unsigned xb_ld(unsigned* p)              { return __hip_atomic_load(p, __ATOMIC_RELAXED, __HIP_MEMORY_SCOPE_AGENT); }
__device__ __forceinline__ unsigned xb_add(unsigned* p, unsigned v) { return __hip_atomic_fetch_add(p, v, __ATOMIC_RELAXED, __HIP_MEMORY_SCOPE_AGENT); }
__device__ __forceinline__ unsigned xb_xcc_id() { return (unsigned)__builtin_amdgcn_s_getreg((3 << 11) | 20) & 0xFu; }
#define XB_SPIN(cond, bar) do { unsigned _sp = 0; while (cond) { __builtin_amdgcn_s_sleep(1); \
    if ((++_sp & 255u) == 0u) { if (xb_ld(&(bar)[XB_TMO])) break; if (_sp > XB_SPIN_CAP) { atomicAdd(&(bar)[XB_TMO], 1u); break; } } } } while (0)
struct XcdBarrier { unsigned* bar; unsigned x; volatile LAS unsigned* st; };
__device__ __forceinline__ XcdBarrier xcd_barrier_post(unsigned* bar, volatile LAS unsigned* st) {
    XcdBarrier b; b.bar = bar; b.x = xb_xcc_id(); b.st = st;
    if (threadIdx.x == 0) (void)xb_add(&bar[XB_XCNT(b.x)], 1u);
    return b;
}
__device__ __forceinline__ void xcd_barrier_complete(unsigned* bar, unsigned x, unsigned& nloc, unsigned& nx) {
    const unsigned G = gridDim.x * gridDim.y * gridDim.z;
    unsigned sum, cnt, mine, sp = 0u;
    for (;;) {
        sum = 0u; cnt = 0u; mine = 0u;
#pragma unroll
        for (unsigned j = 0; j < 16; ++j) { const unsigned c = xb_ld(&bar[XB_XCNT(j)]); sum += c; cnt += (c > 0u) ? 1u : 0u; mine = (j == x) ? c : mine; }
        if (sum == G) break;
        __builtin_amdgcn_s_sleep(1);
        if ((++sp & 255u) == 0u) { if (xb_ld(&bar[XB_TMO])) break; if (sp > XB_SPIN_CAP) { atomicAdd(&bar[XB_TMO], 1u); break; } }
    }
    nloc = mine > 0u ? mine : 1u; nx = cnt > 0u ? cnt : 1u;
}
__device__ __forceinline__ void xcd_barrier(const XcdBarrier& b) {
    asm volatile("s_waitcnt vmcnt(0)" ::: "memory");
    __syncthreads();
    if (threadIdx.x == 0) {
        unsigned* bar = b.bar;
        __builtin_amdgcn_s_waitcnt(0);
        unsigned nloc = b.st[0], nx = b.st[1];
        if (nloc == 0u) { xcd_barrier_complete(bar, b.x, nloc, nx); b.st[0] = nloc; b.st[1] = nx; }
        const unsigned old = xb_add(&bar[XB_XSUB(b.x)], 1u);
        const unsigned gen = old / nloc;
        if (old + 1u == (gen + 1u) * nloc) {
            __builtin_amdgcn_fence(__ATOMIC_RELEASE, "agent");
            asm volatile("s_waitcnt vmcnt(0)" ::: "memory");
            const unsigned og = xb_add(&bar[XB_TOP], 1u);
            const unsigned tg = og / nx;
            if (og + 1u == (tg + 1u) * nx) xb_add(&bar[XB_TOPGEN], 1u);
            else XB_SPIN(xb_ld(&bar[XB_TOPGEN]) == tg, bar);
            __builtin_amdgcn_fence(__ATOMIC_ACQUIRE, "agent");
            xb_add(&bar[XB_XGEN(b.x)], 1u);
            asm volatile("s_waitcnt vmcnt(0)" ::: "memory");
        } else {
            XB_SPIN(xb_ld(&bar[XB_XGEN(b.x)]) == gen, bar);
            __builtin_amdgcn_fence(__ATOMIC_ACQUIRE, "agent");
            asm volatile("s_waitcnt vmcnt(0)" ::: "memory");
        }
    }
    __syncthreads();
}

namespace pg8 {
constexpr int BM = 256, BK = 64, HALF = 128, HTB = HALF * BK * 2, STAGE_BYTES = 8 * HTB, NXCD = 8, WGM = 8;
__host__ __device__ __forceinline__ int lds_byte(int r, int c) { const int st = (r >> 4) * 2 + (c >> 5), rr = r & 15, cc = c & 31, ob = rr * 64 + cc * 2; return st * 1024 + (ob ^ (((ob >> 9) & 1) << 5)); }
__host__ __device__ __forceinline__ void stage_rc(int b, int& R, int& C) { const int st = b / 1024, sb = b % 1024, swz = sb ^ (((sb >> 9) & 1) << 5); R = (st >> 1) * 16 + swz / 64; C = (st & 1) * 32 + (swz % 64) / 2; }
__host__ __device__ __forceinline__ int perm32(int rho) { const int n = rho >> 4, i = rho & 15; return 8 * (i >> 2) + 4 * n + (i & 3); }
struct Unit { const char* a; const char* b; int pm, pn, e; };
struct Gemm { int lda, ldb, K; int sa = 0x7f7f7f7f, sb = 0x7f7f7f7f, sb1 = 0; };
typedef int i32x8 __attribute__((ext_vector_type(8)));
typedef int i32x4 __attribute__((ext_vector_type(4)));
__device__ __forceinline__ bool tile_of(int i, int G, int c, int nM, int nN, int& pm, int& pn) {
    const int nwg = nM * nN; const long Lq = (long)i * G + c; if (Lq >= nwg) return false;
    int wgid = (int)Lq; { const int q = nwg / NXCD, r = nwg % NXCD, xcd = wgid % NXCD, off = wgid / NXCD; wgid = (xcd < r ? xcd * (q + 1) : r * (q + 1) + (xcd - r) * q) + off; }
    const int nig = WGM * nN, gid = wgid / nig, fm = gid * WGM, gsz = (nM - fm) < WGM ? (nM - fm) : WGM;
    pm = fm + ((wgid % nig) % gsz); pn = (wgid % nig) / gsz; return true;
}
template <class...> struct epi_void { typedef void type; };
template <class E, class = void> struct EpiHasPre { static constexpr bool value = false; };
template <class E> struct EpiHasPre<E, typename epi_void<decltype(E::HAS_PRE)>::type> { static constexpr bool value = E::HAS_PRE; };
template <class S, class = void> struct SchedHasNt { static constexpr bool value = false; };
template <class S> struct SchedHasNt<S, typename epi_void<decltype(S::HAS_NT)>::type> { static constexpr bool value = S::HAS_NT; };
template <class E, bool H> struct EpiPreOf { struct type {}; };
template <class E> struct EpiPreOf<E, true> { using type = typename E::Pre; };
struct RopeF { float inv[4]; bool rowf; };
__device__ __forceinline__ RopeF rope_freqs(int f0) { RopeF r; r.rowf = f0 < 16;
#pragma unroll
    for (int j = 0; j < 4; ++j) r.inv[j] = __builtin_amdgcn_exp2f(-(float)((f0 + j) & 15) * 0.8304820237218407f) * 0.15915494309189535f;
    return r; }
__device__ __forceinline__ void rope_cs4(const RopeF& rf, int t, f32x4& cs, f32x4& sn) { const float pos = (float)(rf.rowf ? (t >> 6) : (t & 63));
#pragma unroll
    for (int j = 0; j < 4; ++j) { const float x = __builtin_amdgcn_fractf(pos * rf.inv[j]); cs[j] = __builtin_amdgcn_cosf(x); sn[j] = __builtin_amdgcn_sinf(x); } }
__device__ __forceinline__ const char* uni_ptr(const char* p) { const unsigned long long v = (unsigned long long)p; const unsigned lo = __builtin_amdgcn_readfirstlane((unsigned)v), hi = __builtin_amdgcn_readfirstlane((unsigned)(v >> 32)); return (const char*)(((unsigned long long)hi << 32) | lo); }
__device__ __forceinline__ void uni_unit(Unit& u) { u.a = uni_ptr(u.a); u.b = uni_ptr(u.b); u.pm = __builtin_amdgcn_readfirstlane(u.pm); u.pn = __builtin_amdgcn_readfirstlane(u.pn); u.e = __builtin_amdgcn_readfirstlane(u.e); }
template <class Epi, class Sched, int MODE = 0>
__device__ __forceinline__ void gemm_phase(LAS unsigned char* lds, const Gemm g, const Sched& S, const Epi& E) {
    const int tid = threadIdx.x, wid = __builtin_amdgcn_readfirstlane(tid >> 6), lane = tid & 63, wr = wid >> 2, wc = wid & 3, fr = lane & 15, fq = lane >> 4;
    constexpr bool FP8 = MODE == 1, I8 = MODE == 2;
    const int K = g.K, nt = K / BK;
    unsigned voffA[2], voffB[2];
#pragma unroll
    for (int i = 0; i < 2; ++i) { int R, C; stage_rc(tid * 16 + i * 8192, R, C); const int Rb = Epi::PERM ? ((R & ~31) + perm32(R & 31)) : R;
        voffA[i] = (unsigned)(R * g.lda + C) * 2u; voffB[i] = (unsigned)(Rb * g.ldb + C) * 2u; }
    const size_t kstep = (size_t)(BK * 2);
    const size_t hstepA = (size_t)HALF * g.lda * 2, hstepB = (size_t)HALF * g.ldb * 2;
    const unsigned ldsw = (unsigned)wid * 1024u;
    const int aoff = lds_byte(wr * 64 + fr, fq * 8), boff = lds_byte(wc * 32 + fr, fq * 8);
#define PG8_SA(b, h) (((b) * 2 + (h)) * HTB)
#define PG8_SB(b, h) ((4 + (b) * 2 + (h)) * HTB)
#define PG8_STAGE(bufoff, gbase, voff) do { const char* _gb = (const char*)(gbase); asm volatile("" : "+s"(_gb));     \
        _Pragma("unroll") for (int _i = 0; _i < 2; ++_i) \
        __builtin_amdgcn_global_load_lds((const unsigned*)(_gb + (voff)[_i]), (LAS unsigned*)(lds + (bufoff) + ldsw + _i * 8192), 16, 0, 0); } while (0)
#define PG8_CAT(x0, x1) __builtin_shufflevector(x0, x1, 0, 1, 2, 3, 4, 5, 6, 7)
#define PG8_LDA(dst, b, h) do { if constexpr (FP8) { _Pragma("unroll") for (int m = 0; m < 4; ++m) dst##8[m] = PG8_CAT(*(const LAS i32x4*)(lds + PG8_SA(b, h) + aoff + m * 2048), *(const LAS i32x4*)(lds + PG8_SA(b, h) + aoff + m * 2048 + 1024)); } \
        else { _Pragma("unroll") for (int m = 0; m < 4; ++m) _Pragma("unroll") for (int k = 0; k < 2; ++k) dst[m][k] = *(const LAS bf16x8*)(lds + PG8_SA(b, h) + aoff + m * 2048 + k * 1024); } } while (0)
#define PG8_LDB(dst, b, h) do { if constexpr (FP8) { _Pragma("unroll") for (int n = 0; n < 2; ++n) dst##8[n] = PG8_CAT(*(const LAS i32x4*)(lds + PG8_SB(b, h) + boff + n * 2048), *(const LAS i32x4*)(lds + PG8_SB(b, h) + boff + n * 2048 + 1024)); } \
        else { _Pragma("unroll") for (int n = 0; n < 2; ++n) _Pragma("unroll") for (int k = 0; k < 2; ++k) dst[n][k] = *(const LAS bf16x8*)(lds + PG8_SB(b, h) + boff + n * 2048 + k * 1024); } } while (0)
#define PG8_MMA(ai, bj, At, Bt) do { __builtin_amdgcn_s_setprio(1); \
        if constexpr (FP8) { _Pragma("unroll") for (int m = 0; m < 4; ++m) _Pragma("unroll") for (int n = 0; n < 2; ++n) \
            asm volatile("v_mfma_scale_f32_16x16x128_f8f6f4 %0, %1, %2, %0, %3, %4 op_sel_hi:[0,0,0]" : "+v"(acc[ai][bj][m][n]) : "v"(Bt##8[n]), "v"(At##8[m]), "v"(sbv[bj]), "v"(g.sa));   } \
        else if constexpr (I8) { _Pragma("unroll") for (int m = 0; m < 4; ++m) _Pragma("unroll") for (int n = 0; n < 2; ++n) _Pragma("unroll") for (int k = 0; k < 2; ++k) \
            acc[ai][bj][m][n] = __builtin_bit_cast(f32x4, __builtin_amdgcn_mfma_i32_16x16x64_i8(__builtin_bit_cast(i32x4, Bt[n][k]), __builtin_bit_cast(i32x4, At[m][k]), __builtin_bit_cast(i32x4, acc[ai][bj][m][n]), 0, 0, 0)); } \
        else { _Pragma("unroll") for (int m = 0; m < 4; ++m) _Pragma("unroll") for (int n = 0; n < 2; ++n) _Pragma("unroll") for (int k = 0; k < 2; ++k) \
            acc[ai][bj][m][n] = __builtin_amdgcn_mfma_f32_16x16x32_bf16(Bt[n][k], At[m][k], acc[ai][bj][m][n], 0, 0, 0); } \
        __builtin_amdgcn_s_setprio(0); } while (0)
#define PG8_WAIT_V(n) asm volatile("s_waitcnt vmcnt(" #n ")" ::: "memory")
#define PG8_WAIT_L(n) asm volatile("s_waitcnt lgkmcnt(" #n ")" ::: "memory")
#define PG8_BAR __builtin_amdgcn_s_barrier()
#define PG8_SCHED __builtin_amdgcn_sched_barrier(0)
    const int sbv[2] = {g.sb, g.sb1 ? g.sb1 : g.sb};
    constexpr bool HASP = EpiHasPre<Epi>::value; typename EpiPreOf<Epi, HASP>::type pre;
    Unit cur, nxt; int ui = 0;
    if (!S.next(0, cur)) return;
    uni_unit(cur);
    constexpr bool HASNT = SchedHasNt<Sched>::value; int ntc = nt; if constexpr (HASNT) ntc = S.nt_of(cur);
    f32x4 acc[2][2][4][2];
#pragma unroll
    for (int a = 0; a < 2; ++a)
#pragma unroll
        for (int b = 0; b < 2; ++b)
#pragma unroll
            for (int m = 0; m < 4; ++m)
#pragma unroll
                for (int n = 0; n < 2; ++n) acc[a][b][m][n] = (f32x4){0.f, 0.f, 0.f, 0.f};
    bf16x8 At[4][2], B0[2][2], B1[2][2]; i32x8 At8[4], B08[2], B18[2];
    const char* cA = cur.a; const char* cB = cur.b;
    PG8_STAGE(PG8_SB(0, 0), cB, voffB); PG8_STAGE(PG8_SA(0, 0), cA, voffA); PG8_STAGE(PG8_SB(0, 1), cB + hstepB, voffB); PG8_STAGE(PG8_SA(0, 1), cA + hstepA, voffA);
    if (wr == 1) PG8_BAR;
    PG8_WAIT_V(4); PG8_BAR;
    PG8_STAGE(PG8_SB(1, 0), cB + kstep, voffB); PG8_STAGE(PG8_SA(1, 0), cA + kstep, voffA); PG8_STAGE(PG8_SB(1, 1), cB + hstepB + kstep, voffB);
    PG8_WAIT_V(6); PG8_BAR;
    for (;;) {
        const bool has_next = S.next(ui + 1, nxt); if (has_next) uni_unit(nxt);
        const char* nA = has_next ? nxt.a : cA; const char* nB = has_next ? nxt.b : cB;
#pragma unroll 1
        for (int t = 0; t < ntc; t += 2) {
            const bool last = (t == ntc - 2);
            if constexpr (HASP) { if (last) E.prefetch(cur, wr, wc, fr, fq, pre); }
            const char* a1 = cA + (size_t)(t + 1) * kstep;
            const char* a2 = last ? nA : cA + (size_t)(t + 2) * kstep; const char* b2 = last ? nB : cB + (size_t)(t + 2) * kstep;
            const char* a3 = a2 + kstep; const char* b3 = b2 + kstep;
            PG8_LDB(B0, 0, 0); PG8_SCHED; PG8_LDA(At, 0, 0); PG8_STAGE(PG8_SA(1, 1), a1 + hstepA, voffA);
            PG8_WAIT_L(8); PG8_BAR; PG8_WAIT_L(0); PG8_MMA(0, 0, At, B0); PG8_BAR; PG8_SCHED;
            PG8_LDB(B1, 0, 1); PG8_STAGE(PG8_SB(0, 0), b2, voffB);
            PG8_BAR; PG8_WAIT_L(0); PG8_MMA(0, 1, At, B1); PG8_BAR;
            PG8_LDA(At, 0, 1); PG8_STAGE(PG8_SA(0, 0), a2, voffA);
            PG8_BAR; PG8_WAIT_L(0); PG8_MMA(1, 0, At, B0); PG8_BAR; PG8_SCHED;
            PG8_STAGE(PG8_SB(0, 1), b2 + hstepB, voffB);
            PG8_WAIT_V(6); PG8_BAR; PG8_MMA(1, 1, At, B1); PG8_BAR;
            PG8_LDB(B0, 1, 0); PG8_SCHED; PG8_LDA(At, 1, 0); PG8_STAGE(PG8_SA(0, 1), a2 + hstepA, voffA);
            PG8_WAIT_L(8); PG8_BAR; PG8_WAIT_L(0); PG8_MMA(0, 0, At, B0); PG8_BAR; PG8_SCHED;
            PG8_LDB(B1, 1, 1); PG8_STAGE(PG8_SB(1, 0), b3, voffB);
            PG8_BAR; PG8_WAIT_L(0); PG8_MMA(0, 1, At, B1); PG8_BAR;
            PG8_LDA(At, 1, 1); PG8_STAGE(PG8_SA(1, 0), a3, voffA);
            PG8_BAR; PG8_WAIT_L(0); PG8_MMA(1, 0, At, B0); PG8_BAR; PG8_SCHED;
            PG8_STAGE(PG8_SB(1, 1), b3 + hstepB, voffB);
            PG8_WAIT_V(6); PG8_BAR; PG8_MMA(1, 1, At, B1); PG8_BAR;
        }
        if constexpr (FP8) asm volatile("s_nop 15\n\ts_nop 7" ::: "memory");
        if constexpr (HASP) E(acc, cur, wr, wc, fr, fq, pre); else E(acc, cur, wr, wc, fr, fq);
        if (!has_next) break;
#pragma unroll
        for (int a = 0; a < 2; ++a)
#pragma unroll
            for (int b = 0; b < 2; ++b)
#pragma unroll
                for (int m = 0; m < 4; ++m)
#pragma unroll
                    for (int n = 0; n < 2; ++n) acc[a][b][m][n] = (f32x4){0.f, 0.f, 0.f, 0.f};
        cur = nxt; cA = nA; cB = nB; ++ui; if constexpr (HASNT) ntc = S.nt_of(cur);
    }
    PG8_WAIT_V(0);
    if (wr == 0) PG8_BAR;
    PG8_BAR;
#undef PG8_SA
#undef PG8_SB
#undef PG8_STAGE
#undef PG8_LDA
#undef PG8_LDB
#undef PG8_MMA
#undef PG8_CAT
#undef PG8_WAIT_V
#undef PG8_WAIT_L
#undef PG8_BAR
#undef PG8_SCHED
}

struct SchedPlain {
    const char* A; const char* Bt; size_t at, bt; int nM, nN, G, c; bool latM;
    __device__ __forceinline__ void init(const void* A_, int lda, const void* Bt_, int ldb, int nM_, int nN_, bool latM_) {
        A = (const char*)A_; Bt = (const char*)Bt_; at = (size_t)256 * lda * 2; bt = (size_t)256 * ldb * 2; nM = nM_; nN = nN_; G = gridDim.x; c = blockIdx.x; latM = latM_; }
    __device__ __forceinline__ bool next(int i, Unit& u) const {
        int pm, pn; if (!tile_of(i, G, c, nM, nN, pm, pn)) return false;
        if (latM) pm = (pm >> 3) * 9 + 1 + (pm & 7);
        u.pm = pm; u.pn = pn; u.e = 0; u.a = A + (size_t)pm * at; u.b = Bt + (size_t)pn * bt; return true; }
};
struct SchedTailK2 {
    const char* A; const char* Bt; size_t at, bt, khb; int G, c;
    __device__ __forceinline__ bool next(int i, Unit& u) const {
        const int L_ = i * G + c; if (L_ >= 256) return false; const int pm = 256 + (L_ >> 3), pn = (L_ >> 1) & 3, kh = L_ & 1;
        u.pm = pm; u.pn = pn; u.e = kh; u.a = A + (size_t)pm * at + (size_t)kh * khb; u.b = Bt + (size_t)pn * bt + (size_t)kh * khb; return true; }
};
struct SchedTailParts {
    static constexpr bool HAS_NT = true;
    const char* A; const char* Bt; size_t at, bt; int pm0, nTail, nN, NP, t0, t1, G, c;
    __device__ __forceinline__ bool next(int i, Unit& u) const {
        const int L_ = i * G + c; if (L_ >= nTail * nN * NP) return false; const int part = L_ % NP, rest = L_ / NP, pn = rest % nN, pm = pm0 + rest / nN; const size_t ko = (size_t)part * t0 * 128;
        u.pm = pm; u.pn = pn; u.e = part; u.a = A + (size_t)pm * at + ko; u.b = Bt + (size_t)pn * bt + ko; return true; }
    __device__ __forceinline__ int nt_of(const Unit& u) const { return u.e == NP - 1 ? t1 : t0; }
};
struct SchedQKV1 {
    const char* A; const char* Bt; int G, c; int rowb = D * 2;
    __device__ __forceinline__ bool next(int i, Unit& u) const {
        const int L_ = i * G + c; constexpr int NLAT = NB * 8 * 9, NCTX = NB * 6; int pm, pn;
        if (L_ < NLAT) { if (!tile_of(i, G, c, NB * 8, 9, pm, pn)) return false; pm = (pm >> 3) * 9 + 1 + (pm & 7); }
        else { const int v = L_ - NLAT; if (v >= NCTX) return false; pm = (v / 6) * 9; pn = 3 + v % 6; }
        u.pm = pm; u.pn = pn; u.e = 0; u.a = A + (size_t)pm * 256 * rowb; u.b = Bt + (size_t)pn * 256 * rowb; return true; }
};
struct SchedF1 {
    const char* A; const char* H; int nN, G, c; int rowb = D * 2;
    __device__ __forceinline__ bool next(int i, Unit& u) const {
        int pm, pn; if (!tile_of(i, G, c, 2, nN, pm, pn)) return false;
        u.pm = pm; u.pn = pn; u.e = 0; u.a = A + (size_t)pm * 256 * rowb; u.b = H + (size_t)((pn >> 3) * 9 + 1 + (pn & 7)) * 256 * rowb; return true; }
};
struct SchedF2 {
    const char* Dft; const char* GT; int G, c;
    __device__ __forceinline__ bool next(int i, Unit& u) const {
        const int L_ = i * G + c; if (L_ >= NB * 8) return false; const int b = L_ >> 3, kt = L_ & 7;
        u.pm = b * 9 + 1 + kt; u.pn = 0; u.e = 0; u.a = Dft + (size_t)kt * 256 * 4096 * 2; u.b = GT + (size_t)b * 256 * 4096 * 2; return true; }
};
struct SchedMoe {
    const char* A; const char* W; size_t at, bt, estride; int t0, nT, nN, G, c; int toff[NE + 1];
    __device__ __forceinline__ bool next(int i, Unit& u) const {
        int pm, pn; if (!tile_of(i, G, c, nT, nN, pm, pn)) return false; pm += t0;
        int e = 0;
#pragma unroll
        for (int j = 1; j < NE; ++j) e += (pm >= toff[j]) ? 1 : 0;
        u.pm = pm; u.pn = pn; u.e = e; u.a = A + (size_t)pm * at; u.b = W + (size_t)e * estride + (size_t)pn * bt; return true; }
};

struct SchedMoeTail {
    static constexpr bool HAS_NT = true;
    const char* A; const char* W; size_t at, bt, estride; int pm0, nTail, nN, t0, t1, G, c; int toff[NE + 1];
    __device__ __forceinline__ bool next(int i, Unit& u) const {
        const int L_ = i * G + c; if (L_ >= nTail * nN * 4) return false; const int part = L_ & 3, rest = L_ >> 2, pn = rest % nN, pm = pm0 + rest / nN; const size_t ko = (size_t)part * t0 * 128;
        int e = 0;
#pragma unroll
        for (int j = 1; j < NE; ++j) e += (pm >= toff[j]) ? 1 : 0;
        u.pm = pm; u.pn = pn; u.e = part; u.a = A + (size_t)pm * at + ko; u.b = W + (size_t)e * estride + (size_t)pn * bt + ko; return true; }
    __device__ __forceinline__ int nt_of(const Unit& u) const { return u.e == 3 ? t1 : t0; }
};

#define EPI_LOOP_ROWS for (int ai = 0; ai < 2; ++ai) _Pragma("unroll") for (int m = 0; m < 4; ++m)
__device__ __forceinline__ u32x4 pack8(const f32x4 a, const f32x4 b) { u32x4 w; w.x = cvt_pk_bf16(a[0], a[1]); w.y = cvt_pk_bf16(a[2], a[3]); w.z = cvt_pk_bf16(b[0], b[1]); w.w = cvt_pk_bf16(b[2], b[3]); return w; }
struct EpiPlain {
    static constexpr bool PERM = true; bf16_t* O; int ldo;
    __device__ __forceinline__ void operator()(const f32x4 (&acc)[2][2][4][2], const Unit& u, int wr, int wc, int fr, int fq) const {
        const int row0 = u.pm * BM + wr * 64 + fr, col0 = u.pn * BM + wc * 32 + 8 * fq;
#pragma unroll
        EPI_LOOP_ROWS { bf16_t* rowp = O + (size_t)(row0 + ai * HALF + m * 16) * ldo + col0;
#pragma unroll
            for (int bj = 0; bj < 2; ++bj) *(u32x4*)(rowp + bj * HALF) = pack8(acc[ai][bj][m][0], acc[ai][bj][m][1]); }
    }
};
struct EpiPlainK2 {
    static constexpr bool PERM = true; bf16_t* O0; bf16_t* O1; int ldo;
    __device__ __forceinline__ void operator()(const f32x4 (&acc)[2][2][4][2], const Unit& u, int wr, int wc, int fr, int fq) const {
        const int row0 = u.pm * BM + wr * 64 + fr, col0 = u.pn * BM + wc * 32 + 8 * fq; bf16_t* base = u.e ? O1 - (size_t)65536 * ldo : O0;
#pragma unroll
        EPI_LOOP_ROWS { bf16_t* rowp = base + (size_t)(row0 + ai * HALF + m * 16) * ldo + col0;
#pragma unroll
            for (int bj = 0; bj < 2; ++bj) *(u32x4*)(rowp + bj * HALF) = pack8(acc[ai][bj][m][0], acc[ai][bj][m][1]); }
    }
};
struct EpiPlainParts {
    static constexpr bool PERM = true; bf16_t* O0; bf16_t* X; int ldo, row0x, xrows;
    __device__ __forceinline__ void operator()(const f32x4 (&acc)[2][2][4][2], const Unit& u, int wr, int wc, int fr, int fq) const {
        const int row0 = u.pm * BM + wr * 64 + fr, col0 = u.pn * BM + wc * 32 + 8 * fq; bf16_t* base = u.e ? X + ((size_t)(u.e - 1) * xrows - row0x) * ldo : O0;
#pragma unroll
        EPI_LOOP_ROWS { bf16_t* rowp = base + (size_t)(row0 + ai * HALF + m * 16) * ldo + col0;
#pragma unroll
            for (int bj = 0; bj < 2; ++bj) *(u32x4*)(rowp + bj * HALF) = pack8(acc[ai][bj][m][0], acc[ai][bj][m][1]); }
    }
};
__device__ __forceinline__ f32x2 swiglu2(f32x2 g, f32x2 up) {
    const f32x2 t = g * (-1.4426950408889634f); f32x2 e; e.x = __builtin_amdgcn_exp2f(t.x); e.y = __builtin_amdgcn_exp2f(t.y);
    const f32x2 d = e + 1.0f; f32x2 r; r.x = __builtin_amdgcn_rcpf(d.x); r.y = __builtin_amdgcn_rcpf(d.y);
    return (g * r) * up; }
__device__ __forceinline__ f32x2 swiglu2f(f32x2 gs, f32x2 ups) {
    f32x2 e; e.x = __builtin_amdgcn_exp2f(-gs.x); e.y = __builtin_amdgcn_exp2f(-gs.y);
    const f32x2 d = e + 1.0f; f32x2 r; r.x = __builtin_amdgcn_rcpf(d.x); r.y = __builtin_amdgcn_rcpf(d.y);
    return (gs * r) * ups; }
struct EpiSwiglu {
    static constexpr bool PERM = true; bf16_t* O; int ldo; int skip = 0;
    __device__ __forceinline__ void operator()(const f32x4 (&acc)[2][2][4][2], const Unit& u, int wr, int wc, int fr, int fq) const {
        if (skip) {
#pragma unroll
            for (int ai = 0; ai < 2; ++ai)
#pragma unroll
                for (int bj = 0; bj < 2; ++bj)
#pragma unroll
                    for (int m = 0; m < 4; ++m) { asm volatile("" :: "v"(acc[ai][bj][m][0]), "v"(acc[ai][bj][m][1])); }
            return; }
        const int row0 = u.pm * BM + wr * 64 + fr, col0 = u.pn * 128 + 8 * (4 * wc + fq);
#pragma unroll
        EPI_LOOP_ROWS { bf16_t* rowp = O + (size_t)(row0 + ai * HALF + m * 16) * ldo + col0; u32x4 w;
#pragma unroll
            for (int n = 0; n < 2; ++n) { const f32x4 g = acc[ai][0][m][n], up = acc[ai][1][m][n];
                const f32x2 a0 = swiglu2((f32x2){g[0], g[1]}, (f32x2){up[0], up[1]}), a1 = swiglu2((f32x2){g[2], g[3]}, (f32x2){up[2], up[3]});
                w[2 * n] = cvt_pk_bf16(a0.x, a0.y); w[2 * n + 1] = cvt_pk_bf16(a1.x, a1.y); }
            *(u32x4*)rowp = w; }
    }
};
__device__ __forceinline__ unsigned pack4_fp8(float a, float b, float c, float d) {
    a = __builtin_amdgcn_fmed3f(a, -448.f, 448.f); b = __builtin_amdgcn_fmed3f(b, -448.f, 448.f); c = __builtin_amdgcn_fmed3f(c, -448.f, 448.f); d = __builtin_amdgcn_fmed3f(d, -448.f, 448.f);
    int p = __builtin_amdgcn_cvt_pk_fp8_f32(a, b, 0, false); p = __builtin_amdgcn_cvt_pk_fp8_f32(c, d, p, true); return (unsigned)p; }
struct EpiSwiglu8 {
    static constexpr bool PERM = true; unsigned char* O; int ldo; float oscale; int skip = 0;
    __device__ __forceinline__ void operator()(const f32x4 (&acc)[2][2][4][2], const Unit& u, int wr, int wc, int fr, int fq) const {
        if (skip) {
#pragma unroll
            for (int ai = 0; ai < 2; ++ai)
#pragma unroll
                for (int bj = 0; bj < 2; ++bj)
#pragma unroll
                    for (int m = 0; m < 4; ++m) { asm volatile("" :: "v"(acc[ai][bj][m][0]), "v"(acc[ai][bj][m][1])); }
            return; }
        const int row0 = u.pm * BM + wr * 64 + fr, col0 = u.pn * 128 + 8 * (4 * wc + fq);
#pragma unroll
        EPI_LOOP_ROWS { unsigned char* rowp = O + (size_t)(row0 + ai * HALF + m * 16) * ldo + col0; u32x2 w;
#pragma unroll
            for (int n = 0; n < 2; ++n) { const f32x4 g = acc[ai][0][m][n], up = acc[ai][1][m][n];
                const f32x2 a0 = swiglu2f((f32x2){g[0], g[1]}, (f32x2){up[0], up[1]}), a1 = swiglu2f((f32x2){g[2], g[3]}, (f32x2){up[2], up[3]});
                w[n] = pack4_fp8(a0.x, a0.y, a1.x, a1.y); }
            *(u32x2*)rowp = w; }
    }
};
__device__ __forceinline__ f32x4 cvt_i4(const f32x4 a, const float sr, const f32x4 sw) { const i32x4 i = __builtin_bit_cast(i32x4, a); return (f32x4){(float)i[0] * sr * sw[0], (float)i[1] * sr * sw[1], (float)i[2] * sr * sw[2], (float)i[3] * sr * sw[3]}; }
struct PreSc { f32x4 w[2][2]; float sr[2][4]; };
struct EpiPlainI8 {
    static constexpr bool PERM = true, HAS_PRE = true; typedef PreSc Pre; bf16_t* O; int ldo; const float* sa; const float* sw;
    __device__ __forceinline__ void prefetch(const Unit& u, int wr, int wc, int fr, int fq, Pre& p) const {
        const int row0 = u.pm * BM + wr * 64 + fr, col0 = u.pn * BM + wc * 32 + 8 * fq;
#pragma unroll
        for (int bj = 0; bj < 2; ++bj)
#pragma unroll
            for (int n = 0; n < 2; ++n) p.w[bj][n] = *(const f32x4*)(sw + col0 + bj * HALF + 4 * n);
#pragma unroll
        for (int ai = 0; ai < 2; ++ai)
#pragma unroll
            for (int m = 0; m < 4; ++m) p.sr[ai][m] = sa[row0 + ai * HALF + m * 16]; }
    __device__ __forceinline__ void operator()(const f32x4 (&acc)[2][2][4][2], const Unit& u, int wr, int wc, int fr, int fq, const Pre& p) const {
        const int row0 = u.pm * BM + wr * 64 + fr, col0 = u.pn * BM + wc * 32 + 8 * fq;
#pragma unroll
        EPI_LOOP_ROWS { const int row = row0 + ai * HALF + m * 16; const float sr = p.sr[ai][m]; bf16_t* rowp = O + (size_t)row * ldo + col0;
#pragma unroll
            for (int bj = 0; bj < 2; ++bj) *(u32x4*)(rowp + bj * HALF) = pack8(cvt_i4(acc[ai][bj][m][0], sr, p.w[bj][0]), cvt_i4(acc[ai][bj][m][1], sr, p.w[bj][1])); }
    }
};
struct EpiQKV1I8 {
    static constexpr bool PERM = true, HAS_PRE = true; typedef PreSc Pre; bf16_t* O; size_t tstride; const float* sa; const float* sw;
    __device__ __forceinline__ void prefetch(const Unit& u, int wr, int wc, int fr, int fq, Pre& p) const {
        const int row0 = u.pm * BM + wr * 64 + fr, pc0 = u.pn * BM + wc * 32 + 8 * fq;
#pragma unroll
        for (int bj = 0; bj < 2; ++bj)
#pragma unroll
            for (int n = 0; n < 2; ++n) p.w[bj][n] = *(const f32x4*)(sw + pc0 + bj * HALF + 4 * n);
#pragma unroll
        for (int ai = 0; ai < 2; ++ai)
#pragma unroll
            for (int m = 0; m < 4; ++m) p.sr[ai][m] = sa[row0 + ai * HALF + m * 16]; }
    __device__ __forceinline__ void operator()(const f32x4 (&acc)[2][2][4][2], const Unit& u, int wr, int wc, int fr, int fq, const Pre& p) const {
        const int which = u.pn / 3; const int row0 = u.pm * BM + wr * 64 + fr, col0 = (u.pn % 3) * BM + wc * 32 + 8 * fq; const int pj = u.pm % 9; const bool rope = (pj != 0) && which < 2;
        const int t0 = (pj - 1) * 256 + wr * 64 + fr; bf16_t* base = O + (size_t)which * tstride; const RopeF rf = rope_freqs(((col0 & 63) >> 3) * 4);
#pragma unroll
        EPI_LOOP_ROWS { const int row = row0 + ai * HALF + m * 16; const int t = t0 + ai * HALF + m * 16; const float sr = p.sr[ai][m]; bf16_t* rowp = base + (size_t)row * 768 + col0;
            f32x4 cs, sn; if (rope) rope_cs4(rf, t, cs, sn);
#pragma unroll
            for (int bj = 0; bj < 2; ++bj) { f32x4 v0 = cvt_i4(acc[ai][bj][m][0], sr, p.w[bj][0]), v1 = cvt_i4(acc[ai][bj][m][1], sr, p.w[bj][1]);
                if (rope) { const f32x4 o1 = v0 * cs - v1 * sn, o2 = v0 * sn + v1 * cs; v0 = o1; v1 = o2; }
                *(u32x4*)(rowp + bj * HALF) = pack8(v0, v1); } }
    }
};
struct EpiGTI8 {
    static constexpr bool PERM = true, HAS_PRE = true; typedef PreSc Pre; bf16_t* O; const float* swf; const float* sa;
    __device__ __forceinline__ void prefetch(const Unit& u, int wr, int wc, int fr, int fq, Pre& p) const {
        const int b = u.pn >> 3, tt = u.pn & 7, part = u.pm; const int c0 = wr * 64 + fr, t0 = tt * 256 + wc * 32 + 8 * fq; const float* sap = sa + (size_t)b * S + L + t0;
#pragma unroll
        for (int bj = 0; bj < 2; ++bj)
#pragma unroll
            for (int n = 0; n < 2; ++n) p.w[bj][n] = *(const f32x4*)(sap + bj * HALF + 4 * n);
#pragma unroll
        for (int ai = 0; ai < 2; ++ai)
#pragma unroll
            for (int m = 0; m < 4; ++m) p.sr[ai][m] = swf[part * 256 + c0 + ai * HALF + m * 16]; }
    __device__ __forceinline__ void operator()(const f32x4 (&acc)[2][2][4][2], const Unit& u, int wr, int wc, int fr, int fq, const Pre& p) const {
        const int b = u.pn >> 3, tt = u.pn & 7, part = u.pm; const int c0 = wr * 64 + fr, t0 = tt * 256 + wc * 32 + 8 * fq;
#pragma unroll
        EPI_LOOP_ROWS { const int c = c0 + ai * HALF + m * 16; const float sr = p.sr[ai][m]; bf16_t* rowp = O + ((size_t)(b * 256 + c) * 2 + part) * 2048 + t0;
#pragma unroll
            for (int bj = 0; bj < 2; ++bj) *(u32x4*)(rowp + bj * HALF) = pack8(cvt_i4(acc[ai][bj][m][0], sr, p.w[bj][0]), cvt_i4(acc[ai][bj][m][1], sr, p.w[bj][1])); }
    }
};
struct PreSw { f32x4 wg[2], wu[2]; float sr[2][4]; };
struct EpiSwigluI8 {
    static constexpr bool PERM = true, HAS_PRE = true; typedef PreSw Pre; void* O; int ldo; const float* sa; const float* sw; int sw_estride; float oscale; bool out8;
    __device__ __forceinline__ void prefetch(const Unit& u, int wr, int wc, int fr, int fq, Pre& p) const {
        const int row0 = u.pm * BM + wr * 64 + fr; const float* swp = sw + (size_t)u.e * sw_estride + u.pn * BM + wc * 32 + 8 * fq;
#pragma unroll
        for (int n = 0; n < 2; ++n) { p.wg[n] = *(const f32x4*)(swp + 4 * n); p.wu[n] = *(const f32x4*)(swp + HALF + 4 * n); }
#pragma unroll
        for (int ai = 0; ai < 2; ++ai)
#pragma unroll
            for (int m = 0; m < 4; ++m) p.sr[ai][m] = sa[row0 + ai * HALF + m * 16]; }
    __device__ __forceinline__ void operator()(const f32x4 (&acc)[2][2][4][2], const Unit& u, int wr, int wc, int fr, int fq, const Pre& p) const {
        const int row0 = u.pm * BM + wr * 64 + fr, col0 = u.pn * 128 + 8 * (4 * wc + fq);
#pragma unroll
        EPI_LOOP_ROWS { const int row = row0 + ai * HALF + m * 16; const float sr = p.sr[ai][m]; unsigned pk[4];
#pragma unroll
            for (int n = 0; n < 2; ++n) { const f32x4 g = cvt_i4(acc[ai][0][m][n], sr, p.wg[n]), up = cvt_i4(acc[ai][1][m][n], sr, p.wu[n]);
                const f32x2 a0 = swiglu2f((f32x2){g[0], g[1]}, (f32x2){up[0], up[1]}), a1 = swiglu2f((f32x2){g[2], g[3]}, (f32x2){up[2], up[3]});
                if (out8) { pk[n] = pack4_fp8(a0.x, a0.y, a1.x, a1.y); } else { pk[2 * n] = cvt_pk_bf16(a0.x, a0.y); pk[2 * n + 1] = cvt_pk_bf16(a1.x, a1.y); } }
            if (out8) *(u32x2*)((unsigned char*)O + (size_t)row * ldo + col0) = (u32x2){pk[0], pk[1]}; else *(u32x4*)((bf16_t*)O + (size_t)row * ldo + col0) = (u32x4){pk[0], pk[1], pk[2], pk[3]}; }
    }
};
constexpr float QSC_MLA = 0.07216878364870322f * 1.4426950408889634f, QSC_DIFF = 0.125f * 1.4426950408889634f;
struct EpiQ0 {
    static constexpr bool PERM = true; bf16_t* O; const float* rc; const float* rs;
    __device__ __forceinline__ void operator()(const f32x4 (&acc)[2][2][4][2], const Unit& u, int wr, int wc, int fr, int fq) const {
        const int row0 = u.pm * BM + wr * 64 + fr, col0 = u.pn * BM + wc * 32 + 8 * fq; const int pj = u.pm % 9; const bool lat = pj != 0; const int t0 = (pj - 1) * 256 + wr * 64 + fr;
#pragma unroll
        EPI_LOOP_ROWS { const int row = row0 + ai * HALF + m * 16; const int t = t0 + ai * HALF + m * 16; bf16_t* rowp = O + (size_t)row * 768 + col0;
#pragma unroll
            for (int bj = 0; bj < 2; ++bj) { const int cb = col0 + bj * HALF, within = cb % MLA_QK; f32x4 v0 = acc[ai][bj][m][0], v1 = acc[ai][bj][m][1];
                if (lat && within >= MLA_NOPE) { const RopeF rf = rope_freqs(((within - MLA_NOPE) >> 3) * 4); f32x4 cs, sn; rope_cs4(rf, t, cs, sn);
                    const f32x4 o1 = v0 * cs - v1 * sn, o2 = v0 * sn + v1 * cs; v0 = o1; v1 = o2; }
                *(u32x4*)(rowp + bj * HALF) = pack8(v0 * QSC_MLA, v1 * QSC_MLA); }
            asm volatile("" ::: "memory"); }
    }
};
struct EpiKV0 {
    static constexpr bool PERM = true; bf16_t* Kn; bf16_t* V;
    __device__ __forceinline__ void operator()(const f32x4 (&acc)[2][2][4][2], const Unit& u, int wr, int wc, int fr, int fq) const {
        const int row0 = u.pm * BM + wr * 64 + fr, col0 = u.pn * 128 + wc * 32 + 8 * fq;
#pragma unroll
        EPI_LOOP_ROWS { const size_t ro = (size_t)(row0 + ai * HALF + m * 16) * 512 + col0;
            *(u32x4*)(Kn + ro) = pack8(acc[ai][0][m][0], acc[ai][0][m][1]); *(u32x4*)(V + ro) = pack8(acc[ai][1][m][0], acc[ai][1][m][1]); }
    }
};
struct EpiQKV1 {
    static constexpr bool PERM = true; bf16_t* O; size_t tstride; const float* rc; const float* rs;
    __device__ __forceinline__ void operator()(const f32x4 (&acc)[2][2][4][2], const Unit& u, int wr, int wc, int fr, int fq) const {
        const int which = u.pn / 3; const int row0 = u.pm * BM + wr * 64 + fr, col0 = (u.pn % 3) * BM + wc * 32 + 8 * fq; const int pj = u.pm % 9; const bool rope = (pj != 0) && which < 2;
        const int t0 = (pj - 1) * 256 + wr * 64 + fr; bf16_t* base = O + (size_t)which * tstride;
#pragma unroll
        EPI_LOOP_ROWS { const int row = row0 + ai * HALF + m * 16; const int t = t0 + ai * HALF + m * 16; bf16_t* rowp = base + (size_t)row * 768 + col0;
#pragma unroll
            for (int bj = 0; bj < 2; ++bj) { const int cb = col0 + bj * HALF; f32x4 v0 = acc[ai][bj][m][0], v1 = acc[ai][bj][m][1];
                if (rope) { const int f0 = ((cb & 63) >> 3) * 4; const f32x4 cs = *(const f32x4*)(rc + t * 32 + f0), sn = *(const f32x4*)(rs + t * 32 + f0);
                    const f32x4 o1 = v0 * cs - v1 * sn, o2 = v0 * sn + v1 * cs; v0 = o1; v1 = o2; }
                *(u32x4*)(rowp + bj * HALF) = pack8(v0, v1); }
            asm volatile("" ::: "memory"); }
    }
};
struct EpiGT {
    static constexpr bool PERM = true; bf16_t* O;
    __device__ __forceinline__ void operator()(const f32x4 (&acc)[2][2][4][2], const Unit& u, int wr, int wc, int fr, int fq) const {
        const int b = u.pn >> 3, tt = u.pn & 7, part = u.pm; const int c0 = wr * 64 + fr, t0 = tt * 256 + wc * 32 + 8 * fq;
#pragma unroll
        EPI_LOOP_ROWS { const int c = c0 + ai * HALF + m * 16; bf16_t* rowp = O + ((size_t)(b * 256 + c) * 2 + part) * 2048 + t0;
#pragma unroll
            for (int bj = 0; bj < 2; ++bj) *(u32x4*)(rowp + bj * HALF) = pack8(acc[ai][bj][m][0], acc[ai][bj][m][1]); }
    }
};
}
namespace att {
constexpr int NW = 8, QBLK = 32, KVBLK = 64, DV = 128;
constexpr float THR = 8.f;
constexpr size_t SHM_V = KVBLK * DV * 2;
template <int DQK> struct Cf {
    static constexpr int ND = DQK / 16, KC = DQK / 64, CPR = DQK / 8;
    static constexpr size_t SHM_K = (size_t)KVBLK * DQK * 2;
    static constexpr float SCALE = DQK == 192 ? 0.07216878364870322f : 0.125f;
    static constexpr size_t LDS_BYTES = 2 * SHM_V + 2 * SHM_K + NW * 64 * 4;
};
#define SBAR() __builtin_amdgcn_sched_barrier(0)
__device__ __forceinline__ int crow(int r, int hi) { return (r & 3) + 8 * (r >> 2) + 4 * hi; }
template <int DQK> __device__ __forceinline__ int kswz(int row, int colB) { return row * (DQK * 2) + (colB ^ (((row >> 1) & 7) << 4)); }

constexpr float THR2 = THR * 1.4426950408889634f;
template <int DQK, int VAR = 0, bool FIRST = false>
__device__ __forceinline__ void partialSM(f32x16& p0, f32x16& p1, f32x16& mC, float& alpha) {
    if constexpr (VAR == 3 || VAR == 7 || VAR == 9) { alpha = 1.f; return; }
    float pmax = p0[0];
#pragma unroll
    for (int r = 1; r < 16; ++r) pmax = fmaxf(pmax, p0[r]);
#pragma unroll
    for (int r = 0; r < 16; ++r) pmax = fmaxf(pmax, p1[r]);
    { auto rr = __builtin_amdgcn_permlane32_swap(__float_as_uint(pmax), __float_as_uint(pmax), false, false);
      pmax = fmaxf(__uint_as_float(rr[0]), __uint_as_float(rr[1])); }
    if (!FIRST && __builtin_expect(__all(pmax <= THR2), 1)) alpha = 1.f;
    else { const float d = FIRST ? pmax : fmaxf(pmax, 0.f); alpha = FIRST ? 1.f : __builtin_amdgcn_exp2f(-d); const float nm = mC[0] - d;
#pragma unroll
        for (int r = 0; r < 16; ++r) { p0[r] -= d; p1[r] -= d; if constexpr (DQK == 64) mC[r] -= d; else mC[r] = nm; } }
#pragma unroll
    for (int r = 0; r < 16; ++r) p0[r] = VAR == 2 ? p0[r] : __builtin_amdgcn_exp2f(p0[r]);
}
template <int VAR = 0>
__device__ __forceinline__ void finishSM(f32x16& p0, f32x16& p1, float alpha, float& l_reg, bf16x8& pa0, bf16x8& pa1, bf16x8& pa2, bf16x8& pa3) {
    float ps = 0;
    if constexpr (VAR != 3 && VAR != 7 && VAR != 9) {
#pragma unroll
    for (int r = 0; r < 16; ++r) p1[r] = VAR == 2 ? p1[r] : __builtin_amdgcn_exp2f(p1[r]);
#pragma unroll
    for (int r = 0; r < 16; ++r) ps += p0[r];
#pragma unroll
    for (int r = 0; r < 16; ++r) ps += p1[r];
    }
    { auto rr = __builtin_amdgcn_permlane32_swap(__float_as_uint(ps), __float_as_uint(ps), false, false);
      ps = __uint_as_float(rr[0]) + __uint_as_float(rr[1]); }
    l_reg = l_reg * alpha + ps;
#define PK4(P, BASE, OUT) do { unsigned a0 = cvt_pk_bf16(P[BASE + 0], P[BASE + 1]), a1 = cvt_pk_bf16(P[BASE + 2], P[BASE + 3]);   \
    unsigned b0 = cvt_pk_bf16(P[BASE + 4], P[BASE + 5]), b1 = cvt_pk_bf16(P[BASE + 6], P[BASE + 7]);                              \
    auto r0 = __builtin_amdgcn_permlane32_swap(a0, b0, false, false); auto r1 = __builtin_amdgcn_permlane32_swap(a1, b1, false, false); \
    u32x4 w = {r0[0], r1[0], r0[1], r1[1]}; OUT = *reinterpret_cast<bf16x8*>(&w); } while (0)
    PK4(p0, 0, pa0); PK4(p0, 8, pa1); PK4(p1, 0, pa2); PK4(p1, 8, pa3);
#undef PK4
}
struct KFrag { bf16x8 b0[4], b1[4]; };
__device__ __forceinline__ void qkt_ld(KFrag& f, const char* Ks, int r32, int hi) {
#pragma unroll
    for (int d0 = 0; d0 < 4; ++d0) { const int cb = (d0 * 16 + hi * 8) * 2; f.b0[d0] = *reinterpret_cast<const bf16x8*>(Ks + kswz<64>(r32, cb)); f.b1[d0] = *reinterpret_cast<const bf16x8*>(Ks + kswz<64>(32 + r32, cb)); }
}
#define PK4H(P, BASE, OUT) do { unsigned a0 = cvt_pk_bf16(P[BASE + 0], P[BASE + 1]), a1 = cvt_pk_bf16(P[BASE + 2], P[BASE + 3]);   \
    unsigned b0 = cvt_pk_bf16(P[BASE + 4], P[BASE + 5]), b1 = cvt_pk_bf16(P[BASE + 6], P[BASE + 7]);                              \
    auto r0 = __builtin_amdgcn_permlane32_swap(a0, b0, false, false); auto r1 = __builtin_amdgcn_permlane32_swap(a1, b1, false, false); \
    u32x4 w = {r0[0], r1[0], r0[1], r1[1]}; OUT = *reinterpret_cast<bf16x8*>(&w); } while (0)
__device__ __forceinline__ f32x16 mfma_c(bf16x8 a, bf16x8 b, const f32x16& c) { f32x16 d; asm volatile("v_mfma_f32_32x32x16_bf16 %0, %1, %2, %3" : "=&v"(d) : "v"(a), "v"(b), "v"(c)); return d; }
__device__ __forceinline__ void qkt_mf(f32x16& p0, f32x16& p1, const KFrag& f, const bf16x8* qr, const f32x16& mC) {
    p0 = mfma_c(f.b0[0], qr[0], mC); p1 = mfma_c(f.b1[0], qr[0], mC);
#pragma unroll
    for (int d0 = 1; d0 < 4; ++d0) { p0 = __builtin_amdgcn_mfma_f32_32x32x16_bf16(f.b0[d0], qr[d0], p0, 0, 0, 0); p1 = __builtin_amdgcn_mfma_f32_32x32x16_bf16(f.b1[d0], qr[d0], p1, 0, 0, 0); }
}
template <int DQK, int NQR, int VAR = 0>
__device__ __forceinline__ void qkt(f32x16& p0, f32x16& p1, const char* Ks, const bf16x8* qr, const char* ql, int r32, int hi, const f32x16& mC) {
    if constexpr (VAR == 5) { p0 = mC; p1 = mC; return; }
#pragma unroll
    for (int d0 = 0; d0 < Cf<DQK>::ND; ++d0) { const int cb = (d0 * 16 + hi * 8) * 2;
        bf16x8 b0, b1;
        if constexpr (VAR == 7 || VAR == 9) { b0 = qr[d0]; b1 = qr[(d0 + 1) % Cf<DQK>::ND]; asm volatile("" : "+v"(b0), "+v"(b1)); }
        else { b0 = *reinterpret_cast<const bf16x8*>(Ks + kswz<DQK>(r32, cb)); b1 = *reinterpret_cast<const bf16x8*>(Ks + kswz<DQK>(32 + r32, cb)); }
        bf16x8 qf; if (d0 < NQR) qf = qr[d0]; else qf = *reinterpret_cast<const bf16x8*>(ql + (d0 - NQR) * 1024);
        if constexpr (VAR == 4) { if (d0 == 0) { p0 = mC; p1 = mC; } p0[d0] += __builtin_bit_cast(float, (int)b0[0] + (int)qf[0]); p1[d0] += __builtin_bit_cast(float, (int)b1[0]); }
        else if (d0 == 0 && DQK == 64) { p0 = mfma_c(b0, qf, mC); p1 = mfma_c(b1, qf, mC); }
        else if (d0 == 0) { p0 = __builtin_amdgcn_mfma_f32_32x32x16_bf16(b0, qf, mC, 0, 0, 0); p1 = __builtin_amdgcn_mfma_f32_32x32x16_bf16(b1, qf, mC, 0, 0, 0); }
        else { p0 = __builtin_amdgcn_mfma_f32_32x32x16_bf16(b0, qf, p0, 0, 0, 0);
        p1 = __builtin_amdgcn_mfma_f32_32x32x16_bf16(b1, qf, p1, 0, 0, 0); } }
}
__device__ __forceinline__ int v_st(int k, int c) { const int kk = (k & ~0xC) | ((k & 4) << 1) | ((k & 8) >> 1); return ((kk >> 3) * 4 + (c >> 5)) * 512 + ((kk & 7) * 32 + (c & 31)) * 2; }
__device__ __forceinline__ int v_rd_base(int lane) { return ((lane & 3) << 3) | (((lane >> 2) & 3) << 6) | (((lane >> 4) & 1) << 5) | (((lane >> 5) & 1) << 8); }
constexpr int v_rd_off(int d0, int ks, int half) { return d0 * 512 + ks * 4096 + half * 2048; }
template <int OFF> __device__ __forceinline__ s16x4 tr_read(int vb) {
    s16x4 r; asm volatile("ds_read_b64_tr_b16 %0, %1 offset:%2" : "=&v"(r) : "v"(vb), "i"(OFF) : "memory"); return r;
}
struct VFrag { s16x4 l0, h0, l1, h1, l2, h2, l3, h3; };
template <int D0> __device__ __forceinline__ void pv_rd(VFrag& f, int vb) {
    f.l0 = tr_read<v_rd_off(D0, 0, 0)>(vb); f.h0 = tr_read<v_rd_off(D0, 0, 1)>(vb); f.l1 = tr_read<v_rd_off(D0, 1, 0)>(vb); f.h1 = tr_read<v_rd_off(D0, 1, 1)>(vb);
    f.l2 = tr_read<v_rd_off(D0, 2, 0)>(vb); f.h2 = tr_read<v_rd_off(D0, 2, 1)>(vb); f.l3 = tr_read<v_rd_off(D0, 3, 0)>(vb); f.h3 = tr_read<v_rd_off(D0, 3, 1)>(vb);
}
template <int VAR = 0>
__device__ __forceinline__ void pv_mf(f32x16& od, const VFrag& f, bf16x8 pa0, bf16x8 pa1, bf16x8 pa2, bf16x8 pa3) {
    if constexpr (VAR == 4) { od[0] += __builtin_bit_cast(float, (int)f.l0[0] + (int)f.h3[0] + (int)pa0[0] + (int)pa3[0]); return; }
#define PK(L_, H_) (bf16x8){L_[0], L_[1], L_[2], L_[3], H_[0], H_[1], H_[2], H_[3]}
    od = __builtin_amdgcn_mfma_f32_32x32x16_bf16(pa0, PK(f.l0, f.h0), od, 0, 0, 0);
    od = __builtin_amdgcn_mfma_f32_32x32x16_bf16(pa1, PK(f.l1, f.h1), od, 0, 0, 0);
    od = __builtin_amdgcn_mfma_f32_32x32x16_bf16(pa2, PK(f.l2, f.h2), od, 0, 0, 0);
    od = __builtin_amdgcn_mfma_f32_32x32x16_bf16(pa3, PK(f.l3, f.h3), od, 0, 0, 0);
#undef PK
}
#ifndef ATT_SG
#define ATT_SG 0
#endif
#ifndef ATT_NOALT
#define ATT_NOALT 1
#endif
__device__ __forceinline__ s16x4 tr_ld(int addr) { return __builtin_amdgcn_ds_read_tr16_b64_v4i16((__attribute__((address_space(3))) s16x4*)(unsigned)addr); }
__device__ __forceinline__ void pv_sg(f32x16* o, int vb, bf16x8 pa0, bf16x8 pa1, bf16x8 pa2, bf16x8 pa3) {
#define PKS(L_, H_) (bf16x8){L_[0], L_[1], L_[2], L_[3], H_[0], H_[1], H_[2], H_[3]}
#pragma unroll
    for (int d0 = 0; d0 < 4; ++d0) {
        const s16x4 l0 = tr_ld(vb + v_rd_off(d0, 0, 0)), h0 = tr_ld(vb + v_rd_off(d0, 0, 1)), l1 = tr_ld(vb + v_rd_off(d0, 1, 0)), h1 = tr_ld(vb + v_rd_off(d0, 1, 1));
        const s16x4 l2 = tr_ld(vb + v_rd_off(d0, 2, 0)), h2 = tr_ld(vb + v_rd_off(d0, 2, 1)), l3 = tr_ld(vb + v_rd_off(d0, 3, 0)), h3 = tr_ld(vb + v_rd_off(d0, 3, 1));
        o[d0] = __builtin_amdgcn_mfma_f32_32x32x16_bf16(pa0, PKS(l0, h0), o[d0], 0, 0, 0);
        o[d0] = __builtin_amdgcn_mfma_f32_32x32x16_bf16(pa1, PKS(l1, h1), o[d0], 0, 0, 0);
        o[d0] = __builtin_amdgcn_mfma_f32_32x32x16_bf16(pa2, PKS(l2, h2), o[d0], 0, 0, 0);
        o[d0] = __builtin_amdgcn_mfma_f32_32x32x16_bf16(pa3, PKS(l3, h3), o[d0], 0, 0, 0); }
#undef PKS
}
#define SG_QK_SM() do { __builtin_amdgcn_sched_group_barrier(0x100, 8, 0); _Pragma("unroll") for (int i_ = 0; i_ < 8; ++i_) { __builtin_amdgcn_sched_group_barrier(0x008, 1, 0); __builtin_amdgcn_sched_group_barrier(0x002, 10, 0); } } while (0)
#define SG_PV_SM() do { __builtin_amdgcn_sched_group_barrier(0x100, 8, 0); _Pragma("unroll") for (int i_ = 0; i_ < 16; ++i_) { __builtin_amdgcn_sched_group_barrier(0x008, 1, 0); __builtin_amdgcn_sched_group_barrier(0x002, 5, 0); if (i_ < 12) __builtin_amdgcn_sched_group_barrier(0x100, 2, 0); } } while (0)
template <int VAR = 0>
__device__ __forceinline__ void pv_d0(f32x16* o, int vb, bf16x8 pa0, bf16x8 pa1, bf16x8 pa2, bf16x8 pa3) {
    if constexpr (VAR == 5) { o[0][0] += __builtin_bit_cast(float, (int)pa0[0] + (int)pa1[0] + (int)pa2[0] + (int)pa3[0]); return; }
    if constexpr (VAR == 7 || VAR == 9) { bf16x8 x = pa0; asm volatile("" : "+v"(x));
#pragma unroll
        for (int d = 0; d < 4; ++d) { o[d] = __builtin_amdgcn_mfma_f32_32x32x16_bf16(pa0, x, o[d], 0, 0, 0); o[d] = __builtin_amdgcn_mfma_f32_32x32x16_bf16(pa1, x, o[d], 0, 0, 0); o[d] = __builtin_amdgcn_mfma_f32_32x32x16_bf16(pa2, x, o[d], 0, 0, 0); o[d] = __builtin_amdgcn_mfma_f32_32x32x16_bf16(pa3, x, o[d], 0, 0, 0); }
        return; }
    VFrag A, B;
    pv_rd<0>(A, vb); pv_rd<1>(B, vb);
    asm volatile("s_waitcnt lgkmcnt(8)" ::: "memory"); SBAR(); pv_mf<VAR>(o[0], A, pa0, pa1, pa2, pa3); SBAR();
    pv_rd<2>(A, vb);
    asm volatile("s_waitcnt lgkmcnt(8)" ::: "memory"); SBAR(); pv_mf<VAR>(o[1], B, pa0, pa1, pa2, pa3); SBAR();
    pv_rd<3>(B, vb);
    asm volatile("s_waitcnt lgkmcnt(8)" ::: "memory"); SBAR(); pv_mf<VAR>(o[2], A, pa0, pa1, pa2, pa3); SBAR();
    asm volatile("s_waitcnt lgkmcnt(0)" ::: "memory"); SBAR(); pv_mf<VAR>(o[3], B, pa0, pa1, pa2, pa3);
}

template <int DQK>
__device__ __forceinline__ void pv_partial(f32x16* o, int vb, bf16x8 pa0, bf16x8 pa1, bf16x8 pa2, bf16x8 pa3, f32x16& p0, f32x16& p1, f32x16& mC, float& alpha, float& ps0) {
    VFrag A, B;
    pv_rd<0>(A, vb); pv_rd<1>(B, vb);
    asm volatile("s_waitcnt lgkmcnt(8)" ::: "memory"); SBAR(); pv_mf<0>(o[0], A, pa0, pa1, pa2, pa3);
    float pmax = p0[0];
#pragma unroll
    for (int r = 1; r < 16; ++r) pmax = fmaxf(pmax, p0[r]);
#pragma unroll
    for (int r = 0; r < 16; ++r) pmax = fmaxf(pmax, p1[r]);
    { auto rr = __builtin_amdgcn_permlane32_swap(__float_as_uint(pmax), __float_as_uint(pmax), false, false);
      pmax = fmaxf(__uint_as_float(rr[0]), __uint_as_float(rr[1])); }
    asm volatile("" : "+v"(pmax));
    SBAR();
    pv_rd<2>(A, vb);
    if (__builtin_expect(__all(pmax <= THR2), 1)) alpha = 1.f;
    else { const float d = fmaxf(pmax, 0.f); alpha = __builtin_amdgcn_exp2f(-d);
#pragma unroll
        for (int r = 0; r < 16; ++r) { p0[r] -= d; p1[r] -= d; mC[r] -= d; } }
#define EXPP(x_) do { float e_ = __builtin_amdgcn_exp2f(x_); asm volatile("" : "+v"(e_)); x_ = e_; } while (0)
    asm volatile("s_waitcnt lgkmcnt(8)" ::: "memory"); SBAR(); pv_mf<0>(o[1], B, pa0, pa1, pa2, pa3);
#pragma unroll
    for (int r = 0; r < 11; ++r) EXPP(p0[r]);
    SBAR();
    pv_rd<3>(B, vb);
    asm volatile("s_waitcnt lgkmcnt(8)" ::: "memory"); SBAR(); pv_mf<0>(o[2], A, pa0, pa1, pa2, pa3);
#pragma unroll
    for (int r = 11; r < 16; ++r) EXPP(p0[r]);
#pragma unroll
    for (int r = 0; r < 6; ++r) EXPP(p1[r]);
    SBAR();
    asm volatile("s_waitcnt lgkmcnt(0)" ::: "memory"); SBAR(); pv_mf<0>(o[3], B, pa0, pa1, pa2, pa3);
#pragma unroll
    for (int r = 6; r < 16; ++r) EXPP(p1[r]);
    float ps = 0.f;
#pragma unroll
    for (int r = 0; r < 16; ++r) ps += p0[r];
    asm volatile("" : "+v"(ps)); ps0 = ps;
    SBAR();
#undef EXPP
}
__device__ __forceinline__ void finishSM2(f32x16& p0, f32x16& p1, float ps0, float alpha, float& l_reg, bf16x8& pa0, bf16x8& pa1, bf16x8& pa2, bf16x8& pa3) {
    float ps = ps0;
#pragma unroll
    for (int r = 0; r < 16; ++r) ps += p1[r];
    { auto rr = __builtin_amdgcn_permlane32_swap(__float_as_uint(ps), __float_as_uint(ps), false, false);
      ps = __uint_as_float(rr[0]) + __uint_as_float(rr[1]); }
    l_reg = l_reg * alpha + ps;
    PK4H(p0, 0, pa0); PK4H(p0, 8, pa1); PK4H(p1, 0, pa2); PK4H(p1, 8, pa3);
}

struct KSrc { const bf16_t* ka; int lda; const bf16_t* kb; int ldb; };
struct AOut {
    bf16_t* O; int ldo; float* stash; const float* subg; float lam; int sub;
};
template <int DQK, int SDEPTH, int MODE, int VAR, bool ALT>
__device__ __forceinline__ void attn_body_impl(const bf16_t* __restrict__ Qb, int ldq, const KSrc ks, const bf16_t* __restrict__ Vh, int ldv, int seq, char* lds, const AOut ao) {
    using C = Cf<DQK>; constexpr int ND = C::ND, KC = C::KC, CPR = C::CPR, CA = DQK == 192 ? 16 : CPR; constexpr size_t SHM_K = C::SHM_K;
    int tid_ = threadIdx.x; asm volatile("" : "+v"(tid_));
    const int tid = tid_, wid = tid >> 6, lane = tid & 63, r32 = lane & 31, hi = lane >> 5;
    char* V_lds = lds; char* K_lds = lds + 2 * SHM_V;
    float* ws = (float*)(lds + 2 * SHM_V + 2 * SHM_K) + wid * 64; float* li_l = ws; float* al_l = ws + 32;
    constexpr int NQR = ND;
    char* ql = lds + 2 * SHM_V + 2 * SHM_K + NW * 64 * 4 + wid * 4096 + lane * 16;
    float l_reg = 0; f32x16 o[4] = {}, mC = {}; bf16x8 qr[NQR];
    const bf16_t* Qw = Qb + (long)(wid * QBLK + r32) * ldq + hi * 8;
#pragma unroll
    for (int d0 = 0; d0 < ND; ++d0) { const bf16x8 qv = *reinterpret_cast<const bf16x8*>(Qw + d0 * 16); if (d0 < NQR) qr[d0] = qv; else *reinterpret_cast<bf16x8*>(ql + (d0 - NQR) * 1024) = qv; }
    const int sr = tid >> 4, sc = (tid & 15) * 8, vst0 = v_st(sr, sc), vst1 = v_st(32 + sr, sc);
    const int vb0 = (int)(uintptr_t)V_lds + v_rd_base(lane);
    const bf16_t* kptr[KC]; int kstride[KC]; int klds[KC];
#pragma unroll
    for (int i = 0; i < KC; ++i) { const int q = tid + 512 * i, row = q / CPR, c8 = q % CPR; klds[i] = kswz<DQK>(row, c8 * 16);
        if (c8 < CA) { kptr[i] = ks.ka + (long)row * ks.lda + c8 * 8; kstride[i] = ks.lda; } else { kptr[i] = ks.kb + (long)row * ks.ldb + (c8 - CA) * 8; kstride[i] = ks.ldb; } }
    struct Slot { bf16x8 vs0, vs1; bf16x8 kk[KC]; } sl[SDEPTH];
#define SLOAD(i_, k0_) do { if constexpr (VAR == 1 || VAR == 9) break; sl[i_].vs0 = *reinterpret_cast<const bf16x8*>(&Vh[(long)((k0_) + sr) * ldv + sc]); sl[i_].vs1 = *reinterpret_cast<const bf16x8*>(&Vh[(long)((k0_) + 32 + sr) * ldv + sc]); \
    _Pragma("unroll") for (int c_ = 0; c_ < KC; ++c_) sl[i_].kk[c_] = *reinterpret_cast<const bf16x8*>(kptr[c_] + (long)(k0_) * kstride[c_]); } while (0)
#define SWRITE(b_, i_) do { if constexpr (VAR == 1 || VAR == 9) break; *(bf16x8*)(V_lds + (b_) * SHM_V + vst0) = sl[i_].vs0; *(bf16x8*)(V_lds + (b_) * SHM_V + vst1) = sl[i_].vs1; \
    _Pragma("unroll") for (int c_ = 0; c_ < KC; ++c_) *(bf16x8*)(K_lds + (b_) * SHM_K + klds[c_]) = sl[i_].kk[c_]; } while (0)
#define SWAIT() do { if constexpr (SDEPTH == 2) { if constexpr (KC == 3) asm volatile("s_waitcnt vmcnt(5)" ::: "memory"); else asm volatile("s_waitcnt vmcnt(3)" ::: "memory"); } \
    else asm volatile("s_waitcnt vmcnt(0)" ::: "memory"); } while (0)
#define RESC(a_) do { if (__any((a_) < 1.f)) { if (hi == 0) al_l[r32] = (a_); asm volatile("s_waitcnt lgkmcnt(0)" ::: "memory"); \
    _Pragma("unroll") for (int d_ = 0; d_ < 4; ++d_) _Pragma("unroll") for (int r_ = 0; r_ < 16; ++r_) o[d_][r_] *= al_l[crow(r_, hi)]; } } while (0)
    f32x16 pA0, pA1, pB0, pB1; float alA, alB; bf16x8 pa0, pa1, pa2, pa3; const int NT = seq / KVBLK;
    constexpr int SE = 0, SO = SDEPTH - 1;
    SLOAD(SE, 0); asm volatile("s_waitcnt vmcnt(0)" ::: "memory"); SWRITE(0, SE); __syncthreads();
    qkt<DQK, NQR, VAR>(pA0, pA1, K_lds, qr, ql, r32, hi, mC); partialSM<DQK, VAR, true>(pA0, pA1, mC, alA);
    SLOAD(SO, KVBLK); if constexpr (SDEPTH == 2) { if (2 < NT) SLOAD(SE, 2 * KVBLK); }
    SWAIT(); SWRITE(1, SO); __syncthreads();
    constexpr bool alt = ALT;
#if ATT_SG
    (void)alt;
    for (int j = 1; j + 1 < NT; j += 2) {
        SBAR(); qkt<DQK, NQR, VAR>(pB0, pB1, K_lds + SHM_K, qr, ql, r32, hi, mC); finishSM<VAR>(pA0, pA1, alA, l_reg, pa0, pa1, pa2, pa3); SG_QK_SM(); SBAR();
        SLOAD(SO, (j + SDEPTH) * KVBLK); SBAR();
        pv_sg(o, vb0, pa0, pa1, pa2, pa3); partialSM<DQK, VAR>(pB0, pB1, mC, alB); SG_PV_SM(); SBAR();
        __syncthreads(); SWAIT(); SWRITE(0, SE);
        RESC(alB); __syncthreads();
        SBAR(); qkt<DQK, NQR, VAR>(pA0, pA1, K_lds, qr, ql, r32, hi, mC); finishSM<VAR>(pB0, pB1, alB, l_reg, pa0, pa1, pa2, pa3); SG_QK_SM(); SBAR();
        if (SDEPTH == 1 || j + 3 < NT) SLOAD(SE, (j + 1 + SDEPTH) * KVBLK); SBAR();
        pv_sg(o, vb0 + (int)SHM_V, pa0, pa1, pa2, pa3); partialSM<DQK, VAR>(pA0, pA1, mC, alA); SG_PV_SM(); SBAR();
        __syncthreads(); SWAIT(); SWRITE(1, SO);
        RESC(alA); __syncthreads();
    }
#else
    for (int j = 1; j + 1 < NT; j += 2) {
        if constexpr (!alt) {
            SBAR(); qkt<DQK, NQR, VAR>(pB0, pB1, K_lds + SHM_K, qr, ql, r32, hi, mC);
            finishSM<VAR>(pA0, pA1, alA, l_reg, pa0, pa1, pa2, pa3); SBAR();
            SLOAD(SO, (j + SDEPTH) * KVBLK); SBAR();
            pv_d0<VAR>(o, vb0, pa0, pa1, pa2, pa3); partialSM<DQK, VAR>(pB0, pB1, mC, alB);
        } else {
            SBAR(); finishSM<VAR>(pA0, pA1, alA, l_reg, pa0, pa1, pa2, pa3); SBAR();
            qkt<DQK, NQR, VAR>(pB0, pB1, K_lds + SHM_K, qr, ql, r32, hi, mC); SBAR();
            SLOAD(SO, (j + SDEPTH) * KVBLK); SBAR();
            partialSM<DQK, VAR>(pB0, pB1, mC, alB); SBAR(); pv_d0<VAR>(o, vb0, pa0, pa1, pa2, pa3);
        }
        if constexpr (VAR != 6 && VAR != 9) __syncthreads(); SWAIT(); SWRITE(0, SE);
        RESC(alB); if constexpr (VAR != 6 && VAR != 9) __syncthreads();
        if constexpr (!alt) {
            SBAR(); qkt<DQK, NQR, VAR>(pA0, pA1, K_lds, qr, ql, r32, hi, mC);
            finishSM<VAR>(pB0, pB1, alB, l_reg, pa0, pa1, pa2, pa3); SBAR();
            if (SDEPTH == 1 || j + 3 < NT) SLOAD(SE, (j + 1 + SDEPTH) * KVBLK); SBAR();
            pv_d0<VAR>(o, vb0 + (int)SHM_V, pa0, pa1, pa2, pa3); partialSM<DQK, VAR>(pA0, pA1, mC, alA);
        } else {
            SBAR(); finishSM<VAR>(pB0, pB1, alB, l_reg, pa0, pa1, pa2, pa3); SBAR();
            qkt<DQK, NQR, VAR>(pA0, pA1, K_lds, qr, ql, r32, hi, mC); SBAR();
            if (SDEPTH == 1 || j + 3 < NT) SLOAD(SE, (j + 1 + SDEPTH) * KVBLK); SBAR();
            partialSM<DQK, VAR>(pA0, pA1, mC, alA); SBAR(); pv_d0<VAR>(o, vb0 + (int)SHM_V, pa0, pa1, pa2, pa3);
        }
        if constexpr (VAR != 6 && VAR != 9) __syncthreads(); SWAIT(); SWRITE(1, SO);
        RESC(alA); if constexpr (VAR != 6 && VAR != 9) __syncthreads();
    }
#endif
    SBAR(); qkt<DQK, NQR, VAR>(pB0, pB1, K_lds + SHM_K, qr, ql, r32, hi, mC);
    finishSM<VAR>(pA0, pA1, alA, l_reg, pa0, pa1, pa2, pa3); SBAR();
    pv_d0<VAR>(o, vb0, pa0, pa1, pa2, pa3); partialSM<DQK, VAR>(pB0, pB1, mC, alB);
    __syncthreads(); RESC(alB);
    finishSM<VAR>(pB0, pB1, alB, l_reg, pa0, pa1, pa2, pa3); SBAR();
    pv_d0<VAR>(o, vb0 + (int)SHM_V, pa0, pa1, pa2, pa3);
    if (hi == 0) li_l[r32] = l_reg; asm volatile("s_waitcnt lgkmcnt(0)" ::: "memory");
    float rli[16];
#pragma unroll
    for (int r = 0; r < 16; ++r) rli[r] = __builtin_amdgcn_rcpf(li_l[crow(r, hi)]);
    if constexpr (MODE == 0) {
        bf16_t* Ow = ao.O + (long)(wid * QBLK) * ao.ldo;
#pragma unroll
        for (int r = 0; r < 16; ++r) { const int orow = crow(r, hi);
#pragma unroll
            for (int d0 = 0; d0 < 4; ++d0) Ow[(long)orow * ao.ldo + d0 * 32 + r32] = f2bf(o[d0][r] * rli[r]); }
    } else {
        float* st = ao.stash + (wid * 64) * 64 + lane;
        if (ao.sub == 0) {
#pragma unroll
            for (int r = 0; r < 16; ++r)
#pragma unroll
                for (int d0 = 0; d0 < 4; ++d0) st[(r * 4 + d0) * 64] = o[d0][r] * rli[r];
        } else {
            const float lam = ao.lam; float sg[4];
#pragma unroll
            for (int d0 = 0; d0 < 4; ++d0) sg[d0] = ao.subg[d0 * 32 + r32] * (1.f - LAM_INIT);
            bf16_t* Ow = ao.O + (long)(wid * QBLK) * ao.ldo;
#pragma unroll
            for (int r = 0; r < 16; ++r) { float ss = 0.f;
#pragma unroll
                for (int d0 = 0; d0 < 4; ++d0) { const float v = st[(r * 4 + d0) * 64] - lam * (o[d0][r] * rli[r]); o[d0][r] = v; ss += v * v; }
                ss += __shfl_xor(ss, 1); ss += __shfl_xor(ss, 2); ss += __shfl_xor(ss, 4); ss += __shfl_xor(ss, 8); ss += __shfl_xor(ss, 16);
                const float rn = 1.0f / sqrtf(ss * (1.f / 128.f) + EPS); const int orow = crow(r, hi);
#pragma unroll
                for (int d0 = 0; d0 < 4; ++d0) Ow[(long)orow * ao.ldo + d0 * 32 + r32] = f2bf(o[d0][r] * rn * sg[d0]); }
        }
    }
    asm volatile("s_waitcnt vmcnt(0) lgkmcnt(0)" ::: "memory");
    __syncthreads();
#undef SLOAD
#undef SWRITE
#undef SWAIT
#undef RESC
}
template <int DQK, int SDEPTH, int MODE, int VAR = 0>
__device__ __forceinline__ void attn_body(const bf16_t* __restrict__ Qb, int ldq, const KSrc ks, const bf16_t* __restrict__ Vh, int ldv, int seq, char* lds, const AOut ao) {
    if (__builtin_amdgcn_readfirstlane((int)threadIdx.x >> 8) == 0) attn_body_impl<DQK, SDEPTH, MODE, VAR, false>(Qb, ldq, ks, Vh, ldv, seq, lds, ao);
    else attn_body_impl<DQK, SDEPTH, MODE, VAR, true>(Qb, ldq, ks, Vh, ldv, seq, lds, ao);
}
template <int MODE, bool ALT>
__device__ __forceinline__ void attn_dma_impl(const bf16_t* __restrict__ Qb, int ldq, const bf16_t* __restrict__ Kh, int ldk, const bf16_t* __restrict__ Vh, int ldv, int seq, char* lds, const AOut ao) {
    constexpr int DQK = 64, ND = 4, SV = 16384, SK = 8192, KOFF = 3 * SV, WSOFF = 3 * SV + 3 * SK;
    int tid_ = threadIdx.x; asm volatile("" : "+v"(tid_));
    const int tid = tid_, wid = tid >> 6, lane = tid & 63, r32 = lane & 31, hi = lane >> 5;
    const unsigned widu = (unsigned)__builtin_amdgcn_readfirstlane(wid), ldsb = (unsigned)(uintptr_t)lds;
    float* ws = (float*)(lds + WSOFF) + wid * 64; float* li_l = ws; float* al_l = ws + 32;
    float l_reg = 0; f32x16 o[4] = {}, mC = {}; bf16x8 qr[ND];
    const bf16_t* Qw = Qb + (long)(wid * QBLK + r32) * ldq + hi * 8;
#pragma unroll
    for (int d0 = 0; d0 < ND; ++d0) qr[d0] = *reinterpret_cast<const bf16x8*>(Qw + d0 * 16);
    const int vb0 = (int)ldsb + v_rd_base(lane);
    const int pk = wid * 64 + lane, krow = pk >> 3, kc8 = (pk & 7) ^ ((krow >> 1) & 7);
    const unsigned koff = (unsigned)(krow * ldk + kc8 * 8) * 2u; unsigned voff[2];
#pragma unroll
    for (int i = 0; i < 2; ++i) { const int pv = (wid + 8 * i) * 64 + lane, kk = ((pv >> 7) << 3) | ((pv >> 2) & 7), k = (kk & ~0xC) | ((kk & 4) << 1) | ((kk & 8) >> 1), cc = (((pv >> 5) & 3) << 5) | ((pv & 3) << 3);
        voff[i] = (unsigned)(k * ldv + cc) * 2u; }
    const size_t kstep = (size_t)64 * ldk * 2, vstep = (size_t)64 * ldv * 2;
#define DMA_K(t_) do { const char* g_ = (const char*)Kh + (size_t)(t_) * kstep; asm volatile("" : "+s"(g_)); \
    __builtin_amdgcn_global_load_lds((const unsigned*)(g_ + koff), (LAS unsigned*)(ldsb + KOFF + ((t_) % 3) * SK + widu * 1024u), 16, 0, 0); } while (0)
#define DMA_V(t_) do { const char* g_ = (const char*)Vh + (size_t)(t_) * vstep; asm volatile("" : "+s"(g_)); \
    __builtin_amdgcn_global_load_lds((const unsigned*)(g_ + voff[0]), (LAS unsigned*)(ldsb + ((t_) % 3) * SV + widu * 1024u), 16, 0, 0); \
    __builtin_amdgcn_global_load_lds((const unsigned*)(g_ + voff[1]), (LAS unsigned*)(ldsb + ((t_) % 3) * SV + (widu + 8u) * 1024u), 16, 0, 0); } while (0)
#define SYNC(n_) do { asm volatile("s_waitcnt vmcnt(" #n_ ") lgkmcnt(0)" ::: "memory"); __builtin_amdgcn_s_barrier(); asm volatile("" ::: "memory"); } while (0)
#define KS(t_) (lds + KOFF + ((t_) % 3) * SK)
#define VS(t_) (vb0 + ((t_) % 3) * SV)
#define RESC(a_) do { if (__any((a_) < 1.f)) { if (hi == 0) al_l[r32] = (a_); asm volatile("s_waitcnt lgkmcnt(0)" ::: "memory"); \
    _Pragma("unroll") for (int d_ = 0; d_ < 4; ++d_) _Pragma("unroll") for (int r_ = 0; r_ < 16; ++r_) o[d_][r_] *= al_l[crow(r_, hi)]; } } while (0)
    f32x16 pA0, pA1, pB0, pB1; float alA, alB, psA = 0.f, psB = 0.f; bf16x8 pa0, pa1, pa2, pa3; const int NT = seq / KVBLK; KFrag kf;
    DMA_K(0); DMA_V(0); DMA_K(1);
    SYNC(3);
    DMA_K(2); DMA_V(1);
    qkt<DQK, ND, 0>(pA0, pA1, KS(0), qr, nullptr, r32, hi, mC); partialSM<DQK, 0, true>(pA0, pA1, mC, alA);
    if constexpr (!ALT) {
#pragma unroll
        for (int r = 0; r < 16; ++r) { pA1[r] = __builtin_amdgcn_exp2f(pA1[r]); psA += pA0[r]; } }
    SYNC(3);
    constexpr bool alt = ALT;
#pragma unroll 1
    for (int j = 1; j + 1 < NT; j += 2) {
        DMA_K(j + 2); DMA_V(j + 1);
        if constexpr (!alt) {
            qkt_ld(kf, KS(j), r32, hi); SBAR(); qkt_mf(pB0, pB1, kf, qr, mC);
            finishSM2(pA0, pA1, psA, alA, l_reg, pa0, pa1, pa2, pa3); SBAR();
            pv_partial<DQK>(o, VS(j - 1), pa0, pa1, pa2, pa3, pB0, pB1, mC, alB, psB);
        } else {
            qkt_ld(kf, KS(j), r32, hi); SBAR(); finishSM<0>(pA0, pA1, alA, l_reg, pa0, pa1, pa2, pa3); SBAR();
            qkt_mf(pB0, pB1, kf, qr, mC); SBAR();
            partialSM<DQK, 0>(pB0, pB1, mC, alB); SBAR(); pv_d0<0>(o, VS(j - 1), pa0, pa1, pa2, pa3);
        }
        RESC(alB); SYNC(3);
        const bool more = j + 3 < NT;
        if (more) DMA_K(j + 3);
        DMA_V(j + 2);
        if constexpr (!alt) {
            qkt_ld(kf, KS(j + 1), r32, hi); SBAR(); qkt_mf(pA0, pA1, kf, qr, mC);
            finishSM2(pB0, pB1, psB, alB, l_reg, pa0, pa1, pa2, pa3); SBAR();
            pv_partial<DQK>(o, VS(j), pa0, pa1, pa2, pa3, pA0, pA1, mC, alA, psA);
        } else {
            qkt_ld(kf, KS(j + 1), r32, hi); SBAR(); finishSM<0>(pB0, pB1, alB, l_reg, pa0, pa1, pa2, pa3); SBAR();
            qkt_mf(pA0, pA1, kf, qr, mC); SBAR();
            partialSM<DQK, 0>(pA0, pA1, mC, alA); SBAR(); pv_d0<0>(o, VS(j), pa0, pa1, pa2, pa3);
        }
        RESC(alA); if (more) SYNC(3); else SYNC(0);
    }
    SBAR(); qkt<DQK, ND, 0>(pB0, pB1, KS(NT - 1), qr, nullptr, r32, hi, mC);
    finishSM2(pA0, pA1, psA, alA, l_reg, pa0, pa1, pa2, pa3); SBAR();
    pv_partial<DQK>(o, VS(NT - 2), pa0, pa1, pa2, pa3, pB0, pB1, mC, alB, psB);
    RESC(alB);
    finishSM2(pB0, pB1, psB, alB, l_reg, pa0, pa1, pa2, pa3); SBAR();
    pv_d0<0>(o, VS(NT - 1), pa0, pa1, pa2, pa3);
    if (hi == 0) li_l[r32] = l_reg; asm volatile("s_waitcnt lgkmcnt(0)" ::: "memory");
    float rli[16];
#pragma unroll
    for (int r = 0; r < 16; ++r) rli[r] = __builtin_amdgcn_rcpf(li_l[crow(r, hi)]);
    if constexpr (MODE == 0) {
        bf16_t* Ow = ao.O + (long)(wid * QBLK) * ao.ldo;
#pragma unroll
        for (int r = 0; r < 16; ++r) { const int orow = crow(r, hi);
#pragma unroll
            for (int d0 = 0; d0 < 4; ++d0) Ow[(long)orow * ao.ldo + d0 * 32 + r32] = f2bf(o[d0][r] * rli[r]); }
    } else {
        float* st = ao.stash + (wid * 64) * 64 + lane;
        if (ao.sub == 0) {
#pragma unroll
            for (int r = 0; r < 16; ++r)
#pragma unroll
                for (int d0 = 0; d0 < 4; ++d0) st[(r * 4 + d0) * 64] = o[d0][r] * rli[r];
        } else {
            const float lam = ao.lam; float sg[4];
#pragma unroll
            for (int d0 = 0; d0 < 4; ++d0) sg[d0] = ao.subg[d0 * 32 + r32] * (1.f - LAM_INIT);
            bf16_t* Ow = ao.O + (long)(wid * QBLK) * ao.ldo;
#pragma unroll
            for (int r = 0; r < 16; ++r) { float ss = 0.f;
#pragma unroll
                for (int d0 = 0; d0 < 4; ++d0) { const float v = st[(r * 4 + d0) * 64] - lam * (o[d0][r] * rli[r]); o[d0][r] = v; ss += v * v; }
                ss += __shfl_xor(ss, 1); ss += __shfl_xor(ss, 2); ss += __shfl_xor(ss, 4); ss += __shfl_xor(ss, 8); ss += __shfl_xor(ss, 16);
                const float rn = 1.0f / sqrtf(ss * (1.f / 128.f) + EPS); const int orow = crow(r, hi);
#pragma unroll
                for (int d0 = 0; d0 < 4; ++d0) Ow[(long)orow * ao.ldo + d0 * 32 + r32] = f2bf(o[d0][r] * rn * sg[d0]); }
        }
    }
    asm volatile("s_waitcnt vmcnt(0) lgkmcnt(0)" ::: "memory");
    __syncthreads();
#undef DMA_K
#undef DMA_V
#undef SYNC
#undef KS
#undef VS
#undef RESC
}
template <int MODE>
__device__ __forceinline__ void attn_body_dma(const bf16_t* __restrict__ Qb, int ldq, const bf16_t* __restrict__ Kh, int ldk, const bf16_t* __restrict__ Vh, int ldv, int seq, char* lds, const AOut ao) {
#if ATT_NOALT
    attn_dma_impl<MODE, false>(Qb, ldq, Kh, ldk, Vh, ldv, seq, lds, ao);
#else
    if (__builtin_amdgcn_readfirstlane((int)threadIdx.x >> 8) == 0) attn_dma_impl<MODE, false>(Qb, ldq, Kh, ldk, Vh, ldv, seq, lds, ao);
    else attn_dma_impl<MODE, true>(Qb, ldq, Kh, ldk, Vh, ldv, seq, lds, ao);
#endif
}
template <int DQK>
__device__ __forceinline__ void attn_body_np(const bf16_t* __restrict__ Qb, int ldq, const KSrc ks, const bf16_t* __restrict__ Vh, int ldv, int seq, char* lds, const AOut ao) {
    using C = Cf<DQK>; constexpr int ND = C::ND, KC = C::KC, CPR = C::CPR, CA = DQK == 192 ? 16 : CPR; constexpr size_t SHM_K = C::SHM_K;
    int tid_ = threadIdx.x; asm volatile("" : "+v"(tid_));
    const int tid = tid_, wid = tid >> 6, lane = tid & 63, r32 = lane & 31, hi = lane >> 5;
    char* V_lds = lds; char* K_lds = lds + 2 * SHM_V;
    float* ws = (float*)(lds + 2 * SHM_V + 2 * SHM_K) + wid * 64; float* li_l = ws; float* al_l = ws + 32;
    float l_reg = 0; f32x16 o[4] = {}, mC = {}; bf16x8 qr[ND];
    const bf16_t* Qw = Qb + (long)(wid * QBLK + r32) * ldq + hi * 8;
#pragma unroll
    for (int d0 = 0; d0 < ND; ++d0) qr[d0] = *reinterpret_cast<const bf16x8*>(Qw + d0 * 16);
    const int sr = tid >> 4, sc = (tid & 15) * 8, vst0 = v_st(sr, sc), vst1 = v_st(32 + sr, sc);
    const int vb0 = (int)(uintptr_t)V_lds + v_rd_base(lane);
    const char* kbase = (const char*)ks.ka < (const char*)ks.kb ? (const char*)ks.ka : (const char*)ks.kb;
    unsigned koff[KC], kstride[KC]; int klds[KC];
#pragma unroll
    for (int i = 0; i < KC; ++i) { const int q = tid + 512 * i, row = q / CPR, c8 = q % CPR; klds[i] = kswz<DQK>(row, c8 * 16);
        if (c8 < CA) { koff[i] = (unsigned)((const char*)(ks.ka + (long)row * ks.lda + c8 * 8) - kbase); kstride[i] = (unsigned)ks.lda * 2u; }
        else { koff[i] = (unsigned)((const char*)(ks.kb + (long)row * ks.ldb + (c8 - CA) * 8) - kbase); kstride[i] = (unsigned)ks.ldb * 2u; } }
    const unsigned voff0 = (unsigned)(sr * ldv + sc) * 2u, voff1 = voff0 + (unsigned)ldv * 64u;
    bf16x8 vs0, vs1, kk[KC];
#define SLOAD1(k0_) do { const char* vb_ = (const char*)Vh + (size_t)(k0_) * (size_t)(ldv * 2); vs0 = *reinterpret_cast<const bf16x8*>(vb_ + voff0); vs1 = *reinterpret_cast<const bf16x8*>(vb_ + voff1); \
    _Pragma("unroll") for (int c_ = 0; c_ < KC; ++c_) kk[c_] = *reinterpret_cast<const bf16x8*>(kbase + (koff[c_] + (unsigned)(k0_) * kstride[c_])); } while (0)
#define SWRITE1(b_) do { *(bf16x8*)(V_lds + (b_) * SHM_V + vst0) = vs0; *(bf16x8*)(V_lds + (b_) * SHM_V + vst1) = vs1; \
    _Pragma("unroll") for (int c_ = 0; c_ < KC; ++c_) *(bf16x8*)(K_lds + (b_) * SHM_K + klds[c_]) = kk[c_]; } while (0)
    f32x16 p0, p1; float al; bf16x8 pa0, pa1, pa2, pa3; const int NT = seq / KVBLK;
    SLOAD1(0); asm volatile("s_waitcnt vmcnt(0)" ::: "memory"); SWRITE1(0); SLOAD1(KVBLK); __syncthreads();
#pragma unroll 1
    for (int j = 0; j < NT; ++j) {
        const int buf = j & 1;
        SBAR(); qkt<DQK, ND>(p0, p1, K_lds + buf * SHM_K, qr, nullptr, r32, hi, mC);
        if (j == 0) partialSM<DQK, 0, true>(p0, p1, mC, al); else partialSM<DQK>(p0, p1, mC, al);
        if (__any(al < 1.f)) { if (hi == 0) al_l[r32] = al; asm volatile("s_waitcnt lgkmcnt(0)" ::: "memory");
#pragma unroll
            for (int d_ = 0; d_ < 4; ++d_)
#pragma unroll
                for (int r_ = 0; r_ < 16; ++r_) o[d_][r_] *= al_l[crow(r_, hi)]; }
        finishSM(p0, p1, al, l_reg, pa0, pa1, pa2, pa3); SBAR();
        if (j + 1 < NT) { asm volatile("s_waitcnt vmcnt(0)" ::: "memory"); SWRITE1(buf ^ 1); if (j + 2 < NT) SLOAD1((j + 2) * KVBLK); }
        SBAR();
        pv_d0(o, vb0 + buf * (int)SHM_V, pa0, pa1, pa2, pa3);
        asm volatile("s_waitcnt lgkmcnt(0)" ::: "memory"); __builtin_amdgcn_s_barrier(); asm volatile("" ::: "memory");
    }
#undef SLOAD1
#undef SWRITE1
    if (hi == 0) li_l[r32] = l_reg; asm volatile("s_waitcnt lgkmcnt(0)" ::: "memory");
    float rli[16];
#pragma unroll
    for (int r = 0; r < 16; ++r) rli[r] = __builtin_amdgcn_rcpf(li_l[crow(r, hi)]);
    bf16_t* Ow = ao.O + (long)(wid * QBLK) * ao.ldo;
#pragma unroll
    for (int r = 0; r < 16; ++r) { const int orow = crow(r, hi);
#pragma unroll
        for (int d0 = 0; d0 < 4; ++d0) Ow[(long)orow * ao.ldo + d0 * 32 + r32] = f2bf(o[d0][r] * rli[r]); }
    asm volatile("s_waitcnt vmcnt(0) lgkmcnt(0)" ::: "memory");
    __syncthreads();
}
}
constexpr int M = NB * S, ML = NB * T;
constexpr int NCH = ML / 256;
constexpr int MAXT = 2 * ML / 256 + NE;
constexpr size_t al256(size_t x) { return (x + 255) / 256 * 256; }
constexpr size_t WS_CTL = 0, CTL_BYTES = 1u << 20;
constexpr int CW_BAR = 4096;
constexpr int CW_TICKET = 64;
constexpr size_t WS_MODV = WS_CTL + CTL_BYTES;
constexpr size_t WS_ROPE = WS_MODV + al256((size_t)2 * 33 * 6144 * 4);
constexpr size_t WS_W = WS_ROPE + 2 * 2048 * 32 * 4;
constexpr size_t W_IN0 = WS_W, W_UQ = W_IN0 + (size_t)2304 * 1024 * 2, W_UKV = W_UQ + (size_t)768 * 384 * 2, W_OUT0 = W_UKV + (size_t)1024 * 256 * 2,
    W_GU0 = W_OUT0 + (size_t)1024 * 1024 * 2, W_DN0 = W_GU0 + (size_t)5632 * 1024 * 2, W_IN1 = W_DN0 + (size_t)1024 * 2816 * 2, W_FOLD = W_IN1 + (size_t)2304 * 1024 * 2,
    W_OUT1 = W_FOLD + (size_t)512 * 1024 * 2, W_GU1 = W_OUT1 + (size_t)1024 * 1024 * 2, W_DN1 = W_GU1 + (size_t)NE * 5632 * 1024, W_DFT = W_DN1 + (size_t)NE * 1024 * 2816,
    WS_WEND = W_DFT + (size_t)2048 * 4096 * 2;
constexpr size_t WS_CTXS = WS_WEND;
constexpr size_t WS_STASH = WS_CTXS;
constexpr size_t CTXS_BYTES = ((size_t)NB * L * D * 4 > (size_t)256 * 131072) ? (size_t)NB * L * D * 4 : (size_t)256 * 131072;
constexpr size_t WS_ROUTE = WS_CTXS + CTXS_BYTES;
constexpr size_t RT_INFO = WS_ROUTE, RT_W = RT_INFO + (size_t)ML * 16, RT_POS = RT_W + (size_t)ML * 8, RT_WCNT = RT_POS + (size_t)ML * 8, RT_TOFF = RT_WCNT + (size_t)NCH * 64 * 4, WS_RTEND = al256(RT_TOFF + 256);
constexpr size_t W8_IN0 = WS_RTEND, W8_GU0 = W8_IN0 + (size_t)2304 * 1024, W8_IN1 = W8_GU0 + (size_t)5632 * 1024, W8_FOLD = W8_IN1 + (size_t)2304 * 1024, W8_END = W8_FOLD + (size_t)512 * 1024;
constexpr size_t SW_IN0 = W8_END, SW_GU0 = SW_IN0 + 2304 * 4, SW_IN1 = SW_GU0 + 5632 * 4, SW_FOLD = SW_IN1 + 2304 * 4, SW_GU1 = SW_FOLD + 512 * 4, SW_END = SW_GU1 + (size_t)NE * 5632 * 4;
constexpr size_t SA_ROW = al256(SW_END), SA_TOK = SA_ROW + (size_t)M * 4, SA_SORT = SA_TOK + (size_t)ML * 4, WS_I8END = al256(SA_SORT + ((size_t)2 * ML + NE * 256) * 4);
constexpr size_t AR = WS_I8END;
constexpr size_t SROWS = (size_t)2 * ML + NE * 256;
constexpr size_t H2S_BYTES = SROWS * 1024, FS_BYTES = SROWS * 2048, ACTM_BYTES = (size_t)MAXT * 256 * 2816, GT_BYTES = (size_t)NB * 256 * 4096 * 2;
#if CFG_NB >= 32
constexpr size_t AR_A = AR, AR_B = AR + (size_t)M * 2048, AR_C = AR + (size_t)M * 4096, AR_D = AR_C + (size_t)M * 5632;
constexpr size_t AR_END = AR_D + (size_t)M * 1280;
constexpr size_t B_H = AR_A, B_Q0 = AR_A, B_Y = AR_A, B_F = AR_A, B_AOUT1 = AR_A, B_H2TOK = AR_A, B_FS = AR_A;
constexpr size_t B_AOUT0 = AR_B, B_H2 = AR_B, B_H1 = AR_B, B_Y1 = AR_B;
constexpr size_t B_Z = AR_C, B_KPE = AR_C + (size_t)M * 4608, B_K0N = AR_C, B_V0 = AR_C + (size_t)M * 1024, B_ACT = AR_C,
    B_QKV1 = AR_C, B_GT = AR_C + (size_t)M * 4608, B_ACTM = AR_C, B_TMPW = AR_C;
static_assert((size_t)NE * 5632 * 1024 * 2 <= (size_t)M * 5632, "TMPW fits C");
constexpr size_t B_ZQN = AR_D, B_ZKVN = AR_D + (size_t)M * 768, B_H2S = AR_B, B_XS_HI = AR_D, B_PART1 = AR_D + (size_t)(ML / 2) * 2048;
constexpr bool SPLIT_TAIL = true;
static_assert((size_t)(ML / 2) * 2048 + (size_t)(M - 65536) * 2048 <= (size_t)M * 1280, "PART1 fits D");
static_assert(H2S_BYTES <= (size_t)M * 2048 && (size_t)(ML / 2) * 2048 <= (size_t)M * 1280, "h2s fits B, XS_HI fits D");
static_assert(FS_BYTES <= (size_t)M * 4096, "f_sorted fits A+B");
static_assert(ACTM_BYTES <= (size_t)M * 5632, "MoE act fits C");
static_assert(GT_BYTES <= (size_t)M * 1024, "GT fits the tail of C");
constexpr size_t B_FSX = AR_END;
static_assert(B_FSX + (size_t)3 * 1792 * 2048 <= ((size_t)1 << 30), "workspace map exceeds 1 GiB");
#else
constexpr size_t B_FSX = 0;
constexpr bool SPLIT_TAIL = false;
constexpr size_t B_H = AR, B_Z = B_H + (size_t)M * 2048, B_KPE = B_Z + (size_t)M * 4608, B_AOUT0 = B_KPE + (size_t)M * 128, B_ZQN = B_AOUT0 + (size_t)M * 2048, B_ZKVN = B_ZQN + (size_t)M * 768,
    B_Q0 = B_ZKVN + (size_t)M * 512, B_K0N = B_Q0 + (size_t)M * 1536, B_V0 = B_K0N + (size_t)M * 1024, B_Y = B_V0 + (size_t)M * 1024, B_H2 = B_Y + (size_t)M * 2048, B_ACT = B_H2 + (size_t)M * 2048,
    B_F = B_ACT + (size_t)M * 5632, B_H1 = B_F + (size_t)M * 2048, B_QKV1 = B_H1 + (size_t)M * 2048, B_GT = B_QKV1 + (size_t)M * 4608, B_AOUT1 = B_GT + GT_BYTES, B_Y1 = B_AOUT1 + (size_t)M * 2048,
    B_H2TOK = B_Y1 + (size_t)M * 2048, B_H2S = B_H2TOK + (size_t)ML * 1024, B_ACTM = B_H2S + H2S_BYTES, B_FS = B_ACTM + ACTM_BYTES, B_XS_HI = B_FS + FS_BYTES, B_PART1 = B_XS_HI, B_TMPW = B_XS_HI + (size_t)(ML / 2) * 2048, AR_END = B_TMPW + (size_t)NE * 5632 * 1024 * 2;
#endif

#ifndef DN0_FP8
#define DN0_FP8 1
#endif
#ifndef FFN0_FP8
#define FFN0_FP8 0
#endif
#ifndef MOE_I8
#define MOE_I8 0
#endif
#ifndef USE_I8
#define USE_I8 1
#endif
struct P {
    const float *x, *c, *ctx, *c_ctx, *ev_mod_w, *ev_mod_b, *ev_norm_g, *ev_w_in, *ev_conv_w, *ev_q_norm_g, *ev_w_uq, *ev_kv_norm_g, *ev_w_ukv, *ev_w_out,
        *ev_ffn_gate, *ev_ffn_up, *ev_ffn_down, *od_mod_w, *od_mod_b, *od_norm_g, *od_w_in, *od_lambda, *od_subln_g, *od_w_out, *od_router, *od_exp_gate, *od_exp_up, *od_exp_down;
    float* out; unsigned char* ws; int ph_lo, ph_hi;
};

__device__ __forceinline__ void ld_f32(const float* p, int lane, float (&v)[16]) {
#pragma unroll
    for (int j2 = 0; j2 < 2; ++j2) { const f32x4 a = *(const f32x4*)(p + 512 * j2 + 8 * lane), b = *(const f32x4*)(p + 512 * j2 + 8 * lane + 4);
#pragma unroll
        for (int i = 0; i < 4; ++i) { v[j2 * 8 + i] = a[i]; v[j2 * 8 + 4 + i] = b[i]; } }
}
__device__ __forceinline__ void st_f32(float* p, int lane, const float (&v)[16]) {
#pragma unroll
    for (int j2 = 0; j2 < 2; ++j2) { f32x4 a, b;
#pragma unroll
        for (int i = 0; i < 4; ++i) { a[i] = v[j2 * 8 + i]; b[i] = v[j2 * 8 + 4 + i]; }
        *(f32x4*)(p + 512 * j2 + 8 * lane) = a; *(f32x4*)(p + 512 * j2 + 8 * lane + 4) = b; }
}
__device__ __forceinline__ void unpack8(const u32x4 w, float* v) { v[0] = bflo(w.x); v[1] = bfhi(w.x); v[2] = bflo(w.y); v[3] = bfhi(w.y); v[4] = bflo(w.z); v[5] = bfhi(w.z); v[6] = bflo(w.w); v[7] = bfhi(w.w); }
__device__ __forceinline__ u32x4 pack8f(const float* v) { u32x4 w; w.x = cvt_pk_bf16(v[0], v[1]); w.y = cvt_pk_bf16(v[2], v[3]); w.z = cvt_pk_bf16(v[4], v[5]); w.w = cvt_pk_bf16(v[6], v[7]); return w; }
__device__ __forceinline__ void ld_bf16(const bf16_t* p, int lane, float (&v)[16]) {
#pragma unroll
    for (int j2 = 0; j2 < 2; ++j2) { const u32x4 w = *(const u32x4*)(p + 512 * j2 + 8 * lane); unpack8(w, &v[j2 * 8]); }
}
__device__ __forceinline__ void st_bf16(bf16_t* p, int lane, const float (&v)[16]) {
#pragma unroll
    for (int j2 = 0; j2 < 2; ++j2) *(u32x4*)(p + 512 * j2 + 8 * lane) = pack8f(&v[j2 * 8]);
}
__device__ __forceinline__ float sumsq16(const float (&v)[16]) { float s = 0.f;
#pragma unroll
    for (int i = 0; i < 16; ++i) s += v[i] * v[i];
    return wave_sum(s); }
__device__ __forceinline__ void resid16(float (&xv)[16], const float (&y)[16], const float* g, const float* gate, int lane) {
    const float ry = 1.0f / sqrtf(sumsq16(y) * (1.f / D) + EPS); float gv[16], tv[16]; ld_f32(g, lane, gv); ld_f32(gate, lane, tv);
#pragma unroll
    for (int i = 0; i < 16; ++i) xv[i] += tv[i] * (y[i] * ry * gv[i]);
}
__device__ __forceinline__ void normmod16(const float (&xv)[16], float (&h)[16], const float* g, const float* shift, const float* scale, int lane) {
    const float rx = 1.0f / sqrtf(sumsq16(xv) * (1.f / D) + EPS); float gv[16], sh[16], sc[16]; ld_f32(g, lane, gv); ld_f32(shift, lane, sh); ld_f32(scale, lane, sc);
#pragma unroll
    for (int i = 0; i < 16; ++i) h[i] = xv[i] * rx * gv[i] * (1.f + sc[i]) + sh[i];
}
__device__ __forceinline__ void resid16r(float (&xv)[16], const float (&y)[16], const float (&gv)[16], const float (&tv)[16]) {
    const float ry = 1.0f / sqrtf(sumsq16(y) * (1.f / D) + EPS);
#pragma unroll
    for (int i = 0; i < 16; ++i) xv[i] += tv[i] * (y[i] * ry * gv[i]);
}
__device__ __forceinline__ void normmod16r(const float (&xv)[16], float (&h)[16], const float (&gv)[16], const float (&sh)[16], const float (&sc)[16]) {
    const float rx = 1.0f / sqrtf(sumsq16(xv) * (1.f / D) + EPS);
#pragma unroll
    for (int i = 0; i < 16; ++i) h[i] = xv[i] * rx * gv[i] * (1.f + sc[i]) + sh[i];
}
__device__ __forceinline__ void st_i8row(unsigned char* dst, float* sc, int row, int lane, const float (&h)[16]) {
    u32x2 q[2]; const float scl = quant_row_i8(h, q);
#pragma unroll
    for (int j2 = 0; j2 < 2; ++j2) *(u32x2*)(dst + (size_t)row * 1024 + 512 * j2 + 8 * lane) = q[j2];
    if (lane == 0) sc[row] = scl;
}
__device__ __forceinline__ void wave_rows_(int gw, int ngw, int n, int& r0, int& r1) { const int per = (((n + ngw - 1) / ngw) + 1) & ~1; r0 = gw * per; r1 = r0 + per < n ? r0 + per : n; if (r0 > n) r0 = n; }
#define wave_rows(c, n, r0, r1) wave_rows_((c).gw, (c).ngw, n, r0, r1)
__device__ __forceinline__ int mod_key(int m) { const int b = m / S, j = m % S; return j < L ? 32 : b; }
__device__ __forceinline__ int rope_pos(int e) { return e < 32 ? 8 * (e >> 2) + (e & 3) : 8 * ((e - 32) >> 2) + 4 + (e & 3); }
__device__ __forceinline__ int rope_elem(int s) { const int i = s >> 3, j = s & 7; return j < 4 ? 4 * i + j : 32 + 4 * i + (j - 4); }

struct Ctx {
    LAS unsigned char* lds; unsigned char* ws; int tid, lane, wave, gw, ngw;
};

constexpr int P0_PITCH = 65, P0_SCR_BYTES = 64 * P0_PITCH * 4;
template <int MAP, bool OUT8 = false>
__device__ __forceinline__ void p0_item(const float* W, const float* W2, int ldw, int nvalid, int K, bf16_t* WT, LAS float* scr, int item, int nblk, int lane, float wscale = 1.f) {
    const int kb = item / nblk, nb = item % nblk, k0 = 64 * kb, n0 = 64 * nb; const int q = lane & 15, kr = lane >> 4; const int np = n0 + 4 * q;
    const float* src = W; int col = np;
    if (MAP == 0) { if (np >= nvalid) col = -1; }
    if (MAP == 1) { const int h = np / MLA_QK, w = np % MLA_QK; col = w < MLA_NOPE ? np : h * MLA_QK + MLA_NOPE + rope_elem(w - MLA_NOPE); }
    if (MAP == 2) { const int tl = np >> 8, cc = np & 255, bj = cc >> 7, wcq = (cc & 127) >> 3, nn = (cc & 7) >> 2; col = tl * 128 + 8 * wcq + 4 * nn; if (bj) src = W2; }
    if (MAP == 3) { col = np < 2 * DIFFW ? (np & ~63) + rope_elem(np & 63) : np; }
    f32x4 v[16];
#pragma unroll
    for (int i = 0; i < 16; ++i) v[i] = col >= 0 ? *(const f32x4*)(src + (size_t)(k0 + kr + 4 * i) * ldw + col) : (f32x4){0.f, 0.f, 0.f, 0.f};
#pragma unroll
    for (int i = 0; i < 16; ++i)
#pragma unroll
        for (int j = 0; j < 4; ++j) scr[(4 * q + j) * P0_PITCH + kr + 4 * i] = v[i][j];
    asm volatile("s_waitcnt lgkmcnt(0)" ::: "memory");
    const int c = lane & 7;
#pragma unroll
    for (int jj = 0; jj < 8; ++jj) { const int n = (lane >> 3) + 8 * jj; const LAS float* s = scr + n * P0_PITCH + 8 * c;
        if constexpr (OUT8) { u32x2 o; o.x = pg8::pack4_fp8(s[0] * wscale, s[1] * wscale, s[2] * wscale, s[3] * wscale); o.y = pg8::pack4_fp8(s[4] * wscale, s[5] * wscale, s[6] * wscale, s[7] * wscale);
            *(u32x2*)((unsigned char*)WT + (size_t)(n0 + n) * K + k0 + 8 * c) = o; }
        else { u32x4 o; o.x = cvt_pk_bf16(s[0], s[1]); o.y = cvt_pk_bf16(s[2], s[3]); o.z = cvt_pk_bf16(s[4], s[5]); o.w = cvt_pk_bf16(s[6], s[7]);
            *(u32x4*)(WT + (size_t)(n0 + n) * K + k0 + 8 * c) = o; } }
    asm volatile("s_waitcnt lgkmcnt(0)" ::: "memory");
}
struct P0Desc { const float* src; const float* src2; unsigned char* dst; int ldw, nvalid, K, nblk, map, out8, item; float scale; };
__device__ __forceinline__ void p0_load(const P0Desc& d, int lane, f32x4 (&v)[16]) {
    const int kb = d.item / d.nblk, nb = d.item % d.nblk, k0 = 64 * kb, n0 = 64 * nb; const int q = lane & 15, kr = lane >> 4; const int np = n0 + 4 * q;
    const float* src = d.src; int col = np;
    if (d.map == 0) { if (np >= d.nvalid) col = -1; }
    else if (d.map == 1) { const int h = np / MLA_QK, w = np % MLA_QK; col = w < MLA_NOPE ? np : h * MLA_QK + MLA_NOPE + rope_elem(w - MLA_NOPE); }
    else if (d.map == 2) { const int tl = np >> 8, cc = np & 255, bj = cc >> 7, wcq = (cc & 127) >> 3, nn = (cc & 7) >> 2; col = tl * 128 + 8 * wcq + 4 * nn; if (bj) src = d.src2; }
    else { col = np < 2 * DIFFW ? (np & ~63) + rope_elem(np & 63) : np; }
#pragma unroll
    for (int i = 0; i < 16; ++i) v[i] = col >= 0 ? *(const f32x4*)(src + (size_t)(k0 + kr + 4 * i) * d.ldw + col) : (f32x4){0.f, 0.f, 0.f, 0.f};
}
__device__ __forceinline__ void p0_store(const P0Desc& d, int lane, LAS float* scr, const f32x4 (&v)[16]) {
    const int kb = d.item / d.nblk, nb = d.item % d.nblk, k0 = 64 * kb, n0 = 64 * nb; const int q = lane & 15, kr = lane >> 4;
#pragma unroll
    for (int i = 0; i < 16; ++i)
#pragma unroll
        for (int j = 0; j < 4; ++j) scr[(4 * q + j) * P0_PITCH + kr + 4 * i] = v[i][j];
    asm volatile("s_waitcnt lgkmcnt(0)" ::: "memory");
    const int c = lane & 7; float ws_ = d.scale; if (d.map == 2 && d.out8) ws_ *= ((n0 & 255) >> 7) ? 0.6931471805599453f : 1.4426950408889634f;
#pragma unroll
    for (int jj = 0; jj < 8; ++jj) { const int n = (lane >> 3) + 8 * jj; const LAS float* s = scr + n * P0_PITCH + 8 * c;
        if (d.out8) { u32x2 o; o.x = pg8::pack4_fp8(s[0] * ws_, s[1] * ws_, s[2] * ws_, s[3] * ws_); o.y = pg8::pack4_fp8(s[4] * ws_, s[5] * ws_, s[6] * ws_, s[7] * ws_);
            *(u32x2*)(d.dst + (size_t)(n0 + n) * d.K + k0 + 8 * c) = o; }
        else { u32x4 o; o.x = cvt_pk_bf16(s[0], s[1]); o.y = cvt_pk_bf16(s[2], s[3]); o.z = cvt_pk_bf16(s[4], s[5]); o.w = cvt_pk_bf16(s[6], s[7]);
            *(u32x4*)((bf16_t*)d.dst + (size_t)(n0 + n) * d.K + k0 + 8 * c) = o; } }
    asm volatile("s_waitcnt lgkmcnt(0)" ::: "memory");
}
__device__ __forceinline__ void p0_fold_item(const float* W, bf16_t* WT, LAS float* scr, const LAS float* tab, int item, int lane) {
    const int kb = item / 16, nb = item % 16, k0 = 64 * kb, n0 = 32 * nb; const int r = n0 + (lane & 31), part = r >> 8, g = (r >> 6) & 3, l = r & 63;
    for (int i = 0; i < 32; ++i) { const int kk = 2 * i + (lane >> 5); const float* wr = W + (size_t)(k0 + kk) * ODD_IN + 3 * DIFFW + g * 64; float a = 0.f;
        for (int j = 0; j < 64; ++j) a += wr[j] * tab[part * 64 + ((l * j) & 63)];
        scr[kk * 33 + (lane & 31)] = a; }
    asm volatile("s_waitcnt lgkmcnt(0)" ::: "memory");
    const int c = lane & 7;
#pragma unroll
    for (int j = 0; j < 4; ++j) { const int n = (lane >> 3) + 8 * j; const LAS float* s = scr + (8 * c) * 33 + n;
        u32x4 o; o.x = cvt_pk_bf16(s[0 * 33], s[1 * 33]); o.y = cvt_pk_bf16(s[2 * 33], s[3 * 33]); o.z = cvt_pk_bf16(s[4 * 33], s[5 * 33]); o.w = cvt_pk_bf16(s[6 * 33], s[7 * 33]);
        *(u32x4*)(WT + (size_t)(n0 + n) * D + k0 + 8 * c) = o; }
    asm volatile("s_waitcnt lgkmcnt(0)" ::: "memory");
}
__device__ __forceinline__ void fmac_s(float& a, float x, float y) { asm("v_fmac_f32 %0, %1, %2" : "+v"(a) : "v"(x), "v"(y)); }
__device__ __forceinline__ void p0_mod_unit(const P& p, const Ctx& c, int u) {
    const int layer = u / 128, col0 = (u % 128) * 48; const float* W = layer ? p.od_mod_w : p.ev_mod_w; const float* bias = layer ? p.od_mod_b : p.ev_mod_b;
    float* mod = (float*)(c.ws + WS_MODV) + (size_t)layer * 33 * 6144;
    LAS float* sc = (LAS float*)c.lds;
    LAS float* red = (LAS float*)(c.lds + 73728);
    const int nl = c.tid & 15, kg = c.tid >> 4; float acc[3][33];
#pragma unroll
    for (int j = 0; j < 3; ++j)
#pragma unroll
        for (int r = 0; r < 33; ++r) acc[j][r] = 0.f;
    for (int ch = 0; ch < 2; ++ch) {
        const char* wb = (const char*)(W + (size_t)ch * 512 * 6144 + col0); const unsigned lo = (unsigned)(kg * 16 * 6144 + nl) * 4u; float wv[3][16];
#pragma unroll
        for (int kk = 0; kk < 16; ++kk) { const char* wk = wb + (size_t)kk * 6144 * 4;
#pragma unroll
            for (int j = 0; j < 3; ++j) wv[j][kk] = *(const float*)(wk + (lo + 64u * j)); }
        __syncthreads();
#pragma unroll 4
        for (int e = c.tid; e < 36 * 512; e += 512) { const int kk = e & 511, r = e >> 9; float v = 0.f;
            if (r < 33) { const float cv = r < 32 ? p.c[r * D + ch * 512 + kk] : p.c_ctx[ch * 512 + kk]; v = cv * __builtin_amdgcn_rcpf(1.f + __builtin_amdgcn_exp2f(-1.4426950408889634f * cv)); }
            sc[kk * 36 + r] = v; }
        __syncthreads();
#pragma unroll
        for (int kk = 0; kk < 16; ++kk) { const LAS f32x4* s4 = (const LAS f32x4*)(sc + (kg * 16 + kk) * 36);
#pragma unroll
            for (int q = 0; q < 8; ++q) { const f32x4 sv = s4[q];
#pragma unroll
                for (int i = 0; i < 4; ++i)
#pragma unroll
                    for (int j = 0; j < 3; ++j) fmac_s(acc[j][q * 4 + i], sv[i], wv[j][kk]); }
            const float s32 = s4[8][0];
#pragma unroll
            for (int j = 0; j < 3; ++j) fmac_s(acc[j][32], s32, wv[j][kk]); }
    }
#pragma unroll
    for (int j = 0; j < 3; ++j)
#pragma unroll
        for (int r = 0; r < 33; ++r) { float v = acc[j][r];
            { auto rr = __builtin_amdgcn_permlane16_swap(__float_as_uint(v), __float_as_uint(v), false, false); v = __uint_as_float(rr[0]) + __uint_as_float(rr[1]); }
            { auto rr = __builtin_amdgcn_permlane32_swap(__float_as_uint(v), __float_as_uint(v), false, false); v = __uint_as_float(rr[0]) + __uint_as_float(rr[1]); }
            acc[j][r] = v; }
    if ((c.lane >> 4) == 0) {
#pragma unroll
        for (int j = 0; j < 3; ++j)
#pragma unroll
            for (int r = 0; r < 33; ++r) red[(c.wave * 33 + r) * 48 + nl + 16 * j] = acc[j][r]; }
    __syncthreads();
    for (int o = c.tid; o < 33 * 48; o += 512) { const int r = o / 48, n = o % 48; float v = bias[col0 + n];
#pragma unroll
        for (int q = 0; q < 8; ++q) v += red[(q * 33 + r) * 48 + n];
        mod[(size_t)r * 6144 + col0 + n] = v; }
    __syncthreads();
}
__device__ __forceinline__ void phase_prologue(const P& p, const Ctx& c, int parts, int rp = 0) {
    if (parts & 1) for (int u = blockIdx.x; u < 256; u += gridDim.x) p0_mod_unit(p, c, u);
    __syncthreads();
    LAS float* tab = (LAS float*)(c.lds + 8 * P0_SCR_BYTES + 512);
    if (c.tid < 64) { const float a = (float)c.tid * (6.283185307179586f / 64.f); tab[c.tid] = cosf(a); tab[64 + c.tid] = sinf(a); }
    __syncthreads();
    LAS float* scr = (LAS float*)(c.lds + c.wave * P0_SCR_BYTES);
    constexpr int I0 = 16 * 36, I1 = 6 * 12, I2 = 4 * 16, I3 = 16 * 16, I4 = 16 * 88, I5 = 44 * 16, I6 = 16 * 36, I7 = 16 * 16, I8 = NE * I4, I9 = NE * I5, I10 = 16 * 16;
    constexpr int NITEMS = I0 + I1 + I2 + I3 + I4 + I5 + I6 + I7 + I8 + I9 + I10;
    (void)rp;
    constexpr int NTR = NITEMS - I10;
    auto resolve = [&](int it, P0Desc& d) {
        int r = it; d.src2 = nullptr; d.out8 = 0; d.scale = 1.f; d.map = 0;
        if (r < I0) { d.src = p.ev_w_in; d.ldw = EVEN_IN; d.nvalid = EVEN_IN; d.K = D; d.dst = c.ws + W_IN0; d.nblk = 36; d.item = r; return; } r -= I0;
        if (r < I1) { d.src = p.ev_w_uq; d.ldw = 768; d.nvalid = 768; d.K = QRANK; d.dst = c.ws + W_UQ; d.nblk = 12; d.map = 1; d.item = r; return; } r -= I1;
        if (r < I2) { d.src = p.ev_w_ukv; d.ldw = 1024; d.nvalid = 1024; d.K = KVRANK; d.dst = c.ws + W_UKV; d.nblk = 16; d.item = r; return; } r -= I2;
        if (r < I3) { d.src = p.ev_w_out; d.ldw = D; d.nvalid = D; d.K = D; d.dst = c.ws + W_OUT0; d.nblk = 16; d.item = r; return; } r -= I3;
        if (r < I4) { d.src = p.ev_ffn_gate; d.src2 = p.ev_ffn_up; d.ldw = FF; d.nvalid = FF; d.K = D; d.dst = c.ws + W_GU0; d.nblk = 88; d.map = 2; d.item = r; if (FFN0_FP8 && !USE_I8) { d.out8 = 1; d.scale = 32.f; } return; } r -= I4;
        if (r < I5) { d.src = p.ev_ffn_down; d.ldw = D; d.nvalid = D; d.K = FF; d.dst = c.ws + W_DN0; d.nblk = 16; d.item = r; if ((FFN0_FP8 && !USE_I8) || (DN0_FP8 && USE_I8)) { d.out8 = 1; d.scale = 64.f; } return; } r -= I5;
        if (r < I6) { d.src = p.od_w_in; d.ldw = ODD_IN; d.nvalid = ODD_IN; d.K = D; d.dst = c.ws + W_IN1; d.nblk = 36; d.map = 3; d.item = r; return; } r -= I6;
        if (r < I7) { d.src = p.od_w_out; d.ldw = D; d.nvalid = D; d.K = D; d.dst = c.ws + W_OUT1; d.nblk = 16; d.item = r; return; } r -= I7;
        if (r < I8) { const int e = r / I4; d.src = p.od_exp_gate + (size_t)e * D * FF; d.src2 = p.od_exp_up + (size_t)e * D * FF; d.ldw = FF; d.nvalid = FF; d.K = D; d.nblk = 88; d.map = 2; d.item = r % I4;
            if (MOE_I8) { d.dst = c.ws + B_TMPW + (size_t)e * 5632 * 1024 * 2; } else { d.dst = c.ws + W_GU1 + (size_t)e * 5632 * 1024; d.out8 = 1; d.scale = 32.f; } return; } r -= I8;
        { const int e = r / I5; d.src = p.od_exp_down + (size_t)e * FF * D; d.ldw = D; d.nvalid = D; d.K = FF; d.dst = c.ws + W_DN1 + (size_t)e * 1024 * 2816; d.nblk = 16; d.item = r % I5; d.out8 = 1; d.scale = 64.f; }
    };
    if (parts & 2) {
        int it = c.gw; P0Desc dA, dB; f32x4 vA[16], vB[16];
        if (it < NTR) { resolve(it, dA); p0_load(dA, c.lane, vA);
            for (;;) {
                int it1 = it + c.ngw; bool h1 = it1 < NTR; if (h1) { resolve(it1, dB); p0_load(dB, c.lane, vB); }
                p0_store(dA, c.lane, scr, vA); if (!h1) break; it = it1;
                it1 = it + c.ngw; h1 = it1 < NTR; if (h1) { resolve(it1, dA); p0_load(dA, c.lane, vA); }
                p0_store(dB, c.lane, scr, vB); if (!h1) break; it = it1;
            } }
        for (int f = c.gw; f < I10; f += c.ngw) p0_fold_item(p.od_w_in, (bf16_t*)(c.ws + W_FOLD), scr, tab, f, c.lane);
    }
    if (parts & 4) { bf16_t* dft = (bf16_t*)(c.ws + W_DFT); const int gt = blockIdx.x * 512 + c.tid, ngt = gridDim.x * 512; const float scl = 0.0027621358640099515f;
      for (int i8 = gt; i8 < 2048 * 4096 / 8; i8 += ngt) { const int k = i8 >> 9, tt0 = (i8 & 511) * 8; float v[8];
#pragma unroll
          for (int j = 0; j < 8; ++j) { const int tt = tt0 + j, t = tt & 2047, q = (k * t) & 2047; const float x = (float)q * (1.f / 2048.f); v[j] = (tt < 2048 ? __builtin_amdgcn_cosf(x) : -__builtin_amdgcn_sinf(x)) * scl; }
          *(u32x4*)(dft + (size_t)i8 * 8) = pack8f(v); } }
    if (parts & 4) { float* rc = (float*)(c.ws + WS_ROPE); float* rs = rc + 2048 * 32; const int gt = blockIdx.x * 512 + c.tid, ngt = gridDim.x * 512;
      for (int i = gt; i < 2048 * 32; i += ngt) { const int t = i >> 5, f = i & 31; const int pos = f < 16 ? t / GW : t % GW; const float inv = powf(10000.f, -(float)(f & 15) / 16.f);
          const float ang = (float)pos * inv; rc[i] = cosf(ang); rs[i] = sinf(ang); } }
}

__device__ __forceinline__ const float* in_row(const P& p, int m) { const int b = m / S, j = m % S; return j < L ? p.ctx + ((size_t)b * L + j) * D : p.x + ((size_t)b * T + (j - L)) * D; }
__device__ __forceinline__ bf16_t* lat_stream(const P& p, unsigned char* ws, int tok) {
    return tok < ML / 2 ? (bf16_t*)((unsigned char*)p.out + ((size_t)128 << 20)) + (size_t)tok * D : (bf16_t*)(ws + B_XS_HI) + (size_t)(tok - ML / 2) * D; }
__device__ __forceinline__ float* ctx_stream(unsigned char* ws, int m) { const int b = m / S, j = m % S; return (float*)(ws + WS_CTXS) + ((size_t)b * L + j) * D; }
__device__ __forceinline__ int tok_of(int m) { return (m / S) * T + (m % S) - L; }
__device__ __forceinline__ float* stream_row_unused(const P& p, unsigned char* ws, int m) { const int b = m / S, j = m % S; return j < L ? (float*)(ws + WS_CTXS) + ((size_t)b * L + j) * D : p.out + ((size_t)b * T + (j - L)) * D; }
__device__ __forceinline__ const float* mod_row(unsigned char* ws, int layer, int m) { const int b = m / S, j = m % S; return (const float*)(ws + WS_MODV) + ((size_t)layer * 33 + (j < L ? 32 : b)) * 6144; }

__device__ __forceinline__ void quant_weight_row(const bf16_t* src, unsigned char* dst, float* sc, int row, int lane, float mul = 1.f) {
    float v[16]; ld_bf16(src + (size_t)row * D, lane, v); u32x2 q[2]; const float scale = quant_row_i8(v, q);
#pragma unroll
    for (int j2 = 0; j2 < 2; ++j2) *(u32x2*)(dst + (size_t)row * D + 512 * j2 + 8 * lane) = q[j2];
    if (lane == 0) sc[row] = scale * mul;
}
__device__ __forceinline__ void phase_quant_weights(const Ctx& c) {
#if USE_I8
    constexpr int R0 = 5632, R1 = R0 + 2304, R2 = R1 + 2304, R3 = R2 + 512, R4 = R3 + (MOE_I8 ? NE * 5632 : 0);
    for (int r = c.gw; r < R4; r += c.ngw) {
        if (r < R0) quant_weight_row((const bf16_t*)(c.ws + W_GU0), c.ws + W8_GU0, (float*)(c.ws + SW_GU0), r, c.lane, (r & 255) < 128 ? 1.4426950408889634f : 0.6931471805599453f * (DN0_FP8 ? 8.f : 1.f));
        else if (r < R1) quant_weight_row((const bf16_t*)(c.ws + W_IN0), c.ws + W8_IN0, (float*)(c.ws + SW_IN0), r - R0, c.lane);
        else if (r < R2) quant_weight_row((const bf16_t*)(c.ws + W_IN1), c.ws + W8_IN1, (float*)(c.ws + SW_IN1), r - R1, c.lane, r - R1 < DIFFW ? pg8::QSC_DIFF : 1.f);
        else if (r < R3) quant_weight_row((const bf16_t*)(c.ws + W_FOLD), c.ws + W8_FOLD, (float*)(c.ws + SW_FOLD), r - R2, c.lane);
        else if (MOE_I8) quant_weight_row((const bf16_t*)(c.ws + B_TMPW), c.ws + W_GU1, (float*)(c.ws + SW_GU1), r - R3, c.lane, ((r - R3) & 255) < 128 ? 1.4426950408889634f : 0.6931471805599453f * 8.f); }
#endif
}
__device__ __forceinline__ void phase_norm0(const P& p, const Ctx& c) {
    bf16_t* H = (bf16_t*)(c.ws + B_H); int r0, r1; wave_rows(c, M, r0, r1);
    float g0[16], sh[16], sc[16]; ld_f32(p.ev_norm_g, c.lane, g0); int key = -1;
    for (int m0 = r0; m0 < r1; m0 += 2) { float xv[2][16];
#pragma unroll
        for (int r = 0; r < 2; ++r) ld_f32(in_row(p, m0 + r), c.lane, xv[r]);
#pragma unroll
        for (int r = 0; r < 2; ++r) { const int m = m0 + r; float h[16]; const int k = mod_key(m);
            if (k != key) { key = k; const float* mr = (const float*)(c.ws + WS_MODV) + (size_t)k * 6144; ld_f32(mr, c.lane, sh); ld_f32(mr + D, c.lane, sc); }
            normmod16r(xv[r], h, g0, sh, sc);
#if USE_I8
            st_i8row((unsigned char*)H, (float*)(c.ws + SA_ROW), m, c.lane, h);
#else
            st_bf16(H + (size_t)m * D, c.lane, h);
#endif
        } }
}
__device__ __forceinline__ void phase_even_elem(const P& p, const Ctx& c) {
    const bf16_t* Z = (const bf16_t*)(c.ws + B_Z); bf16_t* AO = (bf16_t*)(c.ws + B_AOUT0); bf16_t* ZQ = (bf16_t*)(c.ws + B_ZQN); bf16_t* ZKV = (bf16_t*)(c.ws + B_ZKVN); bf16_t* KPE = (bf16_t*)(c.ws + B_KPE);
    const float* rc = (const float*)(c.ws + WS_ROPE); const float* rs = rc + 2048 * 32; const int lane = c.lane;
    float cw[3][8];
#pragma unroll
    for (int t = 0; t < 3; ++t) { const f32x4 w0 = *(const f32x4*)(p.ev_conv_w + t * SCW + 8 * lane), w1 = *(const f32x4*)(p.ev_conv_w + t * SCW + 8 * lane + 4);
#pragma unroll
        for (int i = 0; i < 4; ++i) { cw[t][i] = w0[i]; cw[t][4 + i] = w1[i]; } }
    float gq[8], gkv[8];
    { const int lq = lane < 48 ? lane : 0, lk = lane < 32 ? lane : 0;
      const f32x4 a0 = *(const f32x4*)(p.ev_q_norm_g + 8 * lq), a1 = *(const f32x4*)(p.ev_q_norm_g + 8 * lq + 4), b0 = *(const f32x4*)(p.ev_kv_norm_g + 8 * lk), b1 = *(const f32x4*)(p.ev_kv_norm_g + 8 * lk + 4);
#pragma unroll
      for (int i = 0; i < 4; ++i) { gq[i] = a0[i]; gq[4 + i] = a1[i]; gkv[i] = b0[i]; gkv[4 + i] = b1[i]; } }
    for (int m0 = c.gw * 4; m0 < M; m0 += c.ngw * 4) {
        const int j0 = m0 % S; const int lo = j0 < L ? 0 : L, hi = j0 < L ? L : S; const bf16_t* z0 = Z + (size_t)m0 * 2304;
        u32x4 rcg[6], ruu[6], rbg[4], rzq[4], rzk[4]; float k1[4], k2[4];
#pragma unroll
        for (int r = 0; r < 6; ++r) { const int jj = j0 + r - 1; const bool ok = jj >= lo && jj < hi; const bf16_t* zn = z0 + (long)(r - 1) * 2304;
            rcg[r] = ok ? *(const u32x4*)(zn + SCW + 8 * lane) : (u32x4){0u, 0u, 0u, 0u}; ruu[r] = ok ? *(const u32x4*)(zn + 2 * SCW + 8 * lane) : (u32x4){0u, 0u, 0u, 0u}; }
#pragma unroll
        for (int r = 0; r < 4; ++r) { const bf16_t* zr = z0 + (size_t)r * 2304; rbg[r] = *(const u32x4*)(zr + 8 * lane);
            rzq[r] = lane < 48 ? *(const u32x4*)(zr + SCIN + 8 * lane) : (u32x4){0u, 0u, 0u, 0u}; rzk[r] = lane < 32 ? *(const u32x4*)(zr + SCIN + QRANK + 8 * lane) : (u32x4){0u, 0u, 0u, 0u};
            const bf16_t* kp = zr + SCIN + QRANK + KVRANK; k1[r] = bf2f(kp[lane & 31]); k2[r] = bf2f(kp[32 + (lane & 31)]); }
        float prod[6][8];
#pragma unroll
        for (int r = 0; r < 6; ++r) { float a[8], b[8]; unpack8(rcg[r], a); unpack8(ruu[r], b);
#pragma unroll
            for (int i = 0; i < 8; ++i) prod[r][i] = a[i] * b[i]; }
#pragma unroll
        for (int r = 0; r < 4; ++r) { const int m = m0 + r, j = j0 + r; float bg[8], acc[8]; unpack8(rbg[r], bg);
#pragma unroll
            for (int i = 0; i < 8; ++i) acc[i] = bg[i] * (cw[0][i] * prod[r][i] + cw[1][i] * prod[r + 1][i] + cw[2][i] * prod[r + 2][i]);
            *(u32x4*)(AO + (size_t)m * D + 8 * lane) = pack8f(acc);
            { float v[8]; unpack8(rzq[r], v); float s = 0.f;
#pragma unroll
              for (int i = 0; i < 8; ++i) s += v[i] * v[i];
              s = wave_sum(s); const float rn = 1.0f / sqrtf(s * (1.f / QRANK) + EPS);
#pragma unroll
              for (int i = 0; i < 8; ++i) v[i] *= rn * gq[i];
              if (lane < 48) *(u32x4*)(ZQ + (size_t)m * QRANK + 8 * lane) = pack8f(v); }
            { float v[8]; unpack8(rzk[r], v); float s = 0.f;
#pragma unroll
              for (int i = 0; i < 8; ++i) s += v[i] * v[i];
              s = wave_sum(s); const float rn = 1.0f / sqrtf(s * (1.f / KVRANK) + EPS);
#pragma unroll
              for (int i = 0; i < 8; ++i) v[i] *= rn * gkv[i];
              if (lane < 32) *(u32x4*)(ZKV + (size_t)m * KVRANK + 8 * lane) = pack8f(v); }
            if (lane < 32) { float cs = 1.f, sn = 0.f;
                if (j >= L) { cs = rc[(j - L) * 32 + lane]; sn = rs[(j - L) * 32 + lane]; }
                bf16_t* ko = KPE + (size_t)m * 64; ko[rope_pos(lane)] = f2bf(k1[r] * cs - k2[r] * sn); ko[rope_pos(32 + lane)] = f2bf(k1[r] * sn + k2[r] * cs); }
        }
    }
}
__device__ __forceinline__ void phase_mid0(const P& p, const Ctx& c, bool split) {
    const bf16_t* Y = (const bf16_t*)(c.ws + B_Y); bf16_t* H2 = (bf16_t*)(c.ws + B_H2); int r0, r1; wave_rows(c, M, r0, r1);
    float ng1[16], ng2[16], gt[16], sh[16], sc[16]; ld_f32(p.ev_norm_g + D, c.lane, ng1); ld_f32(p.ev_norm_g + 2 * D, c.lane, ng2); int key = -1;
    for (int m0 = r0; m0 < r1; m0 += 2) { float xv[2][16], y[2][16];
#pragma unroll
        for (int r = 0; r < 2; ++r) { ld_f32(in_row(p, m0 + r), c.lane, xv[r]); ld_bf16(Y + (size_t)(m0 + r) * D, c.lane, y[r]);
            if (split && m0 + r >= 65536) { float y1[16]; ld_bf16((const bf16_t*)(c.ws + B_PART1) + (size_t)(m0 + r - 65536) * D, c.lane, y1);
#pragma unroll
                for (int i = 0; i < 16; ++i) y[r][i] += y1[i]; } }
#pragma unroll
        for (int r = 0; r < 2; ++r) { const int m = m0 + r; float h[16]; const int k = mod_key(m);
            if (k != key) { key = k; const float* mr = (const float*)(c.ws + WS_MODV) + (size_t)k * 6144; ld_f32(mr + 2 * D, c.lane, gt); ld_f32(mr + 3 * D, c.lane, sh); ld_f32(mr + 4 * D, c.lane, sc); }
            resid16r(xv[r], y[r], ng1, gt); if ((m % S) >= L) st_bf16(lat_stream(p, c.ws, tok_of(m)), c.lane, xv[r]); else st_f32(ctx_stream(c.ws, m), c.lane, xv[r]);
            normmod16r(xv[r], h, ng2, sh, sc);
#if USE_I8
            st_i8row((unsigned char*)H2, (float*)(c.ws + SA_ROW), m, c.lane, h);
#else
            st_bf16(H2 + (size_t)m * D, c.lane, h);
#endif
        } }
}
__device__ __forceinline__ void phase_end0(const P& p, const Ctx& c, bool split) {
    const bf16_t* F = (const bf16_t*)(c.ws + B_F); bf16_t* H = (bf16_t*)(c.ws + B_H1); int r0, r1; wave_rows(c, M, r0, r1);
    float ng3[16], ng0[16], gt[16], sh[16], sc[16]; ld_f32(p.ev_norm_g + 3 * D, c.lane, ng3); ld_f32(p.od_norm_g, c.lane, ng0); int key = -1;
    for (int m0 = r0; m0 < r1; m0 += 2) { float xv[2][16], y[2][16];
#pragma unroll
        for (int r = 0; r < 2; ++r) { const int m = m0 + r; if ((m % S) >= L) ld_bf16(lat_stream(p, c.ws, tok_of(m)), c.lane, xv[r]); else ld_f32(ctx_stream(c.ws, m), c.lane, xv[r]); ld_bf16(F + (size_t)m * D, c.lane, y[r]);
            if (split && m >= 65536) { float y1[16]; ld_bf16((const bf16_t*)(c.ws + B_PART1) + (size_t)(m - 65536) * D, c.lane, y1);
#pragma unroll
                for (int i = 0; i < 16; ++i) y[r][i] += y1[i]; } }
#pragma unroll
        for (int r = 0; r < 2; ++r) { const int m = m0 + r; float h[16]; const int k = mod_key(m);
            if (k != key) { key = k; const float* mr = (const float*)(c.ws + WS_MODV) + (size_t)k * 6144; const float* mr1 = mr + (size_t)33 * 6144; ld_f32(mr + 5 * D, c.lane, gt); ld_f32(mr1, c.lane, sh); ld_f32(mr1 + D, c.lane, sc); }
            resid16r(xv[r], y[r], ng3, gt);
            if ((m % S) >= L) st_bf16(lat_stream(p, c.ws, tok_of(m)), c.lane, xv[r]);
            normmod16r(xv[r], h, ng0, sh, sc);
#if USE_I8
            st_i8row((unsigned char*)H, (float*)(c.ws + SA_ROW), m, c.lane, h);
#else
            st_bf16(H + (size_t)m * D, c.lane, h);
#endif
        } }
}
__device__ __forceinline__ void phase_mid1(const P& p, const Ctx& c) {
    const bf16_t* Y = (const bf16_t*)(c.ws + B_Y1); unsigned char* H8 = c.ws + B_H2TOK;
    int* rinfo = (int*)(c.ws + RT_INFO); float* rw = (float*)(c.ws + RT_W); int* wcnt = (int*)(c.ws + RT_WCNT);
    volatile LAS int* wc = (volatile LAS int*)(c.lds) + c.wave * 8; const int lane = c.lane;
    LAS float* rtr = (LAS float*)(c.lds + 1024);
    for (int i = c.tid; i < D * NE; i += 512) rtr[(i & 7) * D + (i >> 3)] = p.od_router[i];
    __syncthreads();
    float ng1[16], ng2[16], gt[16], sh[16], sc[16]; ld_f32(p.od_norm_g + D, lane, ng1); ld_f32(p.od_norm_g + 2 * D, lane, ng2); int key = -1;
    for (int ch = blockIdx.x; ch < NCH; ch += gridDim.x) {
        if (lane < 8) wc[lane] = 0;
        const int b = (ch * 256) / T;
        if (b != key) { key = b; const float* mr = (const float*)(c.ws + WS_MODV) + ((size_t)33 + b) * 6144; ld_f32(mr + 2 * D, lane, gt); ld_f32(mr + 3 * D, lane, sh); ld_f32(mr + 4 * D, lane, sc); }
        for (int i0 = 0; i0 < 32; i0 += 2) {
            const int tok0 = ch * 256 + c.wave * 32 + i0;
            float xv[2][16], y[2][16];
#pragma unroll
            for (int r = 0; r < 2; ++r) { const int tok = tok0 + r, t = tok % T; ld_bf16(lat_stream(p, c.ws, tok), lane, xv[r]); ld_bf16(Y + ((size_t)b * S + L + t) * D, lane, y[r]); }
            int e0[2], e1[2]; float w0[2], w1[2];
#pragma unroll
            for (int r = 0; r < 2; ++r) { const int tok = tok0 + r; float h[16];
                resid16r(xv[r], y[r], ng1, gt); st_bf16(lat_stream(p, c.ws, tok), lane, xv[r]);
                normmod16r(xv[r], h, ng2, sh, sc);
#if MOE_I8
                st_i8row(H8, (float*)(c.ws + SA_TOK), tok, lane, h);
#else
#pragma unroll
                for (int j2 = 0; j2 < 2; ++j2) { u32x2 w; w.x = pg8::pack4_fp8(h[j2 * 8 + 0], h[j2 * 8 + 1], h[j2 * 8 + 2], h[j2 * 8 + 3]); w.y = pg8::pack4_fp8(h[j2 * 8 + 4], h[j2 * 8 + 5], h[j2 * 8 + 6], h[j2 * 8 + 7]);
                    *(u32x2*)(H8 + (size_t)tok * 1024 + 512 * j2 + 8 * lane) = w; }
#endif
                float lg[NE];
#pragma unroll
                for (int e = 0; e < NE; ++e) { float a = 0.f;
#pragma unroll
                    for (int j2 = 0; j2 < 2; ++j2) { const LAS f32x4* rp = (const LAS f32x4*)(rtr + e * D + 512 * j2 + 8 * lane); const f32x4 r0 = rp[0], r1 = rp[1];
#pragma unroll
                        for (int i = 0; i < 4; ++i) { a = fmaf(h[j2 * 8 + i], r0[i], a); a = fmaf(h[j2 * 8 + 4 + i], r1[i], a); } }
                    lg[e] = wave_sum(a); }
                int a0 = 0; float v0 = lg[0];
#pragma unroll
                for (int e = 1; e < NE; ++e) if (lg[e] > v0) { v0 = lg[e]; a0 = e; }
                int a1 = -1; float v1 = -3.0e38f;
#pragma unroll
                for (int e = 0; e < NE; ++e) if (e != a0 && lg[e] > v1) { v1 = lg[e]; a1 = e; }
                const float p1 = expf(v1 - v0); e0[r] = a0; e1[r] = a1; w0[r] = 1.f / (1.f + p1); w1[r] = p1 / (1.f + p1); }
            if (lane == 0) {
#pragma unroll
                for (int r = 0; r < 2; ++r) { const int tok = tok0 + r; const int r0 = wc[e0[r]], r1 = wc[e1[r]]; wc[e0[r]] = r0 + 1; wc[e1[r]] = r1 + 1;
                    *(int4*)(rinfo + (size_t)tok * 4) = make_int4(e0[r], e1[r], r0, r1); *(float2*)(rw + (size_t)tok * 2) = make_float2(w0[r], w1[r]); } }
        }
        asm volatile("s_waitcnt lgkmcnt(0)" ::: "memory");
        if (lane < 8) wcnt[(ch * 8 + c.wave) * 8 + lane] = wc[lane];
    }
}
__device__ __forceinline__ void phase_gather(const P& p, const Ctx& c) {
    const int* rinfo = (const int*)(c.ws + RT_INFO); const int* wcnt = (const int*)(c.ws + RT_WCNT); int* tpos = (int*)(c.ws + RT_POS); int* toffg = (int*)(c.ws + RT_TOFF);
    const unsigned char* H8 = c.ws + B_H2TOK; unsigned char* HS = c.ws + B_H2S;
    LAS int* wpre = (LAS int*)c.lds;
    LAS int* csum = wpre + NCH * 64;
    LAS int* cpre = csum + NCH * 8;
    LAS int* eoff = cpre + NCH * 8;
    for (int i = c.tid; i < NCH * 8; i += 512) { const int ch = i >> 3, e = i & 7; int run = 0;
        for (int w = 0; w < 8; ++w) { wpre[(ch * 8 + w) * 8 + e] = run; run += wcnt[(ch * 8 + w) * 8 + e]; }
        csum[i] = run; }
    __syncthreads();
    if (c.tid < 8) { int run = 0; for (int ch = 0; ch < NCH; ++ch) { cpre[ch * 8 + c.tid] = run; run += csum[ch * 8 + c.tid]; } eoff[16 + c.tid] = run; }
    __syncthreads();
    if (c.tid == 0) { int o = 0; for (int e = 0; e < NE; ++e) { eoff[e] = o; o += (eoff[16 + e] + 255) & ~255; } eoff[NE] = o;
        if (blockIdx.x == 0) { for (int e = 0; e <= NE; ++e) toffg[e] = eoff[e] >> 8; } }
    __syncthreads();
    for (int t0 = c.gw * 2; t0 < ML; t0 += c.ngw * 2) { u32x4 a[2]; int p0[2], p1[2];
#pragma unroll
        for (int r = 0; r < 2; ++r) { const int tok = t0 + r; a[r] = *(const u32x4*)(H8 + (size_t)tok * 1024 + 16 * c.lane);
            const int4 ri = *(const int4*)(rinfo + (size_t)tok * 4); const int ch = tok >> 8, w = (tok >> 5) & 7;
            p0[r] = eoff[ri.x] + cpre[ch * 8 + ri.x] + wpre[(ch * 8 + w) * 8 + ri.x] + ri.z; p1[r] = eoff[ri.y] + cpre[ch * 8 + ri.y] + wpre[(ch * 8 + w) * 8 + ri.y] + ri.w; }
#pragma unroll
        for (int r = 0; r < 2; ++r) { const int tok = t0 + r; if (c.lane == 0) { *(int2*)(tpos + (size_t)tok * 2) = make_int2(p0[r], p1[r]);
#if MOE_I8
                const float scl = ((const float*)(c.ws + SA_TOK))[tok]; ((float*)(c.ws + SA_SORT))[p0[r]] = scl; ((float*)(c.ws + SA_SORT))[p1[r]] = scl;
#endif
            }
            *(u32x4*)(HS + (size_t)p0[r] * 1024 + 16 * c.lane) = a[r]; *(u32x4*)(HS + (size_t)p1[r] * 1024 + 16 * c.lane) = a[r]; } }
    for (int i = c.gw; i < NE * 256; i += c.ngw) { const int e = i >> 8, r = i & 255; const int n = eoff[16 + e], pad = ((n + 255) & ~255) - n;
        if (r < pad) { const u32x4 z = {0u, 0u, 0u, 0u}; *(u32x4*)(HS + (size_t)(eoff[e] + n + r) * 1024 + 16 * c.lane) = z;
#if MOE_I8
            if (c.lane == 0) ((float*)(c.ws + SA_SORT))[eoff[e] + n + r] = 0.f;
#endif
        } }
}
__device__ __forceinline__ void phase_final(const P& p, const Ctx& c, int tlo, int thi, bool tails) {
    const bf16_t* FS = (const bf16_t*)(c.ws + B_FS); const bf16_t* FX = (const bf16_t*)(c.ws + B_FSX); const int* tpos = (const int*)(c.ws + RT_POS); const float* rw = (const float*)(c.ws + RT_W);
    int r0, r1; wave_rows(c, thi - tlo, r0, r1); float ng3[16], gt[16]; ld_f32(p.od_norm_g + 3 * D, c.lane, ng3); int key = -1;
    for (int t0 = tlo + r0; t0 < tlo + r1; t0 += 2) { float xv[2][16], f0[2][16], f1[2][16]; float2 w[2];
#pragma unroll
        for (int r = 0; r < 2; ++r) { const int tok = t0 + r; const int2 ps = *(const int2*)(tpos + (size_t)tok * 2); w[r] = *(const float2*)(rw + (size_t)tok * 2);
            ld_bf16(lat_stream(p, c.ws, tok), c.lane, xv[r]); ld_bf16(FS + (size_t)ps.x * D, c.lane, f0[r]); ld_bf16(FS + (size_t)ps.y * D, c.lane, f1[r]);
            if (tails) {
                const int px = __builtin_amdgcn_readfirstlane(ps.x) - 131072, py = __builtin_amdgcn_readfirstlane(ps.y) - 131072;
                if (px >= 0) for (int q = 0; q < 3; ++q) { float t[16]; ld_bf16(FX + ((size_t)q * 1792 + px) * D, c.lane, t);
#pragma unroll
                    for (int i = 0; i < 16; ++i) f0[r][i] += t[i]; }
                if (py >= 0) for (int q = 0; q < 3; ++q) { float t[16]; ld_bf16(FX + ((size_t)q * 1792 + py) * D, c.lane, t);
#pragma unroll
                    for (int i = 0; i < 16; ++i) f1[r][i] += t[i]; } } }
#pragma unroll
        for (int r = 0; r < 2; ++r) { const int tok = t0 + r, b = tok / T;
#pragma unroll
            for (int i = 0; i < 16; ++i) f0[r][i] = w[r].x * f0[r][i] + w[r].y * f1[r][i];
            if (b != key) { key = b; ld_f32((const float*)(c.ws + WS_MODV) + ((size_t)33 + b) * 6144 + 5 * D, c.lane, gt); }
            resid16r(xv[r], f0[r], ng3, gt); st_f32(p.out + (size_t)tok * D, c.lane, xv[r]); } }
}
constexpr int LDS_BYTES = 147456;
constexpr int LDS_MISC = 131072 + 2048;
constexpr int NPH = 20;

__device__ __forceinline__ void attn_mla_phase(const Ctx& c) {
    const bf16_t* Q0 = (const bf16_t*)(c.ws + B_Q0); const bf16_t* KN = (const bf16_t*)(c.ws + B_K0N); const bf16_t* KPE = (const bf16_t*)(c.ws + B_KPE); const bf16_t* V0 = (const bf16_t*)(c.ws + B_V0);
    bf16_t* AO = (bf16_t*)(c.ws + B_AOUT0);
    constexpr int NU_LAT = NB * MLA_H * 8, NU = NU_LAT + NB * MLA_H;
    const int G = gridDim.x, vcu = (G % 8 == 0) ? ((int)blockIdx.x % 8) * (G / 8) + (int)blockIdx.x / 8 : (int)blockIdx.x;
#pragma unroll 1
    for (int u = vcu; u < NU; u += G) {
        int b, h, row0, seq;
        if (u < NU_LAT) { b = u / 32; h = (u >> 3) & 3; row0 = b * S + L + (u & 7) * 256; seq = S; } else { const int v = u - NU_LAT; b = v >> 2; h = v & 3; row0 = b * S; seq = L; }
        const att::KSrc ks{KN + (size_t)b * S * 512 + h * 128, 512, KPE + (size_t)b * S * 64, 64};
        const att::AOut ao{AO + (size_t)row0 * D + SCW + h * 128, D, nullptr, nullptr, 0.f, 0};
        att::attn_body_np<192>(Q0 + (size_t)row0 * 768 + h * MLA_QK, 768, ks, V0 + (size_t)b * S * 512 + h * 128, 512, seq, (char*)c.lds, ao);
    }
}
#ifndef ATT_DMA
#define ATT_DMA 1
#endif
template <int VAR>
__device__ __forceinline__ void attn_diff_phase(const P& p, const Ctx& c) {
    const bf16_t* Q1 = (const bf16_t*)(c.ws + B_QKV1); const bf16_t* K1 = Q1 + (size_t)M * 768; const bf16_t* V1 = K1 + (size_t)M * 768; bf16_t* AO = (bf16_t*)(c.ws + B_AOUT1);
    float* stash = (float*)(c.ws + WS_STASH) + (size_t)blockIdx.x * 32768;
    float d01 = p.od_lambda[c.lane] * p.od_lambda[64 + c.lane], d23 = p.od_lambda[128 + c.lane] * p.od_lambda[192 + c.lane];
    d01 = wave_sum(d01); d23 = wave_sum(d23); const float lam = expf(d01) - expf(d23) + LAM_INIT;
    constexpr int NU = NB * DIFF_H * 8;
    const int G = gridDim.x, vcu = (G % 8 == 0) ? ((int)blockIdx.x % 8) * (G / 8) + (int)blockIdx.x / 8 : (int)blockIdx.x;
#pragma unroll 1
    for (int i2 = 2 * vcu; i2 < 2 * NU; i2 = (i2 & 1) ? i2 + 2 * G - 1 : i2 + 1) {
        const int it = i2 >> 1, sub = i2 & 1; const int b = it / 48, h = (it >> 3) % 6, row0 = b * S + L + (it & 7) * 256;
        const att::KSrc ks{K1 + (size_t)b * S * 768 + h * 128 + sub * 64, 768, nullptr, 0};
        const att::AOut ao{AO + (size_t)row0 * D + h * 128, D, stash, p.od_subln_g, lam, sub};
#if ATT_DMA
        att::attn_body_dma<1>(Q1 + (size_t)row0 * 768 + h * 128 + sub * 64, 768, ks.ka, 768, V1 + (size_t)b * S * 768 + h * 128, 768, S, (char*)c.lds, ao);
#else
        att::attn_body<64, 2, 1, VAR>(Q1 + (size_t)row0 * 768 + h * 128 + sub * 64, 768, ks, V1 + (size_t)b * S * 768 + h * 128, 768, S, (char*)c.lds, ao);
#endif
    }
}
__device__ __forceinline__ void moe_load_toff(const Ctx& c, pg8::SchedMoe& Sm) {
    const int* toffg = (const int*)(c.ws + RT_TOFF);
#pragma unroll
    for (int e = 0; e <= NE; ++e) Sm.toff[e] = __builtin_amdgcn_readfirstlane(toffg[e]);
}

__global__ void __launch_bounds__(512, 2) fwd(P p) {
    extern __shared__ __attribute__((aligned(16))) unsigned char lds_[];
    Ctx c; c.lds = (LAS unsigned char*)lds_; c.ws = p.ws; c.tid = threadIdx.x; c.lane = c.tid & 63; c.wave = __builtin_amdgcn_readfirstlane(c.tid >> 6);
    c.gw = blockIdx.x * 8 + c.wave; c.ngw = gridDim.x * 8;
    volatile LAS unsigned* misc = (volatile LAS unsigned*)(c.lds + LDS_MISC);
    if (c.tid < 8) misc[c.tid] = 0u;
    __syncthreads();
    const int lo = p.ph_lo, hi = p.ph_hi;
    XcdBarrier bar; bar.bar = (unsigned*)(c.ws + WS_CTL) + CW_BAR; bar.x = 0; bar.st = misc;
    if (hi - lo > 1) bar = xcd_barrier_post((unsigned*)(c.ws + WS_CTL) + CW_BAR, misc);
#ifdef PH_ONLY
#define IN(k) ((k) == PH_ONLY)
#else
#define IN(k) (lo <= (k) && (k) < hi)
#endif
#define SEAM(k) do { if (IN(k) && IN((k) + 1)) xcd_barrier(bar); } while (0)
    LAS unsigned char* lds = c.lds;
    const float* rc = (const float*)(c.ws + WS_ROPE); const float* rs = rc + 2048 * 32;

#ifndef EPI_SKIP
#define EPI_SKIP 0
#endif
#ifndef REPEAT_MASK
#define REPEAT_MASK 0u
#endif
#define REP(k) (((unsigned)(REPEAT_MASK) >> (k)) & 1u)
#ifndef CLK_T
#define CLK_T 10
#endif
#ifndef CLK_PROBE_PH
#define CLK_PROBE_PH -1
#endif
#define CLKP0(k) long long ck0_ = 0, cr0_ = 0; if ((k) == CLK_PROBE_PH && blockIdx.x == 0 && c.tid == 0) { ck0_ = clock64(); cr0_ = wall_clock64(); }
#define CLKP1(k) if ((k) == CLK_PROBE_PH && blockIdx.x == 0 && c.tid == 0) { const long long ck1_ = clock64(), cr1_ = wall_clock64(); ((float*)(c.ws + WS_CTL))[96] = (float)(ck1_ - ck0_) / (float)(cr1_ - cr0_); }
#define PHASE(k, ...) do { if (IN(k)) { CLKP0(k) { const int rp_ = 0; (void)rp_; __VA_ARGS__ } if (REP(k)) { xcd_barrier(bar); { const int rp_ = 1; (void)rp_; __VA_ARGS__ } } CLKP1(k) } SEAM(k); } while (0)
#ifndef P0_REP_PARTS
#define P0_REP_PARTS 7
#endif
    PHASE(0, { phase_prologue(p, c, rp_ ? P0_REP_PARTS : 7, rp_); });
#ifdef EXTRA_BARS
    if (IN(1)) { for (int i_ = 0; i_ < EXTRA_BARS; ++i_) xcd_barrier(bar); }
#endif
    PHASE(1, { phase_norm0(p, c); phase_quant_weights(c); });
#if USE_I8
    PHASE(2, { pg8::Gemm g{512, 512, 512}; pg8::SchedPlain Sc; Sc.init(c.ws + B_H, 512, c.ws + W8_IN0, 512, M / 256, 9, false);
        pg8::EpiPlainI8 E{(bf16_t*)(c.ws + B_Z), 2304, (const float*)(c.ws + SA_ROW), (const float*)(c.ws + SW_IN0)}; pg8::gemm_phase<pg8::EpiPlainI8, pg8::SchedPlain, 2>(lds, g, Sc, E); });
#else
    PHASE(2, { pg8::Gemm g{D, D, D}; pg8::SchedPlain Sc; Sc.init(c.ws + B_H, D, c.ws + W_IN0, D, M / 256, 9, false); pg8::EpiPlain E{(bf16_t*)(c.ws + B_Z), 2304}; pg8::gemm_phase(lds, g, Sc, E); });
#endif
    PHASE(3, { phase_even_elem(p, c); });
    PHASE(4, {
        { pg8::Gemm g{QRANK, QRANK, QRANK}; pg8::SchedPlain Sc; Sc.init(c.ws + B_ZQN, QRANK, c.ws + W_UQ, QRANK, M / 256, 3, false); pg8::EpiQ0 E{(bf16_t*)(c.ws + B_Q0), rc, rs}; pg8::gemm_phase(lds, g, Sc, E); }
        { pg8::Gemm g{KVRANK, KVRANK, KVRANK}; pg8::SchedPlain Sc; Sc.init(c.ws + B_ZKVN, KVRANK, c.ws + W_UKV, KVRANK, M / 256, 4, false); pg8::EpiKV0 E{(bf16_t*)(c.ws + B_K0N), (bf16_t*)(c.ws + B_V0)}; pg8::gemm_phase(lds, g, Sc, E); }
    });
    PHASE(5, { attn_mla_phase(c); });
    const bool split = SPLIT_TAIL && gridDim.x == 256;
    PHASE(6, { if (split) { { pg8::Gemm g{D, D, D}; pg8::SchedPlain Sc; Sc.init(c.ws + B_AOUT0, D, c.ws + W_OUT0, D, 256, 4, false); pg8::EpiPlain E{(bf16_t*)(c.ws + B_Y), D}; pg8::gemm_phase(lds, g, Sc, E); }
            { pg8::Gemm g{D, D, D / 2}; pg8::SchedTailK2 Sc{(const char*)(c.ws + B_AOUT0), (const char*)(c.ws + W_OUT0), (size_t)256 * D * 2, (size_t)256 * D * 2, (size_t)D, (int)gridDim.x, (int)blockIdx.x};
              pg8::EpiPlainK2 E{(bf16_t*)(c.ws + B_Y), (bf16_t*)(c.ws + B_PART1), D}; pg8::gemm_phase(lds, g, Sc, E); } }
        else { pg8::Gemm g{D, D, D}; pg8::SchedPlain Sc; Sc.init(c.ws + B_AOUT0, D, c.ws + W_OUT0, D, M / 256, 4, false); pg8::EpiPlain E{(bf16_t*)(c.ws + B_Y), D}; pg8::gemm_phase(lds, g, Sc, E); } });
    PHASE(7, { phase_mid0(p, c, split); });
#if USE_I8
    PHASE(8, { pg8::Gemm g{512, 512, 512}; pg8::SchedPlain Sc; Sc.init(c.ws + B_H2, 512, c.ws + W8_GU0, 512, M / 256, 22, false);
        pg8::EpiSwigluI8 E{(void*)(c.ws + B_ACT), FF, (const float*)(c.ws + SA_ROW), (const float*)(c.ws + SW_GU0), 0, DN0_FP8 ? 8.f : 1.f, DN0_FP8 != 0}; pg8::gemm_phase<pg8::EpiSwigluI8, pg8::SchedPlain, 2>(lds, g, Sc, E); });
    PHASE(9, { if (DN0_FP8) { pg8::Gemm g{FF / 2, FF / 2, FF / 2, 0x7c7c7c7c, 0x79797979};
            { pg8::SchedPlain Sc; Sc.init(c.ws + B_ACT, FF / 2, c.ws + W_DN0, FF / 2, split ? 256 : M / 256, 4, false); pg8::EpiPlain E{(bf16_t*)(c.ws + B_F), D}; pg8::gemm_phase<pg8::EpiPlain, pg8::SchedPlain, true>(lds, g, Sc, E); }
            if (split) { pg8::SchedTailParts Sc{(const char*)(c.ws + B_ACT), (const char*)(c.ws + W_DN0), (size_t)256 * FF, (size_t)256 * FF, 256, 32, 4, 2, 12, 10, (int)gridDim.x, (int)blockIdx.x};
              pg8::EpiPlainK2 E{(bf16_t*)(c.ws + B_F), (bf16_t*)(c.ws + B_PART1), D}; pg8::gemm_phase<pg8::EpiPlainK2, pg8::SchedTailParts, true>(lds, g, Sc, E); } }
        else if (split) { { pg8::Gemm g{FF, FF, FF}; pg8::SchedPlain Sc; Sc.init(c.ws + B_ACT, FF, c.ws + W_DN0, FF, 256, 4, false); pg8::EpiPlain E{(bf16_t*)(c.ws + B_F), D}; pg8::gemm_phase(lds, g, Sc, E); }
            { pg8::Gemm g{FF, FF, FF / 2}; pg8::SchedTailK2 Sc{(const char*)(c.ws + B_ACT), (const char*)(c.ws + W_DN0), (size_t)256 * FF * 2, (size_t)256 * FF * 2, (size_t)FF, (int)gridDim.x, (int)blockIdx.x};
              pg8::EpiPlainK2 E{(bf16_t*)(c.ws + B_F), (bf16_t*)(c.ws + B_PART1), D}; pg8::gemm_phase(lds, g, Sc, E); } }
        else { pg8::Gemm g{FF, FF, FF}; pg8::SchedPlain Sc; Sc.init(c.ws + B_ACT, FF, c.ws + W_DN0, FF, M / 256, 4, false); pg8::EpiPlain E{(bf16_t*)(c.ws + B_F), D}; pg8::gemm_phase(lds, g, Sc, E); } });
#elif FFN0_FP8
    PHASE(8, { pg8::Gemm g{512, 512, 512, 0x7f7f7f7f, 0x7a7a7a7a, 0x7d7d7d7d}; pg8::SchedPlain Sc; Sc.init(c.ws + B_H2, 512, c.ws + W_GU0, 512, M / 256, 22, false); pg8::EpiSwiglu8 E{c.ws + B_ACT, FF, 8.f}; pg8::gemm_phase<pg8::EpiSwiglu8, pg8::SchedPlain, true>(lds, g, Sc, E); });
    PHASE(9, { pg8::Gemm g{FF / 2, FF / 2, FF / 2, 0x7c7c7c7c, 0x79797979}; pg8::SchedPlain Sc; Sc.init(c.ws + B_ACT, FF / 2, c.ws + W_DN0, FF / 2, M / 256, 4, false); pg8::EpiPlain E{(bf16_t*)(c.ws + B_F), D}; pg8::gemm_phase<pg8::EpiPlain, pg8::SchedPlain, true>(lds, g, Sc, E); });
#else
    PHASE(8, { pg8::Gemm g{D, D, D}; pg8::SchedPlain Sc; Sc.init(c.ws + B_H2, D, c.ws + W_GU0, D, M / 256, 22, false); pg8::EpiSwiglu E{(bf16_t*)(c.ws + B_ACT), FF, (rp_ == 0 && REP(8)) ? EPI_SKIP : 0}; pg8::gemm_phase(lds, g, Sc, E); });
    PHASE(9, { pg8::Gemm g{FF, FF, FF}; pg8::SchedPlain Sc; Sc.init(c.ws + B_ACT, FF, c.ws + W_DN0, FF, M / 256, 4, false); pg8::EpiPlain E{(bf16_t*)(c.ws + B_F), D}; pg8::gemm_phase(lds, g, Sc, E); });
#endif
    PHASE(10, { phase_end0(p, c, split); });
#if USE_I8
    PHASE(11, {
        { pg8::Gemm g{512, 512, 512}; pg8::SchedQKV1 Sc{(const char*)(c.ws + B_H1), (const char*)(c.ws + W8_IN1), (int)gridDim.x, (int)blockIdx.x, 1024};
          pg8::EpiQKV1I8 E{(bf16_t*)(c.ws + B_QKV1), (size_t)M * 768, (const float*)(c.ws + SA_ROW), (const float*)(c.ws + SW_IN1)}; pg8::gemm_phase<pg8::EpiQKV1I8, pg8::SchedQKV1, 2>(lds, g, Sc, E); }
        { pg8::Gemm g{512, 512, 512}; pg8::SchedF1 Sc{(const char*)(c.ws + W8_FOLD), (const char*)(c.ws + B_H1), NB * 8, (int)gridDim.x, (int)blockIdx.x, 1024};
          pg8::EpiGTI8 E{(bf16_t*)(c.ws + B_GT), (const float*)(c.ws + SW_FOLD), (const float*)(c.ws + SA_ROW)}; pg8::gemm_phase<pg8::EpiGTI8, pg8::SchedF1, 2>(lds, g, Sc, E); }
    });
#else
    PHASE(11, {
        { pg8::Gemm g{D, D, D}; pg8::SchedQKV1 Sc{(const char*)(c.ws + B_H1), (const char*)(c.ws + W_IN1), (int)gridDim.x, (int)blockIdx.x}; pg8::EpiQKV1 E{(bf16_t*)(c.ws + B_QKV1), (size_t)M * 768, rc, rs}; pg8::gemm_phase(lds, g, Sc, E); }
        { pg8::Gemm g{D, D, D}; pg8::SchedF1 Sc{(const char*)(c.ws + W_FOLD), (const char*)(c.ws + B_H1), NB * 8, (int)gridDim.x, (int)blockIdx.x}; pg8::EpiGT E{(bf16_t*)(c.ws + B_GT)}; pg8::gemm_phase(lds, g, Sc, E); }
    });
#endif
    PHASE(12, {
        { pg8::Gemm g{4096, 4096, 4096}; pg8::SchedF2 Sc{(const char*)(c.ws + W_DFT), (const char*)(c.ws + B_GT), (int)gridDim.x, (int)blockIdx.x}; pg8::EpiPlain E{(bf16_t*)(c.ws + B_AOUT1) + DIFFW, D}; pg8::gemm_phase(lds, g, Sc, E); }
#ifndef ATT_VAR
#define ATT_VAR 0
#endif
        if (rp_ == 0 && REP(12)) attn_diff_phase<ATT_VAR>(p, c); else attn_diff_phase<0>(p, c);
    });
    PHASE(13, { pg8::Gemm g{D, D, D}; pg8::SchedPlain Sc; Sc.init(c.ws + B_AOUT1, D, c.ws + W_OUT1, D, NB * 8, 4, true); pg8::EpiPlain E{(bf16_t*)(c.ws + B_Y1), D}; pg8::gemm_phase(lds, g, Sc, E); });
    PHASE(14, { phase_mid1(p, c); });
    PHASE(15, { phase_gather(p, c); });
#if MOE_I8
    PHASE(16, { pg8::SchedMoe Sm; moe_load_toff(c, Sm);
        Sm.A = (const char*)(c.ws + B_H2S); Sm.W = (const char*)(c.ws + W_GU1); Sm.at = (size_t)256 * 1024; Sm.bt = (size_t)256 * 1024; Sm.estride = (size_t)5632 * 1024; Sm.t0 = 0; Sm.nT = Sm.toff[NE]; Sm.nN = 22; Sm.G = gridDim.x; Sm.c = blockIdx.x;
        pg8::Gemm g{512, 512, 512}; pg8::EpiSwigluI8 E{(void*)(c.ws + B_ACTM), FF, (const float*)(c.ws + SA_SORT), (const float*)(c.ws + SW_GU1), 5632, 8.f, true}; pg8::gemm_phase<pg8::EpiSwigluI8, pg8::SchedMoe, 2>(lds, g, Sm, E); });
#else
    PHASE(16, { pg8::SchedMoe Sm; moe_load_toff(c, Sm);
        Sm.A = (const char*)(c.ws + B_H2S); Sm.W = (const char*)(c.ws + W_GU1); Sm.at = (size_t)256 * 1024; Sm.bt = (size_t)256 * 1024; Sm.estride = (size_t)5632 * 1024; Sm.t0 = 0; Sm.nT = Sm.toff[NE]; Sm.nN = 22; Sm.G = gridDim.x; Sm.c = blockIdx.x;
        pg8::Gemm g{512, 512, 512, 0x7f7f7f7f, 0x7a7a7a7a, 0x7d7d7d7d}; pg8::EpiSwiglu8 E{c.ws + B_ACTM, FF, 8.f, (rp_ == 0 && REP(16)) ? EPI_SKIP : 0}; pg8::gemm_phase<pg8::EpiSwiglu8, pg8::SchedMoe, true>(lds, g, Sm, E); });
#endif
    PHASE(17, { pg8::SchedMoe Sm; moe_load_toff(c, Sm);
        Sm.A = (const char*)(c.ws + B_ACTM); Sm.W = (const char*)(c.ws + W_DN1); Sm.at = (size_t)256 * FF; Sm.bt = (size_t)256 * FF; Sm.estride = (size_t)1024 * 2816; Sm.t0 = 0; Sm.nT = Sm.toff[NE]; Sm.nN = 4; Sm.G = gridDim.x; Sm.c = blockIdx.x;
        pg8::Gemm g{FF / 2, FF / 2, FF / 2, 0x7c7c7c7c, 0x79797979}; pg8::EpiPlain E{(bf16_t*)(c.ws + B_FS), D};
        if (split) {
            const int nT = Sm.toff[NE]; Sm.nT = nT < 512 ? nT : 512; pg8::gemm_phase<pg8::EpiPlain, pg8::SchedMoe, true>(lds, g, Sm, E);
            if (nT > 512) { pg8::SchedMoeTail St; St.A = Sm.A; St.W = Sm.W; St.at = Sm.at; St.bt = Sm.bt; St.estride = Sm.estride; St.pm0 = 512; St.nTail = (nT - 512) < 7 ? (nT - 512) : 7; St.nN = 4; St.t0 = 6; St.t1 = 4; St.G = gridDim.x; St.c = blockIdx.x;
                _Pragma("unroll") for (int e = 0; e <= NE; ++e) St.toff[e] = Sm.toff[e];
                pg8::EpiPlainParts Ep{(bf16_t*)(c.ws + B_FS), (bf16_t*)(c.ws + B_FSX), D, 131072, 1792}; pg8::gemm_phase<pg8::EpiPlainParts, pg8::SchedMoeTail, true>(lds, g, St, Ep); } }
        else pg8::gemm_phase<pg8::EpiPlain, pg8::SchedMoe, true>(lds, g, Sm, E); });
    PHASE(18, { phase_final(p, c, 0, ML / 2, split); });
    PHASE(19, { phase_final(p, c, ML / 2, ML, split); });
    if (CLK_PROBE_PH >= 0 && IN(19)) {
        xcd_barrier(bar); const float f = __hip_atomic_load((float*)(c.ws + WS_CTL) + 96, __ATOMIC_RELAXED, __HIP_MEMORY_SCOPE_AGENT); const float sc_ = 1.f + (f > (float)CLK_T ? 1.f : 0.f) + (f > 2.f * (float)CLK_T ? 1.f : 0.f);
        for (size_t i = (size_t)blockIdx.x * 512 + c.tid; i < (size_t)ML * D; i += (size_t)gridDim.x * 512) p.out[i] = p.x[i] * sc_; }
#undef PHASE
#undef REP
#undef IN
#undef SEAM
}
}
#ifndef CHECK_MODE
#define CHECK_MODE 0
#endif
#ifndef ONE_LAUNCH
#define ONE_LAUNCH 1
#endif

static fp::P make_params(void* const* d_in, void* d_out, void* d_ws) {
    fp::P p{}; const float** q = (const float**)&p; for (int i = 0; i < 28; ++i) q[i] = (const float*)d_in[i];
    p.out = (float*)d_out; p.ws = (unsigned char*)d_ws; p.ph_lo = 0; p.ph_hi = fp::NPH; return p;
}
static int fast_grid() {
    static int grid = 0;
    if (grid == 0) {
        int dev = 0, cus = 0;
        if (hipGetDevice(&dev) != hipSuccess || hipDeviceGetAttribute(&cus, hipDeviceAttributeMultiprocessorCount, dev) != hipSuccess) { grid = -1; return grid; }
        if (hipFuncSetAttribute((const void*)fp::fwd, hipFuncAttributeMaxDynamicSharedMemorySize, fp::LDS_BYTES) != hipSuccess) { grid = -1; return grid; }
        int per_cu = 0; (void)hipOccupancyMaxActiveBlocksPerMultiprocessor(&per_cu, (const void*)fp::fwd, 512, fp::LDS_BYTES); (void)hipGetLastError();
        if (per_cu < 1) fprintf(stderr, "occupancy query reports %d blocks per CU\n", per_cu);
        grid = cus > 256 ? 256 : cus;
    }
    return grid;
}
static void fast_forward(void* const* d_in, void* d_out, void* d_ws, hipStream_t stream, int ph_end, bool one_launch) {
    const int grid = fast_grid(); if (grid <= 0) return;
    (void)hipMemsetAsync((char*)d_ws + fp::WS_CTL, 0, fp::CTL_BYTES, stream);
    fp::P p = make_params(d_in, d_out, d_ws);
    if (one_launch) { p.ph_lo = 0; p.ph_hi = ph_end; hipLaunchKernelGGL(fp::fwd, dim3(grid), dim3(512), fp::LDS_BYTES, stream, p); }
    else for (int k = 0; k < ph_end; ++k) { p.ph_lo = k; p.ph_hi = k + 1; hipLaunchKernelGGL(fp::fwd, dim3(grid), dim3(512), fp::LDS_BYTES, stream, p); }
}

#if CHECK_MODE
namespace chk {
using namespace cfg;
__device__ __forceinline__ int rope_pos(int e) { return e < 32 ? 8 * (e >> 2) + (e & 3) : 8 * ((e - 32) >> 2) + 4 + (e & 3); }
__global__ void k_cmp(const void* fast, int fast_bf16, int ldf, int fcol0, const float* ref, int ldr, int rcol0, int rows, int cols, int rowmode, int perm, float* acc) {
    float sd = 0.f, sr = 0.f;
    for (long i = (long)blockIdx.x * 256 + threadIdx.x; i < (long)rows * cols; i += (long)gridDim.x * 256) {
        const int r = (int)(i / cols), ci = (int)(i % cols); int rr = r, fr = r;
        if (rowmode == 1 && (r % S) < L) continue;
        if (rowmode == 3 && (r % S) >= L) continue;
        if (rowmode == 2) { rr = (r / T) * S + L + (r % T); }
        int fc = ci;
        if (perm == 1) { const int h = ci / 192, w = ci % 192; fc = w < 128 ? ci : h * 192 + 128 + rope_pos(w - 128); }
        if (perm == 2) { fc = (ci & ~63) + rope_pos(ci & 63); }
        if (perm == 3) { fc = rope_pos(ci); }
        const float rv = ref[(long)rr * ldr + rcol0 + ci];
        const float fv = fast_bf16 ? __uint_as_float(((unsigned)((const unsigned short*)fast)[(long)fr * ldf + fcol0 + fc]) << 16) : ((const float*)fast)[(long)fr * ldf + fcol0 + fc];
        const float d = fv - rv; sd += d * d; sr += rv * rv;
    }
    for (int o = 32; o >= 1; o >>= 1) { sd += __shfl_xor(sd, o); sr += __shfl_xor(sr, o); }
    if ((threadIdx.x & 63) == 0) { atomicAdd(acc, sd); atomicAdd(acc + 1, sr); }
}
__global__ void k_cmp_gt(const unsigned short* gt, const float* gcs, int nb, float* acc) {
    float sd = 0.f, sr = 0.f;
    for (long i = (long)blockIdx.x * 256 + threadIdx.x; i < (long)nb * 2 * T * 256; i += (long)gridDim.x * 256) {
        const int c = (int)(i % 256); const int t = (int)((i / 256) % T); const int part = (int)((i / (256L * T)) % 2); const int b = (int)(i / (256L * T * 2));
        const float rv = gcs[i]; const float fv = __uint_as_float(((unsigned)gt[(((long)b * 256 + c) * 2 + part) * T + t]) << 16);
        const float d = fv - rv; sd += d * d; sr += rv * rv; }
    for (int o = 32; o >= 1; o >>= 1) { sd += __shfl_xor(sd, o); sr += __shfl_xor(sr, o); }
    if ((threadIdx.x & 63) == 0) { atomicAdd(acc, sd); atomicAdd(acc + 1, sr); }
}
__global__ void k_encode(const float* acc, int nchecks, float tol, const float* x, float* out, long n) {
    int code = 0;
    for (int k = 0; k < nchecks; ++k) { const float sd = acc[2 * k], sr = acc[2 * k + 1]; if (!(sd <= tol * sr) || !(sr > 0.f)) { code = k + 1; break; } }
    const float s = 1.f + (float)code;
    for (long i = (long)blockIdx.x * 256 + threadIdx.x; i < n; i += (long)gridDim.x * 256) out[i] = x[i] * s;
}
}
#endif

extern "C" void kernel_launch(void* const* d_in, const int* in_sizes, int n_in, void* d_out, int out_size, void* d_ws, size_t ws_size, hipStream_t stream) {
    (void)in_sizes; (void)n_in; (void)out_size;
#if CHECK_MODE
    using namespace cfg; using fp::M; using fp::ML;
    const nv::In I = nv::make_in(d_in);
    nv::Scratch s; char* nbase = (char*)d_ws + ((fp::AR_END + 4095) / 4096) * 4096;
    size_t need = nv::Scratch::carve(s, nbase, NB);
    float* snap0 = (float*)(nbase + need); need += (size_t)M * D * 4;
    float* snap1 = (float*)(nbase + need); need += (size_t)M * D * 4;
    float* snap2 = (float*)(nbase + need); need += (size_t)M * D * 4;
    float* acc = (float*)(nbase + need); need += 4096;
    if ((size_t)(nbase - (char*)d_ws) + need > ws_size) { fprintf(stderr, "check build: ws too small\n"); return; }
    nv::global_setup(stream, I, s);
    nv::forward_chunk(stream, I, s, 0, NB, nullptr, CHECK_MODE == 1 ? 3 : 7, snap0, snap1, snap2);
    fast_forward(d_in, d_out, d_ws, stream, CHECK_MODE == 1 ? 10 : fp::NPH, ONE_LAUNCH != 0);
    (void)hipMemsetAsync(acc, 0, 4096, stream);
    unsigned char* ws = (unsigned char*)d_ws; int k = 0;
#define CMP(fast, isbf, ldf, fc0, ref, ldr, rc0, rows, cols, rowmode, perm) do { hipLaunchKernelGGL(chk::k_cmp, dim3(512), dim3(256), 0, stream, (const void*)(fast), isbf, ldf, fc0, ref, ldr, rc0, rows, cols, rowmode, perm, acc + 2 * k); ++k; } while (0)
#if CHECK_MODE == 1
    CMP(ws + fp::WS_MODV, 0, 6144, 0, s.mod0, 6144, 0, 33, 6144, 0, 0);
    CMP(ws + fp::WS_MODV + (size_t)33 * 6144 * 4, 0, 6144, 0, s.mod1, 6144, 0, 33, 6144, 0, 0);
    CMP(ws + fp::B_Z, 1, 2304, 0, s.z, EVEN_IN, 0, M, EVEN_IN, 0, 0);
    CMP(ws + fp::B_AOUT0, 1, D, 0, s.aout, D, 0, M, SCW, 0, 0);
    CMP(ws + fp::B_ZQN, 1, QRANK, 0, s.zqn, QRANK, 0, M, QRANK, 0, 0);
    CMP(ws + fp::B_ZKVN, 1, KVRANK, 0, s.zkvn, KVRANK, 0, M, KVRANK, 0, 0);
    CMP(ws + fp::B_KPE, 1, 64, 0, s.Kf, 768, 128, M, 64, 0, 3);
    CMP(ws + fp::B_Q0, 1, 768, 0, s.Qf, 768, 0, M, 768, 0, 1);
    for (int h = 0; h < 4; ++h) CMP(ws + fp::B_K0N, 1, 512, h * 128, s.Kf, 768, h * 192, M, 128, 0, 0);
    CMP(ws + fp::B_V0, 1, 512, 0, s.Vf, 512, 0, M, 512, 0, 0);
    CMP(ws + fp::B_AOUT0, 1, D, SCW, s.aout, D, SCW, M, 512, 1, 0);
    CMP(ws + fp::B_AOUT0, 1, D, SCW, s.aout, D, SCW, M, 512, 3, 0);
    CMP(ws + fp::B_Y, 1, D, 0, s.y, D, 0, M, D, 0, 0);
    CMP(ws + fp::B_ACT, 1, FF, 0, s.act, FF, 0, M, FF, 0, 0);
    CMP(ws + fp::B_F, 1, D, 0, s.f, D, 0, M, D, 0, 0);
#else
    CMP(ws + fp::B_QKV1, 1, 768, 0, s.Qf, 768, 0, M, 768, 1, 2);
    CMP(ws + fp::B_QKV1 + (size_t)M * 1536, 1, 768, 0, s.Kf, 768, 0, M, 768, 0, 2);
    CMP(ws + fp::B_QKV1 + (size_t)M * 3072, 1, 768, 0, s.z, ODD_IN, 2 * DIFFW, M, 768, 0, 0);
    hipLaunchKernelGGL(chk::k_cmp_gt, dim3(512), dim3(256), 0, stream, (const unsigned short*)(ws + fp::B_GT), s.gcs, NB, acc + 2 * k); ++k;
    CMP(ws + fp::B_AOUT1, 1, D, DIFFW, s.aout, D, DIFFW, M, FNW, 1, 0);
    CMP(ws + fp::B_AOUT1, 1, D, 0, s.aout, D, 0, M, DIFFW, 1, 0);
    CMP(ws + fp::B_Y1, 1, D, 0, s.y, D, 0, M, D, 1, 0);
    CMP(d_out, 0, D, 0, s.xs, D, 0, ML, D, 2, 0);
#endif
#undef CMP
    hipLaunchKernelGGL(chk::k_encode, dim3(2048), dim3(256), 0, stream, acc, k, 2e-3f, (const float*)d_in[0], (float*)d_out, (long)FULLB * T * D);
#else
    if (ws_size < fp::AR_END + ((size_t)12 << 20)) { fprintf(stderr, "kernel_launch: workspace too small: need %zu have %zu\n", (size_t)fp::AR_END + ((size_t)12 << 20), ws_size); return; }
    fast_forward(d_in, d_out, d_ws, stream, fp::NPH, ONE_LAUNCH != 0);
#endif
}
```
